# Optimizing an MI355X kernel written in HIP

```python
import jax, jax.numpy as jnp
from jax import lax
import numpy as np

D_MODEL = 1024
BATCH = 8
SEQ = 2048
DEPTH = 2

D_MIX = D_MODEL
ATTN_DIM = D_MIX // 2
CONV_DIM = D_MIX - ATTN_DIM
HEAD_DIM = 64
N_HEADS = ATTN_DIM // HEAD_DIM
CONV_WIDTH = 31
Q_BLOCK = 128
PLE_DIM = 256
D_IN = 4 * ATTN_DIM + 3 * CONV_DIM
EPS = 1e-6

kernel_name = "hymba_conformer_stickbreaking_ple"


def rms_norm(x, g):
    xf = x.astype(jnp.float32)
    y = xf * lax.rsqrt(jnp.mean(xf * xf, axis=-1, keepdims=True) + EPS)
    return (y * g.astype(jnp.float32)).astype(x.dtype)


def layer_norm(x, g, b):
    xf = x.astype(jnp.float32)
    mu = jnp.mean(xf, axis=-1, keepdims=True)
    xc = xf - mu
    y = xc * lax.rsqrt(jnp.mean(xc * xc, axis=-1, keepdims=True) + EPS)
    return (y * g.astype(jnp.float32) + b.astype(jnp.float32)).astype(x.dtype)


def stick_breaking_attention(q, k, v):
    S = q.shape[1]
    scale = HEAD_DIM ** -0.5
    outs = []
    for blk in range(S // Q_BLOCK):
        q0 = blk * Q_BLOCK
        kend = q0 + Q_BLOCK
        qb = q[:, q0:kend]
        kb = k[:, :kend]
        vb = v[:, :kend]
        z = jnp.einsum('bqhd,bkhd->bhqk', qb, kb).astype(jnp.float32) * scale
        qpos = q0 + jnp.arange(Q_BLOCK)[:, None]
        kpos = jnp.arange(kend)[None, :]
        causal = kpos < qpos
        log_1m_beta = jnp.where(causal, -jax.nn.softplus(z), 0.0)
        suffix = lax.cumsum(log_1m_beta, axis=3, reverse=True) - log_1m_beta
        log_a = jax.nn.log_sigmoid(z) + suffix
        a = jnp.where(causal, jnp.exp(log_a), 0.0)
        outs.append(jnp.einsum('bhqk,bkhd->bqhd', a.astype(v.dtype), vb))
    return jnp.concatenate(outs, axis=1)


def causal_depthwise_conv(x, w, b):
    rhs = w[:, None, :].astype(x.dtype)
    y = lax.conv_general_dilated(
        x, rhs, window_strides=(1,), padding=((CONV_WIDTH - 1, 0),),
        dimension_numbers=('NWC', 'WIO', 'NWC'), feature_group_count=x.shape[-1])
    return y + b.astype(x.dtype)


def setup_inputs(seed: int = 0) -> dict:
    key = jax.random.key(seed)
    ks = jax.random.split(key, 16)
    f32 = jnp.float32
    nrm = lambda k, shape, s: jax.random.normal(k, shape, f32) * s
    return {
        "x": nrm(ks[0], (BATCH, SEQ, D_MODEL), 1.0),
        "p": nrm(ks[1], (DEPTH, BATCH, SEQ, PLE_DIM), 1.0),
        "norm_g": 1.0 + nrm(ks[2], (DEPTH, D_MODEL), 0.02),
        "w_in": nrm(ks[3], (DEPTH, D_MODEL, D_IN), D_MODEL ** -0.5),
        "attn_out_g": 1.0 + nrm(ks[4], (DEPTH, HEAD_DIM), 0.02),
        "dw_w": nrm(ks[5], (DEPTH, CONV_WIDTH, CONV_DIM), CONV_WIDTH ** -0.5),
        "dw_b": nrm(ks[6], (DEPTH, CONV_DIM), 0.02),
        "conv_ln_g": 1.0 + nrm(ks[7], (DEPTH, CONV_DIM), 0.02),
        "conv_ln_b": nrm(ks[8], (DEPTH, CONV_DIM), 0.02),
        "w_pw": nrm(ks[9], (DEPTH, CONV_DIM, CONV_DIM), CONV_DIM ** -0.5),
        "conv_out_g": 1.0 + nrm(ks[10], (DEPTH, CONV_DIM), 0.02),
        "w_out": nrm(ks[11], (DEPTH, D_MIX, D_MODEL), D_MIX ** -0.5),
        "ple_norm_g": 1.0 + nrm(ks[12], (DEPTH, D_MODEL), 0.02),
        "w_ple_gate": nrm(ks[13], (DEPTH, D_MODEL, D_MODEL), D_MODEL ** -0.5),
        "w_ple": nrm(ks[14], (DEPTH, PLE_DIM, D_MODEL), PLE_DIM ** -0.5),
        "final_g": 1.0 + nrm(ks[15], (D_MODEL,), 0.02),
    }


def reference(x, p, norm_g, w_in, attn_out_g, dw_w, dw_b, conv_ln_g, conv_ln_b,
              w_pw, conv_out_g, w_out, ple_norm_g, w_ple_gate, w_ple, final_g):
    B, S, _ = x.shape
    split_at = np.cumsum([ATTN_DIM, ATTN_DIM, ATTN_DIM, ATTN_DIM,
                          CONV_DIM, CONV_DIM])
    h = x
    for i in range(DEPTH):
        hn = rms_norm(h, norm_g[i])
        u = hn @ w_in[i]
        q, k, v, g_attn, c_val, c_gate, g_conv = jnp.split(u, split_at, axis=-1)

        heads = lambda t: t.reshape(B, S, N_HEADS, HEAD_DIM)
        o = stick_breaking_attention(heads(q), heads(k), heads(v))
        o = rms_norm(o, attn_out_g[i]).reshape(B, S, ATTN_DIM)
        y_attn = o * jax.nn.silu(g_attn)

        c = c_val * jax.nn.sigmoid(c_gate)
        c = causal_depthwise_conv(c, dw_w[i], dw_b[i])
        c = jax.nn.silu(layer_norm(c, conv_ln_g[i], conv_ln_b[i]))
        c = c @ w_pw[i]
        y_conv = rms_norm(c, conv_out_g[i]) * jax.nn.silu(g_conv)

        y = jnp.concatenate([y_attn, y_conv], axis=-1) @ w_out[i]
        h = h + y

        gate = jax.nn.sigmoid(rms_norm(h, ple_norm_g[i]) @ w_ple_gate[i])
        h = h + (p[i].astype(h.dtype) @ w_ple[i]) * gate
    return rms_norm(h, final_g)
```

```cpp
#include <hip/hip_runtime.h>
#include <hip/hip_cooperative_groups.h>
#include <cstdio>
#include <cstdint>
namespace cg = cooperative_groups;
namespace pg8 {
#define PG8_LAS __attribute__((address_space(3)))
typedef unsigned short bf16_t;
typedef short bf16x8 __attribute__((ext_vector_type(8)));
typedef float f32x4 __attribute__((ext_vector_type(4)));
typedef unsigned u32x4 __attribute__((ext_vector_type(4)));
constexpr int BM = 256, BK = 64, HALF = 128, HTB = HALF * BK * 2  , STAGE_BYTES = 8 * HTB, NXCD = 8, WGM = 8;

__host__ __device__ __forceinline__ int lds_byte(int r, int c) { const int st = (r >> 4) * 2 + (c >> 5), rr = r & 15, cc = c & 31, ob = rr * 64 + cc * 2; return st * 1024 + (ob ^ (((ob >> 9) & 1) << 5)); }
__host__ __device__ __forceinline__ void stage_rc(int b, int& R, int& C) { const int st = b / 1024, sb = b % 1024, swz = sb ^ (((sb >> 9) & 1) << 5); R = (st >> 1) * 16 + swz / 64; C = (st & 1) * 32 + (swz % 64) / 2; }
__host__ __device__ __forceinline__ int perm32(int rho) { const int n = rho >> 4, i = rho & 15; return 8 * (i >> 2) + 4 * n + (i & 3); }

struct Unit { int pm, pn; };
struct Gemm { const bf16_t* A; const bf16_t* Bt; int M, N, K; };

struct StaticOrder {
    int nM, nN, nwg, G, c;
    __host__ __device__ void init(int M, int N, int G_, int c_) { nM = M / BM; nN = N / BM; nwg = nM * nN; G = G_; c = c_; }
    __host__ __device__ bool next(int i, Unit& u) const {
        const long L = (long)i * G + c; if (L >= nwg) return false;
        int wgid = (int)L; { const int q = nwg / NXCD, r = nwg % NXCD, xcd = wgid % NXCD, off = wgid / NXCD; wgid = (xcd < r ? xcd * (q + 1) : r * (q + 1) + (xcd - r) * q) + off; }
        const int nig = WGM * nN, gid = wgid / nig, fm = gid * WGM, gsz = (nM - fm) < WGM ? (nM - fm) : WGM;
        u.pm = fm + ((wgid % nig) % gsz); u.pn = (wgid % nig) / gsz; return true;
    }
    __device__ __forceinline__ void a_ready(const Unit&) const {}
    __device__ __forceinline__ void done(const Unit&) const {}
};

template <class Epi, class Sched, bool ALIGN_EPI = false, bool SP2 = false>
__device__ __forceinline__ void gemm_phase(PG8_LAS unsigned char* lds, const Gemm g, const Sched& S, const Epi& E, const int tid_in) {
    const int tid = tid_in, wid = __builtin_amdgcn_readfirstlane(tid >> 6), lane = tid & 63, wr = wid >> 2, wc = wid & 3, fr = lane & 15, fq = lane >> 4;
    const int K = g.K, nt = K / BK;
    unsigned voffA[2], voffB[2];
#pragma unroll
    for (int i = 0; i < 2; ++i) { int R, C; stage_rc(tid * 16 + i * 8192, R, C); const int Rb = Epi::PERM ? ((R & ~31) + perm32(R & 31)) : R;
        voffA[i] = (unsigned)(R * K + C) * 2u; voffB[i] = (unsigned)(Rb * K + C) * 2u; }
    const size_t kstep = (size_t)(BK * 2);
    const size_t hstep = (size_t)HALF * K * 2;
    const size_t tstep = 2 * hstep;
    const unsigned ldsw = (unsigned)wid * 1024u;
    const int aoff = lds_byte(wr * 64 + fr, fq * 8), boff = lds_byte(wc * 32 + fr, fq * 8);
#define PG8_SA(b, h) (((b) * 2 + (h)) * HTB)
#define PG8_SB(b, h) ((4 + (b) * 2 + (h)) * HTB)
#define PG8_STAGE(bufoff, gbase, voff) do { _Pragma("unroll") for (int _i = 0; _i < 2; ++_i) \
        __builtin_amdgcn_global_load_lds((const unsigned*)((const char*)(gbase) + (voff)[_i]), (PG8_LAS unsigned*)(lds + (bufoff) + ldsw + _i * 8192), 16, 0, 0); } while (0)
#define PG8_LDA(dst, b, h) do { _Pragma("unroll") for (int m = 0; m < 4; ++m) _Pragma("unroll") for (int k = 0; k < 2; ++k) dst[m][k] = *(const PG8_LAS bf16x8*)(lds + PG8_SA(b, h) + aoff + m * 2048 + k * 1024); } while (0)
#define PG8_LDB(dst, b, h) do { _Pragma("unroll") for (int n = 0; n < 2; ++n) _Pragma("unroll") for (int k = 0; k < 2; ++k) dst[n][k] = *(const PG8_LAS bf16x8*)(lds + PG8_SB(b, h) + boff + n * 2048 + k * 1024); } while (0)
#define PG8_MMA(ai, bj, At, Bt) do { __builtin_amdgcn_s_setprio(1); _Pragma("unroll") for (int m = 0; m < 4; ++m) _Pragma("unroll") for (int n = 0; n < 2; ++n) _Pragma("unroll") for (int k = 0; k < 2; ++k) \
        acc[ai][bj][m][n] = __builtin_amdgcn_mfma_f32_16x16x32_bf16(Bt[n][k], At[m][k], acc[ai][bj][m][n], 0, 0, 0); __builtin_amdgcn_s_setprio(0); } while (0)
#define PG8_WAIT_V(n) asm volatile("s_waitcnt vmcnt(" #n ")" ::: "memory")
#define PG8_WAIT_L(n) asm volatile("s_waitcnt lgkmcnt(" #n ")" ::: "memory")
#define PG8_BAR __builtin_amdgcn_s_barrier()
#define PG8_SCHED __builtin_amdgcn_sched_barrier(0)
    Unit cur, nxt; int ui = 0;
    if (!S.next(0, cur)) return;
    f32x4 acc[2][2][4][2];
#pragma unroll
    for (int a = 0; a < 2; ++a)
#pragma unroll
        for (int b = 0; b < 2; ++b)
#pragma unroll
            for (int m = 0; m < 4; ++m)
#pragma unroll
                for (int n = 0; n < 2; ++n) acc[a][b][m][n] = (f32x4){0.f, 0.f, 0.f, 0.f};
    bf16x8 At[4][2], B0[2][2], B1[2][2];
    const char* cA = (const char*)g.A + (size_t)cur.pm * tstep; const char* cB = (const char*)g.Bt + (size_t)cur.pn * tstep;
    S.a_ready(cur);
    if constexpr (SP2) {
        PG8_STAGE(PG8_SB(0, 0), cB, voffB); PG8_STAGE(PG8_SB(0, 1), cB + hstep, voffB); PG8_STAGE(PG8_SA(0, 0), cA, voffA); PG8_STAGE(PG8_SA(0, 1), cA + hstep, voffA);
        if (wr == 1) PG8_BAR;
        PG8_WAIT_V(2); PG8_BAR;
        PG8_STAGE(PG8_SB(1, 0), cB + kstep, voffB); PG8_STAGE(PG8_SA(1, 0), cA + kstep, voffA); PG8_STAGE(PG8_SB(1, 1), cB + hstep + kstep, voffB);
        PG8_WAIT_V(6); PG8_BAR;
    } else {
        PG8_STAGE(PG8_SB(0, 0), cB, voffB); PG8_STAGE(PG8_SA(0, 0), cA, voffA); PG8_STAGE(PG8_SB(0, 1), cB + hstep, voffB); PG8_STAGE(PG8_SA(0, 1), cA + hstep, voffA);
        if (wr == 1) PG8_BAR;
        PG8_WAIT_V(4); PG8_BAR;
        PG8_STAGE(PG8_SB(1, 0), cB + kstep, voffB); PG8_STAGE(PG8_SA(1, 0), cA + kstep, voffA); PG8_STAGE(PG8_SB(1, 1), cB + hstep + kstep, voffB);
        PG8_WAIT_V(6); PG8_BAR;
    }
    for (;;) {
        const bool has_next = S.next(ui + 1, nxt);
        const char* nA = has_next ? (const char*)g.A + (size_t)nxt.pm * tstep : cA; const char* nB = has_next ? (const char*)g.Bt + (size_t)nxt.pn * tstep : cB;
        for (int t = 0; t < nt; t += 2) {
            const bool last = (t == nt - 2);
            const char* a1 = cA + (size_t)(t + 1) * kstep;
            const char* a2 = last ? nA : cA + (size_t)(t + 2) * kstep; const char* b2 = last ? nB : cB + (size_t)(t + 2) * kstep;
            const char* a3 = a2 + kstep; const char* b3 = b2 + kstep;
            if (last && has_next) S.a_ready(nxt);
            if constexpr (SP2) {
            PG8_LDB(B0, 0, 0); PG8_LDB(B1, 0, 1); PG8_SCHED; PG8_LDA(At, 0, 0); PG8_STAGE(PG8_SA(1, 1), a1 + hstep, voffA);
            PG8_WAIT_V(8); PG8_WAIT_L(0); PG8_BAR; PG8_MMA(0, 0, At, B0); PG8_MMA(0, 1, At, B1); PG8_BAR; PG8_SCHED;
            PG8_LDA(At, 0, 1); PG8_STAGE(PG8_SB(0, 0), b2, voffB); PG8_STAGE(PG8_SB(0, 1), b2 + hstep, voffB); PG8_STAGE(PG8_SA(0, 0), a2, voffA);
            PG8_WAIT_V(8); PG8_WAIT_L(0); PG8_BAR; PG8_MMA(1, 0, At, B0); PG8_MMA(1, 1, At, B1); PG8_BAR; PG8_SCHED;
            PG8_LDB(B0, 1, 0); PG8_LDB(B1, 1, 1); PG8_SCHED; PG8_LDA(At, 1, 0); PG8_STAGE(PG8_SA(0, 1), a2 + hstep, voffA);
            PG8_WAIT_V(8); PG8_WAIT_L(0); PG8_BAR; PG8_MMA(0, 0, At, B0); PG8_MMA(0, 1, At, B1); PG8_BAR; PG8_SCHED;
            PG8_LDA(At, 1, 1); PG8_STAGE(PG8_SB(1, 0), b3, voffB); PG8_STAGE(PG8_SB(1, 1), b3 + hstep, voffB); PG8_STAGE(PG8_SA(1, 0), a3, voffA);
            PG8_WAIT_V(8); PG8_WAIT_L(0); PG8_BAR; PG8_MMA(1, 0, At, B0); PG8_MMA(1, 1, At, B1); PG8_BAR; PG8_SCHED;
            } else {
            PG8_LDB(B0, 0, 0); PG8_SCHED; PG8_LDA(At, 0, 0); PG8_STAGE(PG8_SA(1, 1), a1 + hstep, voffA);
            PG8_WAIT_L(8); PG8_BAR; PG8_WAIT_L(0); PG8_MMA(0, 0, At, B0); PG8_BAR; PG8_SCHED;
            PG8_LDB(B1, 0, 1); PG8_STAGE(PG8_SB(0, 0), b2, voffB);
            PG8_BAR; PG8_WAIT_L(0); PG8_MMA(0, 1, At, B1); PG8_BAR;
            PG8_LDA(At, 0, 1); PG8_STAGE(PG8_SA(0, 0), a2, voffA);
            PG8_BAR; PG8_WAIT_L(0); PG8_MMA(1, 0, At, B0); PG8_BAR; PG8_SCHED;
            PG8_STAGE(PG8_SB(0, 1), b2 + hstep, voffB);
            PG8_WAIT_V(6); PG8_BAR; PG8_MMA(1, 1, At, B1); PG8_BAR;
            PG8_LDB(B0, 1, 0); PG8_SCHED; PG8_LDA(At, 1, 0); PG8_STAGE(PG8_SA(0, 1), a2 + hstep, voffA);
            PG8_WAIT_L(8); PG8_BAR; PG8_WAIT_L(0); PG8_MMA(0, 0, At, B0); PG8_BAR; PG8_SCHED;
            PG8_LDB(B1, 1, 1); PG8_STAGE(PG8_SB(1, 0), b3, voffB);
            PG8_BAR; PG8_WAIT_L(0); PG8_MMA(0, 1, At, B1); PG8_BAR;
            PG8_LDA(At, 1, 1); PG8_STAGE(PG8_SA(1, 0), a3, voffA);
            PG8_BAR; PG8_WAIT_L(0); PG8_MMA(1, 0, At, B0); PG8_BAR; PG8_SCHED;
            PG8_STAGE(PG8_SB(1, 1), b3 + hstep, voffB);
            PG8_WAIT_V(6); PG8_BAR; PG8_MMA(1, 1, At, B1); PG8_BAR;
            }
        }
        if constexpr (ALIGN_EPI) { if (wr == 0) PG8_BAR; }
        if constexpr (!Epi::AFTER_DRAIN) { E(acc, cur, wr, wc, fr, fq); S.done(cur); }
        if (!has_next) break;
#pragma unroll
        for (int a = 0; a < 2; ++a)
#pragma unroll
            for (int b = 0; b < 2; ++b)
#pragma unroll
                for (int m = 0; m < 4; ++m)
#pragma unroll
                    for (int n = 0; n < 2; ++n) acc[a][b][m][n] = (f32x4){0.f, 0.f, 0.f, 0.f};
        cur = nxt; cA = nA; cB = nB; ++ui;
        if constexpr (ALIGN_EPI) { if (wr == 1) PG8_BAR; }
    }
    PG8_WAIT_V(0);
    if constexpr (!ALIGN_EPI) { if (wr == 0) PG8_BAR; }
    PG8_BAR;
    if constexpr (Epi::AFTER_DRAIN) { E.fused(acc, cur, wr, wc, fr, fq, lds, wid, lane); S.done(cur); }
#undef PG8_SA
#undef PG8_SB
#undef PG8_STAGE
#undef PG8_LDA
#undef PG8_LDB
#undef PG8_MMA
#undef PG8_WAIT_V
#undef PG8_WAIT_L
#undef PG8_BAR
#undef PG8_SCHED
}
}

#define LAS __attribute__((address_space(3)))
typedef unsigned short bf16_t;
typedef short bf16x8 __attribute__((ext_vector_type(8)));
typedef float f32x4 __attribute__((ext_vector_type(4)));
typedef float f32x2 __attribute__((ext_vector_type(2)));
typedef float f32x16 __attribute__((ext_vector_type(16)));
typedef unsigned u32x4 __attribute__((ext_vector_type(4)));
typedef unsigned u32x2 __attribute__((ext_vector_type(2)));
typedef __bf16 bf16x2_t __attribute__((ext_vector_type(2)));

constexpr int NB = 8, SEQ = 2048, DM = 1024, MT = NB * SEQ, DIN = 3584, NH = 8, HD = 64, CWID = 31, PLE = 256, CD = 512;
constexpr float EPS = 1e-6f;
constexpr float QSCALE = 0.125f * 1.4426950408889634f;

constexpr size_t MiB = 1u << 20;
constexpr size_t W_IN = 0, W_PW = 7340032, W_OUT = W_PW + 524288, W_PG = W_OUT + 2097152, W_PLE = W_PG + 2097152, W_LAYER = 12 * MiB;
static_assert(W_PLE + 524288 == W_LAYER, "weight map");
constexpr size_t WS_PB = 24 * MiB, WS_HB = 40 * MiB, WS_Y = 72 * MiB, WS_VT = 104 * MiB, WS_SSA = 120 * MiB, WS_SSB = 121 * MiB, WS_U = 122 * MiB;
constexpr size_t WS_H1B = WS_U, WS_EB = WS_U + 32 * MiB, WS_END = 234 * MiB;
constexpr int LDS_BYTES = 147456;
constexpr int NPHASE = 10;

__device__ __forceinline__ unsigned pk2(float lo, float hi) { f32x2 v = {lo, hi}; bf16x2_t b = __builtin_convertvector(v, bf16x2_t); return __builtin_bit_cast(unsigned, b); }
__device__ __forceinline__ float bflo(unsigned u) { return __builtin_bit_cast(float, u << 16); }
__device__ __forceinline__ float bfhi(unsigned u) { return __builtin_bit_cast(float, u & 0xffff0000u); }
__device__ __forceinline__ float fexp2(float x) { return __builtin_amdgcn_exp2f(x); }
__device__ __forceinline__ float flog2(float x) { return __builtin_amdgcn_logf(x); }
__device__ __forceinline__ float frcp(float x) { return __builtin_amdgcn_rcpf(x); }
__device__ __forceinline__ float frsq(float x) { return __builtin_amdgcn_rsqf(x); }
__device__ __forceinline__ float sigmoidf_(float x) { return frcp(1.0f + fexp2(-1.4426950408889634f * x)); }
__device__ __forceinline__ float siluf_(float x) { return x * sigmoidf_(x); }
#define MFMA32(a, b, c) __builtin_amdgcn_mfma_f32_32x32x16_bf16((a), (b), (c), 0, 0, 0)

__device__ __forceinline__ float shx(float v, int m, int lane) { return __builtin_bit_cast(float, __builtin_amdgcn_ds_bpermute((lane ^ m) << 2, __builtin_bit_cast(int, v))); }
__device__ __forceinline__ float wave_sum(float v, int lane) {
#pragma unroll
    for (int o = 1; o < 64; o <<= 1) v += shx(v, o, lane);
    return v;
}
__device__ __forceinline__ float row_rstd(const float* ss, int row, int fq, int lane) {
    const f32x4 p = *(const f32x4*)(ss + (size_t)row * 16 + fq * 4);
    float s = (p[0] + p[1]) + (p[2] + p[3]);
    s += shx(s, 16, lane); s += shx(s, 32, lane);
    return frsq(s * (1.0f / DM) + EPS);
}

struct EpiIn {
    static constexpr bool PERM = true, AFTER_DRAIN = false;
    bf16_t* U; bf16_t* VT; const float* ss;
    __device__ __forceinline__ void operator()(const f32x4 (&acc)[2][2][4][2], const pg8::Unit& u, int, int, int, int) const {
        int t_ = threadIdx.x; asm volatile("" : "+v"(t_));
        const int lane = t_ & 63, fr = lane & 15, fq = lane >> 4, wid_ = __builtin_amdgcn_readfirstlane(t_ >> 6), wr = wid_ >> 2, wc = wid_ & 3;
        const int pn = u.pn;
#pragma unroll
        for (int ai = 0; ai < 2; ++ai)
#pragma unroll
            for (int m = 0; m < 4; ++m) {
                const int row = u.pm * 256 + ai * 128 + wr * 64 + m * 16 + fr;
                const float rs = row_rstd(ss, row, fq, lane);
#pragma unroll
                for (int bj = 0; bj < 2; ++bj) {
                    const int col0 = pn * 256 + bj * 128 + wc * 32 + 8 * fq;
                    f32x4 v0 = acc[ai][bj][m][0] * rs, v1 = acc[ai][bj][m][1] * rs;
                    if (pn < 4) {
                        const float sc = pn < 2 ? QSCALE : 1.0f;
                        v0 = v0 * sc; v1 = v1 * sc;
                        u32x4 w; w[0] = pk2(v0[0], v0[1]); w[1] = pk2(v0[2], v0[3]); w[2] = pk2(v1[0], v1[1]); w[3] = pk2(v1[2], v1[3]);
                        *(u32x4*)(U + (size_t)row * DIN + col0) = w;
                    } else if (pn < 6) {
                        const int vc = col0 - 1024, hh = vc >> 6, d0 = vc & 63, b = row >> 11, s = row & 2047;
                        bf16_t* vp = VT + ((size_t)((b * NH + hh) * HD + d0)) * SEQ + s;
                        const unsigned w0 = pk2(v0[0], v0[1]), w1 = pk2(v0[2], v0[3]), w2 = pk2(v1[0], v1[1]), w3 = pk2(v1[2], v1[3]);
                        vp[0 * SEQ] = (bf16_t)(w0 & 0xffffu); vp[1 * SEQ] = (bf16_t)(w0 >> 16);
                        vp[2 * SEQ] = (bf16_t)(w1 & 0xffffu); vp[3 * SEQ] = (bf16_t)(w1 >> 16);
                        vp[4 * SEQ] = (bf16_t)(w2 & 0xffffu); vp[5 * SEQ] = (bf16_t)(w2 >> 16);
                        vp[6 * SEQ] = (bf16_t)(w3 & 0xffffu); vp[7 * SEQ] = (bf16_t)(w3 >> 16);
                    } else if (pn < 8 || pn >= 12) {
                        u32x4 w; w[0] = pk2(siluf_(v0[0]), siluf_(v0[1])); w[1] = pk2(siluf_(v0[2]), siluf_(v0[3]));
                        w[2] = pk2(siluf_(v1[0]), siluf_(v1[1])); w[3] = pk2(siluf_(v1[2]), siluf_(v1[3]));
                        *(u32x4*)(U + (size_t)row * DIN + col0) = w;
                    } else {
                        const int ch0 = (col0 - 2048) >> 1;
                        u32x2 w; w[0] = pk2(v0[0] * sigmoidf_(v0[1]), v0[2] * sigmoidf_(v0[3])); w[1] = pk2(v1[0] * sigmoidf_(v1[1]), v1[2] * sigmoidf_(v1[3]));
                        *(u32x2*)(U + (size_t)row * DIN + 2048 + ch0) = w;
                    }
                }
                asm volatile("" ::: "memory");
            }
    }
};

struct EpiOut {
    static constexpr bool PERM = false, AFTER_DRAIN = false;
    const float* base; float* out; bf16_t* HB; float* ss;
    __device__ __forceinline__ void operator()(const f32x4 (&acc)[2][2][4][2], const pg8::Unit& u, int, int, int, int) const {
        int t_ = threadIdx.x; asm volatile("" : "+v"(t_));
        const int lane = t_ & 63, fr = lane & 15, fq = lane >> 4, wid_ = __builtin_amdgcn_readfirstlane(t_ >> 6), wr = wid_ >> 2, wc = wid_ & 3;
#pragma unroll
        for (int ai = 0; ai < 2; ++ai)
#pragma unroll
            for (int m = 0; m < 4; ++m) {
                const int row = u.pm * 256 + ai * 128 + wr * 64 + m * 16 + fr;
                float sq = 0.f;
#pragma unroll
                for (int bj = 0; bj < 2; ++bj)
#pragma unroll
                    for (int n = 0; n < 2; ++n) {
                        const size_t off = (size_t)row * DM + u.pn * 256 + bj * 128 + wc * 32 + n * 16 + 4 * fq;
                        const f32x4 h = *(const f32x4*)(base + off) + acc[ai][bj][m][n];
                        *(f32x4*)(out + off) = h;
                        u32x2 w; w[0] = pk2(h[0], h[1]); w[1] = pk2(h[2], h[3]);
                        *(u32x2*)(HB + off) = w;
                        sq += (h[0] * h[0] + h[1] * h[1]) + (h[2] * h[2] + h[3] * h[3]);
                    }
                sq += shx(sq, 16, lane); sq += shx(sq, 32, lane);
                if (fq == 0) ss[(size_t)row * 16 + u.pn * 4 + wc] = sq;
                asm volatile("" ::: "memory");
            }
    }
};

struct EpiE {
    static constexpr bool PERM = false, AFTER_DRAIN = false;
    float* EB;
    __device__ __forceinline__ void operator()(const f32x4 (&acc)[2][2][4][2], const pg8::Unit& u, int, int, int, int) const {
        int t_ = threadIdx.x; asm volatile("" : "+v"(t_));
        const int lane = t_ & 63, fr = lane & 15, fq = lane >> 4, wid_ = __builtin_amdgcn_readfirstlane(t_ >> 6), wr = wid_ >> 2, wc = wid_ & 3;
#pragma unroll
        for (int ai = 0; ai < 2; ++ai)
#pragma unroll
            for (int m = 0; m < 4; ++m) {
                const int row = u.pm * 256 + ai * 128 + wr * 64 + m * 16 + fr;
#pragma unroll
                for (int bj = 0; bj < 2; ++bj)
#pragma unroll
                    for (int n = 0; n < 2; ++n) {
                        const size_t off = (size_t)row * DM + u.pn * 256 + bj * 128 + wc * 32 + n * 16 + 4 * fq;
                        *(f32x4*)(EB + off) = acc[ai][bj][m][n];
                    }
                asm volatile("" ::: "memory");
            }
    }
};

struct EpiGate {
    static constexpr bool PERM = false, AFTER_DRAIN = false;
    float* out; const float* EB; bf16_t* HB; const float* ss_in; float* ss_out;
    __device__ __forceinline__ void operator()(const f32x4 (&acc)[2][2][4][2], const pg8::Unit& u, int, int, int, int) const {
        int t_ = threadIdx.x; asm volatile("" : "+v"(t_));
        const int lane = t_ & 63, fr = lane & 15, fq = lane >> 4, wid_ = __builtin_amdgcn_readfirstlane(t_ >> 6), wr = wid_ >> 2, wc = wid_ & 3;
#pragma unroll
        for (int ai = 0; ai < 2; ++ai)
#pragma unroll
            for (int m = 0; m < 4; ++m) {
                const int row = u.pm * 256 + ai * 128 + wr * 64 + m * 16 + fr;
                const float rs = row_rstd(ss_in, row, fq, lane);
                float sq = 0.f;
#pragma unroll
                for (int bj = 0; bj < 2; ++bj)
#pragma unroll
                    for (int n = 0; n < 2; ++n) {
                        const size_t off = (size_t)row * DM + u.pn * 256 + bj * 128 + wc * 32 + n * 16 + 4 * fq;
                        const f32x4 a = acc[ai][bj][m][n] * rs;
                        const f32x4 e = *(const f32x4*)(EB + off);
                        f32x4 h = *(const f32x4*)(out + off);
                        h[0] += e[0] * sigmoidf_(a[0]); h[1] += e[1] * sigmoidf_(a[1]); h[2] += e[2] * sigmoidf_(a[2]); h[3] += e[3] * sigmoidf_(a[3]);
                        *(f32x4*)(out + off) = h;
                        u32x2 w; w[0] = pk2(h[0], h[1]); w[1] = pk2(h[2], h[3]);
                        *(u32x2*)(HB + off) = w;
                        sq += (h[0] * h[0] + h[1] * h[1]) + (h[2] * h[2] + h[3] * h[3]);
                    }
                sq += shx(sq, 16, lane); sq += shx(sq, 32, lane);
                if (fq == 0) ss_out[(size_t)row * 16 + u.pn * 4 + wc] = sq;
                asm volatile("" ::: "memory");
            }
    }
};

template <bool REMAP>
__device__ __forceinline__ void tr_item(const float* W, int K, int N, bf16_t* WT, const float* g, LAS float* scr, int item, int lane) {
    const int nblk = N / 32, kb = item / nblk, nb = item % nblk, k0 = 64 * kb, n0 = 32 * nb;
    int src = n0 + (lane & 31);
    if (REMAP) { if (src >= 2048 && src < 3072) { const int jj = src - 2048; src = (jj & 1) ? 2560 + (jj >> 1) : 2048 + (jj >> 1); } }
#pragma unroll 8
    for (int i = 0; i < 32; ++i) { const int kk = 2 * i + (lane >> 5); float v = W[(size_t)(k0 + kk) * N + src]; if (g) v *= g[k0 + kk]; scr[kk * 33 + (lane & 31)] = v; }
    asm volatile("s_waitcnt lgkmcnt(0)" ::: "memory");
    const int c = lane & 7;
#pragma unroll
    for (int j = 0; j < 4; ++j) { const int n = (lane >> 3) + 8 * j; const LAS float* s = scr + (8 * c) * 33 + n;
        u32x4 o; o[0] = pk2(s[0 * 33], s[1 * 33]); o[1] = pk2(s[2 * 33], s[3 * 33]); o[2] = pk2(s[4 * 33], s[5 * 33]); o[3] = pk2(s[6 * 33], s[7 * 33]);
        *(u32x4*)(WT + (size_t)(n0 + n) * K + k0 + 8 * c) = o; }
    asm volatile("s_waitcnt lgkmcnt(0)" ::: "memory");
}

constexpr int AK_STRIDE = 144, AV_STRIDE = 136, A_KBYTES = 64 * AK_STRIDE, A_VBYTES = 64 * AV_STRIDE, A_BUF = 18432;
static_assert(A_KBYTES + A_VBYTES <= A_BUF, "attention LDS buffer");

__device__ __forceinline__ void attn_unit(const bf16_t* U, const bf16_t* VT, bf16_t* Y, const float* aog, int b, int h, int qb, LAS unsigned char* lds) {
    int tid = threadIdx.x; asm volatile("" : "+v"(tid));
    const int wave = __builtin_amdgcn_readfirstlane(tid >> 6), lane = tid & 63, l31 = lane & 31, hi = lane >> 5;
    const int q0 = qb * 256 + wave * 32, t = q0 + l31;
    const size_t trow = (size_t)(b * SEQ + t);
    bf16x8 qf[4];
    {
        const bf16_t* qp = U + trow * DIN + h * HD + 8 * hi;
#pragma unroll
        for (int s = 0; s < 4; ++s) qf[s] = *(const bf16x8*)(qp + 16 * s);
    }
    f32x16 o0, o1;
#pragma unroll
    for (int i = 0; i < 16; ++i) { o0[i] = 0.f; o1[i] = 0.f; }
    float C = 0.f;
    const int ktmax = 4 * qb + 3, wkt = (q0 + 30) >> 6;
    const int srow = tid >> 3, sch = tid & 7;
    const bf16_t* gk = U + (size_t)(b * SEQ + srow) * DIN + 512 + h * HD + sch * 8;
    const bf16_t* gv = VT + ((size_t)((b * NH + h) * HD + srow)) * SEQ + sch * 8;
    const int kwoff = srow * AK_STRIDE + sch * 16, vwoff = A_KBYTES + srow * AV_STRIDE + sch * 16;
    __syncthreads();
    {
        const u32x4 kr = *(const u32x4*)(gk + (size_t)ktmax * 64 * DIN), vr = *(const u32x4*)(gv + ktmax * 64);
        *(LAS u32x4*)(lds + kwoff) = kr;
        u32x2 a = {vr[0], vr[1]}, c = {vr[2], vr[3]};
        *(LAS u32x2*)(lds + vwoff) = a; *(LAS u32x2*)(lds + vwoff + 8) = c;
    }
    __syncthreads();
    int cur = 0;
    for (int kt = ktmax; kt >= 0; --kt) {
        u32x4 kr = {0u, 0u, 0u, 0u}, vr = {0u, 0u, 0u, 0u};
        if (kt > 0) { kr = *(const u32x4*)(gk + (size_t)(kt - 1) * 64 * DIN); vr = *(const u32x4*)(gv + (kt - 1) * 64); }
        if (kt <= wkt) {
            const LAS unsigned char* kb = lds + cur * A_BUF;
            const LAS unsigned char* vb = kb + A_KBYTES;
            f32x16 p0, p1;
#pragma unroll
            for (int i = 0; i < 16; ++i) { p0[i] = 0.f; p1[i] = 0.f; }
#pragma unroll
            for (int s = 0; s < 4; ++s) {
                const bf16x8 ka = *(const LAS bf16x8*)(kb + l31 * AK_STRIDE + 32 * s + 16 * hi);
                const bf16x8 kc = *(const LAS bf16x8*)(kb + (32 + l31) * AK_STRIDE + 32 * s + 16 * hi);
                p0 = MFMA32(ka, qf[s], p0); p1 = MFMA32(kc, qf[s], p1);
            }
            const int lim0 = t - (64 * kt + 4 * hi), lim1 = lim0 - 32;
            f32x16 l0, l1;
            float G0[4], G1[4];
#pragma unroll
            for (int g = 0; g < 4; ++g) {
                float s0 = 0.f, s1 = 0.f;
#pragma unroll
                for (int i = 0; i < 4; ++i) {
                    const int r = 4 * g + i, cr = i + 8 * g;
                    const float z0 = p0[r], z1 = p1[r];
                    const float sp0 = fmaxf(z0, 0.f) + flog2(1.0f + fexp2(-fabsf(z0)));
                    const float sp1 = fmaxf(z1, 0.f) + flog2(1.0f + fexp2(-fabsf(z1)));
                    const float a0 = (cr < lim0) ? -sp0 : 0.f, a1 = (cr < lim1) ? -sp1 : 0.f;
                    l0[r] = a0; l1[r] = a1; s0 += a0; s1 += a1;
                }
                G0[g] = s0; G1[g] = s1;
            }
            float X0[4], X1[4];
#pragma unroll
            for (int g = 0; g < 4; ++g) { X0[g] = shx(G0[g], 32, lane); X1[g] = shx(G1[g], 32, lane); }
            float run = C;
#pragma unroll
            for (int g = 3; g >= 0; --g) {
                float a = run + (hi == 0 ? X1[g] : 0.f);
#pragma unroll
                for (int i = 3; i >= 0; --i) { const int r = 4 * g + i, cr = i + 8 * g; a += l1[r]; const float e = fexp2(p1[r] + a); p1[r] = (cr < lim1) ? e : 0.f; }
                run += G1[g] + X1[g];
            }
#pragma unroll
            for (int g = 3; g >= 0; --g) {
                float a = run + (hi == 0 ? X0[g] : 0.f);
#pragma unroll
                for (int i = 3; i >= 0; --i) { const int r = 4 * g + i, cr = i + 8 * g; a += l0[r]; const float e = fexp2(p0[r] + a); p0[r] = (cr < lim0) ? e : 0.f; }
                run += G0[g] + X0[g];
            }
            C = run;
#pragma unroll
            for (int kh = 0; kh < 2; ++kh)
#pragma unroll
                for (int sh = 0; sh < 2; ++sh) {
                    u32x4 xw;
                    if (kh == 0) { xw[0] = pk2(p0[8 * sh + 0], p0[8 * sh + 1]); xw[1] = pk2(p0[8 * sh + 2], p0[8 * sh + 3]); xw[2] = pk2(p0[8 * sh + 4], p0[8 * sh + 5]); xw[3] = pk2(p0[8 * sh + 6], p0[8 * sh + 7]); }
                    else         { xw[0] = pk2(p1[8 * sh + 0], p1[8 * sh + 1]); xw[1] = pk2(p1[8 * sh + 2], p1[8 * sh + 3]); xw[2] = pk2(p1[8 * sh + 4], p1[8 * sh + 5]); xw[3] = pk2(p1[8 * sh + 6], p1[8 * sh + 7]); }
                    const bf16x8 xf = __builtin_bit_cast(bf16x8, xw);
                    const int koff = 2 * (32 * kh + 16 * sh + 4 * hi);
                    {
                        const LAS unsigned char* vp = vb + l31 * AV_STRIDE + koff;
                        const u32x2 lo = *(const LAS u32x2*)vp, hh = *(const LAS u32x2*)(vp + 16);
                        u32x4 vw = {lo[0], lo[1], hh[0], hh[1]};
                        o0 = MFMA32(__builtin_bit_cast(bf16x8, vw), xf, o0);
                    }
                    {
                        const LAS unsigned char* vp = vb + (32 + l31) * AV_STRIDE + koff;
                        const u32x2 lo = *(const LAS u32x2*)vp, hh = *(const LAS u32x2*)(vp + 16);
                        u32x4 vw = {lo[0], lo[1], hh[0], hh[1]};
                        o1 = MFMA32(__builtin_bit_cast(bf16x8, vw), xf, o1);
                    }
                }
        }
        if (kt > 0) {
            LAS unsigned char* nb = lds + (cur ^ 1) * A_BUF;
            *(LAS u32x4*)(nb + kwoff) = kr;
            u32x2 a = {vr[0], vr[1]}, c = {vr[2], vr[3]};
            *(LAS u32x2*)(nb + vwoff) = a; *(LAS u32x2*)(nb + vwoff + 8) = c;
        }
        __syncthreads();
        cur ^= 1;
    }
    float sq = 0.f;
#pragma unroll
    for (int i = 0; i < 16; ++i) sq += o0[i] * o0[i] + o1[i] * o1[i];
    sq += shx(sq, 32, lane);
    const float rs = frsq(sq * (1.0f / HD) + EPS);
    const bf16_t* sgp = U + trow * DIN + 1536 + h * HD;
    bf16_t* yp = Y + trow * DM + h * HD;
#pragma unroll
    for (int dt = 0; dt < 2; ++dt)
#pragma unroll
        for (int g = 0; g < 4; ++g) {
            const int d0 = 32 * dt + 8 * g + 4 * hi;
            const f32x4 gn = *(const f32x4*)(aog + d0);
            const u32x2 sg = *(const u32x2*)(sgp + d0);
            float v0, v1, v2, v3;
            if (dt == 0) { v0 = o0[4 * g + 0]; v1 = o0[4 * g + 1]; v2 = o0[4 * g + 2]; v3 = o0[4 * g + 3]; }
            else         { v0 = o1[4 * g + 0]; v1 = o1[4 * g + 1]; v2 = o1[4 * g + 2]; v3 = o1[4 * g + 3]; }
            u32x2 w;
            w[0] = pk2(v0 * rs * gn[0] * bflo(sg[0]), v1 * rs * gn[1] * bfhi(sg[0]));
            w[1] = pk2(v2 * rs * gn[2] * bflo(sg[1]), v3 * rs * gn[3] * bfhi(sg[1]));
            *(u32x2*)(yp + d0) = w;
        }
}

constexpr int CT = 32, C_XH = 0, C_XH_BYTES = (CT + 30) * 1024, C_CO = C_XH_BYTES, C_CO_BYTES = CT * CD * 4, C_RED = C_CO + C_CO_BYTES, C_AT = 0, C_AT_STRIDE = 1040;
static_assert(C_RED + 1024 <= LDS_BYTES && CT * C_AT_STRIDE <= C_XH_BYTES, "conv LDS map");

__device__ __forceinline__ void conv_unit(const bf16_t* U, bf16_t* Y, const float* dww, const float* dwb, const float* lng, const float* lnb, const bf16_t* Wpw, const float* cog,
                                          int cu, LAS unsigned char* lds) {
    int tid = threadIdx.x; asm volatile("" : "+v"(tid));
    const int wave = __builtin_amdgcn_readfirstlane(tid >> 6), lane = tid & 63, l31 = lane & 31, hi = lane >> 5;
    const int r0 = cu * CT, b = r0 >> 11, s0 = r0 & 2047;
    __syncthreads();
    for (int i = tid; i < (CT + 30) * 64; i += 512) {
        const int row = i >> 6, ch = i & 63, s = s0 - 30 + row;
        u32x4 v = {0u, 0u, 0u, 0u};
        if (s >= 0) v = *(const u32x4*)(U + (size_t)(b * SEQ + s) * DIN + 2048 + ch * 8);
        *(LAS u32x4*)(lds + C_XH + row * 1024 + ch * 16) = v;
    }
    __syncthreads();
    {
        const int chp = tid & 255, tg = tid >> 8;
        float w0[CWID], w1[CWID];
#pragma unroll
        for (int j = 0; j < CWID; ++j) { const f32x2 ww = *(const f32x2*)(dww + (size_t)j * CD + 2 * chp); w0[j] = ww[0]; w1[j] = ww[1]; }
        const f32x2 bias = *(const f32x2*)(dwb + 2 * chp);
        const LAS unsigned char* xp = lds + C_XH + chp * 4;
#pragma unroll 1
        for (int tt = 0; tt < 16; ++tt) {
            const int tl = tg * 16 + tt;
            float a0 = bias[0], a1 = bias[1];
#pragma unroll
            for (int j = 0; j < CWID; ++j) { const unsigned xv = *(const LAS unsigned*)(xp + (tl + j) * 1024); a0 += w0[j] * bflo(xv); a1 += w1[j] * bfhi(xv); }
            f32x2 o = {a0, a1};
            *(LAS f32x2*)(lds + C_CO + tl * 2048 + chp * 8) = o;
        }
    }
    __syncthreads();
    {
        const f32x4 g0 = *(const f32x4*)(lng + lane * 4), g1 = *(const f32x4*)(lng + 256 + lane * 4);
        const f32x4 b0 = *(const f32x4*)(lnb + lane * 4), b1 = *(const f32x4*)(lnb + 256 + lane * 4);
#pragma unroll
        for (int tt = 0; tt < 4; ++tt) {
            const int tl = wave * 4 + tt;
            f32x4 v0 = *(const LAS f32x4*)(lds + C_CO + tl * 2048 + lane * 16), v1 = *(const LAS f32x4*)(lds + C_CO + tl * 2048 + 1024 + lane * 16);
            const float mean = wave_sum((v0[0] + v0[1]) + (v0[2] + v0[3]) + (v1[0] + v1[1]) + (v1[2] + v1[3]), lane) * (1.0f / CD);
            v0 = v0 - mean; v1 = v1 - mean;
            const float var = wave_sum((v0[0] * v0[0] + v0[1] * v0[1]) + (v0[2] * v0[2] + v0[3] * v0[3]) + (v1[0] * v1[0] + v1[1] * v1[1]) + (v1[2] * v1[2] + v1[3] * v1[3]), lane) * (1.0f / CD);
            const float rs = frsq(var + EPS);
            v0 = v0 * rs * g0 + b0; v1 = v1 * rs * g1 + b1;
            u32x2 wa, wb;
            wa[0] = pk2(siluf_(v0[0]), siluf_(v0[1])); wa[1] = pk2(siluf_(v0[2]), siluf_(v0[3]));
            wb[0] = pk2(siluf_(v1[0]), siluf_(v1[1])); wb[1] = pk2(siluf_(v1[2]), siluf_(v1[3]));
            *(LAS u32x2*)(lds + C_AT + tl * C_AT_STRIDE + lane * 8) = wa;
            *(LAS u32x2*)(lds + C_AT + tl * C_AT_STRIDE + 512 + lane * 8) = wb;
        }
    }
    __syncthreads();
    f32x16 c0, c1;
#pragma unroll
    for (int i = 0; i < 16; ++i) { c0[i] = 0.f; c1[i] = 0.f; }
    {
        const bf16_t* wp = Wpw + (size_t)(64 * wave + l31) * CD + 8 * hi;
        const LAS unsigned char* ap = lds + C_AT + l31 * C_AT_STRIDE + 16 * hi;
#pragma unroll 8
        for (int s = 0; s < 32; ++s) {
            const bf16x8 a = *(const LAS bf16x8*)(ap + 32 * s);
            const bf16x8 wa = *(const bf16x8*)(wp + 16 * s), wb = *(const bf16x8*)(wp + 32 * CD + 16 * s);
            c0 = MFMA32(wa, a, c0); c1 = MFMA32(wb, a, c1);
        }
    }
    float sq = 0.f;
#pragma unroll
    for (int i = 0; i < 16; ++i) sq += c0[i] * c0[i] + c1[i] * c1[i];
    sq += shx(sq, 32, lane);
    LAS float* red = (LAS float*)(lds + C_RED);
    if (hi == 0) red[wave * 32 + l31] = sq;
    __syncthreads();
    float tot = 0.f;
#pragma unroll
    for (int w = 0; w < 8; ++w) tot += red[w * 32 + l31];
    const float rs = frsq(tot * (1.0f / CD) + EPS);
    const size_t trow = (size_t)(r0 + l31);
    const bf16_t* sgp = U + trow * DIN + 3072;
    bf16_t* yp = Y + trow * DM + 512;
#pragma unroll
    for (int nt = 0; nt < 2; ++nt)
#pragma unroll
        for (int g = 0; g < 4; ++g) {
            const int n0 = 64 * wave + 32 * nt + 8 * g + 4 * hi;
            const f32x4 gn = *(const f32x4*)(cog + n0);
            const u32x2 sg = *(const u32x2*)(sgp + n0);
            float v0, v1, v2, v3;
            if (nt == 0) { v0 = c0[4 * g + 0]; v1 = c0[4 * g + 1]; v2 = c0[4 * g + 2]; v3 = c0[4 * g + 3]; }
            else         { v0 = c1[4 * g + 0]; v1 = c1[4 * g + 1]; v2 = c1[4 * g + 2]; v3 = c1[4 * g + 3]; }
            u32x2 w;
            w[0] = pk2(v0 * rs * gn[0] * bflo(sg[0]), v1 * rs * gn[1] * bfhi(sg[0]));
            w[1] = pk2(v2 * rs * gn[2] * bflo(sg[1]), v3 * rs * gn[3] * bfhi(sg[1]));
            *(u32x2*)(yp + n0) = w;
        }
}

struct Params { const float* in[16]; float* out; unsigned char* ws; int ph_lo, ph_hi; };

template <int ph>
__device__ __forceinline__ void run_phase(const Params& P, LAS unsigned char* lds) {
    const int G = gridDim.x, bid = blockIdx.x;
    unsigned char* ws = P.ws;
    const float* x = P.in[0];
    float* out = P.out;
    bf16_t* HB = (bf16_t*)(ws + WS_HB); bf16_t* H1B = (bf16_t*)(ws + WS_H1B); bf16_t* Ub = (bf16_t*)(ws + WS_U); bf16_t* VT = (bf16_t*)(ws + WS_VT); bf16_t* Yb = (bf16_t*)(ws + WS_Y);
    float* EB = (float*)(ws + WS_EB); float* ssA = (float*)(ws + WS_SSA); float* ssB = (float*)(ws + WS_SSB);

    {
        int tid = threadIdx.x; asm volatile("" : "+v"(tid));
        const int lane = tid & 63, wave = __builtin_amdgcn_readfirstlane(tid >> 6);
        const int gw = bid * 8 + wave, NGW = G * 8;
        if constexpr (ph == 0) {
            LAS float* scr = (LAS float*)(lds + wave * 16384);
            for (int it = gw; it < 2 * 3072; it += NGW) {
                const int l = it / 3072; int r = it - l * 3072;
                unsigned char* wb = ws + (size_t)l * W_LAYER;
                if (r < 1792) { tr_item<true>(P.in[3] + (size_t)l * DM * DIN, DM, DIN, (bf16_t*)(wb + W_IN), P.in[2] + l * DM, scr, r, lane); continue; } r -= 1792;
                if (r < 128) { tr_item<false>(P.in[9] + (size_t)l * CD * CD, CD, CD, (bf16_t*)(wb + W_PW), nullptr, scr, r, lane); continue; } r -= 128;
                if (r < 512) { tr_item<false>(P.in[11] + (size_t)l * DM * DM, DM, DM, (bf16_t*)(wb + W_OUT), nullptr, scr, r, lane); continue; } r -= 512;
                if (r < 512) { tr_item<false>(P.in[13] + (size_t)l * DM * DM, DM, DM, (bf16_t*)(wb + W_PG), P.in[12] + l * DM, scr, r, lane); continue; } r -= 512;
                tr_item<false>(P.in[14] + (size_t)l * PLE * DM, PLE, DM, (bf16_t*)(wb + W_PLE), nullptr, scr, r, lane);
            }
            for (int row = gw; row < MT; row += NGW) {
                const f32x4* xr = (const f32x4*)(x + (size_t)row * DM) + lane;
                u32x2* ob = (u32x2*)(HB + (size_t)row * DM) + lane;
                float s = 0.f;
#pragma unroll
                for (int j = 0; j < 4; ++j) { const f32x4 v = xr[64 * j]; s += (v[0] * v[0] + v[1] * v[1]) + (v[2] * v[2] + v[3] * v[3]); u32x2 w; w[0] = pk2(v[0], v[1]); w[1] = pk2(v[2], v[3]); ob[64 * j] = w; }
                s = wave_sum(s, lane);
                if (lane < 16) ssA[(size_t)row * 16 + lane] = (lane == 0) ? s : 0.f;
            }
            {
                const f32x4* pp = (const f32x4*)P.in[1]; u32x2* pb = (u32x2*)(ws + WS_PB);
                for (int i = bid * 512 + tid; i < 2 * MT * PLE / 4; i += G * 512) { const f32x4 v = pp[i]; u32x2 w; w[0] = pk2(v[0], v[1]); w[1] = pk2(v[2], v[3]); pb[i] = w; }
            }
        } else if constexpr (ph == NPHASE - 1) {
            const float* fg = P.in[15];
            for (int row = gw; row < MT; row += NGW) {
                f32x4* xr = (f32x4*)(out + (size_t)row * DM) + lane;
                f32x4 v[4]; float s = 0.f;
#pragma unroll
                for (int j = 0; j < 4; ++j) { v[j] = xr[64 * j]; s += (v[j][0] * v[j][0] + v[j][1] * v[j][1]) + (v[j][2] * v[j][2] + v[j][3] * v[j][3]); }
                const float rs = frsq(wave_sum(s, lane) * (1.0f / DM) + EPS);
#pragma unroll
                for (int j = 0; j < 4; ++j) { const f32x4 g = *((const f32x4*)fg + lane + 64 * j); xr[64 * j] = v[j] * rs * g; }
            }
        } else {
            constexpr int l = (ph - 1) >> 2, k = (ph - 1) & 3;
            unsigned char* wb = ws + (size_t)l * W_LAYER;
            if constexpr (k == 0) {
                pg8::Gemm g{HB, (const bf16_t*)(wb + W_IN), MT, DIN, DM}; pg8::StaticOrder S; S.init(MT, DIN, G, bid);
                EpiIn E{Ub, VT, ssA};
                pg8::gemm_phase<EpiIn, pg8::StaticOrder, true, true>(lds, g, S, E, threadIdx.x);
            } else if constexpr (k == 1) {
                const float* aog = P.in[4] + l * HD;
                const float* dww = P.in[5] + (size_t)l * CWID * CD; const float* dwb = P.in[6] + l * CD;
                const float* lng = P.in[7] + l * CD; const float* lnb = P.in[8] + l * CD; const float* cog = P.in[10] + l * CD;
                const bf16_t* Wpw = (const bf16_t*)(wb + W_PW);
                for (int it = bid; it < 256; it += G) {
                    const int bh = it >> 2, pr = it & 3, b = bh >> 3, h = bh & 7;
#pragma unroll 1
                    for (int uu = 0; uu < 2; ++uu) attn_unit(Ub, VT, Yb, aog, b, h, uu == 0 ? 7 - pr : pr, lds);
#pragma unroll 1
                    for (int uu = 0; uu < 2; ++uu) conv_unit(Ub, Yb, dww, dwb, lng, lnb, Wpw, cog, 2 * it + uu, lds);
                }
                __syncthreads();
            } else if constexpr (k == 2) {
                pg8::Gemm g{Yb, (const bf16_t*)(wb + W_OUT), MT, DM, DM}; pg8::StaticOrder S; S.init(MT, DM, G, bid);
                EpiOut E{l == 0 ? x : out, out, H1B, ssB};
                pg8::gemm_phase<EpiOut, pg8::StaticOrder, true, true>(lds, g, S, E, threadIdx.x);
            } else {
                {
                    pg8::Gemm g{(const bf16_t*)(ws + WS_PB) + (size_t)l * MT * PLE, (const bf16_t*)(wb + W_PLE), MT, DM, PLE}; pg8::StaticOrder S; S.init(MT, DM, G, bid);
                    EpiE E{EB};
                    pg8::gemm_phase<EpiE, pg8::StaticOrder, true, true>(lds, g, S, E, threadIdx.x);
                }
                {
                    pg8::Gemm g{H1B, (const bf16_t*)(wb + W_PG), MT, DM, DM}; pg8::StaticOrder S; S.init(MT, DM, G, bid);
                    EpiGate E{out, EB, HB, ssB, ssA};
                    int t2 = threadIdx.x; asm volatile("" : "+v"(t2));
                    pg8::gemm_phase<EpiGate, pg8::StaticOrder, true, true>(lds, g, S, E, t2);
                }
            }
        }
    }
}


__global__ void __launch_bounds__(512, 2) fwd(Params P) {
    extern __shared__ __attribute__((aligned(16))) unsigned char lds_raw[];
    LAS unsigned char* lds = (LAS unsigned char*)lds_raw;
    const int lo = P.ph_lo, hi = P.ph_hi;
#define PHASE(k) if (lo <= (k) && (k) < hi) { run_phase<(k)>(P, lds); if ((k) + 1 < hi) cg::this_grid().sync(); }
    PHASE(0) PHASE(1) PHASE(2) PHASE(3) PHASE(4) PHASE(5) PHASE(6) PHASE(7) PHASE(8) PHASE(9)
#undef PHASE
}

#ifndef MK_N_LAUNCHES
#define MK_N_LAUNCHES 1
#endif
extern "C" void kernel_launch(void* const* d_in, const int* in_sizes, int n_in, void* d_out, int out_size, void* d_ws, size_t ws_size, hipStream_t stream) {
    static int grid = 0;
    if (grid == 0) {
        if (n_in != 16 || out_size != MT * DM || ws_size < WS_END) { fprintf(stderr, "kernel_launch: unexpected shapes (n_in %d, out %d, ws %zu)\n", n_in, out_size, ws_size); grid = -1; return; }
        int dev = 0, cus = 0, per_cu = 0;
        (void)hipGetDevice(&dev);
        (void)hipDeviceGetAttribute(&cus, hipDeviceAttributeMultiprocessorCount, dev);
        if (hipFuncSetAttribute((const void*)fwd, hipFuncAttributeMaxDynamicSharedMemorySize, LDS_BYTES) != hipSuccess) { fprintf(stderr, "kernel_launch: hipFuncSetAttribute failed\n"); grid = -1; return; }
        if (hipOccupancyMaxActiveBlocksPerMultiprocessor(&per_cu, (const void*)fwd, 512, LDS_BYTES) != hipSuccess || per_cu < 1) { fprintf(stderr, "kernel_launch: occupancy query says %d\n", per_cu); per_cu = 1; }
        (void)hipGetLastError();
        grid = cus * 1;
        if (grid <= 0) grid = 256;
    }
    if (grid < 0) return;
    Params p{};
    for (int i = 0; i < 16; ++i) p.in[i] = (const float*)d_in[i];
    p.out = (float*)d_out; p.ws = (unsigned char*)d_ws;
#if MK_N_LAUNCHES == 1
    p.ph_lo = 0; p.ph_hi = NPHASE;
    void* args[] = {&p};
    hipError_t e = hipLaunchCooperativeKernel((const void*)fwd, dim3(grid), dim3(512), args, LDS_BYTES, stream);
    if (e != hipSuccess) fprintf(stderr, "kernel_launch: cooperative launch failed: %s (grid %d)\n", hipGetErrorString(e), grid);
#else
    for (int ph = 0; ph < NPHASE; ++ph) {
        p.ph_lo = ph; p.ph_hi = ph + 1;
        hipLaunchKernelGGL(fwd, dim3(grid), dim3(512), LDS_BYTES, stream, p);
    }
#endif
}
```

```cpp
#include <hip/hip_runtime.h>
#include <hip/hip_cooperative_groups.h>
#include <cstdio>
#include <cstdint>
namespace cg = cooperative_groups;
namespace pg8 {
#define PG8_LAS __attribute__((address_space(3)))
typedef unsigned short bf16_t;
typedef short bf16x8 __attribute__((ext_vector_type(8)));
typedef float f32x4 __attribute__((ext_vector_type(4)));
typedef unsigned u32x4 __attribute__((ext_vector_type(4)));
constexpr int BM = 256, BK = 64, HALF = 128, HTB = HALF * BK * 2  , STAGE_BYTES = 8 * HTB, NXCD = 8, WGM = 8;

__host__ __device__ __forceinline__ int lds_byte(int r, int c) { const int st = (r >> 4) * 2 + (c >> 5), rr = r & 15, cc = c & 31, ob = rr * 64 + cc * 2; return st * 1024 + (ob ^ (((ob >> 9) & 1) << 5)); }
__host__ __device__ __forceinline__ void stage_rc(int b, int& R, int& C) { const int st = b / 1024, sb = b % 1024, swz = sb ^ (((sb >> 9) & 1) << 5); R = (st >> 1) * 16 + swz / 64; C = (st & 1) * 32 + (swz % 64) / 2; }
__host__ __device__ __forceinline__ int perm32(int rho) { const int n = rho >> 4, i = rho & 15; return 8 * (i >> 2) + 4 * n + (i & 3); }

struct Unit { int pm, pn; };
struct Gemm { const bf16_t* A; const bf16_t* Bt; int M, N, K; };

struct StaticOrder {
    int nM, nN, nwg, G, c;
    __host__ __device__ void init(int M, int N, int G_, int c_) { nM = M / BM; nN = N / BM; nwg = nM * nN; G = G_; c = c_; }
    __host__ __device__ bool next(int i, Unit& u) const {
        const long L = (long)i * G + c; if (L >= nwg) return false;
        int wgid = (int)L; { const int q = nwg / NXCD, r = nwg % NXCD, xcd = wgid % NXCD, off = wgid / NXCD; wgid = (xcd < r ? xcd * (q + 1) : r * (q + 1) + (xcd - r) * q) + off; }
        const int nig = WGM * nN, gid = wgid / nig, fm = gid * WGM, gsz = (nM - fm) < WGM ? (nM - fm) : WGM;
        u.pm = fm + ((wgid % nig) % gsz); u.pn = (wgid % nig) / gsz; return true;
    }
    __device__ __forceinline__ void a_ready(const Unit&) const {}
    __device__ __forceinline__ void done(const Unit&) const {}
};

template <class Epi, class Sched, bool ALIGN_EPI = false, bool SP2 = false>
__device__ __forceinline__ void gemm_phase(PG8_LAS unsigned char* lds, const Gemm g, const Sched& S, const Epi& E, const int tid_in) {
    const int tid = tid_in, wid = __builtin_amdgcn_readfirstlane(tid >> 6), lane = tid & 63, wr = wid >> 2, wc = wid & 3, fr = lane & 15, fq = lane >> 4;
    const int K = g.K, nt = K / BK;
    unsigned voffA[2], voffB[2];
#pragma unroll
    for (int i = 0; i < 2; ++i) { int R, C; stage_rc(tid * 16 + i * 8192, R, C); const int Rb = Epi::PERM ? ((R & ~31) + perm32(R & 31)) : R;
        voffA[i] = (unsigned)(R * K + C) * 2u; voffB[i] = (unsigned)(Rb * K + C) * 2u; }
    const size_t kstep = (size_t)(BK * 2);
    const size_t hstep = (size_t)HALF * K * 2;
    const size_t tstep = 2 * hstep;
    const unsigned ldsw = (unsigned)wid * 1024u;
    const int aoff = lds_byte(wr * 64 + fr, fq * 8), boff = lds_byte(wc * 32 + fr, fq * 8);
#define PG8_SA(b, h) (((b) * 2 + (h)) * HTB)
#define PG8_SB(b, h) ((4 + (b) * 2 + (h)) * HTB)
#define PG8_STAGE(bufoff, gbase, voff) do { _Pragma("unroll") for (int _i = 0; _i < 2; ++_i) \
        __builtin_amdgcn_global_load_lds((const unsigned*)((const char*)(gbase) + (voff)[_i]), (PG8_LAS unsigned*)(lds + (bufoff) + ldsw + _i * 8192), 16, 0, 0); } while (0)
#define PG8_LDA(dst, b, h) do { _Pragma("unroll") for (int m = 0; m < 4; ++m) _Pragma("unroll") for (int k = 0; k < 2; ++k) dst[m][k] = *(const PG8_LAS bf16x8*)(lds + PG8_SA(b, h) + aoff + m * 2048 + k * 1024); } while (0)
#define PG8_LDB(dst, b, h) do { _Pragma("unroll") for (int n = 0; n < 2; ++n) _Pragma("unroll") for (int k = 0; k < 2; ++k) dst[n][k] = *(const PG8_LAS bf16x8*)(lds + PG8_SB(b, h) + boff + n * 2048 + k * 1024); } while (0)
#define PG8_MMA(ai, bj, At, Bt) do { __builtin_amdgcn_s_setprio(1); _Pragma("unroll") for (int m = 0; m < 4; ++m) _Pragma("unroll") for (int n = 0; n < 2; ++n) _Pragma("unroll") for (int k = 0; k < 2; ++k) \
        acc[ai][bj][m][n] = __builtin_amdgcn_mfma_f32_16x16x32_bf16(Bt[n][k], At[m][k], acc[ai][bj][m][n], 0, 0, 0); __builtin_amdgcn_s_setprio(0); } while (0)
#define PG8_WAIT_V(n) asm volatile("s_waitcnt vmcnt(" #n ")" ::: "memory")
#define PG8_WAIT_L(n) asm volatile("s_waitcnt lgkmcnt(" #n ")" ::: "memory")
#define PG8_BAR __builtin_amdgcn_s_barrier()
#define PG8_SCHED __builtin_amdgcn_sched_barrier(0)
    Unit cur, nxt; int ui = 0;
    if (!S.next(0, cur)) return;
    f32x4 acc[2][2][4][2];
#pragma unroll
    for (int a = 0; a < 2; ++a)
#pragma unroll
        for (int b = 0; b < 2; ++b)
#pragma unroll
            for (int m = 0; m < 4; ++m)
#pragma unroll
                for (int n = 0; n < 2; ++n) acc[a][b][m][n] = (f32x4){0.f, 0.f, 0.f, 0.f};
    bf16x8 At[4][2], B0[2][2], B1[2][2];
    const char* cA = (const char*)g.A + (size_t)cur.pm * tstep; const char* cB = (const char*)g.Bt + (size_t)cur.pn * tstep;
    S.a_ready(cur);
    if constexpr (SP2) {
        PG8_STAGE(PG8_SB(0, 0), cB, voffB); PG8_STAGE(PG8_SB(0, 1), cB + hstep, voffB); PG8_STAGE(PG8_SA(0, 0), cA, voffA); PG8_STAGE(PG8_SA(0, 1), cA + hstep, voffA);
        if (wr == 1) PG8_BAR;
        PG8_WAIT_V(2); PG8_BAR;
        PG8_STAGE(PG8_SB(1, 0), cB + kstep, voffB); PG8_STAGE(PG8_SA(1, 0), cA + kstep, voffA); PG8_STAGE(PG8_SB(1, 1), cB + hstep + kstep, voffB);
        PG8_WAIT_V(6); PG8_BAR;
    } else {
        PG8_STAGE(PG8_SB(0, 0), cB, voffB); PG8_STAGE(PG8_SA(0, 0), cA, voffA); PG8_STAGE(PG8_SB(0, 1), cB + hstep, voffB); PG8_STAGE(PG8_SA(0, 1), cA + hstep, voffA);
        if (wr == 1) PG8_BAR;
        PG8_WAIT_V(4); PG8_BAR;
        PG8_STAGE(PG8_SB(1, 0), cB + kstep, voffB); PG8_STAGE(PG8_SA(1, 0), cA + kstep, voffA); PG8_STAGE(PG8_SB(1, 1), cB + hstep + kstep, voffB);
        PG8_WAIT_V(6); PG8_BAR;
    }
    for (;;) {
        const bool has_next = S.next(ui + 1, nxt);
        const char* nA = has_next ? (const char*)g.A + (size_t)nxt.pm * tstep : cA; const char* nB = has_next ? (const char*)g.Bt + (size_t)nxt.pn * tstep : cB;
        for (int t = 0; t < nt; t += 2) {
            const bool last = (t == nt - 2);
            const char* a1 = cA + (size_t)(t + 1) * kstep;
            const char* a2 = last ? nA : cA + (size_t)(t + 2) * kstep; const char* b2 = last ? nB : cB + (size_t)(t + 2) * kstep;
            const char* a3 = a2 + kstep; const char* b3 = b2 + kstep;
            if (last && has_next) S.a_ready(nxt);
            if constexpr (SP2) {
            PG8_LDB(B0, 0, 0); PG8_LDB(B1, 0, 1); PG8_SCHED; PG8_LDA(At, 0, 0); PG8_STAGE(PG8_SA(1, 1), a1 + hstep, voffA);
            PG8_WAIT_V(8); PG8_WAIT_L(0); PG8_BAR; PG8_MMA(0, 0, At, B0); PG8_MMA(0, 1, At, B1); PG8_BAR; PG8_SCHED;
            PG8_LDA(At, 0, 1); PG8_STAGE(PG8_SB(0, 0), b2, voffB); PG8_STAGE(PG8_SB(0, 1), b2 + hstep, voffB); PG8_STAGE(PG8_SA(0, 0), a2, voffA);
            PG8_WAIT_V(8); PG8_WAIT_L(0); PG8_BAR; PG8_MMA(1, 0, At, B0); PG8_MMA(1, 1, At, B1); PG8_BAR; PG8_SCHED;
            PG8_LDB(B0, 1, 0); PG8_LDB(B1, 1, 1); PG8_SCHED; PG8_LDA(At, 1, 0); PG8_STAGE(PG8_SA(0, 1), a2 + hstep, voffA);
            PG8_WAIT_V(8); PG8_WAIT_L(0); PG8_BAR; PG8_MMA(0, 0, At, B0); PG8_MMA(0, 1, At, B1); PG8_BAR; PG8_SCHED;
            PG8_LDA(At, 1, 1); PG8_STAGE(PG8_SB(1, 0), b3, voffB); PG8_STAGE(PG8_SB(1, 1), b3 + hstep, voffB); PG8_STAGE(PG8_SA(1, 0), a3, voffA);
            PG8_WAIT_V(8); PG8_WAIT_L(0); PG8_BAR; PG8_MMA(1, 0, At, B0); PG8_MMA(1, 1, At, B1); PG8_BAR; PG8_SCHED;
            } else {
            PG8_LDB(B0, 0, 0); PG8_SCHED; PG8_LDA(At, 0, 0); PG8_STAGE(PG8_SA(1, 1), a1 + hstep, voffA);
            PG8_WAIT_L(8); PG8_BAR; PG8_WAIT_L(0); PG8_MMA(0, 0, At, B0); PG8_BAR; PG8_SCHED;
            PG8_LDB(B1, 0, 1); PG8_STAGE(PG8_SB(0, 0), b2, voffB);
            PG8_BAR; PG8_WAIT_L(0); PG8_MMA(0, 1, At, B1); PG8_BAR;
            PG8_LDA(At, 0, 1); PG8_STAGE(PG8_SA(0, 0), a2, voffA);
            PG8_BAR; PG8_WAIT_L(0); PG8_MMA(1, 0, At, B0); PG8_BAR; PG8_SCHED;
            PG8_STAGE(PG8_SB(0, 1), b2 + hstep, voffB);
            PG8_WAIT_V(6); PG8_BAR; PG8_MMA(1, 1, At, B1); PG8_BAR;
            PG8_LDB(B0, 1, 0); PG8_SCHED; PG8_LDA(At, 1, 0); PG8_STAGE(PG8_SA(0, 1), a2 + hstep, voffA);
            PG8_WAIT_L(8); PG8_BAR; PG8_WAIT_L(0); PG8_MMA(0, 0, At, B0); PG8_BAR; PG8_SCHED;
            PG8_LDB(B1, 1, 1); PG8_STAGE(PG8_SB(1, 0), b3, voffB);
            PG8_BAR; PG8_WAIT_L(0); PG8_MMA(0, 1, At, B1); PG8_BAR;
            PG8_LDA(At, 1, 1); PG8_STAGE(PG8_SA(1, 0), a3, voffA);
            PG8_BAR; PG8_WAIT_L(0); PG8_MMA(1, 0, At, B0); PG8_BAR; PG8_SCHED;
            PG8_STAGE(PG8_SB(1, 1), b3 + hstep, voffB);
            PG8_WAIT_V(6); PG8_BAR; PG8_MMA(1, 1, At, B1); PG8_BAR;
            }
        }
        if constexpr (ALIGN_EPI) { if (wr == 0) PG8_BAR; }
        if constexpr (!Epi::AFTER_DRAIN) { E(acc, cur, wr, wc, fr, fq); S.done(cur); }
        if (!has_next) break;
#pragma unroll
        for (int a = 0; a < 2; ++a)
#pragma unroll
            for (int b = 0; b < 2; ++b)
#pragma unroll
                for (int m = 0; m < 4; ++m)
#pragma unroll
                    for (int n = 0; n < 2; ++n) acc[a][b][m][n] = (f32x4){0.f, 0.f, 0.f, 0.f};
        cur = nxt; cA = nA; cB = nB; ++ui;
        if constexpr (ALIGN_EPI) { if (wr == 1) PG8_BAR; }
    }
    PG8_WAIT_V(0);
    if constexpr (!ALIGN_EPI) { if (wr == 0) PG8_BAR; }
    PG8_BAR;
    if constexpr (Epi::AFTER_DRAIN) { E.fused(acc, cur, wr, wc, fr, fq, lds, wid, lane); S.done(cur); }
#undef PG8_SA
#undef PG8_SB
#undef PG8_STAGE
#undef PG8_LDA
#undef PG8_LDB
#undef PG8_MMA
#undef PG8_WAIT_V
#undef PG8_WAIT_L
#undef PG8_BAR
#undef PG8_SCHED
}
}

#define LAS __attribute__((address_space(3)))
typedef unsigned short bf16_t;
typedef short bf16x8 __attribute__((ext_vector_type(8)));
typedef float f32x4 __attribute__((ext_vector_type(4)));
typedef float f32x2 __attribute__((ext_vector_type(2)));
typedef float f32x16 __attribute__((ext_vector_type(16)));
typedef unsigned u32x4 __attribute__((ext_vector_type(4)));
typedef unsigned u32x2 __attribute__((ext_vector_type(2)));
typedef __bf16 bf16x2_t __attribute__((ext_vector_type(2)));

constexpr int NB = 8, SEQ = 2048, DM = 1024, MT = NB * SEQ, DIN = 3584, NH = 8, HD = 64, CWID = 31, PLE = 256, CD = 512;
constexpr float EPS = 1e-6f;
constexpr float QSCALE = 0.125f * 1.4426950408889634f;

constexpr size_t MiB = 1u << 20;
constexpr size_t W_IN = 0, W_PW = 7340032, W_OUT = W_PW + 524288, W_PG = W_OUT + 2097152, W_PLE = W_PG + 2097152, W_LAYER = 12 * MiB;
static_assert(W_PLE + 524288 == W_LAYER, "weight map");
constexpr size_t WS_PB = 24 * MiB, WS_HB = 40 * MiB, WS_Y = 72 * MiB, WS_VT = 104 * MiB, WS_SSA = 120 * MiB, WS_SSB = 121 * MiB, WS_U = 122 * MiB;
constexpr size_t WS_H1B = WS_U, WS_EB = WS_U + 32 * MiB, WS_END = 234 * MiB;
constexpr int LDS_BYTES = 147456;
constexpr int NPHASE = 10;
#ifndef PROBE_DUP
#define PROBE_DUP 0
#endif

__device__ __forceinline__ unsigned pk2(float lo, float hi) { f32x2 v = {lo, hi}; bf16x2_t b = __builtin_convertvector(v, bf16x2_t); return __builtin_bit_cast(unsigned, b); }
__device__ __forceinline__ float bflo(unsigned u) { return __builtin_bit_cast(float, u << 16); }
__device__ __forceinline__ float bfhi(unsigned u) { return __builtin_bit_cast(float, u & 0xffff0000u); }
__device__ __forceinline__ float fexp2(float x) { return __builtin_amdgcn_exp2f(x); }
__device__ __forceinline__ float flog2(float x) { return __builtin_amdgcn_logf(x); }
__device__ __forceinline__ float frcp(float x) { return __builtin_amdgcn_rcpf(x); }
__device__ __forceinline__ float frsq(float x) { return __builtin_amdgcn_rsqf(x); }
__device__ __forceinline__ float sigmoidf_(float x) { return frcp(1.0f + fexp2(-1.4426950408889634f * x)); }
__device__ __forceinline__ float siluf_(float x) { return x * sigmoidf_(x); }
#define MFMA32(a, b, c) __builtin_amdgcn_mfma_f32_32x32x16_bf16((a), (b), (c), 0, 0, 0)

__device__ __forceinline__ float shx(float v, int m, int lane) { return __builtin_bit_cast(float, __builtin_amdgcn_ds_bpermute((lane ^ m) << 2, __builtin_bit_cast(int, v))); }
__device__ __forceinline__ float wave_sum(float v, int lane) {
#pragma unroll
    for (int o = 1; o < 64; o <<= 1) v += shx(v, o, lane);
    return v;
}
__device__ __forceinline__ float row_rstd(const float* ss, int row, int fq, int lane) {
    const f32x4 p = *(const f32x4*)(ss + (size_t)row * 16 + fq * 4);
    float s = (p[0] + p[1]) + (p[2] + p[3]);
    s += shx(s, 16, lane); s += shx(s, 32, lane);
    return frsq(s * (1.0f / DM) + EPS);
}

struct EpiIn {
    static constexpr bool PERM = true, AFTER_DRAIN = false;
    bf16_t* U; bf16_t* VT; const float* ss;
    __device__ __forceinline__ void operator()(const f32x4 (&acc)[2][2][4][2], const pg8::Unit& u, int, int, int, int) const {
        int t_ = threadIdx.x; asm volatile("" : "+v"(t_));
        const int lane = t_ & 63, fr = lane & 15, fq = lane >> 4, wid_ = __builtin_amdgcn_readfirstlane(t_ >> 6), wr = wid_ >> 2, wc = wid_ & 3;
        const int pn = u.pn;
#pragma unroll
        for (int ai = 0; ai < 2; ++ai)
#pragma unroll
            for (int m = 0; m < 4; ++m) {
                const int row = u.pm * 256 + ai * 128 + wr * 64 + m * 16 + fr;
                const float rs = row_rstd(ss, row, fq, lane);
#pragma unroll
                for (int bj = 0; bj < 2; ++bj) {
                    const int col0 = pn * 256 + bj * 128 + wc * 32 + 8 * fq;
                    f32x4 v0 = acc[ai][bj][m][0] * rs, v1 = acc[ai][bj][m][1] * rs;
                    if (pn < 4) {
                        const float sc = pn < 2 ? QSCALE : 1.0f;
                        v0 = v0 * sc; v1 = v1 * sc;
                        u32x4 w; w[0] = pk2(v0[0], v0[1]); w[1] = pk2(v0[2], v0[3]); w[2] = pk2(v1[0], v1[1]); w[3] = pk2(v1[2], v1[3]);
                        *(u32x4*)(U + (size_t)row * DIN + col0) = w;
                    } else if (pn < 6) {
                        const int vc = col0 - 1024, hh = vc >> 6, d0 = vc & 63, b = row >> 11, s = row & 2047;
                        bf16_t* vp = VT + ((size_t)((b * NH + hh) * HD + d0)) * SEQ + s;
                        const unsigned w0 = pk2(v0[0], v0[1]), w1 = pk2(v0[2], v0[3]), w2 = pk2(v1[0], v1[1]), w3 = pk2(v1[2], v1[3]);
                        vp[0 * SEQ] = (bf16_t)(w0 & 0xffffu); vp[1 * SEQ] = (bf16_t)(w0 >> 16);
                        vp[2 * SEQ] = (bf16_t)(w1 & 0xffffu); vp[3 * SEQ] = (bf16_t)(w1 >> 16);
                        vp[4 * SEQ] = (bf16_t)(w2 & 0xffffu); vp[5 * SEQ] = (bf16_t)(w2 >> 16);
                        vp[6 * SEQ] = (bf16_t)(w3 & 0xffffu); vp[7 * SEQ] = (bf16_t)(w3 >> 16);
                    } else if (pn < 8 || pn >= 12) {
                        u32x4 w; w[0] = pk2(siluf_(v0[0]), siluf_(v0[1])); w[1] = pk2(siluf_(v0[2]), siluf_(v0[3]));
                        w[2] = pk2(siluf_(v1[0]), siluf_(v1[1])); w[3] = pk2(siluf_(v1[2]), siluf_(v1[3]));
                        *(u32x4*)(U + (size_t)row * DIN + col0) = w;
                    } else {
                        const int ch0 = (col0 - 2048) >> 1;
                        u32x2 w; w[0] = pk2(v0[0] * sigmoidf_(v0[1]), v0[2] * sigmoidf_(v0[3])); w[1] = pk2(v1[0] * sigmoidf_(v1[1]), v1[2] * sigmoidf_(v1[3]));
                        *(u32x2*)(U + (size_t)row * DIN + 2048 + ch0) = w;
                    }
                }
                asm volatile("" ::: "memory");
            }
    }
};

struct EpiOut {
    static constexpr bool PERM = false, AFTER_DRAIN = false;
    const float* base; float* out; bf16_t* HB; float* ss;
    __device__ __forceinline__ void operator()(const f32x4 (&acc)[2][2][4][2], const pg8::Unit& u, int, int, int, int) const {
        int t_ = threadIdx.x; asm volatile("" : "+v"(t_));
        const int lane = t_ & 63, fr = lane & 15, fq = lane >> 4, wid_ = __builtin_amdgcn_readfirstlane(t_ >> 6), wr = wid_ >> 2, wc = wid_ & 3;
#pragma unroll
        for (int ai = 0; ai < 2; ++ai)
#pragma unroll
            for (int m = 0; m < 4; ++m) {
                const int row = u.pm * 256 + ai * 128 + wr * 64 + m * 16 + fr;
                float sq = 0.f;
#pragma unroll
                for (int bj = 0; bj < 2; ++bj)
#pragma unroll
                    for (int n = 0; n < 2; ++n) {
                        const size_t off = (size_t)row * DM + u.pn * 256 + bj * 128 + wc * 32 + n * 16 + 4 * fq;
                        const f32x4 h = *(const f32x4*)(base + off) + acc[ai][bj][m][n];
                        *(f32x4*)(out + off) = h;
                        u32x2 w; w[0] = pk2(h[0], h[1]); w[1] = pk2(h[2], h[3]);
                        *(u32x2*)(HB + off) = w;
                        sq += (h[0] * h[0] + h[1] * h[1]) + (h[2] * h[2] + h[3] * h[3]);
                    }
                sq += shx(sq, 16, lane); sq += shx(sq, 32, lane);
                if (fq == 0) ss[(size_t)row * 16 + u.pn * 4 + wc] = sq;
                asm volatile("" ::: "memory");
            }
    }
};

struct EpiE {
    static constexpr bool PERM = false, AFTER_DRAIN = false;
    float* EB;
    __device__ __forceinline__ void operator()(const f32x4 (&acc)[2][2][4][2], const pg8::Unit& u, int, int, int, int) const {
        int t_ = threadIdx.x; asm volatile("" : "+v"(t_));
        const int lane = t_ & 63, fr = lane & 15, fq = lane >> 4, wid_ = __builtin_amdgcn_readfirstlane(t_ >> 6), wr = wid_ >> 2, wc = wid_ & 3;
#pragma unroll
        for (int ai = 0; ai < 2; ++ai)
#pragma unroll
            for (int m = 0; m < 4; ++m) {
                const int row = u.pm * 256 + ai * 128 + wr * 64 + m * 16 + fr;
#pragma unroll
                for (int bj = 0; bj < 2; ++bj)
#pragma unroll
                    for (int n = 0; n < 2; ++n) {
                        const size_t off = (size_t)row * DM + u.pn * 256 + bj * 128 + wc * 32 + n * 16 + 4 * fq;
                        *(f32x4*)(EB + off) = acc[ai][bj][m][n];
                    }
                asm volatile("" ::: "memory");
            }
    }
};

struct EpiGate {
    static constexpr bool PERM = false, AFTER_DRAIN = false;
    float* out; const float* EB; bf16_t* HB; const float* ss_in; float* ss_out;
    __device__ __forceinline__ void operator()(const f32x4 (&acc)[2][2][4][2], const pg8::Unit& u, int, int, int, int) const {
        int t_ = threadIdx.x; asm volatile("" : "+v"(t_));
        const int lane = t_ & 63, fr = lane & 15, fq = lane >> 4, wid_ = __builtin_amdgcn_readfirstlane(t_ >> 6), wr = wid_ >> 2, wc = wid_ & 3;
#pragma unroll
        for (int ai = 0; ai < 2; ++ai)
#pragma unroll
            for (int m = 0; m < 4; ++m) {
                const int row = u.pm * 256 + ai * 128 + wr * 64 + m * 16 + fr;
                const float rs = row_rstd(ss_in, row, fq, lane);
                float sq = 0.f;
#pragma unroll
                for (int bj = 0; bj < 2; ++bj)
#pragma unroll
                    for (int n = 0; n < 2; ++n) {
                        const size_t off = (size_t)row * DM + u.pn * 256 + bj * 128 + wc * 32 + n * 16 + 4 * fq;
                        const f32x4 a = acc[ai][bj][m][n] * rs;
                        const f32x4 e = *(const f32x4*)(EB + off);
                        f32x4 h = *(const f32x4*)(out + off);
                        h[0] += e[0] * sigmoidf_(a[0]); h[1] += e[1] * sigmoidf_(a[1]); h[2] += e[2] * sigmoidf_(a[2]); h[3] += e[3] * sigmoidf_(a[3]);
                        *(f32x4*)(out + off) = h;
                        u32x2 w; w[0] = pk2(h[0], h[1]); w[1] = pk2(h[2], h[3]);
                        *(u32x2*)(HB + off) = w;
                        sq += (h[0] * h[0] + h[1] * h[1]) + (h[2] * h[2] + h[3] * h[3]);
                    }
                sq += shx(sq, 16, lane); sq += shx(sq, 32, lane);
                if (fq == 0) ss_out[(size_t)row * 16 + u.pn * 4 + wc] = sq;
                asm volatile("" ::: "memory");
            }
    }
};

template <bool REMAP>
__device__ __forceinline__ void tr_item(const float* W, int K, int N, bf16_t* WT, const float* g, LAS float* scr, int item, int lane) {
    const int nblk = N / 32, kb = item / nblk, nb = item % nblk, k0 = 64 * kb, n0 = 32 * nb;
    int src = n0 + (lane & 31);
    if (REMAP) { if (src >= 2048 && src < 3072) { const int jj = src - 2048; src = (jj & 1) ? 2560 + (jj >> 1) : 2048 + (jj >> 1); } }
#pragma unroll 8
    for (int i = 0; i < 32; ++i) { const int kk = 2 * i + (lane >> 5); float v = W[(size_t)(k0 + kk) * N + src]; if (g) v *= g[k0 + kk]; scr[kk * 33 + (lane & 31)] = v; }
    asm volatile("s_waitcnt lgkmcnt(0)" ::: "memory");
    const int c = lane & 7;
#pragma unroll
    for (int j = 0; j < 4; ++j) { const int n = (lane >> 3) + 8 * j; const LAS float* s = scr + (8 * c) * 33 + n;
        u32x4 o; o[0] = pk2(s[0 * 33], s[1 * 33]); o[1] = pk2(s[2 * 33], s[3 * 33]); o[2] = pk2(s[4 * 33], s[5 * 33]); o[3] = pk2(s[6 * 33], s[7 * 33]);
        *(u32x4*)(WT + (size_t)(n0 + n) * K + k0 + 8 * c) = o; }
    asm volatile("s_waitcnt lgkmcnt(0)" ::: "memory");
}

constexpr int AK_STRIDE = 144, AV_STRIDE = 136, A_KBYTES = 64 * AK_STRIDE, A_VBYTES = 64 * AV_STRIDE, A_BUF = 18432;
static_assert(A_KBYTES + A_VBYTES <= A_BUF, "attention LDS buffer");

__device__ __forceinline__ void attn_unit(const bf16_t* U, const bf16_t* VT, bf16_t* Y, const float* aog, int b, int h, int qb, LAS unsigned char* lds) {
    int tid = threadIdx.x; asm volatile("" : "+v"(tid));
    const int wave = __builtin_amdgcn_readfirstlane(tid >> 6), lane = tid & 63, l31 = lane & 31, hi = lane >> 5;
    const int q0 = qb * 256 + wave * 32, t = q0 + l31;
    const size_t trow = (size_t)(b * SEQ + t);
    bf16x8 qf[4];
    {
        const bf16_t* qp = U + trow * DIN + h * HD + 8 * hi;
#pragma unroll
        for (int s = 0; s < 4; ++s) qf[s] = *(const bf16x8*)(qp + 16 * s);
    }
    f32x16 o0, o1;
#pragma unroll
    for (int i = 0; i < 16; ++i) { o0[i] = 0.f; o1[i] = 0.f; }
    float C = 0.f;
    const int ktmax = 4 * qb + 3, wkt = (q0 + 30) >> 6;
    const int srow = tid >> 3, sch = tid & 7;
    const bf16_t* gk = U + (size_t)(b * SEQ + srow) * DIN + 512 + h * HD + sch * 8;
    const bf16_t* gv = VT + ((size_t)((b * NH + h) * HD + srow)) * SEQ + sch * 8;
    const int kwoff = srow * AK_STRIDE + sch * 16, vwoff = A_KBYTES + srow * AV_STRIDE + sch * 16;
    __syncthreads();
    {
        const u32x4 kr = *(const u32x4*)(gk + (size_t)ktmax * 64 * DIN), vr = *(const u32x4*)(gv + ktmax * 64);
        *(LAS u32x4*)(lds + kwoff) = kr;
        u32x2 a = {vr[0], vr[1]}, c = {vr[2], vr[3]};
        *(LAS u32x2*)(lds + vwoff) = a; *(LAS u32x2*)(lds + vwoff + 8) = c;
    }
    __syncthreads();
    int cur = 0;
    LAS unsigned* dflag = (LAS unsigned*)(lds + 2 * A_BUF);
    bool wdone = false;
    for (int kt = ktmax; kt >= 0; --kt) {
        u32x4 kr = {0u, 0u, 0u, 0u}, vr = {0u, 0u, 0u, 0u};
        if (kt > 0) { kr = *(const u32x4*)(gk + (size_t)(kt - 1) * 64 * DIN); vr = *(const u32x4*)(gv + (kt - 1) * 64); }
        if (kt <= wkt && !wdone) {
            const LAS unsigned char* kb = lds + cur * A_BUF;
            const LAS unsigned char* vb = kb + A_KBYTES;
            f32x16 p0, p1;
#pragma unroll
            for (int i = 0; i < 16; ++i) { p0[i] = 0.f; p1[i] = 0.f; }
#pragma unroll
            for (int s = 0; s < 4; ++s) {
                const bf16x8 ka = *(const LAS bf16x8*)(kb + l31 * AK_STRIDE + 32 * s + 16 * hi);
                const bf16x8 kc = *(const LAS bf16x8*)(kb + (32 + l31) * AK_STRIDE + 32 * s + 16 * hi);
                p0 = MFMA32(ka, qf[s], p0); p1 = MFMA32(kc, qf[s], p1);
            }
            const int lim0 = t - (64 * kt + 4 * hi), lim1 = lim0 - 32;
            f32x16 l0, l1;
            float G0[4], G1[4];
#pragma unroll
            for (int g = 0; g < 4; ++g) {
                float s0 = 0.f, s1 = 0.f;
#pragma unroll
                for (int i = 0; i < 4; ++i) {
                    const int r = 4 * g + i, cr = i + 8 * g;
                    const float z0 = p0[r], z1 = p1[r];
                    const float sp0 = fmaxf(z0, 0.f) + flog2(1.0f + fexp2(-fabsf(z0)));
                    const float sp1 = fmaxf(z1, 0.f) + flog2(1.0f + fexp2(-fabsf(z1)));
                    const float a0 = (cr < lim0) ? -sp0 : 0.f, a1 = (cr < lim1) ? -sp1 : 0.f;
                    l0[r] = a0; l1[r] = a1; s0 += a0; s1 += a1;
                }
                G0[g] = s0; G1[g] = s1;
            }
            float X0[4], X1[4];
#pragma unroll
            for (int g = 0; g < 4; ++g) { X0[g] = shx(G0[g], 32, lane); X1[g] = shx(G1[g], 32, lane); }
            float run = C;
#pragma unroll
            for (int g = 3; g >= 0; --g) {
                float a = run + (hi == 0 ? X1[g] : 0.f);
#pragma unroll
                for (int i = 3; i >= 0; --i) { const int r = 4 * g + i, cr = i + 8 * g; a += l1[r]; const float e = fexp2(p1[r] + a); p1[r] = (cr < lim1) ? e : 0.f; }
                run += G1[g] + X1[g];
            }
#pragma unroll
            for (int g = 3; g >= 0; --g) {
                float a = run + (hi == 0 ? X0[g] : 0.f);
#pragma unroll
                for (int i = 3; i >= 0; --i) { const int r = 4 * g + i, cr = i + 8 * g; a += l0[r]; const float e = fexp2(p0[r] + a); p0[r] = (cr < lim0) ? e : 0.f; }
                run += G0[g] + X0[g];
            }
            C = run;
#pragma unroll
            for (int kh = 0; kh < 2; ++kh)
#pragma unroll
                for (int sh = 0; sh < 2; ++sh) {
                    u32x4 xw;
                    if (kh == 0) { xw[0] = pk2(p0[8 * sh + 0], p0[8 * sh + 1]); xw[1] = pk2(p0[8 * sh + 2], p0[8 * sh + 3]); xw[2] = pk2(p0[8 * sh + 4], p0[8 * sh + 5]); xw[3] = pk2(p0[8 * sh + 6], p0[8 * sh + 7]); }
                    else         { xw[0] = pk2(p1[8 * sh + 0], p1[8 * sh + 1]); xw[1] = pk2(p1[8 * sh + 2], p1[8 * sh + 3]); xw[2] = pk2(p1[8 * sh + 4], p1[8 * sh + 5]); xw[3] = pk2(p1[8 * sh + 6], p1[8 * sh + 7]); }
                    const bf16x8 xf = __builtin_bit_cast(bf16x8, xw);
                    const int koff = 2 * (32 * kh + 16 * sh + 4 * hi);
                    {
                        const LAS unsigned char* vp = vb + l31 * AV_STRIDE + koff;
                        const u32x2 lo = *(const LAS u32x2*)vp, hh = *(const LAS u32x2*)(vp + 16);
                        u32x4 vw = {lo[0], lo[1], hh[0], hh[1]};
                        o0 = MFMA32(__builtin_bit_cast(bf16x8, vw), xf, o0);
                    }
                    {
                        const LAS unsigned char* vp = vb + (32 + l31) * AV_STRIDE + koff;
                        const u32x2 lo = *(const LAS u32x2*)vp, hh = *(const LAS u32x2*)(vp + 16);
                        u32x4 vw = {lo[0], lo[1], hh[0], hh[1]};
                        o1 = MFMA32(__builtin_bit_cast(bf16x8, vw), xf, o1);
                    }
                }
        }
        wdone = (__builtin_amdgcn_ballot_w64(C > -160.0f) == 0ull);
        if (lane == 0) dflag[(kt & 1) * 8 + wave] = wdone ? 1u : 0u;
        if (kt > 0) {
            LAS unsigned char* nb = lds + (cur ^ 1) * A_BUF;
            *(LAS u32x4*)(nb + kwoff) = kr;
            u32x2 a = {vr[0], vr[1]}, c = {vr[2], vr[3]};
            *(LAS u32x2*)(nb + vwoff) = a; *(LAS u32x2*)(nb + vwoff + 8) = c;
        }
        __syncthreads();
        cur ^= 1;
        {
            const LAS u32x4* df = (const LAS u32x4*)(dflag + (kt & 1) * 8);
            const u32x4 f0 = df[0], f1 = df[1];
            if ((f0[0] & f0[1] & f0[2] & f0[3] & f1[0] & f1[1] & f1[2] & f1[3]) != 0u) break;
        }
    }
    float sq = 0.f;
#pragma unroll
    for (int i = 0; i < 16; ++i) sq += o0[i] * o0[i] + o1[i] * o1[i];
    sq += shx(sq, 32, lane);
    const float rs = frsq(sq * (1.0f / HD) + EPS);
    const bf16_t* sgp = U + trow * DIN + 1536 + h * HD;
    bf16_t* yp = Y + trow * DM + h * HD;
#pragma unroll
    for (int dt = 0; dt < 2; ++dt)
#pragma unroll
        for (int g = 0; g < 4; ++g) {
            const int d0 = 32 * dt + 8 * g + 4 * hi;
            const f32x4 gn = *(const f32x4*)(aog + d0);
            const u32x2 sg = *(const u32x2*)(sgp + d0);
            float v0, v1, v2, v3;
            if (dt == 0) { v0 = o0[4 * g + 0]; v1 = o0[4 * g + 1]; v2 = o0[4 * g + 2]; v3 = o0[4 * g + 3]; }
            else         { v0 = o1[4 * g + 0]; v1 = o1[4 * g + 1]; v2 = o1[4 * g + 2]; v3 = o1[4 * g + 3]; }
            u32x2 w;
            w[0] = pk2(v0 * rs * gn[0] * bflo(sg[0]), v1 * rs * gn[1] * bfhi(sg[0]));
            w[1] = pk2(v2 * rs * gn[2] * bflo(sg[1]), v3 * rs * gn[3] * bfhi(sg[1]));
            *(u32x2*)(yp + d0) = w;
        }
}

constexpr int CT = 32, C_XH = 0, C_XH_BYTES = (CT + 30) * 1024, C_CO = C_XH_BYTES, C_CO_BYTES = CT * CD * 4, C_RED = C_CO + C_CO_BYTES, C_AT = 0, C_AT_STRIDE = 1040;
static_assert(C_RED + 1024 <= LDS_BYTES && CT * C_AT_STRIDE <= C_XH_BYTES, "conv LDS map");

__device__ __forceinline__ void conv_unit(const bf16_t* U, bf16_t* Y, const float* dww, const float* dwb, const float* lng, const float* lnb, const bf16_t* Wpw, const float* cog,
                                          int cu, LAS unsigned char* lds) {
    int tid = threadIdx.x; asm volatile("" : "+v"(tid));
    const int wave = __builtin_amdgcn_readfirstlane(tid >> 6), lane = tid & 63, l31 = lane & 31, hi = lane >> 5;
    const int r0 = cu * CT, b = r0 >> 11, s0 = r0 & 2047;
    __syncthreads();
    for (int i = tid; i < (CT + 30) * 64; i += 512) {
        const int row = i >> 6, ch = i & 63, s = s0 - 30 + row;
        u32x4 v = {0u, 0u, 0u, 0u};
        if (s >= 0) v = *(const u32x4*)(U + (size_t)(b * SEQ + s) * DIN + 2048 + ch * 8);
        *(LAS u32x4*)(lds + C_XH + row * 1024 + ch * 16) = v;
    }
    __syncthreads();
    {
        const int chp = tid & 255, tg = tid >> 8;
        float w0[CWID], w1[CWID];
#pragma unroll
        for (int j = 0; j < CWID; ++j) { const f32x2 ww = *(const f32x2*)(dww + (size_t)j * CD + 2 * chp); w0[j] = ww[0]; w1[j] = ww[1]; }
        const f32x2 bias = *(const f32x2*)(dwb + 2 * chp);
        const LAS unsigned char* xp = lds + C_XH + chp * 4;
#pragma unroll 1
        for (int tt = 0; tt < 16; ++tt) {
            const int tl = tg * 16 + tt;
            float a0 = bias[0], a1 = bias[1];
#pragma unroll
            for (int j = 0; j < CWID; ++j) { const unsigned xv = *(const LAS unsigned*)(xp + (tl + j) * 1024); a0 += w0[j] * bflo(xv); a1 += w1[j] * bfhi(xv); }
            f32x2 o = {a0, a1};
            *(LAS f32x2*)(lds + C_CO + tl * 2048 + chp * 8) = o;
        }
    }
    __syncthreads();
    {
        const f32x4 g0 = *(const f32x4*)(lng + lane * 4), g1 = *(const f32x4*)(lng + 256 + lane * 4);
        const f32x4 b0 = *(const f32x4*)(lnb + lane * 4), b1 = *(const f32x4*)(lnb + 256 + lane * 4);
#pragma unroll
        for (int tt = 0; tt < 4; ++tt) {
            const int tl = wave * 4 + tt;
            f32x4 v0 = *(const LAS f32x4*)(lds + C_CO + tl * 2048 + lane * 16), v1 = *(const LAS f32x4*)(lds + C_CO + tl * 2048 + 1024 + lane * 16);
            const float mean = wave_sum((v0[0] + v0[1]) + (v0[2] + v0[3]) + (v1[0] + v1[1]) + (v1[2] + v1[3]), lane) * (1.0f / CD);
            v0 = v0 - mean; v1 = v1 - mean;
            const float var = wave_sum((v0[0] * v0[0] + v0[1] * v0[1]) + (v0[2] * v0[2] + v0[3] * v0[3]) + (v1[0] * v1[0] + v1[1] * v1[1]) + (v1[2] * v1[2] + v1[3] * v1[3]), lane) * (1.0f / CD);
            const float rs = frsq(var + EPS);
            v0 = v0 * rs * g0 + b0; v1 = v1 * rs * g1 + b1;
            u32x2 wa, wb;
            wa[0] = pk2(siluf_(v0[0]), siluf_(v0[1])); wa[1] = pk2(siluf_(v0[2]), siluf_(v0[3]));
            wb[0] = pk2(siluf_(v1[0]), siluf_(v1[1])); wb[1] = pk2(siluf_(v1[2]), siluf_(v1[3]));
            *(LAS u32x2*)(lds + C_AT + tl * C_AT_STRIDE + lane * 8) = wa;
            *(LAS u32x2*)(lds + C_AT + tl * C_AT_STRIDE + 512 + lane * 8) = wb;
        }
    }
    __syncthreads();
    f32x16 c0, c1;
#pragma unroll
    for (int i = 0; i < 16; ++i) { c0[i] = 0.f; c1[i] = 0.f; }
    {
        const bf16_t* wp = Wpw + (size_t)(64 * wave + l31) * CD + 8 * hi;
        const LAS unsigned char* ap = lds + C_AT + l31 * C_AT_STRIDE + 16 * hi;
#pragma unroll 8
        for (int s = 0; s < 32; ++s) {
            const bf16x8 a = *(const LAS bf16x8*)(ap + 32 * s);
            const bf16x8 wa = *(const bf16x8*)(wp + 16 * s), wb = *(const bf16x8*)(wp + 32 * CD + 16 * s);
            c0 = MFMA32(wa, a, c0); c1 = MFMA32(wb, a, c1);
        }
    }
    float sq = 0.f;
#pragma unroll
    for (int i = 0; i < 16; ++i) sq += c0[i] * c0[i] + c1[i] * c1[i];
    sq += shx(sq, 32, lane);
    LAS float* red = (LAS float*)(lds + C_RED);
    if (hi == 0) red[wave * 32 + l31] = sq;
    __syncthreads();
    float tot = 0.f;
#pragma unroll
    for (int w = 0; w < 8; ++w) tot += red[w * 32 + l31];
    const float rs = frsq(tot * (1.0f / CD) + EPS);
    const size_t trow = (size_t)(r0 + l31);
    const bf16_t* sgp = U + trow * DIN + 3072;
    bf16_t* yp = Y + trow * DM + 512;
#pragma unroll
    for (int nt = 0; nt < 2; ++nt)
#pragma unroll
        for (int g = 0; g < 4; ++g) {
            const int n0 = 64 * wave + 32 * nt + 8 * g + 4 * hi;
            const f32x4 gn = *(const f32x4*)(cog + n0);
            const u32x2 sg = *(const u32x2*)(sgp + n0);
            float v0, v1, v2, v3;
            if (nt == 0) { v0 = c0[4 * g + 0]; v1 = c0[4 * g + 1]; v2 = c0[4 * g + 2]; v3 = c0[4 * g + 3]; }
            else         { v0 = c1[4 * g + 0]; v1 = c1[4 * g + 1]; v2 = c1[4 * g + 2]; v3 = c1[4 * g + 3]; }
            u32x2 w;
            w[0] = pk2(v0 * rs * gn[0] * bflo(sg[0]), v1 * rs * gn[1] * bfhi(sg[0]));
            w[1] = pk2(v2 * rs * gn[2] * bflo(sg[1]), v3 * rs * gn[3] * bfhi(sg[1]));
            *(u32x2*)(yp + n0) = w;
        }
}

struct Params { const float* in[16]; float* out; unsigned char* ws; int ph_lo, ph_hi; };

template <int ph>
__device__ __forceinline__ void run_phase(const Params& P, LAS unsigned char* lds) {
    const int G = gridDim.x, bid = blockIdx.x;
    unsigned char* ws = P.ws;
    const float* x = P.in[0];
    float* out = P.out;
    bf16_t* HB = (bf16_t*)(ws + WS_HB); bf16_t* H1B = (bf16_t*)(ws + WS_H1B); bf16_t* Ub = (bf16_t*)(ws + WS_U); bf16_t* VT = (bf16_t*)(ws + WS_VT); bf16_t* Yb = (bf16_t*)(ws + WS_Y);
    float* EB = (float*)(ws + WS_EB); float* ssA = (float*)(ws + WS_SSA); float* ssB = (float*)(ws + WS_SSB);

    {
        int tid = threadIdx.x; asm volatile("" : "+v"(tid));
        const int lane = tid & 63, wave = __builtin_amdgcn_readfirstlane(tid >> 6);
        const int gw = bid * 8 + wave, NGW = G * 8;
        if constexpr (ph == 0) {
            LAS float* scr = (LAS float*)(lds + wave * 16384);
            for (int it = gw; it < 2 * 3072; it += NGW) {
                const int l = it / 3072; int r = it - l * 3072;
                unsigned char* wb = ws + (size_t)l * W_LAYER;
                if (r < 1792) { tr_item<true>(P.in[3] + (size_t)l * DM * DIN, DM, DIN, (bf16_t*)(wb + W_IN), P.in[2] + l * DM, scr, r, lane); continue; } r -= 1792;
                if (r < 128) { tr_item<false>(P.in[9] + (size_t)l * CD * CD, CD, CD, (bf16_t*)(wb + W_PW), nullptr, scr, r, lane); continue; } r -= 128;
                if (r < 512) { tr_item<false>(P.in[11] + (size_t)l * DM * DM, DM, DM, (bf16_t*)(wb + W_OUT), nullptr, scr, r, lane); continue; } r -= 512;
                if (r < 512) { tr_item<false>(P.in[13] + (size_t)l * DM * DM, DM, DM, (bf16_t*)(wb + W_PG), P.in[12] + l * DM, scr, r, lane); continue; } r -= 512;
                tr_item<false>(P.in[14] + (size_t)l * PLE * DM, PLE, DM, (bf16_t*)(wb + W_PLE), nullptr, scr, r, lane);
            }
            for (int row = gw; row < MT; row += NGW) {
                const f32x4* xr = (const f32x4*)(x + (size_t)row * DM) + lane;
                u32x2* ob = (u32x2*)(HB + (size_t)row * DM) + lane;
                float s = 0.f;
#pragma unroll
                for (int j = 0; j < 4; ++j) { const f32x4 v = xr[64 * j]; s += (v[0] * v[0] + v[1] * v[1]) + (v[2] * v[2] + v[3] * v[3]); u32x2 w; w[0] = pk2(v[0], v[1]); w[1] = pk2(v[2], v[3]); ob[64 * j] = w; }
                s = wave_sum(s, lane);
                if (lane < 16) ssA[(size_t)row * 16 + lane] = (lane == 0) ? s : 0.f;
            }
            {
                const f32x4* pp = (const f32x4*)P.in[1]; u32x2* pb = (u32x2*)(ws + WS_PB);
                for (int i = bid * 512 + tid; i < 2 * MT * PLE / 4; i += G * 512) { const f32x4 v = pp[i]; u32x2 w; w[0] = pk2(v[0], v[1]); w[1] = pk2(v[2], v[3]); pb[i] = w; }
            }
        } else if constexpr (ph == NPHASE - 1) {
            const float* fg = P.in[15];
            for (int row = gw; row < MT; row += NGW) {
                f32x4* xr = (f32x4*)(out + (size_t)row * DM) + lane;
                f32x4 v[4]; float s = 0.f;
#pragma unroll
                for (int j = 0; j < 4; ++j) { v[j] = xr[64 * j]; s += (v[j][0] * v[j][0] + v[j][1] * v[j][1]) + (v[j][2] * v[j][2] + v[j][3] * v[j][3]); }
                const float rs = frsq(wave_sum(s, lane) * (1.0f / DM) + EPS);
#pragma unroll
                for (int j = 0; j < 4; ++j) { const f32x4 g = *((const f32x4*)fg + lane + 64 * j); xr[64 * j] = v[j] * rs * g; }
            }
        } else {
            constexpr int l = (ph - 1) >> 2, k = (ph - 1) & 3;
            unsigned char* wb = ws + (size_t)l * W_LAYER;
            if constexpr (k == 0) {
                pg8::Gemm g{HB, (const bf16_t*)(wb + W_IN), MT, DIN, DM}; pg8::StaticOrder S; S.init(MT, DIN, G, bid);
                EpiIn E{Ub, VT, ssA};
                pg8::gemm_phase<EpiIn, pg8::StaticOrder, true, true>(lds, g, S, E, threadIdx.x);
                if constexpr ((PROBE_DUP & 1) && l == 0) { int t3 = threadIdx.x; asm volatile("" : "+v"(t3)); pg8::gemm_phase<EpiIn, pg8::StaticOrder, true, true>(lds, g, S, E, t3); }
            } else if constexpr (k == 1) {
                const float* aog = P.in[4] + l * HD;
                const float* dww = P.in[5] + (size_t)l * CWID * CD; const float* dwb = P.in[6] + l * CD;
                const float* lng = P.in[7] + l * CD; const float* lnb = P.in[8] + l * CD; const float* cog = P.in[10] + l * CD;
                const bf16_t* Wpw = (const bf16_t*)(wb + W_PW);
                for (int it = bid; it < 256; it += G) {
                    const int bh = it >> 2, pr = it & 3, b = bh >> 3, h = bh & 7;
#pragma unroll 1
                    for (int uu = 0; uu < ((PROBE_DUP & 2) ? 4 : 2); ++uu) attn_unit(Ub, VT, Yb, aog, b, h, (uu & 1) == 0 ? 7 - pr : pr, lds);
#pragma unroll 1
                    for (int uu = 0; uu < ((PROBE_DUP & 4) ? 4 : 2); ++uu) conv_unit(Ub, Yb, dww, dwb, lng, lnb, Wpw, cog, 2 * it + (uu & 1), lds);
                }
                __syncthreads();
            } else if constexpr (k == 2) {
                pg8::Gemm g{Yb, (const bf16_t*)(wb + W_OUT), MT, DM, DM}; pg8::StaticOrder S; S.init(MT, DM, G, bid);
                EpiOut E{l == 0 ? x : out, out, H1B, ssB};
                pg8::gemm_phase<EpiOut, pg8::StaticOrder, true, true>(lds, g, S, E, threadIdx.x);
                if constexpr ((PROBE_DUP & 16) && l == 0) { int t3 = threadIdx.x; asm volatile("" : "+v"(t3)); pg8::gemm_phase<EpiOut, pg8::StaticOrder, true, true>(lds, g, S, E, t3); }
            } else {
                {
                    pg8::Gemm g{(const bf16_t*)(ws + WS_PB) + (size_t)l * MT * PLE, (const bf16_t*)(wb + W_PLE), MT, DM, PLE}; pg8::StaticOrder S; S.init(MT, DM, G, bid);
                    EpiE E{EB};
                    pg8::gemm_phase<EpiE, pg8::StaticOrder, true, true>(lds, g, S, E, threadIdx.x);
                    if constexpr ((PROBE_DUP & 32) != 0) { int t3 = threadIdx.x; asm volatile("" : "+v"(t3)); pg8::gemm_phase<EpiE, pg8::StaticOrder, true, true>(lds, g, S, E, t3); }
                }
                {
                    pg8::Gemm g{H1B, (const bf16_t*)(wb + W_PG), MT, DM, DM}; pg8::StaticOrder S; S.init(MT, DM, G, bid);
                    EpiGate E{out, EB, HB, ssB, ssA};
                    int t2 = threadIdx.x; asm volatile("" : "+v"(t2));
                    pg8::gemm_phase<EpiGate, pg8::StaticOrder, true, true>(lds, g, S, E, t2);
                }
            }
        }
    }
}


__global__ void __launch_bounds__(512, 2) fwd(Params P) {
    extern __shared__ __attribute__((aligned(16))) unsigned char lds_raw[];
    LAS unsigned char* lds = (LAS unsigned char*)lds_raw;
    const int lo = P.ph_lo, hi = P.ph_hi;
#define PHASE(k) if (lo <= (k) && (k) < hi) { run_phase<(k)>(P, lds); if ((k) + 1 < hi) cg::this_grid().sync(); }
    PHASE(0) PHASE(1) PHASE(2) PHASE(3) PHASE(4) PHASE(5) PHASE(6) PHASE(7) PHASE(8) PHASE(9)
#undef PHASE
}

#ifndef MK_N_LAUNCHES
#define MK_N_LAUNCHES 1
#endif
extern "C" void kernel_launch(void* const* d_in, const int* in_sizes, int n_in, void* d_out, int out_size, void* d_ws, size_t ws_size, hipStream_t stream) {
    static int grid = 0;
    if (grid == 0) {
        if (n_in != 16 || out_size != MT * DM || ws_size < WS_END) { fprintf(stderr, "kernel_launch: unexpected shapes (n_in %d, out %d, ws %zu)\n", n_in, out_size, ws_size); grid = -1; return; }
        int dev = 0, cus = 0, per_cu = 0;
        (void)hipGetDevice(&dev);
        (void)hipDeviceGetAttribute(&cus, hipDeviceAttributeMultiprocessorCount, dev);
        if (hipFuncSetAttribute((const void*)fwd, hipFuncAttributeMaxDynamicSharedMemorySize, LDS_BYTES) != hipSuccess) { fprintf(stderr, "kernel_launch: hipFuncSetAttribute failed\n"); grid = -1; return; }
        if (hipOccupancyMaxActiveBlocksPerMultiprocessor(&per_cu, (const void*)fwd, 512, LDS_BYTES) != hipSuccess || per_cu < 1) { fprintf(stderr, "kernel_launch: occupancy query says %d\n", per_cu); per_cu = 1; }
        (void)hipGetLastError();
        grid = cus * 1;
        if (grid <= 0) grid = 256;
    }
    if (grid < 0) return;
    Params p{};
    for (int i = 0; i < 16; ++i) p.in[i] = (const float*)d_in[i];
    p.out = (float*)d_out; p.ws = (unsigned char*)d_ws;
#if MK_N_LAUNCHES == 1
    p.ph_lo = 0; p.ph_hi = NPHASE;
    void* args[] = {&p};
    hipError_t e = hipLaunchCooperativeKernel((const void*)fwd, dim3(grid), dim3(512), args, LDS_BYTES, stream);
    if (e != hipSuccess) fprintf(stderr, "kernel_launch: cooperative launch failed: %s (grid %d)\n", hipGetErrorString(e), grid);
#else
    for (int ph = 0; ph < NPHASE; ++ph) {
        p.ph_lo = ph; p.ph_hi = ph + 1;
        hipLaunchKernelGGL(fwd, dim3(grid), dim3(512), LDS_BYTES, stream, p);
    }
#endif
}
```

```cpp
#include <hip/hip_runtime.h>
#include <hip/hip_cooperative_groups.h>
#include <cstdio>
#include <cstdint>
namespace cg = cooperative_groups;
namespace pg8 {
#define PG8_LAS __attribute__((address_space(3)))
typedef unsigned short bf16_t;
typedef short bf16x8 __attribute__((ext_vector_type(8)));
typedef float f32x4 __attribute__((ext_vector_type(4)));
typedef unsigned u32x4 __attribute__((ext_vector_type(4)));
constexpr int BM = 256, BK = 64, HALF = 128, HTB = HALF * BK * 2  , STAGE_BYTES = 8 * HTB, NXCD = 8, WGM = 8;

__host__ __device__ __forceinline__ int lds_byte(int r, int c) { const int st = (r >> 4) * 2 + (c >> 5), rr = r & 15, cc = c & 31, ob = rr * 64 + cc * 2; return st * 1024 + (ob ^ (((ob >> 9) & 1) << 5)); }
__host__ __device__ __forceinline__ void stage_rc(int b, int& R, int& C) { const int st = b / 1024, sb = b % 1024, swz = sb ^ (((sb >> 9) & 1) << 5); R = (st >> 1) * 16 + swz / 64; C = (st & 1) * 32 + (swz % 64) / 2; }
__host__ __device__ __forceinline__ int perm32(int rho) { const int n = rho >> 4, i = rho & 15; return 8 * (i >> 2) + 4 * n + (i & 3); }

struct Unit { int pm, pn; };
struct Gemm { const bf16_t* A; const bf16_t* Bt; int M, N, K; };

struct StaticOrder {
    int nM, nN, nwg, G, c;
    __host__ __device__ void init(int M, int N, int G_, int c_) { nM = M / BM; nN = N / BM; nwg = nM * nN; G = G_; c = c_; }
    __host__ __device__ bool next(int i, Unit& u) const {
        const long L = (long)i * G + c; if (L >= nwg) return false;
        int wgid = (int)L; { const int q = nwg / NXCD, r = nwg % NXCD, xcd = wgid % NXCD, off = wgid / NXCD; wgid = (xcd < r ? xcd * (q + 1) : r * (q + 1) + (xcd - r) * q) + off; }
        const int nig = WGM * nN, gid = wgid / nig, fm = gid * WGM, gsz = (nM - fm) < WGM ? (nM - fm) : WGM;
        u.pm = fm + ((wgid % nig) % gsz); u.pn = (wgid % nig) / gsz; return true;
    }
    __device__ __forceinline__ void a_ready(const Unit&) const {}
    __device__ __forceinline__ void done(const Unit&) const {}
};

template <class Epi, class Sched, bool ALIGN_EPI = false, bool SP2 = false>
__device__ __forceinline__ void gemm_phase(PG8_LAS unsigned char* lds, const Gemm g, const Sched& S, const Epi& E, const int tid_in) {
    const int tid = tid_in, wid = __builtin_amdgcn_readfirstlane(tid >> 6), lane = tid & 63, wr = wid >> 2, wc = wid & 3, fr = lane & 15, fq = lane >> 4;
    const int K = g.K, nt = K / BK;
    unsigned voffA[2], voffB[2];
#pragma unroll
    for (int i = 0; i < 2; ++i) { int R, C; stage_rc(tid * 16 + i * 8192, R, C); const int Rb = Epi::PERM ? ((R & ~31) + perm32(R & 31)) : R;
        voffA[i] = (unsigned)(R * K + C) * 2u; voffB[i] = (unsigned)(Rb * K + C) * 2u; }
    const size_t kstep = (size_t)(BK * 2);
    const size_t hstep = (size_t)HALF * K * 2;
    const size_t tstep = 2 * hstep;
    const unsigned ldsw = (unsigned)wid * 1024u;
    const int aoff = lds_byte(wr * 64 + fr, fq * 8), boff = lds_byte(wc * 32 + fr, fq * 8);
#define PG8_SA(b, h) (((b) * 2 + (h)) * HTB)
#define PG8_SB(b, h) ((4 + (b) * 2 + (h)) * HTB)
#define PG8_STAGE(bufoff, gbase, voff) do { _Pragma("unroll") for (int _i = 0; _i < 2; ++_i) \
        __builtin_amdgcn_global_load_lds((const unsigned*)((const char*)(gbase) + (voff)[_i]), (PG8_LAS unsigned*)(lds + (bufoff) + ldsw + _i * 8192), 16, 0, 0); } while (0)
#define PG8_LDA(dst, b, h) do { _Pragma("unroll") for (int m = 0; m < 4; ++m) _Pragma("unroll") for (int k = 0; k < 2; ++k) dst[m][k] = *(const PG8_LAS bf16x8*)(lds + PG8_SA(b, h) + aoff + m * 2048 + k * 1024); } while (0)
#define PG8_LDB(dst, b, h) do { _Pragma("unroll") for (int n = 0; n < 2; ++n) _Pragma("unroll") for (int k = 0; k < 2; ++k) dst[n][k] = *(const PG8_LAS bf16x8*)(lds + PG8_SB(b, h) + boff + n * 2048 + k * 1024); } while (0)
#define PG8_MMA(ai, bj, At, Bt) do { __builtin_amdgcn_s_setprio(1); _Pragma("unroll") for (int m = 0; m < 4; ++m) _Pragma("unroll") for (int n = 0; n < 2; ++n) _Pragma("unroll") for (int k = 0; k < 2; ++k) \
        acc[ai][bj][m][n] = __builtin_amdgcn_mfma_f32_16x16x32_bf16(Bt[n][k], At[m][k], acc[ai][bj][m][n], 0, 0, 0); __builtin_amdgcn_s_setprio(0); } while (0)
#define PG8_WAIT_V(n) asm volatile("s_waitcnt vmcnt(" #n ")" ::: "memory")
#define PG8_WAIT_L(n) asm volatile("s_waitcnt lgkmcnt(" #n ")" ::: "memory")
#define PG8_BAR __builtin_amdgcn_s_barrier()
#define PG8_SCHED __builtin_amdgcn_sched_barrier(0)
    Unit cur, nxt; int ui = 0;
    if (!S.next(0, cur)) return;
    f32x4 acc[2][2][4][2];
#pragma unroll
    for (int a = 0; a < 2; ++a)
#pragma unroll
        for (int b = 0; b < 2; ++b)
#pragma unroll
            for (int m = 0; m < 4; ++m)
#pragma unroll
                for (int n = 0; n < 2; ++n) acc[a][b][m][n] = (f32x4){0.f, 0.f, 0.f, 0.f};
    bf16x8 At[4][2], B0[2][2], B1[2][2];
    const char* cA = (const char*)g.A + (size_t)cur.pm * tstep; const char* cB = (const char*)g.Bt + (size_t)cur.pn * tstep;
    S.a_ready(cur);
    if constexpr (SP2) {
        PG8_STAGE(PG8_SB(0, 0), cB, voffB); PG8_STAGE(PG8_SB(0, 1), cB + hstep, voffB); PG8_STAGE(PG8_SA(0, 0), cA, voffA); PG8_STAGE(PG8_SA(0, 1), cA + hstep, voffA);
        if (wr == 1) PG8_BAR;
        PG8_WAIT_V(2); PG8_BAR;
        PG8_STAGE(PG8_SB(1, 0), cB + kstep, voffB); PG8_STAGE(PG8_SA(1, 0), cA + kstep, voffA); PG8_STAGE(PG8_SB(1, 1), cB + hstep + kstep, voffB);
        PG8_WAIT_V(6); PG8_BAR;
    } else {
        PG8_STAGE(PG8_SB(0, 0), cB, voffB); PG8_STAGE(PG8_SA(0, 0), cA, voffA); PG8_STAGE(PG8_SB(0, 1), cB + hstep, voffB); PG8_STAGE(PG8_SA(0, 1), cA + hstep, voffA);
        if (wr == 1) PG8_BAR;
        PG8_WAIT_V(4); PG8_BAR;
        PG8_STAGE(PG8_SB(1, 0), cB + kstep, voffB); PG8_STAGE(PG8_SA(1, 0), cA + kstep, voffA); PG8_STAGE(PG8_SB(1, 1), cB + hstep + kstep, voffB);
        PG8_WAIT_V(6); PG8_BAR;
    }
    for (;;) {
        const bool has_next = S.next(ui + 1, nxt);
        const char* nA = has_next ? (const char*)g.A + (size_t)nxt.pm * tstep : cA; const char* nB = has_next ? (const char*)g.Bt + (size_t)nxt.pn * tstep : cB;
        for (int t = 0; t < nt; t += 2) {
            if constexpr (Epi::MID_T > 0) { if (t == Epi::MID_T) E.mid(acc, cur); }
            const bool last = (t == nt - 2);
            const char* a1 = cA + (size_t)(t + 1) * kstep;
            const char* a2 = last ? nA : cA + (size_t)(t + 2) * kstep; const char* b2 = last ? nB : cB + (size_t)(t + 2) * kstep;
            const char* a3 = a2 + kstep; const char* b3 = b2 + kstep;
            if (last && has_next) S.a_ready(nxt);
            if constexpr (SP2) {
            PG8_LDB(B0, 0, 0); PG8_LDB(B1, 0, 1); PG8_SCHED; PG8_LDA(At, 0, 0); PG8_STAGE(PG8_SA(1, 1), a1 + hstep, voffA);
            PG8_WAIT_V(8); PG8_WAIT_L(0); PG8_BAR; PG8_MMA(0, 0, At, B0); PG8_MMA(0, 1, At, B1); PG8_BAR; PG8_SCHED;
            PG8_LDA(At, 0, 1); PG8_STAGE(PG8_SB(0, 0), b2, voffB); PG8_STAGE(PG8_SB(0, 1), b2 + hstep, voffB); PG8_STAGE(PG8_SA(0, 0), a2, voffA);
            PG8_WAIT_V(8); PG8_WAIT_L(0); PG8_BAR; PG8_MMA(1, 0, At, B0); PG8_MMA(1, 1, At, B1); PG8_BAR; PG8_SCHED;
            PG8_LDB(B0, 1, 0); PG8_LDB(B1, 1, 1); PG8_SCHED; PG8_LDA(At, 1, 0); PG8_STAGE(PG8_SA(0, 1), a2 + hstep, voffA);
            PG8_WAIT_V(8); PG8_WAIT_L(0); PG8_BAR; PG8_MMA(0, 0, At, B0); PG8_MMA(0, 1, At, B1); PG8_BAR; PG8_SCHED;
            PG8_LDA(At, 1, 1); PG8_STAGE(PG8_SB(1, 0), b3, voffB); PG8_STAGE(PG8_SB(1, 1), b3 + hstep, voffB); PG8_STAGE(PG8_SA(1, 0), a3, voffA);
            PG8_WAIT_V(8); PG8_WAIT_L(0); PG8_BAR; PG8_MMA(1, 0, At, B0); PG8_MMA(1, 1, At, B1); PG8_BAR; PG8_SCHED;
            } else {
            PG8_LDB(B0, 0, 0); PG8_SCHED; PG8_LDA(At, 0, 0); PG8_STAGE(PG8_SA(1, 1), a1 + hstep, voffA);
            PG8_WAIT_L(8); PG8_BAR; PG8_WAIT_L(0); PG8_MMA(0, 0, At, B0); PG8_BAR; PG8_SCHED;
            PG8_LDB(B1, 0, 1); PG8_STAGE(PG8_SB(0, 0), b2, voffB);
            PG8_BAR; PG8_WAIT_L(0); PG8_MMA(0, 1, At, B1); PG8_BAR;
            PG8_LDA(At, 0, 1); PG8_STAGE(PG8_SA(0, 0), a2, voffA);
            PG8_BAR; PG8_WAIT_L(0); PG8_MMA(1, 0, At, B0); PG8_BAR; PG8_SCHED;
            PG8_STAGE(PG8_SB(0, 1), b2 + hstep, voffB);
            PG8_WAIT_V(6); PG8_BAR; PG8_MMA(1, 1, At, B1); PG8_BAR;
            PG8_LDB(B0, 1, 0); PG8_SCHED; PG8_LDA(At, 1, 0); PG8_STAGE(PG8_SA(0, 1), a2 + hstep, voffA);
            PG8_WAIT_L(8); PG8_BAR; PG8_WAIT_L(0); PG8_MMA(0, 0, At, B0); PG8_BAR; PG8_SCHED;
            PG8_LDB(B1, 1, 1); PG8_STAGE(PG8_SB(1, 0), b3, voffB);
            PG8_BAR; PG8_WAIT_L(0); PG8_MMA(0, 1, At, B1); PG8_BAR;
            PG8_LDA(At, 1, 1); PG8_STAGE(PG8_SA(1, 0), a3, voffA);
            PG8_BAR; PG8_WAIT_L(0); PG8_MMA(1, 0, At, B0); PG8_BAR; PG8_SCHED;
            PG8_STAGE(PG8_SB(1, 1), b3 + hstep, voffB);
            PG8_WAIT_V(6); PG8_BAR; PG8_MMA(1, 1, At, B1); PG8_BAR;
            }
        }
        if constexpr (ALIGN_EPI) { if (wr == 0) PG8_BAR; }
        if constexpr (!Epi::AFTER_DRAIN) { E(acc, cur, wr, wc, fr, fq); S.done(cur); }
        if (!has_next) break;
#pragma unroll
        for (int a = 0; a < 2; ++a)
#pragma unroll
            for (int b = 0; b < 2; ++b)
#pragma unroll
                for (int m = 0; m < 4; ++m)
#pragma unroll
                    for (int n = 0; n < 2; ++n) acc[a][b][m][n] = (f32x4){0.f, 0.f, 0.f, 0.f};
        cur = nxt; cA = nA; cB = nB; ++ui;
        if constexpr (ALIGN_EPI) { if (wr == 1) PG8_BAR; }
    }
    PG8_WAIT_V(0);
    if constexpr (!ALIGN_EPI) { if (wr == 0) PG8_BAR; }
    PG8_BAR;
    if constexpr (Epi::AFTER_DRAIN) { E.fused(acc, cur, wr, wc, fr, fq, lds, wid, lane); S.done(cur); }
#undef PG8_SA
#undef PG8_SB
#undef PG8_STAGE
#undef PG8_LDA
#undef PG8_LDB
#undef PG8_MMA
#undef PG8_WAIT_V
#undef PG8_WAIT_L
#undef PG8_BAR
#undef PG8_SCHED
}
}

#define LAS __attribute__((address_space(3)))
typedef unsigned short bf16_t;
typedef short bf16x8 __attribute__((ext_vector_type(8)));
typedef float f32x4 __attribute__((ext_vector_type(4)));
typedef float f32x2 __attribute__((ext_vector_type(2)));
typedef float f32x16 __attribute__((ext_vector_type(16)));
typedef unsigned u32x4 __attribute__((ext_vector_type(4)));
typedef unsigned u32x2 __attribute__((ext_vector_type(2)));
typedef __bf16 bf16x2_t __attribute__((ext_vector_type(2)));

constexpr int NB = 8, SEQ = 2048, DM = 1024, MT = NB * SEQ, DIN = 3584, NH = 8, HD = 64, CWID = 31, PLE = 256, CD = 512;
constexpr float EPS = 1e-6f;
constexpr float QSCALE = 0.125f * 1.4426950408889634f;

constexpr size_t MiB = 1u << 20;
constexpr size_t W_IN = 0, W_PW = 7340032, W_OUT = W_PW + 524288, W_PG = W_OUT + 2097152, W_PLE = W_PG + 2097152, W_LAYER = 12 * MiB;
static_assert(W_PLE + 524288 == W_LAYER, "weight map");
constexpr int UP = 2560, UQ = 0, UK = 512, USGA = 1024, UGLU = 1536, USGC = 2048;
constexpr size_t WS_PB = 24 * MiB, WS_HB = 40 * MiB, WS_Y = 72 * MiB, WS_VT = 104 * MiB, WS_SSA = 120 * MiB, WS_SSB = 121 * MiB, WS_SSC = 122 * MiB, WS_U = 123 * MiB;
constexpr size_t WS_H1B = WS_U  , WS_C2 = 203 * MiB, WS_EB = 219 * MiB, WS_END = 251 * MiB;
static_assert(WS_U + (size_t)MT * UP * 2 <= WS_C2, "ws map");
constexpr int LDS_BYTES = 147456;
constexpr int NPHASE = 12;
#ifndef PROBE_DUP
#define PROBE_DUP 0
#endif

__device__ __forceinline__ unsigned pk2(float lo, float hi) { f32x2 v = {lo, hi}; bf16x2_t b = __builtin_convertvector(v, bf16x2_t); return __builtin_bit_cast(unsigned, b); }
__device__ __forceinline__ float bflo(unsigned u) { return __builtin_bit_cast(float, u << 16); }
__device__ __forceinline__ float bfhi(unsigned u) { return __builtin_bit_cast(float, u & 0xffff0000u); }
__device__ __forceinline__ float fexp2(float x) { return __builtin_amdgcn_exp2f(x); }
__device__ __forceinline__ float flog2(float x) { return __builtin_amdgcn_logf(x); }
__device__ __forceinline__ float frcp(float x) { return __builtin_amdgcn_rcpf(x); }
__device__ __forceinline__ float frsq(float x) { return __builtin_amdgcn_rsqf(x); }
__device__ __forceinline__ float sigmoidf_(float x) { return frcp(1.0f + fexp2(-1.4426950408889634f * x)); }
__device__ __forceinline__ float siluf_(float x) { return x * sigmoidf_(x); }
#define MFMA32(a, b, c) __builtin_amdgcn_mfma_f32_32x32x16_bf16((a), (b), (c), 0, 0, 0)

__device__ __forceinline__ float shx(float v, int m, int lane) { return __builtin_bit_cast(float, __builtin_amdgcn_ds_bpermute((lane ^ m) << 2, __builtin_bit_cast(int, v))); }
__device__ __forceinline__ float wave_sum(float v, int lane) {
#pragma unroll
    for (int o = 1; o < 64; o <<= 1) v += shx(v, o, lane);
    return v;
}
__device__ __forceinline__ float row_rstd(const float* ss, int row, int fq, int lane) {
    const f32x4 p = *(const f32x4*)(ss + (size_t)row * 16 + fq * 4);
    float s = (p[0] + p[1]) + (p[2] + p[3]);
    s += shx(s, 16, lane); s += shx(s, 32, lane);
    return frsq(s * (1.0f / DM) + EPS);
}

struct EpiIn {
    static constexpr bool PERM = true, AFTER_DRAIN = false; static constexpr int MID_T = 0;
    bf16_t* U; bf16_t* VT; const float* ss;
    __device__ __forceinline__ void operator()(const f32x4 (&acc)[2][2][4][2], const pg8::Unit& u, int, int, int, int) const {
        int t_ = threadIdx.x; asm volatile("" : "+v"(t_));
        const int lane = t_ & 63, fr = lane & 15, fq = lane >> 4, wid_ = __builtin_amdgcn_readfirstlane(t_ >> 6), wr = wid_ >> 2, wc = wid_ & 3;
        const int pn = u.pn;
#pragma unroll
        for (int ai = 0; ai < 2; ++ai)
#pragma unroll
            for (int m = 0; m < 4; ++m) {
                const int row = u.pm * 256 + ai * 128 + wr * 64 + m * 16 + fr;
                const float rs = row_rstd(ss, row, fq, lane);
#pragma unroll
                for (int bj = 0; bj < 2; ++bj) {
                    const int col0 = pn * 256 + bj * 128 + wc * 32 + 8 * fq;
                    f32x4 v0 = acc[ai][bj][m][0] * rs, v1 = acc[ai][bj][m][1] * rs;
                    if (pn < 4) {
                        const float sc = pn < 2 ? QSCALE : 1.0f;
                        v0 = v0 * sc; v1 = v1 * sc;
                        u32x4 w; w[0] = pk2(v0[0], v0[1]); w[1] = pk2(v0[2], v0[3]); w[2] = pk2(v1[0], v1[1]); w[3] = pk2(v1[2], v1[3]);
                        *(u32x4*)(U + (size_t)row * UP + col0) = w;
                    } else if (pn < 6) {
                        const int vc = col0 - 1024, hh = vc >> 6, d0 = vc & 63, b = row >> 11, s = row & 2047;
                        bf16_t* vp = VT + ((size_t)((b * NH + hh) * HD + d0)) * SEQ + s;
                        const unsigned w0 = pk2(v0[0], v0[1]), w1 = pk2(v0[2], v0[3]), w2 = pk2(v1[0], v1[1]), w3 = pk2(v1[2], v1[3]);
                        vp[0 * SEQ] = (bf16_t)(w0 & 0xffffu); vp[1 * SEQ] = (bf16_t)(w0 >> 16);
                        vp[2 * SEQ] = (bf16_t)(w1 & 0xffffu); vp[3 * SEQ] = (bf16_t)(w1 >> 16);
                        vp[4 * SEQ] = (bf16_t)(w2 & 0xffffu); vp[5 * SEQ] = (bf16_t)(w2 >> 16);
                        vp[6 * SEQ] = (bf16_t)(w3 & 0xffffu); vp[7 * SEQ] = (bf16_t)(w3 >> 16);
                    } else if (pn < 8 || pn >= 12) {
                        u32x4 w; w[0] = pk2(siluf_(v0[0]), siluf_(v0[1])); w[1] = pk2(siluf_(v0[2]), siluf_(v0[3]));
                        w[2] = pk2(siluf_(v1[0]), siluf_(v1[1])); w[3] = pk2(siluf_(v1[2]), siluf_(v1[3]));
                        *(u32x4*)(U + (size_t)row * UP + (pn < 8 ? col0 - 512 : col0 - 1024)) = w;
                    } else {
                        const int ch0 = (col0 - 2048) >> 1;
                        u32x2 w; w[0] = pk2(v0[0] * sigmoidf_(v0[1]), v0[2] * sigmoidf_(v0[3])); w[1] = pk2(v1[0] * sigmoidf_(v1[1]), v1[2] * sigmoidf_(v1[3]));
                        *(u32x2*)(U + (size_t)row * UP + UGLU + ch0) = w;
                    }
                }
                asm volatile("" ::: "memory");
            }
    }
};

struct EpiPw {
    static constexpr bool PERM = true, AFTER_DRAIN = false; static constexpr int MID_T = 0;
    const bf16_t* U; bf16_t* Y; const float* cog; float* ssC;
    __device__ __forceinline__ void operator()(const f32x4 (&acc)[2][2][4][2], const pg8::Unit& u, int, int, int, int) const {
        int t_ = threadIdx.x; asm volatile("" : "+v"(t_));
        const int lane = t_ & 63, fr = lane & 15, fq = lane >> 4, wid_ = __builtin_amdgcn_readfirstlane(t_ >> 6), wr = wid_ >> 2, wc = wid_ & 3;
#pragma unroll
        for (int ai = 0; ai < 2; ++ai)
#pragma unroll
            for (int m = 0; m < 4; ++m) {
                const int row = u.pm * 256 + ai * 128 + wr * 64 + m * 16 + fr;
                float sq = 0.f;
#pragma unroll
                for (int bj = 0; bj < 2; ++bj) {
                    const int col0 = u.pn * 256 + bj * 128 + wc * 32 + 8 * fq;
                    const f32x4 v0 = acc[ai][bj][m][0], v1 = acc[ai][bj][m][1];
                    sq += (v0[0] * v0[0] + v0[1] * v0[1]) + (v0[2] * v0[2] + v0[3] * v0[3]) + (v1[0] * v1[0] + v1[1] * v1[1]) + (v1[2] * v1[2] + v1[3] * v1[3]);
                    const f32x4 g0 = *(const f32x4*)(cog + col0), g1 = *(const f32x4*)(cog + col0 + 4);
                    const u32x4 sg = *(const u32x4*)(U + (size_t)row * UP + USGC + col0);
                    u32x4 w;
                    w[0] = pk2(v0[0] * g0[0] * bflo(sg[0]), v0[1] * g0[1] * bfhi(sg[0])); w[1] = pk2(v0[2] * g0[2] * bflo(sg[1]), v0[3] * g0[3] * bfhi(sg[1]));
                    w[2] = pk2(v1[0] * g1[0] * bflo(sg[2]), v1[1] * g1[1] * bfhi(sg[2])); w[3] = pk2(v1[2] * g1[2] * bflo(sg[3]), v1[3] * g1[3] * bfhi(sg[3]));
                    *(u32x4*)(Y + (size_t)row * DM + col0) = w;
                }
                sq += shx(sq, 16, lane); sq += shx(sq, 32, lane);
                if (fq == 0) ssC[(size_t)row * 8 + u.pn * 4 + wc] = sq;
                asm volatile("" ::: "memory");
            }
    }
};

struct EpiE {
    static constexpr bool PERM = true, AFTER_DRAIN = false; static constexpr int MID_T = 0;
    bf16_t* EB;
    __device__ __forceinline__ void operator()(const f32x4 (&acc)[2][2][4][2], const pg8::Unit& u, int, int, int, int) const {
        int t_ = threadIdx.x; asm volatile("" : "+v"(t_));
        const int lane = t_ & 63, fr = lane & 15, fq = lane >> 4, wid_ = __builtin_amdgcn_readfirstlane(t_ >> 6), wr = wid_ >> 2, wc = wid_ & 3;
#pragma unroll
        for (int ai = 0; ai < 2; ++ai)
#pragma unroll
            for (int m = 0; m < 4; ++m) {
                const int row = u.pm * 256 + ai * 128 + wr * 64 + m * 16 + fr;
#pragma unroll
                for (int bj = 0; bj < 2; ++bj) {
                    const int col0 = u.pn * 256 + bj * 128 + wc * 32 + 8 * fq;
                    const f32x4 v0 = acc[ai][bj][m][0], v1 = acc[ai][bj][m][1];
                    u32x4 w; w[0] = pk2(v0[0], v0[1]); w[1] = pk2(v0[2], v0[3]); w[2] = pk2(v1[0], v1[1]); w[3] = pk2(v1[2], v1[3]);
                    *(u32x4*)(EB + (size_t)row * DM + col0) = w;
                }
                asm volatile("" ::: "memory");
            }
    }
};

struct EpiOut {
    static constexpr bool PERM = true, AFTER_DRAIN = false; static constexpr int MID_T = 8;
    const float* base; float* out; bf16_t* HB; float* ss; const float* ssC;
    __device__ __forceinline__ void mid(f32x4 (&acc)[2][2][4][2], const pg8::Unit& u) const {
        int t_ = threadIdx.x; asm volatile("" : "+v"(t_));
        const int lane = t_ & 63, fr = lane & 15, fq = lane >> 4, wid_ = __builtin_amdgcn_readfirstlane(t_ >> 6), wr = wid_ >> 2;
#pragma unroll
        for (int ai = 0; ai < 2; ++ai)
#pragma unroll
            for (int m = 0; m < 4; ++m) {
                const int row = u.pm * 256 + ai * 128 + wr * 64 + m * 16 + fr;
                const f32x2 p = *(const f32x2*)(ssC + (size_t)row * 8 + fq * 2);
                float s = p[0] + p[1];
                s += shx(s, 16, lane); s += shx(s, 32, lane);
                const float rs = frsq(s * (1.0f / CD) + EPS);
#pragma unroll
                for (int bj = 0; bj < 2; ++bj)
#pragma unroll
                    for (int n = 0; n < 2; ++n) acc[ai][bj][m][n] = acc[ai][bj][m][n] * rs;
            }
    }
    __device__ __forceinline__ void operator()(const f32x4 (&acc)[2][2][4][2], const pg8::Unit& u, int, int, int, int) const {
        int t_ = threadIdx.x; asm volatile("" : "+v"(t_));
        const int lane = t_ & 63, fr = lane & 15, fq = lane >> 4, wid_ = __builtin_amdgcn_readfirstlane(t_ >> 6), wr = wid_ >> 2, wc = wid_ & 3;
#pragma unroll
        for (int ai = 0; ai < 2; ++ai)
#pragma unroll
            for (int m = 0; m < 4; ++m) {
                const int row = u.pm * 256 + ai * 128 + wr * 64 + m * 16 + fr;
                float sq = 0.f;
#pragma unroll
                for (int bj = 0; bj < 2; ++bj) {
                    const size_t off = (size_t)row * DM + u.pn * 256 + bj * 128 + wc * 32 + 8 * fq;
                    const f32x4 h0 = *(const f32x4*)(base + off) + acc[ai][bj][m][0], h1 = *(const f32x4*)(base + off + 4) + acc[ai][bj][m][1];
                    *(f32x4*)(out + off) = h0; *(f32x4*)(out + off + 4) = h1;
                    u32x4 w; w[0] = pk2(h0[0], h0[1]); w[1] = pk2(h0[2], h0[3]); w[2] = pk2(h1[0], h1[1]); w[3] = pk2(h1[2], h1[3]);
                    *(u32x4*)(HB + off) = w;
                    sq += (h0[0] * h0[0] + h0[1] * h0[1]) + (h0[2] * h0[2] + h0[3] * h0[3]) + (h1[0] * h1[0] + h1[1] * h1[1]) + (h1[2] * h1[2] + h1[3] * h1[3]);
                }
                sq += shx(sq, 16, lane); sq += shx(sq, 32, lane);
                if (fq == 0) ss[(size_t)row * 16 + u.pn * 4 + wc] = sq;
                if (m & 1) asm volatile("" ::: "memory");
            }
    }
};

struct EpiGate {
    static constexpr bool PERM = true, AFTER_DRAIN = false; static constexpr int MID_T = 0;
    float* out; const bf16_t* EB; bf16_t* HB; const float* ss_in; float* ss_out;
    __device__ __forceinline__ void operator()(const f32x4 (&acc)[2][2][4][2], const pg8::Unit& u, int, int, int, int) const {
        int t_ = threadIdx.x; asm volatile("" : "+v"(t_));
        const int lane = t_ & 63, fr = lane & 15, fq = lane >> 4, wid_ = __builtin_amdgcn_readfirstlane(t_ >> 6), wr = wid_ >> 2, wc = wid_ & 3;
#pragma unroll
        for (int ai = 0; ai < 2; ++ai)
#pragma unroll
            for (int m = 0; m < 4; ++m) {
                const int row = u.pm * 256 + ai * 128 + wr * 64 + m * 16 + fr;
                const float rs = row_rstd(ss_in, row, fq, lane);
                float sq = 0.f;
#pragma unroll
                for (int bj = 0; bj < 2; ++bj) {
                    const size_t off = (size_t)row * DM + u.pn * 256 + bj * 128 + wc * 32 + 8 * fq;
                    const f32x4 a0 = acc[ai][bj][m][0] * rs, a1 = acc[ai][bj][m][1] * rs;
                    const u32x4 e = *(const u32x4*)(EB + off);
                    f32x4 h0 = *(const f32x4*)(out + off), h1 = *(const f32x4*)(out + off + 4);
                    h0[0] += bflo(e[0]) * sigmoidf_(a0[0]); h0[1] += bfhi(e[0]) * sigmoidf_(a0[1]); h0[2] += bflo(e[1]) * sigmoidf_(a0[2]); h0[3] += bfhi(e[1]) * sigmoidf_(a0[3]);
                    h1[0] += bflo(e[2]) * sigmoidf_(a1[0]); h1[1] += bfhi(e[2]) * sigmoidf_(a1[1]); h1[2] += bflo(e[3]) * sigmoidf_(a1[2]); h1[3] += bfhi(e[3]) * sigmoidf_(a1[3]);
                    *(f32x4*)(out + off) = h0; *(f32x4*)(out + off + 4) = h1;
                    u32x4 w; w[0] = pk2(h0[0], h0[1]); w[1] = pk2(h0[2], h0[3]); w[2] = pk2(h1[0], h1[1]); w[3] = pk2(h1[2], h1[3]);
                    *(u32x4*)(HB + off) = w;
                    sq += (h0[0] * h0[0] + h0[1] * h0[1]) + (h0[2] * h0[2] + h0[3] * h0[3]) + (h1[0] * h1[0] + h1[1] * h1[1]) + (h1[2] * h1[2] + h1[3] * h1[3]);
                }
                sq += shx(sq, 16, lane); sq += shx(sq, 32, lane);
                if (fq == 0) ss_out[(size_t)row * 16 + u.pn * 4 + wc] = sq;
                if (m & 1) asm volatile("" ::: "memory");
            }
    }
};

struct SubOrder {
    int nN, nwg, nb, c;
    __device__ void init(int M, int N, int nb_, int c_) { nN = N / 256; nwg = (M / 256) * nN; nb = nb_; c = c_; }
    __device__ bool next(int i, pg8::Unit& u) const { if (c < 0 || c >= nb) return false; const int L = i * nb + c; if (L >= nwg) return false; u.pm = L / nN; u.pn = L % nN; return true; }
    __device__ __forceinline__ void a_ready(const pg8::Unit&) const {}
    __device__ __forceinline__ void done(const pg8::Unit&) const {}
};

template <bool REMAP>
__device__ __forceinline__ void tr_item(const float* W, int K, int N, bf16_t* WT, const float* g, LAS float* scr, int item, int lane, int kshift = 0) {
    const int nblk = N / 32, kb = item / nblk, nb = item % nblk, k0 = 64 * kb, n0 = 32 * nb;
    int src = n0 + (lane & 31);
    if (REMAP) { if (src >= 2048 && src < 3072) { const int jj = src - 2048; src = (jj & 1) ? 2560 + (jj >> 1) : 2048 + (jj >> 1); } }
#pragma unroll 8
    for (int i = 0; i < 32; ++i) { const int kk = 2 * i + (lane >> 5); float v = W[(size_t)((k0 + kk + kshift) & (K - 1)) * N + src]; if (g) v *= g[k0 + kk]; scr[kk * 33 + (lane & 31)] = v; }
    asm volatile("s_waitcnt lgkmcnt(0)" ::: "memory");
    const int c = lane & 7;
#pragma unroll
    for (int j = 0; j < 4; ++j) { const int n = (lane >> 3) + 8 * j; const LAS float* s = scr + (8 * c) * 33 + n;
        u32x4 o; o[0] = pk2(s[0 * 33], s[1 * 33]); o[1] = pk2(s[2 * 33], s[3 * 33]); o[2] = pk2(s[4 * 33], s[5 * 33]); o[3] = pk2(s[6 * 33], s[7 * 33]);
        *(u32x4*)(WT + (size_t)(n0 + n) * K + k0 + 8 * c) = o; }
    asm volatile("s_waitcnt lgkmcnt(0)" ::: "memory");
}

constexpr int AK_STRIDE = 144, AV_STRIDE = 136, A_KBYTES = 64 * AK_STRIDE, A_VBYTES = 64 * AV_STRIDE, A_BUF = 18432;
static_assert(A_KBYTES + A_VBYTES <= A_BUF, "attention LDS buffer");

__device__ __forceinline__ void attn_unit(const bf16_t* U, const bf16_t* VT, bf16_t* Y, const float* aog, int b, int h, int qb, LAS unsigned char* lds) {
    int tid = threadIdx.x; asm volatile("" : "+v"(tid));
    const int wave = __builtin_amdgcn_readfirstlane(tid >> 6), lane = tid & 63, l31 = lane & 31, hi = lane >> 5;
    const int q0 = qb * 256 + wave * 32, t = q0 + l31;
    const size_t trow = (size_t)(b * SEQ + t);
    bf16x8 qf[4];
    {
        const bf16_t* qp = U + trow * UP + UQ + h * HD + 8 * hi;
#pragma unroll
        for (int s = 0; s < 4; ++s) qf[s] = *(const bf16x8*)(qp + 16 * s);
    }
    f32x16 o0, o1;
#pragma unroll
    for (int i = 0; i < 16; ++i) { o0[i] = 0.f; o1[i] = 0.f; }
    float C = 0.f;
    const int ktmax = 4 * qb + 3, wkt = (q0 + 30) >> 6;
    const int srow = tid >> 3, sch = tid & 7;
    const bf16_t* gk = U + (size_t)(b * SEQ + srow) * UP + UK + h * HD + sch * 8;
    const bf16_t* gv = VT + ((size_t)((b * NH + h) * HD + srow)) * SEQ + sch * 8;
    const int kwoff = srow * AK_STRIDE + sch * 16, vwoff = A_KBYTES + srow * AV_STRIDE + sch * 16;
    __syncthreads();
    {
        const u32x4 kr = *(const u32x4*)(gk + (size_t)ktmax * 64 * UP), vr = *(const u32x4*)(gv + ktmax * 64);
        *(LAS u32x4*)(lds + kwoff) = kr;
        u32x2 a = {vr[0], vr[1]}, c = {vr[2], vr[3]};
        *(LAS u32x2*)(lds + vwoff) = a; *(LAS u32x2*)(lds + vwoff + 8) = c;
    }
    __syncthreads();
    int cur = 0;
    LAS unsigned* dflag = (LAS unsigned*)(lds + 2 * A_BUF);
    bool wdone = false;
    for (int kt = ktmax; kt >= 0; --kt) {
        u32x4 kr = {0u, 0u, 0u, 0u}, vr = {0u, 0u, 0u, 0u};
        if (kt > 0) { kr = *(const u32x4*)(gk + (size_t)(kt - 1) * 64 * UP); vr = *(const u32x4*)(gv + (kt - 1) * 64); }
        if (kt <= wkt && !wdone) {
            const LAS unsigned char* kb = lds + cur * A_BUF;
            const LAS unsigned char* vb = kb + A_KBYTES;
            f32x16 p0, p1;
#pragma unroll
            for (int i = 0; i < 16; ++i) { p0[i] = 0.f; p1[i] = 0.f; }
#pragma unroll
            for (int s = 0; s < 4; ++s) {
                const bf16x8 ka = *(const LAS bf16x8*)(kb + l31 * AK_STRIDE + 32 * s + 16 * hi);
                const bf16x8 kc = *(const LAS bf16x8*)(kb + (32 + l31) * AK_STRIDE + 32 * s + 16 * hi);
                p0 = MFMA32(ka, qf[s], p0); p1 = MFMA32(kc, qf[s], p1);
            }
            const int lim0 = t - (64 * kt + 4 * hi), lim1 = lim0 - 32;
            f32x16 l0, l1;
            float G0[4], G1[4];
#pragma unroll
            for (int g = 0; g < 4; ++g) {
                float s0 = 0.f, s1 = 0.f;
#pragma unroll
                for (int i = 0; i < 4; ++i) {
                    const int r = 4 * g + i, cr = i + 8 * g;
                    const float z0 = p0[r], z1 = p1[r];
                    const float sp0 = fmaxf(z0, 0.f) + flog2(1.0f + fexp2(-fabsf(z0)));
                    const float sp1 = fmaxf(z1, 0.f) + flog2(1.0f + fexp2(-fabsf(z1)));
                    const float a0 = (cr < lim0) ? -sp0 : 0.f, a1 = (cr < lim1) ? -sp1 : 0.f;
                    l0[r] = a0; l1[r] = a1; s0 += a0; s1 += a1;
                }
                G0[g] = s0; G1[g] = s1;
            }
            float X0[4], X1[4];
#pragma unroll
            for (int g = 0; g < 4; ++g) { X0[g] = shx(G0[g], 32, lane); X1[g] = shx(G1[g], 32, lane); }
            float run = C;
#pragma unroll
            for (int g = 3; g >= 0; --g) {
                float a = run + (hi == 0 ? X1[g] : 0.f);
#pragma unroll
                for (int i = 3; i >= 0; --i) { const int r = 4 * g + i, cr = i + 8 * g; a += l1[r]; const float e = fexp2(p1[r] + a); p1[r] = (cr < lim1) ? e : 0.f; }
                run += G1[g] + X1[g];
            }
#pragma unroll
            for (int g = 3; g >= 0; --g) {
                float a = run + (hi == 0 ? X0[g] : 0.f);
#pragma unroll
                for (int i = 3; i >= 0; --i) { const int r = 4 * g + i, cr = i + 8 * g; a += l0[r]; const float e = fexp2(p0[r] + a); p0[r] = (cr < lim0) ? e : 0.f; }
                run += G0[g] + X0[g];
            }
            C = run;
#pragma unroll
            for (int kh = 0; kh < 2; ++kh)
#pragma unroll
                for (int sh = 0; sh < 2; ++sh) {
                    u32x4 xw;
                    if (kh == 0) { xw[0] = pk2(p0[8 * sh + 0], p0[8 * sh + 1]); xw[1] = pk2(p0[8 * sh + 2], p0[8 * sh + 3]); xw[2] = pk2(p0[8 * sh + 4], p0[8 * sh + 5]); xw[3] = pk2(p0[8 * sh + 6], p0[8 * sh + 7]); }
                    else         { xw[0] = pk2(p1[8 * sh + 0], p1[8 * sh + 1]); xw[1] = pk2(p1[8 * sh + 2], p1[8 * sh + 3]); xw[2] = pk2(p1[8 * sh + 4], p1[8 * sh + 5]); xw[3] = pk2(p1[8 * sh + 6], p1[8 * sh + 7]); }
                    const bf16x8 xf = __builtin_bit_cast(bf16x8, xw);
                    const int koff = 2 * (32 * kh + 16 * sh + 4 * hi);
                    {
                        const LAS unsigned char* vp = vb + l31 * AV_STRIDE + koff;
                        const u32x2 lo = *(const LAS u32x2*)vp, hh = *(const LAS u32x2*)(vp + 16);
                        u32x4 vw = {lo[0], lo[1], hh[0], hh[1]};
                        o0 = MFMA32(__builtin_bit_cast(bf16x8, vw), xf, o0);
                    }
                    {
                        const LAS unsigned char* vp = vb + (32 + l31) * AV_STRIDE + koff;
                        const u32x2 lo = *(const LAS u32x2*)vp, hh = *(const LAS u32x2*)(vp + 16);
                        u32x4 vw = {lo[0], lo[1], hh[0], hh[1]};
                        o1 = MFMA32(__builtin_bit_cast(bf16x8, vw), xf, o1);
                    }
                }
        }
        wdone = (__builtin_amdgcn_ballot_w64(C > -160.0f) == 0ull);
        if (lane == 0) dflag[(kt & 1) * 8 + wave] = wdone ? 1u : 0u;
        if (kt > 0) {
            LAS unsigned char* nb = lds + (cur ^ 1) * A_BUF;
            *(LAS u32x4*)(nb + kwoff) = kr;
            u32x2 a = {vr[0], vr[1]}, c = {vr[2], vr[3]};
            *(LAS u32x2*)(nb + vwoff) = a; *(LAS u32x2*)(nb + vwoff + 8) = c;
        }
        __syncthreads();
        cur ^= 1;
        {
            const LAS u32x4* df = (const LAS u32x4*)(dflag + (kt & 1) * 8);
            const u32x4 f0 = df[0], f1 = df[1];
            if ((f0[0] & f0[1] & f0[2] & f0[3] & f1[0] & f1[1] & f1[2] & f1[3]) != 0u) break;
        }
    }
    float sq = 0.f;
#pragma unroll
    for (int i = 0; i < 16; ++i) sq += o0[i] * o0[i] + o1[i] * o1[i];
    sq += shx(sq, 32, lane);
    const float rs = frsq(sq * (1.0f / HD) + EPS);
    const bf16_t* sgp = U + trow * UP + USGA + h * HD;
    bf16_t* yp = Y + trow * DM + 512 + h * HD;
#pragma unroll
    for (int dt = 0; dt < 2; ++dt)
#pragma unroll
        for (int g = 0; g < 4; ++g) {
            const int d0 = 32 * dt + 8 * g + 4 * hi;
            const f32x4 gn = *(const f32x4*)(aog + d0);
            const u32x2 sg = *(const u32x2*)(sgp + d0);
            float v0, v1, v2, v3;
            if (dt == 0) { v0 = o0[4 * g + 0]; v1 = o0[4 * g + 1]; v2 = o0[4 * g + 2]; v3 = o0[4 * g + 3]; }
            else         { v0 = o1[4 * g + 0]; v1 = o1[4 * g + 1]; v2 = o1[4 * g + 2]; v3 = o1[4 * g + 3]; }
            u32x2 w;
            w[0] = pk2(v0 * rs * gn[0] * bflo(sg[0]), v1 * rs * gn[1] * bfhi(sg[0]));
            w[1] = pk2(v2 * rs * gn[2] * bflo(sg[1]), v3 * rs * gn[3] * bfhi(sg[1]));
            *(u32x2*)(yp + d0) = w;
        }
}

constexpr int CT = 32, C_XH = 0, C_XH_BYTES = (CT + 30) * 1024, C_CO = C_XH_BYTES, C_CO_BYTES = CT * CD * 4;
static_assert(C_CO + C_CO_BYTES <= LDS_BYTES, "conv LDS map");

__device__ __forceinline__ void convpre_unit(const bf16_t* U, bf16_t* C2, const float* dww, const float* dwb, const float* lng, const float* lnb, int cu, LAS unsigned char* lds) {
    int tid = threadIdx.x; asm volatile("" : "+v"(tid));
    const int wave = __builtin_amdgcn_readfirstlane(tid >> 6), lane = tid & 63;
    const int r0 = cu * CT, b = r0 >> 11, s0 = r0 & 2047;
    __syncthreads();
    for (int i = tid; i < (CT + 30) * 64; i += 512) {
        const int row = i >> 6, ch = i & 63, s = s0 - 30 + row;
        u32x4 v = {0u, 0u, 0u, 0u};
        if (s >= 0) v = *(const u32x4*)(U + (size_t)(b * SEQ + s) * UP + UGLU + ch * 8);
        *(LAS u32x4*)(lds + C_XH + row * 1024 + ch * 16) = v;
    }
    __syncthreads();
    {
        const int chp = tid & 255, tg = tid >> 8;
        float w0[CWID], w1[CWID];
#pragma unroll
        for (int j = 0; j < CWID; ++j) { const f32x2 ww = *(const f32x2*)(dww + (size_t)j * CD + 2 * chp); w0[j] = ww[0]; w1[j] = ww[1]; }
        const f32x2 bias = *(const f32x2*)(dwb + 2 * chp);
        const LAS unsigned char* xp = lds + C_XH + chp * 4;
#pragma unroll 1
        for (int tt = 0; tt < 16; ++tt) {
            const int tl = tg * 16 + tt;
            float a0 = bias[0], a1 = bias[1];
#pragma unroll
            for (int j = 0; j < CWID; ++j) { const unsigned xv = *(const LAS unsigned*)(xp + (tl + j) * 1024); a0 += w0[j] * bflo(xv); a1 += w1[j] * bfhi(xv); }
            f32x2 o = {a0, a1};
            *(LAS f32x2*)(lds + C_CO + tl * 2048 + chp * 8) = o;
        }
    }
    __syncthreads();
    {
        const f32x4 g0 = *(const f32x4*)(lng + lane * 4), g1 = *(const f32x4*)(lng + 256 + lane * 4);
        const f32x4 b0 = *(const f32x4*)(lnb + lane * 4), b1 = *(const f32x4*)(lnb + 256 + lane * 4);
#pragma unroll
        for (int tt = 0; tt < 4; ++tt) {
            const int tl = wave * 4 + tt;
            f32x4 v0 = *(const LAS f32x4*)(lds + C_CO + tl * 2048 + lane * 16), v1 = *(const LAS f32x4*)(lds + C_CO + tl * 2048 + 1024 + lane * 16);
            const float mean = wave_sum((v0[0] + v0[1]) + (v0[2] + v0[3]) + (v1[0] + v1[1]) + (v1[2] + v1[3]), lane) * (1.0f / CD);
            v0 = v0 - mean; v1 = v1 - mean;
            const float var = wave_sum((v0[0] * v0[0] + v0[1] * v0[1]) + (v0[2] * v0[2] + v0[3] * v0[3]) + (v1[0] * v1[0] + v1[1] * v1[1]) + (v1[2] * v1[2] + v1[3] * v1[3]), lane) * (1.0f / CD);
            const float rs = frsq(var + EPS);
            v0 = v0 * rs * g0 + b0; v1 = v1 * rs * g1 + b1;
            u32x2 wa, wb;
            wa[0] = pk2(siluf_(v0[0]), siluf_(v0[1])); wa[1] = pk2(siluf_(v0[2]), siluf_(v0[3]));
            wb[0] = pk2(siluf_(v1[0]), siluf_(v1[1])); wb[1] = pk2(siluf_(v1[2]), siluf_(v1[3]));
            bf16_t* cp = C2 + (size_t)(r0 + tl) * CD + lane * 4;
            *(u32x2*)cp = wa; *(u32x2*)(cp + 256) = wb;
        }
    }
}

struct Params { const float* in[16]; float* out; unsigned char* ws; int ph_lo, ph_hi; };

template <int ph>
__device__ __forceinline__ void run_phase(const Params& P, LAS unsigned char* lds) {
    const int G = gridDim.x, bid = blockIdx.x;
    unsigned char* ws = P.ws;
    const float* x = P.in[0];
    float* out = P.out;
    bf16_t* HB = (bf16_t*)(ws + WS_HB); bf16_t* H1B = (bf16_t*)(ws + WS_H1B); bf16_t* Ub = (bf16_t*)(ws + WS_U); bf16_t* VT = (bf16_t*)(ws + WS_VT); bf16_t* Yb = (bf16_t*)(ws + WS_Y);
    bf16_t* C2 = (bf16_t*)(ws + WS_C2); bf16_t* EB = (bf16_t*)(ws + WS_EB);
    float* ssA = (float*)(ws + WS_SSA); float* ssB = (float*)(ws + WS_SSB); float* ssC = (float*)(ws + WS_SSC);
    int tid = threadIdx.x; asm volatile("" : "+v"(tid));
    const int lane = tid & 63, wave = __builtin_amdgcn_readfirstlane(tid >> 6);
    const int gw = bid * 8 + wave, NGW = G * 8;
    if constexpr (ph == 0) {
        LAS float* scr = (LAS float*)(lds + wave * 16384);
        for (int it = gw; it < 2 * 3072; it += NGW) {
            const int l = it / 3072; int r = it - l * 3072;
            unsigned char* wb = ws + (size_t)l * W_LAYER;
            if (r < 1792) { tr_item<true>(P.in[3] + (size_t)l * DM * DIN, DM, DIN, (bf16_t*)(wb + W_IN), P.in[2] + l * DM, scr, r, lane); continue; } r -= 1792;
            if (r < 128) { tr_item<false>(P.in[9] + (size_t)l * CD * CD, CD, CD, (bf16_t*)(wb + W_PW), nullptr, scr, r, lane); continue; } r -= 128;
            if (r < 512) { tr_item<false>(P.in[11] + (size_t)l * DM * DM, DM, DM, (bf16_t*)(wb + W_OUT), nullptr, scr, r, lane, 512); continue; } r -= 512;
            if (r < 512) { tr_item<false>(P.in[13] + (size_t)l * DM * DM, DM, DM, (bf16_t*)(wb + W_PG), P.in[12] + l * DM, scr, r, lane); continue; } r -= 512;
            tr_item<false>(P.in[14] + (size_t)l * PLE * DM, PLE, DM, (bf16_t*)(wb + W_PLE), nullptr, scr, r, lane);
        }
        for (int row = gw; row < MT; row += NGW) {
            const f32x4* xr = (const f32x4*)(x + (size_t)row * DM) + lane;
            u32x2* ob = (u32x2*)(HB + (size_t)row * DM) + lane;
            float s = 0.f;
#pragma unroll
            for (int j = 0; j < 4; ++j) { const f32x4 v = xr[64 * j]; s += (v[0] * v[0] + v[1] * v[1]) + (v[2] * v[2] + v[3] * v[3]); u32x2 w; w[0] = pk2(v[0], v[1]); w[1] = pk2(v[2], v[3]); ob[64 * j] = w; }
            s = wave_sum(s, lane);
            if (lane < 16) ssA[(size_t)row * 16 + lane] = (lane == 0) ? s : 0.f;
        }
        {
            const f32x4* pp = (const f32x4*)P.in[1]; u32x2* pb = (u32x2*)(ws + WS_PB);
            for (int i = bid * 512 + tid; i < 2 * MT * PLE / 4; i += G * 512) { const f32x4 v = pp[i]; u32x2 w; w[0] = pk2(v[0], v[1]); w[1] = pk2(v[2], v[3]); pb[i] = w; }
        }
    } else if constexpr (ph == NPHASE - 1) {
        const float* fg = P.in[15];
        for (int row = gw; row < MT; row += NGW) {
            f32x4* xr = (f32x4*)(out + (size_t)row * DM) + lane;
            f32x4 v[4]; float s = 0.f;
#pragma unroll
            for (int j = 0; j < 4; ++j) { v[j] = xr[64 * j]; s += (v[j][0] * v[j][0] + v[j][1] * v[j][1]) + (v[j][2] * v[j][2] + v[j][3] * v[j][3]); }
            const float rs = frsq(wave_sum(s, lane) * (1.0f / DM) + EPS);
#pragma unroll
            for (int j = 0; j < 4; ++j) { const f32x4 g = *((const f32x4*)fg + lane + 64 * j); xr[64 * j] = v[j] * rs * g; }
        }
    } else {
        constexpr int l = (ph - 1) / 5, k = (ph - 1) % 5;
        unsigned char* wb = ws + (size_t)l * W_LAYER;
        if constexpr (k == 0) {
            pg8::Gemm g{HB, (const bf16_t*)(wb + W_IN), MT, DIN, DM}; pg8::StaticOrder S; S.init(MT, DIN, G, bid);
            EpiIn E{Ub, VT, ssA};
            pg8::gemm_phase<EpiIn, pg8::StaticOrder, true, true>(lds, g, S, E, threadIdx.x);
        } else if constexpr (k == 1) {
            const float* aog = P.in[4] + l * HD;
            const float* dww = P.in[5] + (size_t)l * CWID * CD; const float* dwb = P.in[6] + l * CD;
            const float* lng = P.in[7] + l * CD; const float* lnb = P.in[8] + l * CD;
            for (int it = bid; it < 256; it += G) {
                const int bh = it >> 2, pr = it & 3, b = bh >> 3, h = bh & 7;
#pragma unroll 1
                for (int uu = 0; uu < ((PROBE_DUP & 2) ? 4 : 2); ++uu) attn_unit(Ub, VT, Yb, aog, b, h, (uu & 1) == 0 ? 7 - pr : pr, lds);
#pragma unroll 1
                for (int uu = 0; uu < ((PROBE_DUP & 4) ? 4 : 2); ++uu) convpre_unit(Ub, C2, dww, dwb, lng, lnb, 2 * it + (uu & 1), lds);
            }
            __syncthreads();
        } else if constexpr (k == 2) {
            const int nb0 = G / 2;
            {
                pg8::Gemm g{C2, (const bf16_t*)(wb + W_PW), MT, CD, CD}; SubOrder S; S.init(MT, CD, nb0, bid);
                EpiPw E{Ub, Yb, P.in[10] + l * CD, ssC};
                pg8::gemm_phase<EpiPw, SubOrder, true, true>(lds, g, S, E, threadIdx.x);
            }
            {
                pg8::Gemm g{(const bf16_t*)(ws + WS_PB) + (size_t)l * MT * PLE, (const bf16_t*)(wb + W_PLE), MT, DM, PLE}; SubOrder S; S.init(MT, DM, G - nb0, bid - nb0);
                EpiE E{EB};
                int t2 = threadIdx.x; asm volatile("" : "+v"(t2));
                pg8::gemm_phase<EpiE, SubOrder, true, true>(lds, g, S, E, t2);
            }
        } else if constexpr (k == 3) {
            pg8::Gemm g{Yb, (const bf16_t*)(wb + W_OUT), MT, DM, DM}; pg8::StaticOrder S; S.init(MT, DM, G, bid);
            EpiOut E{l == 0 ? x : out, out, H1B, ssB, ssC};
            pg8::gemm_phase<EpiOut, pg8::StaticOrder, true, true>(lds, g, S, E, threadIdx.x);
        } else {
            pg8::Gemm g{H1B, (const bf16_t*)(wb + W_PG), MT, DM, DM}; pg8::StaticOrder S; S.init(MT, DM, G, bid);
            EpiGate E{out, EB, HB, ssB, ssA};
            pg8::gemm_phase<EpiGate, pg8::StaticOrder, true, true>(lds, g, S, E, threadIdx.x);
        }
    }
}

__global__ void __launch_bounds__(512, 2) fwd(Params P) {
    extern __shared__ __attribute__((aligned(16))) unsigned char lds_raw[];
    LAS unsigned char* lds = (LAS unsigned char*)lds_raw;
    const int lo = P.ph_lo, hi = P.ph_hi;
#define PHASE(k) if (lo <= (k) && (k) < hi) { run_phase<(k)>(P, lds); if ((k) + 1 < hi) cg::this_grid().sync(); }
    PHASE(0) PHASE(1) PHASE(2) PHASE(3) PHASE(4) PHASE(5) PHASE(6) PHASE(7) PHASE(8) PHASE(9) PHASE(10) PHASE(11)
#undef PHASE
}

#ifndef MK_N_LAUNCHES
#define MK_N_LAUNCHES 1
#endif
extern "C" void kernel_launch(void* const* d_in, const int* in_sizes, int n_in, void* d_out, int out_size, void* d_ws, size_t ws_size, hipStream_t stream) {
    static int grid = 0;
    if (grid == 0) {
        if (n_in != 16 || out_size != MT * DM || ws_size < WS_END) { fprintf(stderr, "kernel_launch: unexpected shapes (n_in %d, out %d, ws %zu)\n", n_in, out_size, ws_size); grid = -1; return; }
        int dev = 0, cus = 0, per_cu = 0;
        (void)hipGetDevice(&dev);
        (void)hipDeviceGetAttribute(&cus, hipDeviceAttributeMultiprocessorCount, dev);
        if (hipFuncSetAttribute((const void*)fwd, hipFuncAttributeMaxDynamicSharedMemorySize, LDS_BYTES) != hipSuccess) { fprintf(stderr, "kernel_launch: hipFuncSetAttribute failed\n"); grid = -1; return; }
        if (hipOccupancyMaxActiveBlocksPerMultiprocessor(&per_cu, (const void*)fwd, 512, LDS_BYTES) != hipSuccess || per_cu < 1) { fprintf(stderr, "kernel_launch: occupancy query says %d\n", per_cu); per_cu = 1; }
        (void)hipGetLastError();
        grid = cus * 1;
        if (grid <= 0) grid = 256;
    }
    if (grid < 0) return;
    Params p{};
    for (int i = 0; i < 16; ++i) p.in[i] = (const float*)d_in[i];
    p.out = (float*)d_out; p.ws = (unsigned char*)d_ws;
#if MK_N_LAUNCHES == 1
    p.ph_lo = 0; p.ph_hi = NPHASE;
    void* args[] = {&p};
    hipError_t e = hipLaunchCooperativeKernel((const void*)fwd, dim3(grid), dim3(512), args, LDS_BYTES, stream);
    if (e != hipSuccess) fprintf(stderr, "kernel_launch: cooperative launch failed: %s (grid %d)\n", hipGetErrorString(e), grid);
#else
    for (int ph = 0; ph < NPHASE; ++ph) {
        p.ph_lo = ph; p.ph_hi = ph + 1;
        hipLaunchKernelGGL(fwd, dim3(grid), dim3(512), LDS_BYTES, stream, p);
    }
#endif
}
```

```cpp
#include <hip/hip_runtime.h>
#include <hip/hip_cooperative_groups.h>
#include <cstdio>
#include <cstdint>
namespace cg = cooperative_groups;
namespace pg8 {
#define PG8_LAS __attribute__((address_space(3)))
typedef unsigned short bf16_t;
typedef short bf16x8 __attribute__((ext_vector_type(8)));
typedef float f32x4 __attribute__((ext_vector_type(4)));
typedef unsigned u32x4 __attribute__((ext_vector_type(4)));
constexpr int BM = 256, BK = 64, HALF = 128, HTB = HALF * BK * 2  , STAGE_BYTES = 8 * HTB, NXCD = 8, WGM = 8;

__host__ __device__ __forceinline__ int lds_byte(int r, int c) { const int st = (r >> 4) * 2 + (c >> 5), rr = r & 15, cc = c & 31, ob = rr * 64 + cc * 2; return st * 1024 + (ob ^ (((ob >> 9) & 1) << 5)); }
__host__ __device__ __forceinline__ void stage_rc(int b, int& R, int& C) { const int st = b / 1024, sb = b % 1024, swz = sb ^ (((sb >> 9) & 1) << 5); R = (st >> 1) * 16 + swz / 64; C = (st & 1) * 32 + (swz % 64) / 2; }
__host__ __device__ __forceinline__ int perm32(int rho) { const int n = rho >> 4, i = rho & 15; return 8 * (i >> 2) + 4 * n + (i & 3); }

struct Unit { int pm, pn; };
struct Gemm { const bf16_t* A; const bf16_t* Bt; int M, N, K; };

struct StaticOrder {
    int nM, nN, nwg, G, c;
    __host__ __device__ void init(int M, int N, int G_, int c_) { nM = M / BM; nN = N / BM; nwg = nM * nN; G = G_; c = c_; }
    __host__ __device__ bool next(int i, Unit& u) const {
        const long L = (long)i * G + c; if (L >= nwg) return false;
        int wgid = (int)L; { const int q = nwg / NXCD, r = nwg % NXCD, xcd = wgid % NXCD, off = wgid / NXCD; wgid = (xcd < r ? xcd * (q + 1) : r * (q + 1) + (xcd - r) * q) + off; }
        const int nig = WGM * nN, gid = wgid / nig, fm = gid * WGM, gsz = (nM - fm) < WGM ? (nM - fm) : WGM;
        u.pm = fm + ((wgid % nig) % gsz); u.pn = (wgid % nig) / gsz; return true;
    }
    __device__ __forceinline__ void a_ready(const Unit&) const {}
    __device__ __forceinline__ void done(const Unit&) const {}
};

template <class Epi, class Sched, bool ALIGN_EPI = false, bool SP2 = false>
__device__ __forceinline__ void gemm_phase(PG8_LAS unsigned char* lds, const Gemm g, const Sched& S, const Epi& E, const int tid_in) {
    const int tid = tid_in, wid = __builtin_amdgcn_readfirstlane(tid >> 6), lane = tid & 63, wr = wid >> 2, wc = wid & 3, fr = lane & 15, fq = lane >> 4;
    const int K = g.K, nt = K / BK;
    unsigned voffA[2], voffB[2];
#pragma unroll
    for (int i = 0; i < 2; ++i) { int R, C; stage_rc(tid * 16 + i * 8192, R, C); const int Rb = Epi::PERM ? ((R & ~31) + perm32(R & 31)) : R;
        voffA[i] = (unsigned)(R * K + C) * 2u; voffB[i] = (unsigned)(Rb * K + C) * 2u; }
    const size_t kstep = (size_t)(BK * 2);
    const size_t hstep = (size_t)HALF * K * 2;
    const size_t tstep = 2 * hstep;
    const unsigned ldsw = (unsigned)wid * 1024u;
    const int aoff = lds_byte(wr * 64 + fr, fq * 8), boff = lds_byte(wc * 32 + fr, fq * 8);
#define PG8_SA(b, h) (((b) * 2 + (h)) * HTB)
#define PG8_SB(b, h) ((4 + (b) * 2 + (h)) * HTB)
#define PG8_STAGE(bufoff, gbase, voff) do { _Pragma("unroll") for (int _i = 0; _i < 2; ++_i) \
        __builtin_amdgcn_global_load_lds((const unsigned*)((const char*)(gbase) + (voff)[_i]), (PG8_LAS unsigned*)(lds + (bufoff) + ldsw + _i * 8192), 16, 0, 0); } while (0)
#define PG8_LDA(dst, b, h) do { _Pragma("unroll") for (int m = 0; m < 4; ++m) _Pragma("unroll") for (int k = 0; k < 2; ++k) dst[m][k] = *(const PG8_LAS bf16x8*)(lds + PG8_SA(b, h) + aoff + m * 2048 + k * 1024); } while (0)
#define PG8_LDB(dst, b, h) do { _Pragma("unroll") for (int n = 0; n < 2; ++n) _Pragma("unroll") for (int k = 0; k < 2; ++k) dst[n][k] = *(const PG8_LAS bf16x8*)(lds + PG8_SB(b, h) + boff + n * 2048 + k * 1024); } while (0)
#define PG8_MMA(ai, bj, At, Bt) do { __builtin_amdgcn_s_setprio(1); _Pragma("unroll") for (int m = 0; m < 4; ++m) _Pragma("unroll") for (int n = 0; n < 2; ++n) _Pragma("unroll") for (int k = 0; k < 2; ++k) \
        acc[ai][bj][m][n] = __builtin_amdgcn_mfma_f32_16x16x32_bf16(Bt[n][k], At[m][k], acc[ai][bj][m][n], 0, 0, 0); __builtin_amdgcn_s_setprio(0); } while (0)
#define PG8_WAIT_V(n) asm volatile("s_waitcnt vmcnt(" #n ")" ::: "memory")
#define PG8_WAIT_L(n) asm volatile("s_waitcnt lgkmcnt(" #n ")" ::: "memory")
#define PG8_BAR __builtin_amdgcn_s_barrier()
#define PG8_SCHED __builtin_amdgcn_sched_barrier(0)
    Unit cur, nxt; int ui = 0;
    if (!S.next(0, cur)) return;
    f32x4 acc[2][2][4][2];
#pragma unroll
    for (int a = 0; a < 2; ++a)
#pragma unroll
        for (int b = 0; b < 2; ++b)
#pragma unroll
            for (int m = 0; m < 4; ++m)
#pragma unroll
                for (int n = 0; n < 2; ++n) acc[a][b][m][n] = (f32x4){0.f, 0.f, 0.f, 0.f};
    bf16x8 At[4][2], B0[2][2], B1[2][2];
    const char* cA = (const char*)g.A + (size_t)cur.pm * tstep; const char* cB = (const char*)g.Bt + (size_t)cur.pn * tstep;
    S.a_ready(cur);
    if constexpr (SP2) {
        PG8_STAGE(PG8_SB(0, 0), cB, voffB); PG8_STAGE(PG8_SB(0, 1), cB + hstep, voffB); PG8_STAGE(PG8_SA(0, 0), cA, voffA); PG8_STAGE(PG8_SA(0, 1), cA + hstep, voffA);
        if (wr == 1) PG8_BAR;
        PG8_WAIT_V(2); PG8_BAR;
        PG8_STAGE(PG8_SB(1, 0), cB + kstep, voffB); PG8_STAGE(PG8_SA(1, 0), cA + kstep, voffA); PG8_STAGE(PG8_SB(1, 1), cB + hstep + kstep, voffB);
        PG8_WAIT_V(6); PG8_BAR;
    } else {
        PG8_STAGE(PG8_SB(0, 0), cB, voffB); PG8_STAGE(PG8_SA(0, 0), cA, voffA); PG8_STAGE(PG8_SB(0, 1), cB + hstep, voffB); PG8_STAGE(PG8_SA(0, 1), cA + hstep, voffA);
        if (wr == 1) PG8_BAR;
        PG8_WAIT_V(4); PG8_BAR;
        PG8_STAGE(PG8_SB(1, 0), cB + kstep, voffB); PG8_STAGE(PG8_SA(1, 0), cA + kstep, voffA); PG8_STAGE(PG8_SB(1, 1), cB + hstep + kstep, voffB);
        PG8_WAIT_V(6); PG8_BAR;
    }
    for (;;) {
        const bool has_next = S.next(ui + 1, nxt);
        const char* nA = has_next ? (const char*)g.A + (size_t)nxt.pm * tstep : cA; const char* nB = has_next ? (const char*)g.Bt + (size_t)nxt.pn * tstep : cB;
        for (int t = 0; t < nt; t += 2) {
            if constexpr (Epi::MID_T > 0) { if (t == Epi::MID_T) E.mid(acc, cur); }
            const bool last = (t == nt - 2);
            const char* a1 = cA + (size_t)(t + 1) * kstep;
            const char* a2 = last ? nA : cA + (size_t)(t + 2) * kstep; const char* b2 = last ? nB : cB + (size_t)(t + 2) * kstep;
            const char* a3 = a2 + kstep; const char* b3 = b2 + kstep;
            if (last && has_next) S.a_ready(nxt);
            if constexpr (SP2) {
            PG8_LDB(B0, 0, 0); PG8_LDB(B1, 0, 1); PG8_SCHED; PG8_LDA(At, 0, 0); PG8_STAGE(PG8_SA(1, 1), a1 + hstep, voffA);
            PG8_WAIT_V(8); PG8_WAIT_L(0); PG8_BAR; PG8_MMA(0, 0, At, B0); PG8_MMA(0, 1, At, B1); PG8_BAR; PG8_SCHED;
            PG8_LDA(At, 0, 1); PG8_STAGE(PG8_SB(0, 0), b2, voffB); PG8_STAGE(PG8_SB(0, 1), b2 + hstep, voffB); PG8_STAGE(PG8_SA(0, 0), a2, voffA);
            PG8_WAIT_V(8); PG8_WAIT_L(0); PG8_BAR; PG8_MMA(1, 0, At, B0); PG8_MMA(1, 1, At, B1); PG8_BAR; PG8_SCHED;
            PG8_LDB(B0, 1, 0); PG8_LDB(B1, 1, 1); PG8_SCHED; PG8_LDA(At, 1, 0); PG8_STAGE(PG8_SA(0, 1), a2 + hstep, voffA);
            PG8_WAIT_V(8); PG8_WAIT_L(0); PG8_BAR; PG8_MMA(0, 0, At, B0); PG8_MMA(0, 1, At, B1); PG8_BAR; PG8_SCHED;
            PG8_LDA(At, 1, 1); PG8_STAGE(PG8_SB(1, 0), b3, voffB); PG8_STAGE(PG8_SB(1, 1), b3 + hstep, voffB); PG8_STAGE(PG8_SA(1, 0), a3, voffA);
            PG8_WAIT_V(8); PG8_WAIT_L(0); PG8_BAR; PG8_MMA(1, 0, At, B0); PG8_MMA(1, 1, At, B1); PG8_BAR; PG8_SCHED;
            } else {
            PG8_LDB(B0, 0, 0); PG8_SCHED; PG8_LDA(At, 0, 0); PG8_STAGE(PG8_SA(1, 1), a1 + hstep, voffA);
            PG8_WAIT_L(8); PG8_BAR; PG8_WAIT_L(0); PG8_MMA(0, 0, At, B0); PG8_BAR; PG8_SCHED;
            PG8_LDB(B1, 0, 1); PG8_STAGE(PG8_SB(0, 0), b2, voffB);
            PG8_BAR; PG8_WAIT_L(0); PG8_MMA(0, 1, At, B1); PG8_BAR;
            PG8_LDA(At, 0, 1); PG8_STAGE(PG8_SA(0, 0), a2, voffA);
            PG8_BAR; PG8_WAIT_L(0); PG8_MMA(1, 0, At, B0); PG8_BAR; PG8_SCHED;
            PG8_STAGE(PG8_SB(0, 1), b2 + hstep, voffB);
            PG8_WAIT_V(6); PG8_BAR; PG8_MMA(1, 1, At, B1); PG8_BAR;
            PG8_LDB(B0, 1, 0); PG8_SCHED; PG8_LDA(At, 1, 0); PG8_STAGE(PG8_SA(0, 1), a2 + hstep, voffA);
            PG8_WAIT_L(8); PG8_BAR; PG8_WAIT_L(0); PG8_MMA(0, 0, At, B0); PG8_BAR; PG8_SCHED;
            PG8_LDB(B1, 1, 1); PG8_STAGE(PG8_SB(1, 0), b3, voffB);
            PG8_BAR; PG8_WAIT_L(0); PG8_MMA(0, 1, At, B1); PG8_BAR;
            PG8_LDA(At, 1, 1); PG8_STAGE(PG8_SA(1, 0), a3, voffA);
            PG8_BAR; PG8_WAIT_L(0); PG8_MMA(1, 0, At, B0); PG8_BAR; PG8_SCHED;
            PG8_STAGE(PG8_SB(1, 1), b3 + hstep, voffB);
            PG8_WAIT_V(6); PG8_BAR; PG8_MMA(1, 1, At, B1); PG8_BAR;
            }
        }
        if constexpr (ALIGN_EPI) { if (wr == 0) PG8_BAR; }
        if constexpr (!Epi::AFTER_DRAIN) { E(acc, cur, wr, wc, fr, fq); S.done(cur); }
        if (!has_next) break;
#pragma unroll
        for (int a = 0; a < 2; ++a)
#pragma unroll
            for (int b = 0; b < 2; ++b)
#pragma unroll
                for (int m = 0; m < 4; ++m)
#pragma unroll
                    for (int n = 0; n < 2; ++n) acc[a][b][m][n] = (f32x4){0.f, 0.f, 0.f, 0.f};
        cur = nxt; cA = nA; cB = nB; ++ui;
        if constexpr (ALIGN_EPI) { if (wr == 1) PG8_BAR; }
    }
    PG8_WAIT_V(0);
    if constexpr (!ALIGN_EPI) { if (wr == 0) PG8_BAR; }
    PG8_BAR;
    if constexpr (Epi::AFTER_DRAIN) { E.fused(acc, cur, wr, wc, fr, fq, lds, wid, lane); S.done(cur); }
#undef PG8_SA
#undef PG8_SB
#undef PG8_STAGE
#undef PG8_LDA
#undef PG8_LDB
#undef PG8_MMA
#undef PG8_WAIT_V
#undef PG8_WAIT_L
#undef PG8_BAR
#undef PG8_SCHED
}
}

#define LAS __attribute__((address_space(3)))
typedef unsigned short bf16_t;
typedef short bf16x8 __attribute__((ext_vector_type(8)));
typedef float f32x4 __attribute__((ext_vector_type(4)));
typedef float f32x2 __attribute__((ext_vector_type(2)));
typedef float f32x16 __attribute__((ext_vector_type(16)));
typedef unsigned u32x4 __attribute__((ext_vector_type(4)));
typedef unsigned u32x2 __attribute__((ext_vector_type(2)));
typedef __bf16 bf16x2_t __attribute__((ext_vector_type(2)));

constexpr int NB = 8, SEQ = 2048, DM = 1024, MT = NB * SEQ, DIN = 3584, NH = 8, HD = 64, CWID = 31, PLE = 256, CD = 512;
constexpr float EPS = 1e-6f;
constexpr float QSCALE = 0.125f * 1.4426950408889634f;

constexpr size_t MiB = 1u << 20;
constexpr size_t W_IN = 0, W_PW = 7340032, W_OUT = W_PW + 524288, W_PG = W_OUT + 2097152, W_PLE = W_PG + 2097152, W_LAYER = 12 * MiB;
static_assert(W_PLE + 524288 == W_LAYER, "weight map");
constexpr int UP = 2560, UQ = 0, UK = 512, USGA = 1024, UGLU = 1536, USGC = 2048;
constexpr size_t WS_PB = 24 * MiB, WS_HB = 40 * MiB, WS_Y = 72 * MiB, WS_VT = 104 * MiB, WS_SSA = 120 * MiB, WS_SSB = 121 * MiB, WS_SSC = 122 * MiB, WS_U = 123 * MiB;
constexpr size_t WS_H1B = WS_U  , WS_C2 = 203 * MiB, WS_EB = 219 * MiB, WS_CTL = 252 * MiB, CTL_BYTES = 16384, WS_END = WS_CTL + CTL_BYTES;
static_assert(WS_U + (size_t)MT * UP * 2 <= WS_C2, "ws map");
constexpr int LDS_BYTES = 147456;
constexpr int NPHASE = 12;
#ifndef PROBE_DUP
#define PROBE_DUP 0
#endif

__device__ __forceinline__ unsigned pk2(float lo, float hi) { f32x2 v = {lo, hi}; bf16x2_t b = __builtin_convertvector(v, bf16x2_t); return __builtin_bit_cast(unsigned, b); }
__device__ __forceinline__ float bflo(unsigned u) { return __builtin_bit_cast(float, u << 16); }
__device__ __forceinline__ float bfhi(unsigned u) { return __builtin_bit_cast(float, u & 0xffff0000u); }
__device__ __forceinline__ float fexp2(float x) { return __builtin_amdgcn_exp2f(x); }
__device__ __forceinline__ float flog2(float x) { return __builtin_amdgcn_logf(x); }
__device__ __forceinline__ float frcp(float x) { return __builtin_amdgcn_rcpf(x); }
__device__ __forceinline__ float frsq(float x) { return __builtin_amdgcn_rsqf(x); }
__device__ __forceinline__ float sigmoidf_(float x) { return frcp(1.0f + fexp2(-1.4426950408889634f * x)); }
__device__ __forceinline__ float siluf_(float x) { return x * sigmoidf_(x); }
#define MFMA32(a, b, c) __builtin_amdgcn_mfma_f32_32x32x16_bf16((a), (b), (c), 0, 0, 0)

__device__ __forceinline__ float shx(float v, int m, int lane) { return __builtin_bit_cast(float, __builtin_amdgcn_ds_bpermute((lane ^ m) << 2, __builtin_bit_cast(int, v))); }
__device__ __forceinline__ float wave_sum(float v, int lane) {
#pragma unroll
    for (int o = 1; o < 64; o <<= 1) v += shx(v, o, lane);
    return v;
}
__device__ __forceinline__ float row_rstd(const float* ss, int row, int fq, int lane) {
    const f32x4 p = *(const f32x4*)(ss + (size_t)row * 16 + fq * 4);
    float s = (p[0] + p[1]) + (p[2] + p[3]);
    s += shx(s, 16, lane); s += shx(s, 32, lane);
    return frsq(s * (1.0f / DM) + EPS);
}

struct EpiIn {
    static constexpr bool PERM = true, AFTER_DRAIN = false; static constexpr int MID_T = 0;
    bf16_t* U; bf16_t* VT; const float* ss;
    __device__ __forceinline__ void operator()(const f32x4 (&acc)[2][2][4][2], const pg8::Unit& u, int, int, int, int) const {
        int t_ = threadIdx.x; asm volatile("" : "+v"(t_));
        const int lane = t_ & 63, fr = lane & 15, fq = lane >> 4, wid_ = __builtin_amdgcn_readfirstlane(t_ >> 6), wr = wid_ >> 2, wc = wid_ & 3;
        const int pn = u.pn;
#pragma unroll
        for (int ai = 0; ai < 2; ++ai)
#pragma unroll
            for (int m = 0; m < 4; ++m) {
                const int row = u.pm * 256 + ai * 128 + wr * 64 + m * 16 + fr;
                const float rs = row_rstd(ss, row, fq, lane);
#pragma unroll
                for (int bj = 0; bj < 2; ++bj) {
                    const int col0 = pn * 256 + bj * 128 + wc * 32 + 8 * fq;
                    f32x4 v0 = acc[ai][bj][m][0] * rs, v1 = acc[ai][bj][m][1] * rs;
                    if (pn < 4) {
                        const float sc = pn < 2 ? QSCALE : 1.0f;
                        v0 = v0 * sc; v1 = v1 * sc;
                        u32x4 w; w[0] = pk2(v0[0], v0[1]); w[1] = pk2(v0[2], v0[3]); w[2] = pk2(v1[0], v1[1]); w[3] = pk2(v1[2], v1[3]);
                        *(u32x4*)(U + (size_t)row * UP + col0) = w;
                    } else if (pn < 6) {
                        const int vc = col0 - 1024, hh = vc >> 6, d0 = vc & 63, b = row >> 11, s = row & 2047;
                        bf16_t* vp = VT + ((size_t)((b * NH + hh) * HD + d0)) * SEQ + s;
                        const unsigned w0 = pk2(v0[0], v0[1]), w1 = pk2(v0[2], v0[3]), w2 = pk2(v1[0], v1[1]), w3 = pk2(v1[2], v1[3]);
                        vp[0 * SEQ] = (bf16_t)(w0 & 0xffffu); vp[1 * SEQ] = (bf16_t)(w0 >> 16);
                        vp[2 * SEQ] = (bf16_t)(w1 & 0xffffu); vp[3 * SEQ] = (bf16_t)(w1 >> 16);
                        vp[4 * SEQ] = (bf16_t)(w2 & 0xffffu); vp[5 * SEQ] = (bf16_t)(w2 >> 16);
                        vp[6 * SEQ] = (bf16_t)(w3 & 0xffffu); vp[7 * SEQ] = (bf16_t)(w3 >> 16);
                    } else if (pn < 8 || pn >= 12) {
                        u32x4 w; w[0] = pk2(siluf_(v0[0]), siluf_(v0[1])); w[1] = pk2(siluf_(v0[2]), siluf_(v0[3]));
                        w[2] = pk2(siluf_(v1[0]), siluf_(v1[1])); w[3] = pk2(siluf_(v1[2]), siluf_(v1[3]));
                        *(u32x4*)(U + (size_t)row * UP + (pn < 8 ? col0 - 512 : col0 - 1024)) = w;
                    } else {
                        const int ch0 = (col0 - 2048) >> 1;
                        u32x2 w; w[0] = pk2(v0[0] * sigmoidf_(v0[1]), v0[2] * sigmoidf_(v0[3])); w[1] = pk2(v1[0] * sigmoidf_(v1[1]), v1[2] * sigmoidf_(v1[3]));
                        *(u32x2*)(U + (size_t)row * UP + UGLU + ch0) = w;
                    }
                }
                asm volatile("" ::: "memory");
            }
    }
};

struct EpiPw {
    static constexpr bool PERM = true, AFTER_DRAIN = false; static constexpr int MID_T = 0;
    const bf16_t* U; bf16_t* Y; const float* cog; float* ssC;
    __device__ __forceinline__ void operator()(const f32x4 (&acc)[2][2][4][2], const pg8::Unit& u, int, int, int, int) const {
        int t_ = threadIdx.x; asm volatile("" : "+v"(t_));
        const int lane = t_ & 63, fr = lane & 15, fq = lane >> 4, wid_ = __builtin_amdgcn_readfirstlane(t_ >> 6), wr = wid_ >> 2, wc = wid_ & 3;
#pragma unroll
        for (int ai = 0; ai < 2; ++ai)
#pragma unroll
            for (int m = 0; m < 4; ++m) {
                const int row = u.pm * 256 + ai * 128 + wr * 64 + m * 16 + fr;
                float sq = 0.f;
#pragma unroll
                for (int bj = 0; bj < 2; ++bj) {
                    const int col0 = u.pn * 256 + bj * 128 + wc * 32 + 8 * fq;
                    const f32x4 v0 = acc[ai][bj][m][0], v1 = acc[ai][bj][m][1];
                    sq += (v0[0] * v0[0] + v0[1] * v0[1]) + (v0[2] * v0[2] + v0[3] * v0[3]) + (v1[0] * v1[0] + v1[1] * v1[1]) + (v1[2] * v1[2] + v1[3] * v1[3]);
                    const f32x4 g0 = *(const f32x4*)(cog + col0), g1 = *(const f32x4*)(cog + col0 + 4);
                    const u32x4 sg = *(const u32x4*)(U + (size_t)row * UP + USGC + col0);
                    u32x4 w;
                    w[0] = pk2(v0[0] * g0[0] * bflo(sg[0]), v0[1] * g0[1] * bfhi(sg[0])); w[1] = pk2(v0[2] * g0[2] * bflo(sg[1]), v0[3] * g0[3] * bfhi(sg[1]));
                    w[2] = pk2(v1[0] * g1[0] * bflo(sg[2]), v1[1] * g1[1] * bfhi(sg[2])); w[3] = pk2(v1[2] * g1[2] * bflo(sg[3]), v1[3] * g1[3] * bfhi(sg[3]));
                    *(u32x4*)(Y + (size_t)row * DM + col0) = w;
                }
                sq += shx(sq, 16, lane); sq += shx(sq, 32, lane);
                if (fq == 0) ssC[(size_t)row * 8 + u.pn * 4 + wc] = sq;
                asm volatile("" ::: "memory");
            }
    }
};

struct EpiE {
    static constexpr bool PERM = true, AFTER_DRAIN = false; static constexpr int MID_T = 0;
    bf16_t* EB;
    __device__ __forceinline__ void operator()(const f32x4 (&acc)[2][2][4][2], const pg8::Unit& u, int, int, int, int) const {
        int t_ = threadIdx.x; asm volatile("" : "+v"(t_));
        const int lane = t_ & 63, fr = lane & 15, fq = lane >> 4, wid_ = __builtin_amdgcn_readfirstlane(t_ >> 6), wr = wid_ >> 2, wc = wid_ & 3;
#pragma unroll
        for (int ai = 0; ai < 2; ++ai)
#pragma unroll
            for (int m = 0; m < 4; ++m) {
                const int row = u.pm * 256 + ai * 128 + wr * 64 + m * 16 + fr;
#pragma unroll
                for (int bj = 0; bj < 2; ++bj) {
                    const int col0 = u.pn * 256 + bj * 128 + wc * 32 + 8 * fq;
                    const f32x4 v0 = acc[ai][bj][m][0], v1 = acc[ai][bj][m][1];
                    u32x4 w; w[0] = pk2(v0[0], v0[1]); w[1] = pk2(v0[2], v0[3]); w[2] = pk2(v1[0], v1[1]); w[3] = pk2(v1[2], v1[3]);
                    *(u32x4*)(EB + (size_t)row * DM + col0) = w;
                }
                asm volatile("" ::: "memory");
            }
    }
};

struct EpiOut {
    static constexpr bool PERM = true, AFTER_DRAIN = false; static constexpr int MID_T = 8;
    const float* base; float* out; bf16_t* HB; float* ss; const float* ssC;
    __device__ __forceinline__ void mid(f32x4 (&acc)[2][2][4][2], const pg8::Unit& u) const {
        int t_ = threadIdx.x; asm volatile("" : "+v"(t_));
        const int lane = t_ & 63, fr = lane & 15, fq = lane >> 4, wid_ = __builtin_amdgcn_readfirstlane(t_ >> 6), wr = wid_ >> 2;
#pragma unroll
        for (int ai = 0; ai < 2; ++ai)
#pragma unroll
            for (int m = 0; m < 4; ++m) {
                const int row = u.pm * 256 + ai * 128 + wr * 64 + m * 16 + fr;
                const f32x2 p = *(const f32x2*)(ssC + (size_t)row * 8 + fq * 2);
                float s = p[0] + p[1];
                s += shx(s, 16, lane); s += shx(s, 32, lane);
                const float rs = frsq(s * (1.0f / CD) + EPS);
#pragma unroll
                for (int bj = 0; bj < 2; ++bj)
#pragma unroll
                    for (int n = 0; n < 2; ++n) acc[ai][bj][m][n] = acc[ai][bj][m][n] * rs;
            }
    }
    __device__ __forceinline__ void operator()(const f32x4 (&acc)[2][2][4][2], const pg8::Unit& u, int, int, int, int) const {
        int t_ = threadIdx.x; asm volatile("" : "+v"(t_));
        const int lane = t_ & 63, fr = lane & 15, fq = lane >> 4, wid_ = __builtin_amdgcn_readfirstlane(t_ >> 6), wr = wid_ >> 2, wc = wid_ & 3;
#pragma unroll
        for (int ai = 0; ai < 2; ++ai)
#pragma unroll
            for (int m = 0; m < 4; ++m) {
                const int row = u.pm * 256 + ai * 128 + wr * 64 + m * 16 + fr;
                float sq = 0.f;
#pragma unroll
                for (int bj = 0; bj < 2; ++bj) {
                    const size_t off = (size_t)row * DM + u.pn * 256 + bj * 128 + wc * 32 + 8 * fq;
                    const f32x4 h0 = *(const f32x4*)(base + off) + acc[ai][bj][m][0], h1 = *(const f32x4*)(base + off + 4) + acc[ai][bj][m][1];
                    *(f32x4*)(out + off) = h0; *(f32x4*)(out + off + 4) = h1;
                    u32x4 w; w[0] = pk2(h0[0], h0[1]); w[1] = pk2(h0[2], h0[3]); w[2] = pk2(h1[0], h1[1]); w[3] = pk2(h1[2], h1[3]);
                    *(u32x4*)(HB + off) = w;
                    sq += (h0[0] * h0[0] + h0[1] * h0[1]) + (h0[2] * h0[2] + h0[3] * h0[3]) + (h1[0] * h1[0] + h1[1] * h1[1]) + (h1[2] * h1[2] + h1[3] * h1[3]);
                }
                sq += shx(sq, 16, lane); sq += shx(sq, 32, lane);
                if (fq == 0) ss[(size_t)row * 16 + u.pn * 4 + wc] = sq;
                if (m & 1) asm volatile("" ::: "memory");
            }
    }
};

struct EpiGate {
    static constexpr bool PERM = true, AFTER_DRAIN = false; static constexpr int MID_T = 0;
    float* out; const bf16_t* EB; bf16_t* HB; const float* ss_in; float* ss_out;
    __device__ __forceinline__ void operator()(const f32x4 (&acc)[2][2][4][2], const pg8::Unit& u, int, int, int, int) const {
        int t_ = threadIdx.x; asm volatile("" : "+v"(t_));
        const int lane = t_ & 63, fr = lane & 15, fq = lane >> 4, wid_ = __builtin_amdgcn_readfirstlane(t_ >> 6), wr = wid_ >> 2, wc = wid_ & 3;
#pragma unroll
        for (int ai = 0; ai < 2; ++ai)
#pragma unroll
            for (int m = 0; m < 4; ++m) {
                const int row = u.pm * 256 + ai * 128 + wr * 64 + m * 16 + fr;
                const float rs = row_rstd(ss_in, row, fq, lane);
                float sq = 0.f;
#pragma unroll
                for (int bj = 0; bj < 2; ++bj) {
                    const size_t off = (size_t)row * DM + u.pn * 256 + bj * 128 + wc * 32 + 8 * fq;
                    const f32x4 a0 = acc[ai][bj][m][0] * rs, a1 = acc[ai][bj][m][1] * rs;
                    const u32x4 e = *(const u32x4*)(EB + off);
                    f32x4 h0 = *(const f32x4*)(out + off), h1 = *(const f32x4*)(out + off + 4);
                    h0[0] += bflo(e[0]) * sigmoidf_(a0[0]); h0[1] += bfhi(e[0]) * sigmoidf_(a0[1]); h0[2] += bflo(e[1]) * sigmoidf_(a0[2]); h0[3] += bfhi(e[1]) * sigmoidf_(a0[3]);
                    h1[0] += bflo(e[2]) * sigmoidf_(a1[0]); h1[1] += bfhi(e[2]) * sigmoidf_(a1[1]); h1[2] += bflo(e[3]) * sigmoidf_(a1[2]); h1[3] += bfhi(e[3]) * sigmoidf_(a1[3]);
                    *(f32x4*)(out + off) = h0; *(f32x4*)(out + off + 4) = h1;
                    u32x4 w; w[0] = pk2(h0[0], h0[1]); w[1] = pk2(h0[2], h0[3]); w[2] = pk2(h1[0], h1[1]); w[3] = pk2(h1[2], h1[3]);
                    *(u32x4*)(HB + off) = w;
                    sq += (h0[0] * h0[0] + h0[1] * h0[1]) + (h0[2] * h0[2] + h0[3] * h0[3]) + (h1[0] * h1[0] + h1[1] * h1[1]) + (h1[2] * h1[2] + h1[3] * h1[3]);
                }
                sq += shx(sq, 16, lane); sq += shx(sq, 32, lane);
                if (fq == 0) ss_out[(size_t)row * 16 + u.pn * 4 + wc] = sq;
                if (m & 1) asm volatile("" ::: "memory");
            }
    }
};

struct SubOrder {
    int nN, nwg, nb, c;
    __device__ void init(int M, int N, int nb_, int c_) { nN = N / 256; nwg = (M / 256) * nN; nb = nb_; c = c_; }
    __device__ bool next(int i, pg8::Unit& u) const { if (c < 0 || c >= nb) return false; const int L = i * nb + c; if (L >= nwg) return false; u.pm = L / nN; u.pn = L % nN; return true; }
    __device__ __forceinline__ void a_ready(const pg8::Unit&) const {}
    __device__ __forceinline__ void done(const pg8::Unit&) const {}
};

template <bool REMAP>
__device__ __forceinline__ void tr_item(const float* W, int K, int N, bf16_t* WT, const float* g, LAS float* scr, int item, int lane, int kshift = 0) {
    const int nblk = N / 32, kb = item / nblk, nb = item % nblk, k0 = 64 * kb, n0 = 32 * nb;
    int src = n0 + (lane & 31);
    if (REMAP) { if (src >= 2048 && src < 3072) { const int jj = src - 2048; src = (jj & 1) ? 2560 + (jj >> 1) : 2048 + (jj >> 1); } }
#pragma unroll 8
    for (int i = 0; i < 32; ++i) { const int kk = 2 * i + (lane >> 5); float v = W[(size_t)((k0 + kk + kshift) & (K - 1)) * N + src]; if (g) v *= g[k0 + kk]; scr[kk * 33 + (lane & 31)] = v; }
    asm volatile("s_waitcnt lgkmcnt(0)" ::: "memory");
    const int c = lane & 7;
#pragma unroll
    for (int j = 0; j < 4; ++j) { const int n = (lane >> 3) + 8 * j; const LAS float* s = scr + (8 * c) * 33 + n;
        u32x4 o; o[0] = pk2(s[0 * 33], s[1 * 33]); o[1] = pk2(s[2 * 33], s[3 * 33]); o[2] = pk2(s[4 * 33], s[5 * 33]); o[3] = pk2(s[6 * 33], s[7 * 33]);
        *(u32x4*)(WT + (size_t)(n0 + n) * K + k0 + 8 * c) = o; }
    asm volatile("s_waitcnt lgkmcnt(0)" ::: "memory");
}

constexpr int AK_STRIDE = 144, AV_STRIDE = 136, A_KBYTES = 64 * AK_STRIDE, A_VBYTES = 64 * AV_STRIDE, A_BUF = 18432;
static_assert(A_KBYTES + A_VBYTES <= A_BUF, "attention LDS buffer");

__device__ __forceinline__ void attn_unit(const bf16_t* U, const bf16_t* VT, bf16_t* Y, const float* aog, int b, int h, int qb, LAS unsigned char* lds) {
    int tid = threadIdx.x; asm volatile("" : "+v"(tid));
    const int wave = __builtin_amdgcn_readfirstlane(tid >> 6), lane = tid & 63, l31 = lane & 31, hi = lane >> 5;
    const int q0 = qb * 256 + wave * 32, t = q0 + l31;
    const size_t trow = (size_t)(b * SEQ + t);
    bf16x8 qf[4];
    {
        const bf16_t* qp = U + trow * UP + UQ + h * HD + 8 * hi;
#pragma unroll
        for (int s = 0; s < 4; ++s) qf[s] = *(const bf16x8*)(qp + 16 * s);
    }
    f32x16 o0, o1;
#pragma unroll
    for (int i = 0; i < 16; ++i) { o0[i] = 0.f; o1[i] = 0.f; }
    float C = 0.f;
    const int ktmax = 4 * qb + 3, wkt = (q0 + 30) >> 6;
    const int srow = tid >> 3, sch = tid & 7;
    const bf16_t* gk = U + (size_t)(b * SEQ + srow) * UP + UK + h * HD + sch * 8;
    const bf16_t* gv = VT + ((size_t)((b * NH + h) * HD + srow)) * SEQ + sch * 8;
    const int kwoff = srow * AK_STRIDE + sch * 16, vwoff = A_KBYTES + srow * AV_STRIDE + sch * 16;
    __syncthreads();
    {
        const u32x4 kr = *(const u32x4*)(gk + (size_t)ktmax * 64 * UP), vr = *(const u32x4*)(gv + ktmax * 64);
        *(LAS u32x4*)(lds + kwoff) = kr;
        u32x2 a = {vr[0], vr[1]}, c = {vr[2], vr[3]};
        *(LAS u32x2*)(lds + vwoff) = a; *(LAS u32x2*)(lds + vwoff + 8) = c;
    }
    __syncthreads();
    int cur = 0;
    LAS unsigned* dflag = (LAS unsigned*)(lds + 2 * A_BUF);
    bool wdone = false;
    for (int kt = ktmax; kt >= 0; --kt) {
        u32x4 kr = {0u, 0u, 0u, 0u}, vr = {0u, 0u, 0u, 0u};
        if (kt > 0) { kr = *(const u32x4*)(gk + (size_t)(kt - 1) * 64 * UP); vr = *(const u32x4*)(gv + (kt - 1) * 64); }
        if (kt <= wkt && !wdone) {
            const LAS unsigned char* kb = lds + cur * A_BUF;
            const LAS unsigned char* vb = kb + A_KBYTES;
            f32x16 p0, p1;
#pragma unroll
            for (int i = 0; i < 16; ++i) { p0[i] = 0.f; p1[i] = 0.f; }
#pragma unroll
            for (int s = 0; s < 4; ++s) {
                const bf16x8 ka = *(const LAS bf16x8*)(kb + l31 * AK_STRIDE + 32 * s + 16 * hi);
                const bf16x8 kc = *(const LAS bf16x8*)(kb + (32 + l31) * AK_STRIDE + 32 * s + 16 * hi);
                p0 = MFMA32(ka, qf[s], p0); p1 = MFMA32(kc, qf[s], p1);
            }
            const int lim0 = t - (64 * kt + 4 * hi), lim1 = lim0 - 32;
            f32x16 l0, l1;
            float G0[4], G1[4];
#pragma unroll
            for (int g = 0; g < 4; ++g) {
                float s0 = 0.f, s1 = 0.f;
#pragma unroll
                for (int i = 0; i < 4; ++i) {
                    const int r = 4 * g + i, cr = i + 8 * g;
                    const float z0 = p0[r], z1 = p1[r];
                    const float sp0 = fmaxf(z0, 0.f) + flog2(1.0f + fexp2(-fabsf(z0)));
                    const float sp1 = fmaxf(z1, 0.f) + flog2(1.0f + fexp2(-fabsf(z1)));
                    const float a0 = (cr < lim0) ? -sp0 : 0.f, a1 = (cr < lim1) ? -sp1 : 0.f;
                    l0[r] = a0; l1[r] = a1; s0 += a0; s1 += a1;
                }
                G0[g] = s0; G1[g] = s1;
            }
            float X0[4], X1[4];
#pragma unroll
            for (int g = 0; g < 4; ++g) { X0[g] = shx(G0[g], 32, lane); X1[g] = shx(G1[g], 32, lane); }
            float run = C;
#pragma unroll
            for (int g = 3; g >= 0; --g) {
                float a = run + (hi == 0 ? X1[g] : 0.f);
#pragma unroll
                for (int i = 3; i >= 0; --i) { const int r = 4 * g + i, cr = i + 8 * g; a += l1[r]; const float e = fexp2(p1[r] + a); p1[r] = (cr < lim1) ? e : 0.f; }
                run += G1[g] + X1[g];
            }
#pragma unroll
            for (int g = 3; g >= 0; --g) {
                float a = run + (hi == 0 ? X0[g] : 0.f);
#pragma unroll
                for (int i = 3; i >= 0; --i) { const int r = 4 * g + i, cr = i + 8 * g; a += l0[r]; const float e = fexp2(p0[r] + a); p0[r] = (cr < lim0) ? e : 0.f; }
                run += G0[g] + X0[g];
            }
            C = run;
#pragma unroll
            for (int kh = 0; kh < 2; ++kh)
#pragma unroll
                for (int sh = 0; sh < 2; ++sh) {
                    u32x4 xw;
                    if (kh == 0) { xw[0] = pk2(p0[8 * sh + 0], p0[8 * sh + 1]); xw[1] = pk2(p0[8 * sh + 2], p0[8 * sh + 3]); xw[2] = pk2(p0[8 * sh + 4], p0[8 * sh + 5]); xw[3] = pk2(p0[8 * sh + 6], p0[8 * sh + 7]); }
                    else         { xw[0] = pk2(p1[8 * sh + 0], p1[8 * sh + 1]); xw[1] = pk2(p1[8 * sh + 2], p1[8 * sh + 3]); xw[2] = pk2(p1[8 * sh + 4], p1[8 * sh + 5]); xw[3] = pk2(p1[8 * sh + 6], p1[8 * sh + 7]); }
                    const bf16x8 xf = __builtin_bit_cast(bf16x8, xw);
                    const int koff = 2 * (32 * kh + 16 * sh + 4 * hi);
                    {
                        const LAS unsigned char* vp = vb + l31 * AV_STRIDE + koff;
                        const u32x2 lo = *(const LAS u32x2*)vp, hh = *(const LAS u32x2*)(vp + 16);
                        u32x4 vw = {lo[0], lo[1], hh[0], hh[1]};
                        o0 = MFMA32(__builtin_bit_cast(bf16x8, vw), xf, o0);
                    }
                    {
                        const LAS unsigned char* vp = vb + (32 + l31) * AV_STRIDE + koff;
                        const u32x2 lo = *(const LAS u32x2*)vp, hh = *(const LAS u32x2*)(vp + 16);
                        u32x4 vw = {lo[0], lo[1], hh[0], hh[1]};
                        o1 = MFMA32(__builtin_bit_cast(bf16x8, vw), xf, o1);
                    }
                }
        }
        wdone = (__builtin_amdgcn_ballot_w64(C > -160.0f) == 0ull);
        if (lane == 0) dflag[(kt & 1) * 8 + wave] = wdone ? 1u : 0u;
        if (kt > 0) {
            LAS unsigned char* nb = lds + (cur ^ 1) * A_BUF;
            *(LAS u32x4*)(nb + kwoff) = kr;
            u32x2 a = {vr[0], vr[1]}, c = {vr[2], vr[3]};
            *(LAS u32x2*)(nb + vwoff) = a; *(LAS u32x2*)(nb + vwoff + 8) = c;
        }
        __syncthreads();
        cur ^= 1;
        {
            const LAS u32x4* df = (const LAS u32x4*)(dflag + (kt & 1) * 8);
            const u32x4 f0 = df[0], f1 = df[1];
            if ((f0[0] & f0[1] & f0[2] & f0[3] & f1[0] & f1[1] & f1[2] & f1[3]) != 0u) break;
        }
    }
    float sq = 0.f;
#pragma unroll
    for (int i = 0; i < 16; ++i) sq += o0[i] * o0[i] + o1[i] * o1[i];
    sq += shx(sq, 32, lane);
    const float rs = frsq(sq * (1.0f / HD) + EPS);
    const bf16_t* sgp = U + trow * UP + USGA + h * HD;
    bf16_t* yp = Y + trow * DM + 512 + h * HD;
#pragma unroll
    for (int dt = 0; dt < 2; ++dt)
#pragma unroll
        for (int g = 0; g < 4; ++g) {
            const int d0 = 32 * dt + 8 * g + 4 * hi;
            const f32x4 gn = *(const f32x4*)(aog + d0);
            const u32x2 sg = *(const u32x2*)(sgp + d0);
            float v0, v1, v2, v3;
            if (dt == 0) { v0 = o0[4 * g + 0]; v1 = o0[4 * g + 1]; v2 = o0[4 * g + 2]; v3 = o0[4 * g + 3]; }
            else         { v0 = o1[4 * g + 0]; v1 = o1[4 * g + 1]; v2 = o1[4 * g + 2]; v3 = o1[4 * g + 3]; }
            u32x2 w;
            w[0] = pk2(v0 * rs * gn[0] * bflo(sg[0]), v1 * rs * gn[1] * bfhi(sg[0]));
            w[1] = pk2(v2 * rs * gn[2] * bflo(sg[1]), v3 * rs * gn[3] * bfhi(sg[1]));
            *(u32x2*)(yp + d0) = w;
        }
}

constexpr int CT = 32, C_XH = 0, C_XH_BYTES = (CT + 30) * 1024, C_CO = C_XH_BYTES, C_CO_BYTES = CT * CD * 4;
static_assert(C_CO + C_CO_BYTES <= LDS_BYTES, "conv LDS map");

__device__ __forceinline__ void convpre_unit(const bf16_t* U, bf16_t* C2, const float* dww, const float* dwb, const float* lng, const float* lnb, int cu, LAS unsigned char* lds) {
    int tid = threadIdx.x; asm volatile("" : "+v"(tid));
    const int wave = __builtin_amdgcn_readfirstlane(tid >> 6), lane = tid & 63;
    const int r0 = cu * CT, b = r0 >> 11, s0 = r0 & 2047;
    __syncthreads();
    for (int i = tid; i < (CT + 30) * 64; i += 512) {
        const int row = i >> 6, ch = i & 63, s = s0 - 30 + row;
        u32x4 v = {0u, 0u, 0u, 0u};
        if (s >= 0) v = *(const u32x4*)(U + (size_t)(b * SEQ + s) * UP + UGLU + ch * 8);
        *(LAS u32x4*)(lds + C_XH + row * 1024 + ch * 16) = v;
    }
    __syncthreads();
    {
        const int chp = tid & 255, tg = tid >> 8;
        float w0[CWID], w1[CWID];
#pragma unroll
        for (int j = 0; j < CWID; ++j) { const f32x2 ww = *(const f32x2*)(dww + (size_t)j * CD + 2 * chp); w0[j] = ww[0]; w1[j] = ww[1]; }
        const f32x2 bias = *(const f32x2*)(dwb + 2 * chp);
        const LAS unsigned char* xp = lds + C_XH + chp * 4;
#pragma unroll 1
        for (int tt = 0; tt < 16; ++tt) {
            const int tl = tg * 16 + tt;
            float a0 = bias[0], a1 = bias[1];
#pragma unroll
            for (int j = 0; j < CWID; ++j) { const unsigned xv = *(const LAS unsigned*)(xp + (tl + j) * 1024); a0 += w0[j] * bflo(xv); a1 += w1[j] * bfhi(xv); }
            f32x2 o = {a0, a1};
            *(LAS f32x2*)(lds + C_CO + tl * 2048 + chp * 8) = o;
        }
    }
    __syncthreads();
    {
        const f32x4 g0 = *(const f32x4*)(lng + lane * 4), g1 = *(const f32x4*)(lng + 256 + lane * 4);
        const f32x4 b0 = *(const f32x4*)(lnb + lane * 4), b1 = *(const f32x4*)(lnb + 256 + lane * 4);
#pragma unroll
        for (int tt = 0; tt < 4; ++tt) {
            const int tl = wave * 4 + tt;
            f32x4 v0 = *(const LAS f32x4*)(lds + C_CO + tl * 2048 + lane * 16), v1 = *(const LAS f32x4*)(lds + C_CO + tl * 2048 + 1024 + lane * 16);
            const float mean = wave_sum((v0[0] + v0[1]) + (v0[2] + v0[3]) + (v1[0] + v1[1]) + (v1[2] + v1[3]), lane) * (1.0f / CD);
            v0 = v0 - mean; v1 = v1 - mean;
            const float var = wave_sum((v0[0] * v0[0] + v0[1] * v0[1]) + (v0[2] * v0[2] + v0[3] * v0[3]) + (v1[0] * v1[0] + v1[1] * v1[1]) + (v1[2] * v1[2] + v1[3] * v1[3]), lane) * (1.0f / CD);
            const float rs = frsq(var + EPS);
            v0 = v0 * rs * g0 + b0; v1 = v1 * rs * g1 + b1;
            u32x2 wa, wb;
            wa[0] = pk2(siluf_(v0[0]), siluf_(v0[1])); wa[1] = pk2(siluf_(v0[2]), siluf_(v0[3]));
            wb[0] = pk2(siluf_(v1[0]), siluf_(v1[1])); wb[1] = pk2(siluf_(v1[2]), siluf_(v1[3]));
            bf16_t* cp = C2 + (size_t)(r0 + tl) * CD + lane * 4;
            *(u32x2*)cp = wa; *(u32x2*)(cp + 256) = wb;
        }
    }
}

#define XB_TMO      128
#define XB_XCNT(j)  (256  + 64 * (j))
#define XB_XSUB(j)  (1280 + 64 * (j))
#define XB_XGEN(j)  (2304 + 64 * (j))
#define XB_TOP      3328
#define XB_TOPGEN   3392
#define XCD_BAR_WORDS 3456
#define XB_SPIN_CAP (1u << 18)

__device__ __forceinline__ unsigned xb_ld(unsigned* p)              { return __hip_atomic_load(p, __ATOMIC_RELAXED, __HIP_MEMORY_SCOPE_AGENT); }
__device__ __forceinline__ unsigned xb_add(unsigned* p, unsigned v) { return __hip_atomic_fetch_add(p, v, __ATOMIC_RELAXED, __HIP_MEMORY_SCOPE_AGENT); }
__device__ __forceinline__ unsigned xb_xcc_id() { return (unsigned)__builtin_amdgcn_s_getreg((3 << 11) | 20) & 0xFu; }
#define XB_SPIN(cond, bar) do { unsigned _sp = 0; while (cond) { __builtin_amdgcn_s_sleep(1); \
    if ((++_sp & 255u) == 0u) { if (xb_ld(&(bar)[XB_TMO])) break; if (_sp > XB_SPIN_CAP) { atomicAdd(&(bar)[XB_TMO], 1u); break; } } } } while (0)

struct XcdBarrier {
    unsigned* bar; unsigned x;
    volatile LAS unsigned* st;
};

__device__ __forceinline__ XcdBarrier xcd_barrier_post(unsigned* bar, volatile LAS unsigned* st) {
    XcdBarrier b; b.bar = bar; b.x = xb_xcc_id(); b.st = st;
    if (threadIdx.x == 0) (void)xb_add(&bar[XB_XCNT(b.x)], 1u);
    return b;
}
__device__ __forceinline__ void xcd_barrier_complete(unsigned* bar, unsigned x, unsigned& nloc, unsigned& nx) {
    const unsigned G = gridDim.x * gridDim.y * gridDim.z;
    unsigned sum, cnt, mine, sp = 0u;
    for (;;) {
        sum = 0u; cnt = 0u; mine = 0u;
#pragma unroll
        for (unsigned j = 0; j < 16; ++j) { const unsigned c = xb_ld(&bar[XB_XCNT(j)]); sum += c; cnt += (c > 0u) ? 1u : 0u; mine = (j == x) ? c : mine; }
        if (sum == G) break;
        __builtin_amdgcn_s_sleep(1);
        if ((++sp & 255u) == 0u) { if (xb_ld(&bar[XB_TMO])) break; if (sp > XB_SPIN_CAP) { atomicAdd(&bar[XB_TMO], 1u); break; } }
    }
    nloc = mine > 0u ? mine : 1u; nx = cnt > 0u ? cnt : 1u;
}

__device__ __forceinline__ void xcd_barrier(const XcdBarrier& b) {
    asm volatile("s_waitcnt vmcnt(0)" ::: "memory");
    __syncthreads();
    if (threadIdx.x == 0) {
        unsigned* bar = b.bar;
        __builtin_amdgcn_s_waitcnt(0);
        unsigned nloc = b.st[0], nx = b.st[1];
        if (nloc == 0u) { xcd_barrier_complete(bar, b.x, nloc, nx); b.st[0] = nloc; b.st[1] = nx; }
        const unsigned old = xb_add(&bar[XB_XSUB(b.x)], 1u);
        const unsigned gen = old / nloc;
        if (old + 1u == (gen + 1u) * nloc) {
            __builtin_amdgcn_fence(__ATOMIC_RELEASE, "agent");
            asm volatile("s_waitcnt vmcnt(0)" ::: "memory");
            const unsigned og = xb_add(&bar[XB_TOP], 1u);
            const unsigned tg = og / nx;
            if (og + 1u == (tg + 1u) * nx) xb_add(&bar[XB_TOPGEN], 1u);
            else XB_SPIN(xb_ld(&bar[XB_TOPGEN]) == tg, bar);
            __builtin_amdgcn_fence(__ATOMIC_ACQUIRE, "agent");
            xb_add(&bar[XB_XGEN(b.x)], 1u);
            asm volatile("s_waitcnt vmcnt(0)" ::: "memory");
        } else {
            XB_SPIN(xb_ld(&bar[XB_XGEN(b.x)]) == gen, bar);
            __builtin_amdgcn_fence(__ATOMIC_ACQUIRE, "agent");
            asm volatile("s_waitcnt vmcnt(0)" ::: "memory");
        }
    }
    __syncthreads();
}

struct Params { const float* in[16]; float* out; unsigned char* ws; int ph_lo, ph_hi; };

template <int ph>
__device__ __forceinline__ void run_phase(const Params& P, LAS unsigned char* lds) {
    const int G = gridDim.x, bid = blockIdx.x;
    unsigned char* ws = P.ws;
    const float* x = P.in[0];
    float* out = P.out;
    bf16_t* HB = (bf16_t*)(ws + WS_HB); bf16_t* H1B = (bf16_t*)(ws + WS_H1B); bf16_t* Ub = (bf16_t*)(ws + WS_U); bf16_t* VT = (bf16_t*)(ws + WS_VT); bf16_t* Yb = (bf16_t*)(ws + WS_Y);
    bf16_t* C2 = (bf16_t*)(ws + WS_C2); bf16_t* EB = (bf16_t*)(ws + WS_EB);
    float* ssA = (float*)(ws + WS_SSA); float* ssB = (float*)(ws + WS_SSB); float* ssC = (float*)(ws + WS_SSC);
    int tid = threadIdx.x; asm volatile("" : "+v"(tid));
    const int lane = tid & 63, wave = __builtin_amdgcn_readfirstlane(tid >> 6);
    const int gw = bid * 8 + wave, NGW = G * 8;
    if constexpr (ph == 0) {
        LAS float* scr = (LAS float*)(lds + wave * 16384);
        for (int it = gw; it < 2 * 3072; it += NGW) {
            const int l = it / 3072; int r = it - l * 3072;
            unsigned char* wb = ws + (size_t)l * W_LAYER;
            if (r < 1792) { tr_item<true>(P.in[3] + (size_t)l * DM * DIN, DM, DIN, (bf16_t*)(wb + W_IN), P.in[2] + l * DM, scr, r, lane); continue; } r -= 1792;
            if (r < 128) { tr_item<false>(P.in[9] + (size_t)l * CD * CD, CD, CD, (bf16_t*)(wb + W_PW), nullptr, scr, r, lane); continue; } r -= 128;
            if (r < 512) { tr_item<false>(P.in[11] + (size_t)l * DM * DM, DM, DM, (bf16_t*)(wb + W_OUT), nullptr, scr, r, lane, 512); continue; } r -= 512;
            if (r < 512) { tr_item<false>(P.in[13] + (size_t)l * DM * DM, DM, DM, (bf16_t*)(wb + W_PG), P.in[12] + l * DM, scr, r, lane); continue; } r -= 512;
            tr_item<false>(P.in[14] + (size_t)l * PLE * DM, PLE, DM, (bf16_t*)(wb + W_PLE), nullptr, scr, r, lane);
        }
        for (int row = gw; row < MT; row += NGW) {
            const f32x4* xr = (const f32x4*)(x + (size_t)row * DM) + lane;
            u32x2* ob = (u32x2*)(HB + (size_t)row * DM) + lane;
            float s = 0.f;
#pragma unroll
            for (int j = 0; j < 4; ++j) { const f32x4 v = xr[64 * j]; s += (v[0] * v[0] + v[1] * v[1]) + (v[2] * v[2] + v[3] * v[3]); u32x2 w; w[0] = pk2(v[0], v[1]); w[1] = pk2(v[2], v[3]); ob[64 * j] = w; }
            s = wave_sum(s, lane);
            if (lane < 16) ssA[(size_t)row * 16 + lane] = (lane == 0) ? s : 0.f;
        }
        {
            const f32x4* pp = (const f32x4*)P.in[1]; u32x2* pb = (u32x2*)(ws + WS_PB);
            for (int i = bid * 512 + tid; i < 2 * MT * PLE / 4; i += G * 512) { const f32x4 v = pp[i]; u32x2 w; w[0] = pk2(v[0], v[1]); w[1] = pk2(v[2], v[3]); pb[i] = w; }
        }
    } else if constexpr (ph == NPHASE - 1) {
        const float* fg = P.in[15];
        for (int row = gw; row < MT; row += NGW) {
            f32x4* xr = (f32x4*)(out + (size_t)row * DM) + lane;
            f32x4 v[4]; float s = 0.f;
#pragma unroll
            for (int j = 0; j < 4; ++j) { v[j] = xr[64 * j]; s += (v[j][0] * v[j][0] + v[j][1] * v[j][1]) + (v[j][2] * v[j][2] + v[j][3] * v[j][3]); }
            const float rs = frsq(wave_sum(s, lane) * (1.0f / DM) + EPS);
#pragma unroll
            for (int j = 0; j < 4; ++j) { const f32x4 g = *((const f32x4*)fg + lane + 64 * j); xr[64 * j] = v[j] * rs * g; }
        }
    } else {
        constexpr int l = (ph - 1) / 5, k = (ph - 1) % 5;
        unsigned char* wb = ws + (size_t)l * W_LAYER;
        if constexpr (k == 0) {
            pg8::Gemm g{HB, (const bf16_t*)(wb + W_IN), MT, DIN, DM}; pg8::StaticOrder S; S.init(MT, DIN, G, bid);
            EpiIn E{Ub, VT, ssA};
            pg8::gemm_phase<EpiIn, pg8::StaticOrder, true, true>(lds, g, S, E, threadIdx.x);
        } else if constexpr (k == 1) {
            const float* aog = P.in[4] + l * HD;
            const float* dww = P.in[5] + (size_t)l * CWID * CD; const float* dwb = P.in[6] + l * CD;
            const float* lng = P.in[7] + l * CD; const float* lnb = P.in[8] + l * CD;
            for (int it = bid; it < 256; it += G) {
                const int bh = it >> 2, pr = it & 3, b = bh >> 3, h = bh & 7;
#pragma unroll 1
                for (int uu = 0; uu < ((PROBE_DUP & 2) ? 4 : 2); ++uu) attn_unit(Ub, VT, Yb, aog, b, h, (uu & 1) == 0 ? 7 - pr : pr, lds);
#pragma unroll 1
                for (int uu = 0; uu < ((PROBE_DUP & 4) ? 4 : 2); ++uu) convpre_unit(Ub, C2, dww, dwb, lng, lnb, 2 * it + (uu & 1), lds);
            }
            __syncthreads();
        } else if constexpr (k == 2) {
            const int nb0 = G / 2;
            {
                pg8::Gemm g{C2, (const bf16_t*)(wb + W_PW), MT, CD, CD}; SubOrder S; S.init(MT, CD, nb0, bid);
                EpiPw E{Ub, Yb, P.in[10] + l * CD, ssC};
                pg8::gemm_phase<EpiPw, SubOrder, true, true>(lds, g, S, E, threadIdx.x);
            }
            {
                pg8::Gemm g{(const bf16_t*)(ws + WS_PB) + (size_t)l * MT * PLE, (const bf16_t*)(wb + W_PLE), MT, DM, PLE}; SubOrder S; S.init(MT, DM, G - nb0, bid - nb0);
                EpiE E{EB};
                int t2 = threadIdx.x; asm volatile("" : "+v"(t2));
                pg8::gemm_phase<EpiE, SubOrder, true, true>(lds, g, S, E, t2);
            }
        } else if constexpr (k == 3) {
            pg8::Gemm g{Yb, (const bf16_t*)(wb + W_OUT), MT, DM, DM}; pg8::StaticOrder S; S.init(MT, DM, G, bid);
            EpiOut E{l == 0 ? x : out, out, H1B, ssB, ssC};
            pg8::gemm_phase<EpiOut, pg8::StaticOrder, true, true>(lds, g, S, E, threadIdx.x);
        } else {
            pg8::Gemm g{H1B, (const bf16_t*)(wb + W_PG), MT, DM, DM}; pg8::StaticOrder S; S.init(MT, DM, G, bid);
            EpiGate E{out, EB, HB, ssB, ssA};
            pg8::gemm_phase<EpiGate, pg8::StaticOrder, true, true>(lds, g, S, E, threadIdx.x);
        }
    }
}

__global__ void __launch_bounds__(512, 2) fwd(Params P) {
    extern __shared__ __attribute__((aligned(16))) unsigned char lds_raw[];
    LAS unsigned char* lds = (LAS unsigned char*)lds_raw;
    const int lo = P.ph_lo, hi = P.ph_hi;
    volatile LAS unsigned* st = (volatile LAS unsigned*)(lds + LDS_BYTES - 64);
    if (threadIdx.x < 16) st[threadIdx.x] = 0u;
    __syncthreads();
    const XcdBarrier bar = xcd_barrier_post((unsigned*)(P.ws + WS_CTL), st);
#define PROBE_PH(k) ((((PROBE_DUP) & 8) && (k) == 0) || (((PROBE_DUP) & 1) && (k) == 1) || (((PROBE_DUP) & 32) && ((k) == 3 || (k) == 8)) || (((PROBE_DUP) & 16) && (k) == 4))
#define SEAM() do { if (hi > NPHASE) cg::this_grid().sync(); else xcd_barrier(bar); } while (0)
#define PHASE(k) if (lo <= (k) && (k) < hi) { run_phase<(k)>(P, lds); if constexpr (PROBE_PH(k)) { __syncthreads(); run_phase<(k)>(P, lds); } \
        if constexpr (((PROBE_DUP) & 64) != 0) { SEAM(); } if ((k) + 1 < hi) SEAM(); }
    PHASE(0) PHASE(1) PHASE(2) PHASE(3) PHASE(4) PHASE(5) PHASE(6) PHASE(7) PHASE(8) PHASE(9) PHASE(10) PHASE(11)
#undef PHASE
#undef SEAM
}

#ifndef MK_N_LAUNCHES
#define MK_N_LAUNCHES 1
#endif
extern "C" void kernel_launch(void* const* d_in, const int* in_sizes, int n_in, void* d_out, int out_size, void* d_ws, size_t ws_size, hipStream_t stream) {
    static int grid = 0;
    if (grid == 0) {
        if (n_in != 16 || out_size != MT * DM || ws_size < WS_END) { fprintf(stderr, "kernel_launch: unexpected shapes (n_in %d, out %d, ws %zu)\n", n_in, out_size, ws_size); grid = -1; return; }
        int dev = 0, cus = 0, per_cu = 0;
        (void)hipGetDevice(&dev);
        (void)hipDeviceGetAttribute(&cus, hipDeviceAttributeMultiprocessorCount, dev);
        if (hipFuncSetAttribute((const void*)fwd, hipFuncAttributeMaxDynamicSharedMemorySize, LDS_BYTES) != hipSuccess) { fprintf(stderr, "kernel_launch: hipFuncSetAttribute failed\n"); grid = -1; return; }
        if (hipOccupancyMaxActiveBlocksPerMultiprocessor(&per_cu, (const void*)fwd, 512, LDS_BYTES) != hipSuccess || per_cu < 1) { fprintf(stderr, "kernel_launch: occupancy query says %d\n", per_cu); per_cu = 1; }
        (void)hipGetLastError();
        grid = cus * 1;
        if (grid <= 0) grid = 256;
    }
    if (grid < 0) return;
    if (hipMemsetAsync((unsigned char*)d_ws + WS_CTL, 0, CTL_BYTES, stream) != hipSuccess) { fprintf(stderr, "kernel_launch: memset of barrier words failed\n"); return; }
    Params p{};
    for (int i = 0; i < 16; ++i) p.in[i] = (const float*)d_in[i];
    p.out = (float*)d_out; p.ws = (unsigned char*)d_ws;
#if MK_N_LAUNCHES == 1
    p.ph_lo = 0; p.ph_hi = NPHASE;
    void* args[] = {&p};
    hipError_t e = hipLaunchCooperativeKernel((const void*)fwd, dim3(grid), dim3(512), args, LDS_BYTES, stream);
    if (e != hipSuccess) fprintf(stderr, "kernel_launch: cooperative launch failed: %s (grid %d)\n", hipGetErrorString(e), grid);
#else
    for (int ph = 0; ph < NPHASE; ++ph) {
        p.ph_lo = ph; p.ph_hi = ph + 1;
        hipLaunchKernelGGL(fwd, dim3(grid), dim3(512), LDS_BYTES, stream, p);
    }
#endif
}
```

```cpp
#include <hip/hip_runtime.h>
#include <hip/hip_cooperative_groups.h>
#include <cstdio>
#include <cstdint>
namespace cg = cooperative_groups;
namespace pg8 {
#define PG8_LAS __attribute__((address_space(3)))
typedef unsigned short bf16_t;
typedef short bf16x8 __attribute__((ext_vector_type(8)));
typedef float f32x4 __attribute__((ext_vector_type(4)));
typedef unsigned u32x4 __attribute__((ext_vector_type(4)));
constexpr int BM = 256, BK = 64, HALF = 128, HTB = HALF * BK * 2  , STAGE_BYTES = 8 * HTB, NXCD = 8, WGM = 8;

__host__ __device__ __forceinline__ int lds_byte(int r, int c) { const int st = (r >> 4) * 2 + (c >> 5), rr = r & 15, cc = c & 31, ob = rr * 64 + cc * 2; return st * 1024 + (ob ^ (((ob >> 9) & 1) << 5)); }
__host__ __device__ __forceinline__ void stage_rc(int b, int& R, int& C) { const int st = b / 1024, sb = b % 1024, swz = sb ^ (((sb >> 9) & 1) << 5); R = (st >> 1) * 16 + swz / 64; C = (st & 1) * 32 + (swz % 64) / 2; }
__host__ __device__ __forceinline__ int perm32(int rho) { const int n = rho >> 4, i = rho & 15; return 8 * (i >> 2) + 4 * n + (i & 3); }

struct Unit { int pm, pn; };
struct Gemm { const bf16_t* A; const bf16_t* Bt; int M, N, K; };

struct StaticOrder {
    int nM, nN, nwg, G, c;
    __host__ __device__ void init(int M, int N, int G_, int c_) { nM = M / BM; nN = N / BM; nwg = nM * nN; G = G_; c = c_; }
    __host__ __device__ bool next(int i, Unit& u) const {
        const long L = (long)i * G + c; if (L >= nwg) return false;
        int wgid = (int)L; { const int q = nwg / NXCD, r = nwg % NXCD, xcd = wgid % NXCD, off = wgid / NXCD; wgid = (xcd < r ? xcd * (q + 1) : r * (q + 1) + (xcd - r) * q) + off; }
        const int nig = WGM * nN, gid = wgid / nig, fm = gid * WGM, gsz = (nM - fm) < WGM ? (nM - fm) : WGM;
        u.pm = fm + ((wgid % nig) % gsz); u.pn = (wgid % nig) / gsz; return true;
    }
    __device__ __forceinline__ void a_ready(const Unit&) const {}
    __device__ __forceinline__ void done(const Unit&) const {}
};

template <class Epi, class Sched, bool ALIGN_EPI = false, bool SP2 = false>
__device__ __forceinline__ void gemm_phase(PG8_LAS unsigned char* lds, const Gemm g, const Sched& S, const Epi& E, const int tid_in) {
    const int tid = tid_in, wid = __builtin_amdgcn_readfirstlane(tid >> 6), lane = tid & 63, wr = wid >> 2, wc = wid & 3, fr = lane & 15, fq = lane >> 4;
    const int K = g.K, nt = K / BK;
    unsigned voffA[2], voffB[2];
#pragma unroll
    for (int i = 0; i < 2; ++i) { int R, C; stage_rc(tid * 16 + i * 8192, R, C); const int Rb = Epi::PERM ? ((R & ~31) + perm32(R & 31)) : R;
        voffA[i] = (unsigned)(R * K + C) * 2u; voffB[i] = (unsigned)(Rb * K + C) * 2u; }
    const size_t kstep = (size_t)(BK * 2);
    const size_t hstep = (size_t)HALF * K * 2;
    const size_t tstep = 2 * hstep;
    const unsigned ldsw = (unsigned)wid * 1024u;
    const int aoff = lds_byte(wr * 64 + fr, fq * 8), boff = lds_byte(wc * 32 + fr, fq * 8);
#define PG8_SA(b, h) (((b) * 2 + (h)) * HTB)
#define PG8_SB(b, h) ((4 + (b) * 2 + (h)) * HTB)
#define PG8_STAGE(bufoff, gbase, voff) do { _Pragma("unroll") for (int _i = 0; _i < 2; ++_i) \
        __builtin_amdgcn_global_load_lds((const unsigned*)((const char*)(gbase) + (voff)[_i]), (PG8_LAS unsigned*)(lds + (bufoff) + ldsw + _i * 8192), 16, 0, 0); } while (0)
#define PG8_LDA(dst, b, h) do { _Pragma("unroll") for (int m = 0; m < 4; ++m) _Pragma("unroll") for (int k = 0; k < 2; ++k) dst[m][k] = *(const PG8_LAS bf16x8*)(lds + PG8_SA(b, h) + aoff + m * 2048 + k * 1024); } while (0)
#define PG8_LDB(dst, b, h) do { _Pragma("unroll") for (int n = 0; n < 2; ++n) _Pragma("unroll") for (int k = 0; k < 2; ++k) dst[n][k] = *(const PG8_LAS bf16x8*)(lds + PG8_SB(b, h) + boff + n * 2048 + k * 1024); } while (0)
#define PG8_MMA(ai, bj, At, Bt) do { __builtin_amdgcn_s_setprio(1); _Pragma("unroll") for (int m = 0; m < 4; ++m) _Pragma("unroll") for (int n = 0; n < 2; ++n) _Pragma("unroll") for (int k = 0; k < 2; ++k) \
        acc[ai][bj][m][n] = __builtin_amdgcn_mfma_f32_16x16x32_bf16(Bt[n][k], At[m][k], acc[ai][bj][m][n], 0, 0, 0); __builtin_amdgcn_s_setprio(0); } while (0)
#define PG8_WAIT_V(n) asm volatile("s_waitcnt vmcnt(" #n ")" ::: "memory")
#define PG8_WAIT_L(n) asm volatile("s_waitcnt lgkmcnt(" #n ")" ::: "memory")
#define PG8_BAR __builtin_amdgcn_s_barrier()
#define PG8_SCHED __builtin_amdgcn_sched_barrier(0)
    Unit cur, nxt; int ui = 0;
    if (!S.next(0, cur)) return;
    f32x4 acc[2][2][4][2];
#pragma unroll
    for (int a = 0; a < 2; ++a)
#pragma unroll
        for (int b = 0; b < 2; ++b)
#pragma unroll
            for (int m = 0; m < 4; ++m)
#pragma unroll
                for (int n = 0; n < 2; ++n) acc[a][b][m][n] = (f32x4){0.f, 0.f, 0.f, 0.f};
    bf16x8 At[4][2], B0[2][2], B1[2][2];
    const char* cA = (const char*)g.A + (size_t)cur.pm * tstep; const char* cB = (const char*)g.Bt + (size_t)cur.pn * tstep;
    S.a_ready(cur);
    if constexpr (SP2) {
        PG8_STAGE(PG8_SB(0, 0), cB, voffB); PG8_STAGE(PG8_SB(0, 1), cB + hstep, voffB); PG8_STAGE(PG8_SA(0, 0), cA, voffA); PG8_STAGE(PG8_SA(0, 1), cA + hstep, voffA);
        if (wr == 1) PG8_BAR;
        PG8_WAIT_V(2); PG8_BAR;
        PG8_STAGE(PG8_SB(1, 0), cB + kstep, voffB); PG8_STAGE(PG8_SA(1, 0), cA + kstep, voffA); PG8_STAGE(PG8_SB(1, 1), cB + hstep + kstep, voffB);
        PG8_WAIT_V(6); PG8_BAR;
    } else {
        PG8_STAGE(PG8_SB(0, 0), cB, voffB); PG8_STAGE(PG8_SA(0, 0), cA, voffA); PG8_STAGE(PG8_SB(0, 1), cB + hstep, voffB); PG8_STAGE(PG8_SA(0, 1), cA + hstep, voffA);
        if (wr == 1) PG8_BAR;
        PG8_WAIT_V(4); PG8_BAR;
        PG8_STAGE(PG8_SB(1, 0), cB + kstep, voffB); PG8_STAGE(PG8_SA(1, 0), cA + kstep, voffA); PG8_STAGE(PG8_SB(1, 1), cB + hstep + kstep, voffB);
        PG8_WAIT_V(6); PG8_BAR;
    }
    for (;;) {
        const bool has_next = S.next(ui + 1, nxt);
        const char* nA = has_next ? (const char*)g.A + (size_t)nxt.pm * tstep : cA; const char* nB = has_next ? (const char*)g.Bt + (size_t)nxt.pn * tstep : cB;
        for (int t = 0; t < nt; t += 2) {
            if constexpr (Epi::MID_T > 0) { if (t == Epi::MID_T) E.mid(acc, cur); }
            const bool last = (t == nt - 2);
            const char* a1 = cA + (size_t)(t + 1) * kstep;
            const char* a2 = last ? nA : cA + (size_t)(t + 2) * kstep; const char* b2 = last ? nB : cB + (size_t)(t + 2) * kstep;
            const char* a3 = a2 + kstep; const char* b3 = b2 + kstep;
            if (last && has_next) S.a_ready(nxt);
            if constexpr (SP2) {
            PG8_LDB(B0, 0, 0); PG8_LDB(B1, 0, 1); PG8_SCHED; PG8_LDA(At, 0, 0); PG8_STAGE(PG8_SA(1, 1), a1 + hstep, voffA);
            PG8_WAIT_V(8); PG8_WAIT_L(0); PG8_BAR; PG8_MMA(0, 0, At, B0); PG8_MMA(0, 1, At, B1); PG8_BAR; PG8_SCHED;
            PG8_LDA(At, 0, 1); PG8_STAGE(PG8_SB(0, 0), b2, voffB); PG8_STAGE(PG8_SB(0, 1), b2 + hstep, voffB); PG8_STAGE(PG8_SA(0, 0), a2, voffA);
            PG8_WAIT_V(8); PG8_WAIT_L(0); PG8_BAR; PG8_MMA(1, 0, At, B0); PG8_MMA(1, 1, At, B1); PG8_BAR; PG8_SCHED;
            PG8_LDB(B0, 1, 0); PG8_LDB(B1, 1, 1); PG8_SCHED; PG8_LDA(At, 1, 0); PG8_STAGE(PG8_SA(0, 1), a2 + hstep, voffA);
            PG8_WAIT_V(8); PG8_WAIT_L(0); PG8_BAR; PG8_MMA(0, 0, At, B0); PG8_MMA(0, 1, At, B1); PG8_BAR; PG8_SCHED;
            PG8_LDA(At, 1, 1); PG8_STAGE(PG8_SB(1, 0), b3, voffB); PG8_STAGE(PG8_SB(1, 1), b3 + hstep, voffB); PG8_STAGE(PG8_SA(1, 0), a3, voffA);
            PG8_WAIT_V(8); PG8_WAIT_L(0); PG8_BAR; PG8_MMA(1, 0, At, B0); PG8_MMA(1, 1, At, B1); PG8_BAR; PG8_SCHED;
            } else {
            PG8_LDB(B0, 0, 0); PG8_SCHED; PG8_LDA(At, 0, 0); PG8_STAGE(PG8_SA(1, 1), a1 + hstep, voffA);
            PG8_WAIT_L(8); PG8_BAR; PG8_WAIT_L(0); PG8_MMA(0, 0, At, B0); PG8_BAR; PG8_SCHED;
            PG8_LDB(B1, 0, 1); PG8_STAGE(PG8_SB(0, 0), b2, voffB);
            PG8_BAR; PG8_WAIT_L(0); PG8_MMA(0, 1, At, B1); PG8_BAR;
            PG8_LDA(At, 0, 1); PG8_STAGE(PG8_SA(0, 0), a2, voffA);
            PG8_BAR; PG8_WAIT_L(0); PG8_MMA(1, 0, At, B0); PG8_BAR; PG8_SCHED;
            PG8_STAGE(PG8_SB(0, 1), b2 + hstep, voffB);
            PG8_WAIT_V(6); PG8_BAR; PG8_MMA(1, 1, At, B1); PG8_BAR;
            PG8_LDB(B0, 1, 0); PG8_SCHED; PG8_LDA(At, 1, 0); PG8_STAGE(PG8_SA(0, 1), a2 + hstep, voffA);
            PG8_WAIT_L(8); PG8_BAR; PG8_WAIT_L(0); PG8_MMA(0, 0, At, B0); PG8_BAR; PG8_SCHED;
            PG8_LDB(B1, 1, 1); PG8_STAGE(PG8_SB(1, 0), b3, voffB);
            PG8_BAR; PG8_WAIT_L(0); PG8_MMA(0, 1, At, B1); PG8_BAR;
            PG8_LDA(At, 1, 1); PG8_STAGE(PG8_SA(1, 0), a3, voffA);
            PG8_BAR; PG8_WAIT_L(0); PG8_MMA(1, 0, At, B0); PG8_BAR; PG8_SCHED;
            PG8_STAGE(PG8_SB(1, 1), b3 + hstep, voffB);
            PG8_WAIT_V(6); PG8_BAR; PG8_MMA(1, 1, At, B1); PG8_BAR;
            }
        }
        if constexpr (ALIGN_EPI) { if (wr == 0) PG8_BAR; }
        if constexpr (!Epi::AFTER_DRAIN) { E(acc, cur, wr, wc, fr, fq); S.done(cur); }
        if (!has_next) break;
#pragma unroll
        for (int a = 0; a < 2; ++a)
#pragma unroll
            for (int b = 0; b < 2; ++b)
#pragma unroll
                for (int m = 0; m < 4; ++m)
#pragma unroll
                    for (int n = 0; n < 2; ++n) acc[a][b][m][n] = (f32x4){0.f, 0.f, 0.f, 0.f};
        cur = nxt; cA = nA; cB = nB; ++ui;
        if constexpr (ALIGN_EPI) { if (wr == 1) PG8_BAR; }
    }
    PG8_WAIT_V(0);
    if constexpr (!ALIGN_EPI) { if (wr == 0) PG8_BAR; }
    PG8_BAR;
    if constexpr (Epi::AFTER_DRAIN) { E.fused(acc, cur, wr, wc, fr, fq, lds, wid, lane); S.done(cur); }
#undef PG8_SA
#undef PG8_SB
#undef PG8_STAGE
#undef PG8_LDA
#undef PG8_LDB
#undef PG8_MMA
#undef PG8_WAIT_V
#undef PG8_WAIT_L
#undef PG8_BAR
#undef PG8_SCHED
}
}

#define LAS __attribute__((address_space(3)))
typedef unsigned short bf16_t;
typedef short bf16x8 __attribute__((ext_vector_type(8)));
typedef float f32x4 __attribute__((ext_vector_type(4)));
typedef float f32x2 __attribute__((ext_vector_type(2)));
typedef float f32x16 __attribute__((ext_vector_type(16)));
typedef unsigned u32x4 __attribute__((ext_vector_type(4)));
typedef unsigned u32x2 __attribute__((ext_vector_type(2)));
typedef __bf16 bf16x2_t __attribute__((ext_vector_type(2)));

constexpr int NB = 8, SEQ = 2048, DM = 1024, MT = NB * SEQ, DIN = 3584, NH = 8, HD = 64, CWID = 31, PLE = 256, CD = 512;
constexpr float EPS = 1e-6f;
constexpr float QSCALE = 0.125f * 1.4426950408889634f;

constexpr size_t MiB = 1u << 20;
constexpr size_t W_IN = 0, W_PW = 7340032, W_OUT = W_PW + 524288, W_PG = W_OUT + 2097152, W_PLE = W_PG + 2097152, W_LAYER = 12 * MiB;
static_assert(W_PLE + 524288 == W_LAYER, "weight map");
constexpr int UP = 2560, UQ = 0, UK = 512, USGA = 1024, UGLU = 1536, USGC = 2048;
constexpr size_t WS_PB = 24 * MiB, WS_HB = 40 * MiB, WS_Y = 72 * MiB, WS_VT = 104 * MiB, WS_SSA = 120 * MiB, WS_SSB = 121 * MiB, WS_SSC = 122 * MiB, WS_U = 123 * MiB;
constexpr size_t WS_H1B = WS_U  , WS_C2 = 203 * MiB, WS_EB = 219 * MiB, WS_CTL = 252 * MiB, CTL_BYTES = 16384, WS_END = WS_CTL + CTL_BYTES;
static_assert(WS_U + (size_t)MT * UP * 2 <= WS_C2, "ws map");
constexpr int LDS_BYTES = 147456;
constexpr int NPHASE = 12;
#ifndef PROBE_DUP
#define PROBE_DUP 0
#endif

__device__ __forceinline__ unsigned pk2(float lo, float hi) { f32x2 v = {lo, hi}; bf16x2_t b = __builtin_convertvector(v, bf16x2_t); return __builtin_bit_cast(unsigned, b); }
__device__ __forceinline__ float bflo(unsigned u) { return __builtin_bit_cast(float, u << 16); }
__device__ __forceinline__ float bfhi(unsigned u) { return __builtin_bit_cast(float, u & 0xffff0000u); }
__device__ __forceinline__ float fexp2(float x) { return __builtin_amdgcn_exp2f(x); }
__device__ __forceinline__ float flog2(float x) { return __builtin_amdgcn_logf(x); }
__device__ __forceinline__ float frcp(float x) { return __builtin_amdgcn_rcpf(x); }
__device__ __forceinline__ float frsq(float x) { return __builtin_amdgcn_rsqf(x); }
__device__ __forceinline__ float sigmoidf_(float x) { return frcp(1.0f + fexp2(-1.4426950408889634f * x)); }
__device__ __forceinline__ float siluf_(float x) { return x * sigmoidf_(x); }
#define MFMA32(a, b, c) __builtin_amdgcn_mfma_f32_32x32x16_bf16((a), (b), (c), 0, 0, 0)

__device__ __forceinline__ float shx(float v, int m, int lane) { return __builtin_bit_cast(float, __builtin_amdgcn_ds_bpermute((lane ^ m) << 2, __builtin_bit_cast(int, v))); }
__device__ __forceinline__ float wave_sum(float v, int lane) {
#pragma unroll
    for (int o = 1; o < 64; o <<= 1) v += shx(v, o, lane);
    return v;
}
__device__ __forceinline__ float row_rstd(const float* ss, int row, int fq, int lane) {
    const f32x4 p = *(const f32x4*)(ss + (size_t)row * 16 + fq * 4);
    float s = (p[0] + p[1]) + (p[2] + p[3]);
    s += shx(s, 16, lane); s += shx(s, 32, lane);
    return frsq(s * (1.0f / DM) + EPS);
}

struct EpiIn {
    static constexpr bool PERM = true, AFTER_DRAIN = false; static constexpr int MID_T = 0;
    bf16_t* U; bf16_t* VT; const float* ss;
    __device__ __forceinline__ void operator()(const f32x4 (&acc)[2][2][4][2], const pg8::Unit& u, int, int, int, int) const {
        int t_ = threadIdx.x; asm volatile("" : "+v"(t_));
        const int lane = t_ & 63, fr = lane & 15, fq = lane >> 4, wid_ = __builtin_amdgcn_readfirstlane(t_ >> 6), wr = wid_ >> 2, wc = wid_ & 3;
        const int pn = u.pn;
        f32x4 pp[2][4];
#pragma unroll
        for (int ai = 0; ai < 2; ++ai)
#pragma unroll
            for (int m = 0; m < 4; ++m) pp[ai][m] = *(const f32x4*)(ss + (size_t)(u.pm * 256 + ai * 128 + wr * 64 + m * 16 + fr) * 16 + fq * 4);
#pragma unroll
        for (int ai = 0; ai < 2; ++ai)
#pragma unroll
            for (int m = 0; m < 4; ++m) {
                const int row = u.pm * 256 + ai * 128 + wr * 64 + m * 16 + fr;
                float s_ = (pp[ai][m][0] + pp[ai][m][1]) + (pp[ai][m][2] + pp[ai][m][3]);
                s_ += shx(s_, 16, lane); s_ += shx(s_, 32, lane);
                const float rs = frsq(s_ * (1.0f / DM) + EPS);
#pragma unroll
                for (int bj = 0; bj < 2; ++bj) {
                    const int col0 = pn * 256 + bj * 128 + wc * 32 + 8 * fq;
                    f32x4 v0 = acc[ai][bj][m][0] * rs, v1 = acc[ai][bj][m][1] * rs;
                    if (pn < 4) {
                        const float sc = pn < 2 ? QSCALE : 1.0f;
                        v0 = v0 * sc; v1 = v1 * sc;
                        u32x4 w; w[0] = pk2(v0[0], v0[1]); w[1] = pk2(v0[2], v0[3]); w[2] = pk2(v1[0], v1[1]); w[3] = pk2(v1[2], v1[3]);
                        *(u32x4*)(U + (size_t)row * UP + col0) = w;
                    } else if (pn < 6) {
                        const int vc = col0 - 1024, hh = vc >> 6, d0 = vc & 63, b = row >> 11, s = row & 2047;
                        bf16_t* vp = VT + ((size_t)((b * NH + hh) * HD + d0)) * SEQ + s;
                        const unsigned w0 = pk2(v0[0], v0[1]), w1 = pk2(v0[2], v0[3]), w2 = pk2(v1[0], v1[1]), w3 = pk2(v1[2], v1[3]);
                        vp[0 * SEQ] = (bf16_t)(w0 & 0xffffu); vp[1 * SEQ] = (bf16_t)(w0 >> 16);
                        vp[2 * SEQ] = (bf16_t)(w1 & 0xffffu); vp[3 * SEQ] = (bf16_t)(w1 >> 16);
                        vp[4 * SEQ] = (bf16_t)(w2 & 0xffffu); vp[5 * SEQ] = (bf16_t)(w2 >> 16);
                        vp[6 * SEQ] = (bf16_t)(w3 & 0xffffu); vp[7 * SEQ] = (bf16_t)(w3 >> 16);
                    } else if (pn < 8 || pn >= 12) {
                        u32x4 w; w[0] = pk2(siluf_(v0[0]), siluf_(v0[1])); w[1] = pk2(siluf_(v0[2]), siluf_(v0[3]));
                        w[2] = pk2(siluf_(v1[0]), siluf_(v1[1])); w[3] = pk2(siluf_(v1[2]), siluf_(v1[3]));
                        *(u32x4*)(U + (size_t)row * UP + (pn < 8 ? col0 - 512 : col0 - 1024)) = w;
                    } else {
                        const int ch0 = (col0 - 2048) >> 1;
                        u32x2 w; w[0] = pk2(v0[0] * sigmoidf_(v0[1]), v0[2] * sigmoidf_(v0[3])); w[1] = pk2(v1[0] * sigmoidf_(v1[1]), v1[2] * sigmoidf_(v1[3]));
                        *(u32x2*)(U + (size_t)row * UP + UGLU + ch0) = w;
                    }
                }
                asm volatile("" ::: "memory");
            }
    }
};

struct EpiPw {
    static constexpr bool PERM = true, AFTER_DRAIN = false; static constexpr int MID_T = 0;
    const bf16_t* U; bf16_t* Y; const float* cog; float* ssC;
    __device__ __forceinline__ void operator()(const f32x4 (&acc)[2][2][4][2], const pg8::Unit& u, int, int, int, int) const {
        int t_ = threadIdx.x; asm volatile("" : "+v"(t_));
        const int lane = t_ & 63, fr = lane & 15, fq = lane >> 4, wid_ = __builtin_amdgcn_readfirstlane(t_ >> 6), wr = wid_ >> 2, wc = wid_ & 3;
#pragma unroll
        for (int ai = 0; ai < 2; ++ai)
#pragma unroll
            for (int m = 0; m < 4; ++m) {
                const int row = u.pm * 256 + ai * 128 + wr * 64 + m * 16 + fr;
                float sq = 0.f;
#pragma unroll
                for (int bj = 0; bj < 2; ++bj) {
                    const int col0 = u.pn * 256 + bj * 128 + wc * 32 + 8 * fq;
                    const f32x4 v0 = acc[ai][bj][m][0], v1 = acc[ai][bj][m][1];
                    sq += (v0[0] * v0[0] + v0[1] * v0[1]) + (v0[2] * v0[2] + v0[3] * v0[3]) + (v1[0] * v1[0] + v1[1] * v1[1]) + (v1[2] * v1[2] + v1[3] * v1[3]);
                    const f32x4 g0 = *(const f32x4*)(cog + col0), g1 = *(const f32x4*)(cog + col0 + 4);
                    const u32x4 sg = *(const u32x4*)(U + (size_t)row * UP + USGC + col0);
                    u32x4 w;
                    w[0] = pk2(v0[0] * g0[0] * bflo(sg[0]), v0[1] * g0[1] * bfhi(sg[0])); w[1] = pk2(v0[2] * g0[2] * bflo(sg[1]), v0[3] * g0[3] * bfhi(sg[1]));
                    w[2] = pk2(v1[0] * g1[0] * bflo(sg[2]), v1[1] * g1[1] * bfhi(sg[2])); w[3] = pk2(v1[2] * g1[2] * bflo(sg[3]), v1[3] * g1[3] * bfhi(sg[3]));
                    *(u32x4*)(Y + (size_t)row * DM + col0) = w;
                }
                sq += shx(sq, 16, lane); sq += shx(sq, 32, lane);
                if (fq == 0) ssC[(size_t)row * 8 + u.pn * 4 + wc] = sq;
                asm volatile("" ::: "memory");
            }
    }
};

struct EpiE {
    static constexpr bool PERM = true, AFTER_DRAIN = false; static constexpr int MID_T = 0;
    bf16_t* EB;
    __device__ __forceinline__ void operator()(const f32x4 (&acc)[2][2][4][2], const pg8::Unit& u, int, int, int, int) const {
        int t_ = threadIdx.x; asm volatile("" : "+v"(t_));
        const int lane = t_ & 63, fr = lane & 15, fq = lane >> 4, wid_ = __builtin_amdgcn_readfirstlane(t_ >> 6), wr = wid_ >> 2, wc = wid_ & 3;
#pragma unroll
        for (int ai = 0; ai < 2; ++ai)
#pragma unroll
            for (int m = 0; m < 4; ++m) {
                const int row = u.pm * 256 + ai * 128 + wr * 64 + m * 16 + fr;
#pragma unroll
                for (int bj = 0; bj < 2; ++bj) {
                    const int col0 = u.pn * 256 + bj * 128 + wc * 32 + 8 * fq;
                    const f32x4 v0 = acc[ai][bj][m][0], v1 = acc[ai][bj][m][1];
                    u32x4 w; w[0] = pk2(v0[0], v0[1]); w[1] = pk2(v0[2], v0[3]); w[2] = pk2(v1[0], v1[1]); w[3] = pk2(v1[2], v1[3]);
                    *(u32x4*)(EB + (size_t)row * DM + col0) = w;
                }
                asm volatile("" ::: "memory");
            }
    }
};

struct EpiOut {
    static constexpr bool PERM = true, AFTER_DRAIN = false; static constexpr int MID_T = 8;
    const float* base; float* out; bf16_t* HB; float* ss; const float* ssC;
    __device__ __forceinline__ void mid(f32x4 (&acc)[2][2][4][2], const pg8::Unit& u) const {
        int t_ = threadIdx.x; asm volatile("" : "+v"(t_));
        const int lane = t_ & 63, fr = lane & 15, fq = lane >> 4, wid_ = __builtin_amdgcn_readfirstlane(t_ >> 6), wr = wid_ >> 2;
        f32x2 pc[2][4];
#pragma unroll
        for (int ai = 0; ai < 2; ++ai)
#pragma unroll
            for (int m = 0; m < 4; ++m) pc[ai][m] = *(const f32x2*)(ssC + (size_t)(u.pm * 256 + ai * 128 + wr * 64 + m * 16 + fr) * 8 + fq * 2);
#pragma unroll
        for (int ai = 0; ai < 2; ++ai)
#pragma unroll
            for (int m = 0; m < 4; ++m) {
                const f32x2 p = pc[ai][m];
                float s = p[0] + p[1];
                s += shx(s, 16, lane); s += shx(s, 32, lane);
                const float rs = frsq(s * (1.0f / CD) + EPS);
#pragma unroll
                for (int bj = 0; bj < 2; ++bj)
#pragma unroll
                    for (int n = 0; n < 2; ++n) acc[ai][bj][m][n] = acc[ai][bj][m][n] * rs;
            }
    }
    __device__ __forceinline__ void operator()(const f32x4 (&acc)[2][2][4][2], const pg8::Unit& u, int, int, int, int) const {
        int t_ = threadIdx.x; asm volatile("" : "+v"(t_));
        const int lane = t_ & 63, fr = lane & 15, fq = lane >> 4, wid_ = __builtin_amdgcn_readfirstlane(t_ >> 6), wr = wid_ >> 2, wc = wid_ & 3;
#pragma unroll
        for (int ai = 0; ai < 2; ++ai)
#pragma unroll
            for (int mp = 0; mp < 2; ++mp) {
                f32x4 bs[2][2][2];
#pragma unroll
                for (int mm = 0; mm < 2; ++mm)
#pragma unroll
                    for (int bj = 0; bj < 2; ++bj) {
                        const size_t off = (size_t)(u.pm * 256 + ai * 128 + wr * 64 + (2 * mp + mm) * 16 + fr) * DM + u.pn * 256 + bj * 128 + wc * 32 + 8 * fq;
                        bs[mm][bj][0] = *(const f32x4*)(base + off); bs[mm][bj][1] = *(const f32x4*)(base + off + 4);
                    }
#pragma unroll
                for (int mm = 0; mm < 2; ++mm) {
                    const int m = 2 * mp + mm;
                    const int row = u.pm * 256 + ai * 128 + wr * 64 + m * 16 + fr;
                    float sq = 0.f;
#pragma unroll
                    for (int bj = 0; bj < 2; ++bj) {
                        const size_t off = (size_t)row * DM + u.pn * 256 + bj * 128 + wc * 32 + 8 * fq;
                        const f32x4 h0 = bs[mm][bj][0] + acc[ai][bj][m][0], h1 = bs[mm][bj][1] + acc[ai][bj][m][1];
                        *(f32x4*)(out + off) = h0; *(f32x4*)(out + off + 4) = h1;
                        u32x4 w; w[0] = pk2(h0[0], h0[1]); w[1] = pk2(h0[2], h0[3]); w[2] = pk2(h1[0], h1[1]); w[3] = pk2(h1[2], h1[3]);
                        *(u32x4*)(HB + off) = w;
                        sq += (h0[0] * h0[0] + h0[1] * h0[1]) + (h0[2] * h0[2] + h0[3] * h0[3]) + (h1[0] * h1[0] + h1[1] * h1[1]) + (h1[2] * h1[2] + h1[3] * h1[3]);
                    }
                    sq += shx(sq, 16, lane); sq += shx(sq, 32, lane);
                    if (fq == 0) ss[(size_t)row * 16 + u.pn * 4 + wc] = sq;
                }
                asm volatile("" ::: "memory");
            }
    }
};

struct EpiGate {
    static constexpr bool PERM = true, AFTER_DRAIN = false; static constexpr int MID_T = 0;
    float* out; const bf16_t* EB; bf16_t* HB; const float* ss_in; float* ss_out;
    __device__ __forceinline__ void operator()(const f32x4 (&acc)[2][2][4][2], const pg8::Unit& u, int, int, int, int) const {
        int t_ = threadIdx.x; asm volatile("" : "+v"(t_));
        const int lane = t_ & 63, fr = lane & 15, fq = lane >> 4, wid_ = __builtin_amdgcn_readfirstlane(t_ >> 6), wr = wid_ >> 2, wc = wid_ & 3;
        f32x4 pp[2][4];
#pragma unroll
        for (int ai = 0; ai < 2; ++ai)
#pragma unroll
            for (int m = 0; m < 4; ++m) pp[ai][m] = *(const f32x4*)(ss_in + (size_t)(u.pm * 256 + ai * 128 + wr * 64 + m * 16 + fr) * 16 + fq * 4);
        float rsv[2][4];
#pragma unroll
        for (int ai = 0; ai < 2; ++ai)
#pragma unroll
            for (int m = 0; m < 4; ++m) {
                float s_ = (pp[ai][m][0] + pp[ai][m][1]) + (pp[ai][m][2] + pp[ai][m][3]);
                s_ += shx(s_, 16, lane); s_ += shx(s_, 32, lane);
                rsv[ai][m] = frsq(s_ * (1.0f / DM) + EPS);
            }
        asm volatile("" ::: "memory");
#pragma unroll
        for (int ai = 0; ai < 2; ++ai)
#pragma unroll
            for (int mp = 0; mp < 2; ++mp) {
                f32x4 bs[2][2][2];
#pragma unroll
                for (int mm = 0; mm < 2; ++mm)
#pragma unroll
                    for (int bj = 0; bj < 2; ++bj) {
                        const size_t off = (size_t)(u.pm * 256 + ai * 128 + wr * 64 + (2 * mp + mm) * 16 + fr) * DM + u.pn * 256 + bj * 128 + wc * 32 + 8 * fq;
                        bs[mm][bj][0] = *(const f32x4*)(out + off); bs[mm][bj][1] = *(const f32x4*)(out + off + 4);
                    }
#pragma unroll
                for (int mm = 0; mm < 2; ++mm) {
                    const int m = 2 * mp + mm;
                    const int row = u.pm * 256 + ai * 128 + wr * 64 + m * 16 + fr;
                    const float rs = rsv[ai][m];
                    float sq = 0.f;
#pragma unroll
                    for (int bj = 0; bj < 2; ++bj) {
                        const size_t off = (size_t)row * DM + u.pn * 256 + bj * 128 + wc * 32 + 8 * fq;
                        const f32x4 a0 = acc[ai][bj][m][0] * rs, a1 = acc[ai][bj][m][1] * rs;
                        const u32x4 e = *(const u32x4*)(EB + off);
                        f32x4 h0 = bs[mm][bj][0], h1 = bs[mm][bj][1];
                        h0[0] += bflo(e[0]) * sigmoidf_(a0[0]); h0[1] += bfhi(e[0]) * sigmoidf_(a0[1]); h0[2] += bflo(e[1]) * sigmoidf_(a0[2]); h0[3] += bfhi(e[1]) * sigmoidf_(a0[3]);
                        h1[0] += bflo(e[2]) * sigmoidf_(a1[0]); h1[1] += bfhi(e[2]) * sigmoidf_(a1[1]); h1[2] += bflo(e[3]) * sigmoidf_(a1[2]); h1[3] += bfhi(e[3]) * sigmoidf_(a1[3]);
                        *(f32x4*)(out + off) = h0; *(f32x4*)(out + off + 4) = h1;
                        u32x4 w; w[0] = pk2(h0[0], h0[1]); w[1] = pk2(h0[2], h0[3]); w[2] = pk2(h1[0], h1[1]); w[3] = pk2(h1[2], h1[3]);
                        *(u32x4*)(HB + off) = w;
                        sq += (h0[0] * h0[0] + h0[1] * h0[1]) + (h0[2] * h0[2] + h0[3] * h0[3]) + (h1[0] * h1[0] + h1[1] * h1[1]) + (h1[2] * h1[2] + h1[3] * h1[3]);
                    }
                    sq += shx(sq, 16, lane); sq += shx(sq, 32, lane);
                    if (fq == 0) ss_out[(size_t)row * 16 + u.pn * 4 + wc] = sq;
                }
                asm volatile("" ::: "memory");
            }
    }
};

struct SubOrder {
    int nN, nwg, nb, c;
    __device__ void init(int M, int N, int nb_, int c_) { nN = N / 256; nwg = (M / 256) * nN; nb = nb_; c = c_; }
    __device__ bool next(int i, pg8::Unit& u) const { if (c < 0 || c >= nb) return false; const int L = i * nb + c; if (L >= nwg) return false; u.pm = L / nN; u.pn = L % nN; return true; }
    __device__ __forceinline__ void a_ready(const pg8::Unit&) const {}
    __device__ __forceinline__ void done(const pg8::Unit&) const {}
};

template <bool REMAP>
__device__ __forceinline__ void tr_item(const float* W, int K, int N, bf16_t* WT, const float* g, LAS float* scr, int item, int lane, int kshift = 0) {
    const int nblk = N / 32, kb = item / nblk, nb = item % nblk, k0 = 64 * kb, n0 = 32 * nb;
    int src = n0 + (lane & 31);
    if (REMAP) { if (src >= 2048 && src < 3072) { const int jj = src - 2048; src = (jj & 1) ? 2560 + (jj >> 1) : 2048 + (jj >> 1); } }
#pragma unroll 8
    for (int i = 0; i < 32; ++i) { const int kk = 2 * i + (lane >> 5); float v = W[(size_t)((k0 + kk + kshift) & (K - 1)) * N + src]; if (g) v *= g[k0 + kk]; scr[kk * 33 + (lane & 31)] = v; }
    asm volatile("s_waitcnt lgkmcnt(0)" ::: "memory");
    const int c = lane & 7;
#pragma unroll
    for (int j = 0; j < 4; ++j) { const int n = (lane >> 3) + 8 * j; const LAS float* s = scr + (8 * c) * 33 + n;
        u32x4 o; o[0] = pk2(s[0 * 33], s[1 * 33]); o[1] = pk2(s[2 * 33], s[3 * 33]); o[2] = pk2(s[4 * 33], s[5 * 33]); o[3] = pk2(s[6 * 33], s[7 * 33]);
        *(u32x4*)(WT + (size_t)(n0 + n) * K + k0 + 8 * c) = o; }
    asm volatile("s_waitcnt lgkmcnt(0)" ::: "memory");
}

constexpr int AK_STRIDE = 144, AV_STRIDE = 136, A_KBYTES = 64 * AK_STRIDE, A_VBYTES = 64 * AV_STRIDE, A_BUF = 18432;
static_assert(A_KBYTES + A_VBYTES <= A_BUF, "attention LDS buffer");

__device__ __forceinline__ void attn_unit(const bf16_t* U, const bf16_t* VT, bf16_t* Y, const float* aog, int b, int h, int qb, LAS unsigned char* lds) {
    int tid = threadIdx.x; asm volatile("" : "+v"(tid));
    const int wave = __builtin_amdgcn_readfirstlane(tid >> 6), lane = tid & 63, l31 = lane & 31, hi = lane >> 5;
    const int q0 = qb * 256 + wave * 32, t = q0 + l31;
    const size_t trow = (size_t)(b * SEQ + t);
    bf16x8 qf[4];
    {
        const bf16_t* qp = U + trow * UP + UQ + h * HD + 8 * hi;
#pragma unroll
        for (int s = 0; s < 4; ++s) qf[s] = *(const bf16x8*)(qp + 16 * s);
    }
    f32x16 o0, o1;
#pragma unroll
    for (int i = 0; i < 16; ++i) { o0[i] = 0.f; o1[i] = 0.f; }
    float C = 1.f;
    const int ktmax = 4 * qb + 3, wkt = (q0 + 30) >> 6;
    const int srow = tid >> 3, sch = tid & 7;
    const bf16_t* gk = U + (size_t)(b * SEQ + srow) * UP + UK + h * HD + sch * 8;
    const bf16_t* gv = VT + ((size_t)((b * NH + h) * HD + srow)) * SEQ + sch * 8;
    const int kwoff = srow * AK_STRIDE + sch * 16, vwoff = A_KBYTES + srow * AV_STRIDE + sch * 16;
    __syncthreads();
    {
        const u32x4 kr = *(const u32x4*)(gk + (size_t)ktmax * 64 * UP), vr = *(const u32x4*)(gv + ktmax * 64);
        *(LAS u32x4*)(lds + kwoff) = kr;
        u32x2 a = {vr[0], vr[1]}, c = {vr[2], vr[3]};
        *(LAS u32x2*)(lds + vwoff) = a; *(LAS u32x2*)(lds + vwoff + 8) = c;
    }
    __syncthreads();
    int cur = 0;
    LAS unsigned* dflag = (LAS unsigned*)(lds + 2 * A_BUF);
    bool wdone = false;
    for (int kt = ktmax; kt >= 0; --kt) {
        u32x4 kr = {0u, 0u, 0u, 0u}, vr = {0u, 0u, 0u, 0u};
        if (kt > 0) { kr = *(const u32x4*)(gk + (size_t)(kt - 1) * 64 * UP); vr = *(const u32x4*)(gv + (kt - 1) * 64); }
        if (kt <= wkt && !wdone) {
            const LAS unsigned char* kb = lds + cur * A_BUF;
            const LAS unsigned char* vb = kb + A_KBYTES;
            f32x16 p0, p1;
#pragma unroll
            for (int i = 0; i < 16; ++i) { p0[i] = 0.f; p1[i] = 0.f; }
#pragma unroll
            for (int s = 0; s < 4; ++s) {
                const bf16x8 ka = *(const LAS bf16x8*)(kb + l31 * AK_STRIDE + 32 * s + 16 * hi);
                const bf16x8 kc = *(const LAS bf16x8*)(kb + (32 + l31) * AK_STRIDE + 32 * s + 16 * hi);
                p0 = MFMA32(ka, qf[s], p0); p1 = MFMA32(kc, qf[s], p1);
            }
            const int lim0 = t - (64 * kt + 4 * hi), lim1 = lim0 - 32;
            const bool diag = (64 * kt + 63 >= q0);
            f32x16 m0, m1;
            float G0[4], G1[4];
#pragma unroll
            for (int g = 0; g < 4; ++g) {
                float s0 = 1.f, s1 = 1.f;
#pragma unroll
                for (int i = 0; i < 4; ++i) {
                    const int r = 4 * g + i, cr = i + 8 * g;
                    const float e0 = fexp2(fminf(p0[r], 100.f)), e1 = fexp2(fminf(p1[r], 100.f));
                    float r0 = frcp(1.0f + e0), r1 = frcp(1.0f + e1);
                    float b0 = e0 * r0, b1 = e1 * r1;
                    if (diag) { const bool v0 = cr < lim0, v1 = cr < lim1; r0 = v0 ? r0 : 1.f; b0 = v0 ? b0 : 0.f; r1 = v1 ? r1 : 1.f; b1 = v1 ? b1 : 0.f; }
                    m0[r] = r0; m1[r] = r1; p0[r] = b0; p1[r] = b1; s0 *= r0; s1 *= r1;
                }
                G0[g] = s0; G1[g] = s1;
            }
            float X0[4], X1[4];
#pragma unroll
            for (int g = 0; g < 4; ++g) { X0[g] = shx(G0[g], 32, lane); X1[g] = shx(G1[g], 32, lane); }
            float run = C;
#pragma unroll
            for (int g = 3; g >= 0; --g) {
                float a = hi == 0 ? run * X1[g] : run;
#pragma unroll
                for (int i = 3; i >= 0; --i) { const int r = 4 * g + i; const float w = a * p1[r]; a *= m1[r]; p1[r] = w; }
                run *= G1[g] * X1[g];
            }
#pragma unroll
            for (int g = 3; g >= 0; --g) {
                float a = hi == 0 ? run * X0[g] : run;
#pragma unroll
                for (int i = 3; i >= 0; --i) { const int r = 4 * g + i; const float w = a * p0[r]; a *= m0[r]; p0[r] = w; }
                run *= G0[g] * X0[g];
            }
            C = run;
#pragma unroll
            for (int kh = 0; kh < 2; ++kh)
#pragma unroll
                for (int sh = 0; sh < 2; ++sh) {
                    u32x4 xw;
                    if (kh == 0) { xw[0] = pk2(p0[8 * sh + 0], p0[8 * sh + 1]); xw[1] = pk2(p0[8 * sh + 2], p0[8 * sh + 3]); xw[2] = pk2(p0[8 * sh + 4], p0[8 * sh + 5]); xw[3] = pk2(p0[8 * sh + 6], p0[8 * sh + 7]); }
                    else         { xw[0] = pk2(p1[8 * sh + 0], p1[8 * sh + 1]); xw[1] = pk2(p1[8 * sh + 2], p1[8 * sh + 3]); xw[2] = pk2(p1[8 * sh + 4], p1[8 * sh + 5]); xw[3] = pk2(p1[8 * sh + 6], p1[8 * sh + 7]); }
                    const bf16x8 xf = __builtin_bit_cast(bf16x8, xw);
                    const int koff = 2 * (32 * kh + 16 * sh + 4 * hi);
                    {
                        const LAS unsigned char* vp = vb + l31 * AV_STRIDE + koff;
                        const u32x2 lo = *(const LAS u32x2*)vp, hh = *(const LAS u32x2*)(vp + 16);
                        u32x4 vw = {lo[0], lo[1], hh[0], hh[1]};
                        o0 = MFMA32(__builtin_bit_cast(bf16x8, vw), xf, o0);
                    }
                    {
                        const LAS unsigned char* vp = vb + (32 + l31) * AV_STRIDE + koff;
                        const u32x2 lo = *(const LAS u32x2*)vp, hh = *(const LAS u32x2*)(vp + 16);
                        u32x4 vw = {lo[0], lo[1], hh[0], hh[1]};
                        o1 = MFMA32(__builtin_bit_cast(bf16x8, vw), xf, o1);
                    }
                }
        }
        wdone = (__builtin_amdgcn_ballot_w64(C > 7.5e-37f) == 0ull);
        if (lane == 0) dflag[(kt & 1) * 8 + wave] = wdone ? 1u : 0u;
        if (kt > 0) {
            LAS unsigned char* nb = lds + (cur ^ 1) * A_BUF;
            *(LAS u32x4*)(nb + kwoff) = kr;
            u32x2 a = {vr[0], vr[1]}, c = {vr[2], vr[3]};
            *(LAS u32x2*)(nb + vwoff) = a; *(LAS u32x2*)(nb + vwoff + 8) = c;
        }
        __syncthreads();
        cur ^= 1;
        {
            const LAS u32x4* df = (const LAS u32x4*)(dflag + (kt & 1) * 8);
            const u32x4 f0 = df[0], f1 = df[1];
            if ((f0[0] & f0[1] & f0[2] & f0[3] & f1[0] & f1[1] & f1[2] & f1[3]) != 0u) break;
        }
    }
    float sq = 0.f;
#pragma unroll
    for (int i = 0; i < 16; ++i) sq += o0[i] * o0[i] + o1[i] * o1[i];
    sq += shx(sq, 32, lane);
    const float rs = frsq(sq * (1.0f / HD) + EPS);
    const bf16_t* sgp = U + trow * UP + USGA + h * HD;
    bf16_t* yp = Y + trow * DM + 512 + h * HD;
#pragma unroll
    for (int dt = 0; dt < 2; ++dt)
#pragma unroll
        for (int g = 0; g < 4; ++g) {
            const int d0 = 32 * dt + 8 * g + 4 * hi;
            const f32x4 gn = *(const f32x4*)(aog + d0);
            const u32x2 sg = *(const u32x2*)(sgp + d0);
            float v0, v1, v2, v3;
            if (dt == 0) { v0 = o0[4 * g + 0]; v1 = o0[4 * g + 1]; v2 = o0[4 * g + 2]; v3 = o0[4 * g + 3]; }
            else         { v0 = o1[4 * g + 0]; v1 = o1[4 * g + 1]; v2 = o1[4 * g + 2]; v3 = o1[4 * g + 3]; }
            u32x2 w;
            w[0] = pk2(v0 * rs * gn[0] * bflo(sg[0]), v1 * rs * gn[1] * bfhi(sg[0]));
            w[1] = pk2(v2 * rs * gn[2] * bflo(sg[1]), v3 * rs * gn[3] * bfhi(sg[1]));
            *(u32x2*)(yp + d0) = w;
        }
}

constexpr int CT = 32, C_XH = 0, C_XH_BYTES = (CT + 30) * 1024, C_CO = C_XH_BYTES, C_CO_BYTES = CT * CD * 4;
static_assert(C_CO + C_CO_BYTES <= LDS_BYTES, "conv LDS map");

__device__ __forceinline__ void convpre_unit(const bf16_t* U, bf16_t* C2, const float* dww, const float* dwb, const float* lng, const float* lnb, int cu, LAS unsigned char* lds) {
    int tid = threadIdx.x; asm volatile("" : "+v"(tid));
    const int wave = __builtin_amdgcn_readfirstlane(tid >> 6), lane = tid & 63;
    const int r0 = cu * CT, b = r0 >> 11, s0 = r0 & 2047;
    __syncthreads();
    for (int i = tid; i < (CT + 30) * 64; i += 512) {
        const int row = i >> 6, ch = i & 63, s = s0 - 30 + row;
        u32x4 v = {0u, 0u, 0u, 0u};
        if (s >= 0) v = *(const u32x4*)(U + (size_t)(b * SEQ + s) * UP + UGLU + ch * 8);
        *(LAS u32x4*)(lds + C_XH + row * 1024 + ch * 16) = v;
    }
    __syncthreads();
    {
        const int chp = tid & 255, tg = tid >> 8;
        float w0[CWID], w1[CWID];
#pragma unroll
        for (int j = 0; j < CWID; ++j) { const f32x2 ww = *(const f32x2*)(dww + (size_t)j * CD + 2 * chp); w0[j] = ww[0]; w1[j] = ww[1]; }
        const f32x2 bias = *(const f32x2*)(dwb + 2 * chp);
        const LAS unsigned char* xp = lds + C_XH + chp * 4;
#pragma unroll 1
        for (int tt = 0; tt < 16; ++tt) {
            const int tl = tg * 16 + tt;
            float a0 = bias[0], a1 = bias[1];
#pragma unroll
            for (int j = 0; j < CWID; ++j) { const unsigned xv = *(const LAS unsigned*)(xp + (tl + j) * 1024); a0 += w0[j] * bflo(xv); a1 += w1[j] * bfhi(xv); }
            f32x2 o = {a0, a1};
            *(LAS f32x2*)(lds + C_CO + tl * 2048 + chp * 8) = o;
        }
    }
    __syncthreads();
    {
        const f32x4 g0 = *(const f32x4*)(lng + lane * 4), g1 = *(const f32x4*)(lng + 256 + lane * 4);
        const f32x4 b0 = *(const f32x4*)(lnb + lane * 4), b1 = *(const f32x4*)(lnb + 256 + lane * 4);
#pragma unroll
        for (int tt = 0; tt < 4; ++tt) {
            const int tl = wave * 4 + tt;
            f32x4 v0 = *(const LAS f32x4*)(lds + C_CO + tl * 2048 + lane * 16), v1 = *(const LAS f32x4*)(lds + C_CO + tl * 2048 + 1024 + lane * 16);
            const float mean = wave_sum((v0[0] + v0[1]) + (v0[2] + v0[3]) + (v1[0] + v1[1]) + (v1[2] + v1[3]), lane) * (1.0f / CD);
            v0 = v0 - mean; v1 = v1 - mean;
            const float var = wave_sum((v0[0] * v0[0] + v0[1] * v0[1]) + (v0[2] * v0[2] + v0[3] * v0[3]) + (v1[0] * v1[0] + v1[1] * v1[1]) + (v1[2] * v1[2] + v1[3] * v1[3]), lane) * (1.0f / CD);
            const float rs = frsq(var + EPS);
            v0 = v0 * rs * g0 + b0; v1 = v1 * rs * g1 + b1;
            u32x2 wa, wb;
            wa[0] = pk2(siluf_(v0[0]), siluf_(v0[1])); wa[1] = pk2(siluf_(v0[2]), siluf_(v0[3]));
            wb[0] = pk2(siluf_(v1[0]), siluf_(v1[1])); wb[1] = pk2(siluf_(v1[2]), siluf_(v1[3]));
            bf16_t* cp = C2 + (size_t)(r0 + tl) * CD + lane * 4;
            *(u32x2*)cp = wa; *(u32x2*)(cp + 256) = wb;
        }
    }
}

#define XB_TMO      128
#define XB_XCNT(j)  (256  + 64 * (j))
#define XB_XSUB(j)  (1280 + 64 * (j))
#define XB_XGEN(j)  (2304 + 64 * (j))
#define XB_TOP      3328
#define XB_TOPGEN   3392
#define XCD_BAR_WORDS 3456
#define XB_SPIN_CAP (1u << 18)

__device__ __forceinline__ unsigned xb_ld(unsigned* p)              { return __hip_atomic_load(p, __ATOMIC_RELAXED, __HIP_MEMORY_SCOPE_AGENT); }
__device__ __forceinline__ unsigned xb_add(unsigned* p, unsigned v) { return __hip_atomic_fetch_add(p, v, __ATOMIC_RELAXED, __HIP_MEMORY_SCOPE_AGENT); }
__device__ __forceinline__ unsigned xb_xcc_id() { return (unsigned)__builtin_amdgcn_s_getreg((3 << 11) | 20) & 0xFu; }
#define XB_SPIN(cond, bar) do { unsigned _sp = 0; while (cond) { __builtin_amdgcn_s_sleep(1); \
    if ((++_sp & 255u) == 0u) { if (xb_ld(&(bar)[XB_TMO])) break; if (_sp > XB_SPIN_CAP) { atomicAdd(&(bar)[XB_TMO], 1u); break; } } } } while (0)

struct XcdBarrier {
    unsigned* bar; unsigned x;
    volatile LAS unsigned* st;
};

__device__ __forceinline__ XcdBarrier xcd_barrier_post(unsigned* bar, volatile LAS unsigned* st) {
    XcdBarrier b; b.bar = bar; b.x = xb_xcc_id(); b.st = st;
    if (threadIdx.x == 0) (void)xb_add(&bar[XB_XCNT(b.x)], 1u);
    return b;
}
__device__ __forceinline__ void xcd_barrier_complete(unsigned* bar, unsigned x, unsigned& nloc, unsigned& nx) {
    const unsigned G = gridDim.x * gridDim.y * gridDim.z;
    unsigned sum, cnt, mine, sp = 0u;
    for (;;) {
        sum = 0u; cnt = 0u; mine = 0u;
#pragma unroll
        for (unsigned j = 0; j < 16; ++j) { const unsigned c = xb_ld(&bar[XB_XCNT(j)]); sum += c; cnt += (c > 0u) ? 1u : 0u; mine = (j == x) ? c : mine; }
        if (sum == G) break;
        __builtin_amdgcn_s_sleep(1);
        if ((++sp & 255u) == 0u) { if (xb_ld(&bar[XB_TMO])) break; if (sp > XB_SPIN_CAP) { atomicAdd(&bar[XB_TMO], 1u); break; } }
    }
    nloc = mine > 0u ? mine : 1u; nx = cnt > 0u ? cnt : 1u;
}

__device__ __forceinline__ void xcd_barrier(const XcdBarrier& b) {
    asm volatile("s_waitcnt vmcnt(0)" ::: "memory");
    __syncthreads();
    if (threadIdx.x == 0) {
        unsigned* bar = b.bar;
        __builtin_amdgcn_s_waitcnt(0);
        unsigned nloc = b.st[0], nx = b.st[1];
        if (nloc == 0u) { xcd_barrier_complete(bar, b.x, nloc, nx); b.st[0] = nloc; b.st[1] = nx; }
        const unsigned old = xb_add(&bar[XB_XSUB(b.x)], 1u);
        const unsigned gen = old / nloc;
        if (old + 1u == (gen + 1u) * nloc) {
            __builtin_amdgcn_fence(__ATOMIC_RELEASE, "agent");
            asm volatile("s_waitcnt vmcnt(0)" ::: "memory");
            const unsigned og = xb_add(&bar[XB_TOP], 1u);
            const unsigned tg = og / nx;
            if (og + 1u == (tg + 1u) * nx) xb_add(&bar[XB_TOPGEN], 1u);
            else XB_SPIN(xb_ld(&bar[XB_TOPGEN]) == tg, bar);
            __builtin_amdgcn_fence(__ATOMIC_ACQUIRE, "agent");
            xb_add(&bar[XB_XGEN(b.x)], 1u);
            asm volatile("s_waitcnt vmcnt(0)" ::: "memory");
        } else {
            XB_SPIN(xb_ld(&bar[XB_XGEN(b.x)]) == gen, bar);
            __builtin_amdgcn_fence(__ATOMIC_ACQUIRE, "agent");
            asm volatile("s_waitcnt vmcnt(0)" ::: "memory");
        }
    }
    __syncthreads();
}

struct Params { const float* in[16]; float* out; unsigned char* ws; int ph_lo, ph_hi; };

template <int ph>
__device__ __forceinline__ void run_phase(const Params& P, LAS unsigned char* lds) {
    const int G = gridDim.x, bid = blockIdx.x;
    unsigned char* ws = P.ws;
    const float* x = P.in[0];
    float* out = P.out;
    bf16_t* HB = (bf16_t*)(ws + WS_HB); bf16_t* H1B = (bf16_t*)(ws + WS_H1B); bf16_t* Ub = (bf16_t*)(ws + WS_U); bf16_t* VT = (bf16_t*)(ws + WS_VT); bf16_t* Yb = (bf16_t*)(ws + WS_Y);
    bf16_t* C2 = (bf16_t*)(ws + WS_C2); bf16_t* EB = (bf16_t*)(ws + WS_EB);
    float* ssA = (float*)(ws + WS_SSA); float* ssB = (float*)(ws + WS_SSB); float* ssC = (float*)(ws + WS_SSC);
    int tid = threadIdx.x; asm volatile("" : "+v"(tid));
    const int lane = tid & 63, wave = __builtin_amdgcn_readfirstlane(tid >> 6);
    const int gw = bid * 8 + wave, NGW = G * 8;
    if constexpr (ph == 0) {
        LAS float* scr = (LAS float*)(lds + wave * 16384);
        for (int it = gw; it < 2 * 3072; it += NGW) {
            const int l = it / 3072; int r = it - l * 3072;
            unsigned char* wb = ws + (size_t)l * W_LAYER;
            if (r < 1792) { tr_item<true>(P.in[3] + (size_t)l * DM * DIN, DM, DIN, (bf16_t*)(wb + W_IN), P.in[2] + l * DM, scr, r, lane); continue; } r -= 1792;
            if (r < 128) { tr_item<false>(P.in[9] + (size_t)l * CD * CD, CD, CD, (bf16_t*)(wb + W_PW), nullptr, scr, r, lane); continue; } r -= 128;
            if (r < 512) { tr_item<false>(P.in[11] + (size_t)l * DM * DM, DM, DM, (bf16_t*)(wb + W_OUT), nullptr, scr, r, lane, 512); continue; } r -= 512;
            if (r < 512) { tr_item<false>(P.in[13] + (size_t)l * DM * DM, DM, DM, (bf16_t*)(wb + W_PG), P.in[12] + l * DM, scr, r, lane); continue; } r -= 512;
            tr_item<false>(P.in[14] + (size_t)l * PLE * DM, PLE, DM, (bf16_t*)(wb + W_PLE), nullptr, scr, r, lane);
        }
        for (int row = gw; row < MT; row += NGW) {
            const f32x4* xr = (const f32x4*)(x + (size_t)row * DM) + lane;
            u32x2* ob = (u32x2*)(HB + (size_t)row * DM) + lane;
            float s = 0.f;
#pragma unroll
            for (int j = 0; j < 4; ++j) { const f32x4 v = xr[64 * j]; s += (v[0] * v[0] + v[1] * v[1]) + (v[2] * v[2] + v[3] * v[3]); u32x2 w; w[0] = pk2(v[0], v[1]); w[1] = pk2(v[2], v[3]); ob[64 * j] = w; }
            s = wave_sum(s, lane);
            if (lane < 16) ssA[(size_t)row * 16 + lane] = (lane == 0) ? s : 0.f;
        }
        {
            const f32x4* pp = (const f32x4*)P.in[1]; u32x2* pb = (u32x2*)(ws + WS_PB);
            for (int i = bid * 512 + tid; i < 2 * MT * PLE / 4; i += G * 512) { const f32x4 v = pp[i]; u32x2 w; w[0] = pk2(v[0], v[1]); w[1] = pk2(v[2], v[3]); pb[i] = w; }
        }
    } else if constexpr (ph == NPHASE - 1) {
        const float* fg = P.in[15];
        for (int row = gw; row < MT; row += NGW) {
            f32x4* xr = (f32x4*)(out + (size_t)row * DM) + lane;
            f32x4 v[4]; float s = 0.f;
#pragma unroll
            for (int j = 0; j < 4; ++j) { v[j] = xr[64 * j]; s += (v[j][0] * v[j][0] + v[j][1] * v[j][1]) + (v[j][2] * v[j][2] + v[j][3] * v[j][3]); }
            const float rs = frsq(wave_sum(s, lane) * (1.0f / DM) + EPS);
#pragma unroll
            for (int j = 0; j < 4; ++j) { const f32x4 g = *((const f32x4*)fg + lane + 64 * j); xr[64 * j] = v[j] * rs * g; }
        }
    } else {
        constexpr int l = (ph - 1) / 5, k = (ph - 1) % 5;
        unsigned char* wb = ws + (size_t)l * W_LAYER;
        if constexpr (k == 0) {
            pg8::Gemm g{HB, (const bf16_t*)(wb + W_IN), MT, DIN, DM}; pg8::StaticOrder S; S.init(MT, DIN, G, bid);
            EpiIn E{Ub, VT, ssA};
            pg8::gemm_phase<EpiIn, pg8::StaticOrder, true, true>(lds, g, S, E, threadIdx.x);
        } else if constexpr (k == 1) {
            const float* aog = P.in[4] + l * HD;
            const float* dww = P.in[5] + (size_t)l * CWID * CD; const float* dwb = P.in[6] + l * CD;
            const float* lng = P.in[7] + l * CD; const float* lnb = P.in[8] + l * CD;
            for (int it = bid; it < 256; it += G) {
                const int bh = it >> 2, pr = it & 3, b = bh >> 3, h = bh & 7;
#pragma unroll 1
                for (int uu = 0; uu < ((PROBE_DUP & 2) ? 4 : 2); ++uu) attn_unit(Ub, VT, Yb, aog, b, h, (uu & 1) == 0 ? 7 - pr : pr, lds);
#pragma unroll 1
                for (int uu = 0; uu < ((PROBE_DUP & 4) ? 4 : 2); ++uu) convpre_unit(Ub, C2, dww, dwb, lng, lnb, 2 * it + (uu & 1), lds);
            }
            __syncthreads();
        } else if constexpr (k == 2) {
            const int nb0 = G / 2;
            {
                pg8::Gemm g{C2, (const bf16_t*)(wb + W_PW), MT, CD, CD}; SubOrder S; S.init(MT, CD, nb0, bid);
                EpiPw E{Ub, Yb, P.in[10] + l * CD, ssC};
                pg8::gemm_phase<EpiPw, SubOrder, true, true>(lds, g, S, E, threadIdx.x);
            }
            {
                pg8::Gemm g{(const bf16_t*)(ws + WS_PB) + (size_t)l * MT * PLE, (const bf16_t*)(wb + W_PLE), MT, DM, PLE}; SubOrder S; S.init(MT, DM, G - nb0, bid - nb0);
                EpiE E{EB};
                int t2 = threadIdx.x; asm volatile("" : "+v"(t2));
                pg8::gemm_phase<EpiE, SubOrder, true, true>(lds, g, S, E, t2);
            }
        } else if constexpr (k == 3) {
            pg8::Gemm g{Yb, (const bf16_t*)(wb + W_OUT), MT, DM, DM}; pg8::StaticOrder S; S.init(MT, DM, G, bid);
            EpiOut E{l == 0 ? x : out, out, H1B, ssB, ssC};
            pg8::gemm_phase<EpiOut, pg8::StaticOrder, true, true>(lds, g, S, E, threadIdx.x);
        } else {
            pg8::Gemm g{H1B, (const bf16_t*)(wb + W_PG), MT, DM, DM}; pg8::StaticOrder S; S.init(MT, DM, G, bid);
            EpiGate E{out, EB, HB, ssB, ssA};
            pg8::gemm_phase<EpiGate, pg8::StaticOrder, true, true>(lds, g, S, E, threadIdx.x);
        }
    }
}

__global__ void __launch_bounds__(512, 2) fwd(Params P) {
    extern __shared__ __attribute__((aligned(16))) unsigned char lds_raw[];
    LAS unsigned char* lds = (LAS unsigned char*)lds_raw;
    const int lo = P.ph_lo, hi = P.ph_hi;
    volatile LAS unsigned* st = (volatile LAS unsigned*)(lds + LDS_BYTES - 64);
    if (threadIdx.x < 16) st[threadIdx.x] = 0u;
    __syncthreads();
    const XcdBarrier bar = xcd_barrier_post((unsigned*)(P.ws + WS_CTL), st);
#define PROBE_PH(k) ((((PROBE_DUP) & 8) && (k) == 0) || (((PROBE_DUP) & 1) && (k) == 1) || (((PROBE_DUP) & 32) && ((k) == 3 || (k) == 8)) || (((PROBE_DUP) & 16) && (k) == 4))
#define SEAM() do { if (hi > NPHASE) cg::this_grid().sync(); else xcd_barrier(bar); } while (0)
#define PHASE(k) if (lo <= (k) && (k) < hi) { run_phase<(k)>(P, lds); if constexpr (PROBE_PH(k)) { __syncthreads(); run_phase<(k)>(P, lds); } \
        if constexpr (((PROBE_DUP) & 64) != 0) { SEAM(); } if ((k) + 1 < hi) SEAM(); }
    PHASE(0) PHASE(1) PHASE(2) PHASE(3) PHASE(4) PHASE(5) PHASE(6) PHASE(7) PHASE(8) PHASE(9) PHASE(10) PHASE(11)
#undef PHASE
#undef SEAM
}

#ifndef MK_N_LAUNCHES
#define MK_N_LAUNCHES 1
#endif
extern "C" void kernel_launch(void* const* d_in, const int* in_sizes, int n_in, void* d_out, int out_size, void* d_ws, size_t ws_size, hipStream_t stream) {
    static int grid = 0;
    if (grid == 0) {
        if (n_in != 16 || out_size != MT * DM || ws_size < WS_END) { fprintf(stderr, "kernel_launch: unexpected shapes (n_in %d, out %d, ws %zu)\n", n_in, out_size, ws_size); grid = -1; return; }
        int dev = 0, cus = 0, per_cu = 0;
        (void)hipGetDevice(&dev);
        (void)hipDeviceGetAttribute(&cus, hipDeviceAttributeMultiprocessorCount, dev);
        if (hipFuncSetAttribute((const void*)fwd, hipFuncAttributeMaxDynamicSharedMemorySize, LDS_BYTES) != hipSuccess) { fprintf(stderr, "kernel_launch: hipFuncSetAttribute failed\n"); grid = -1; return; }
        if (hipOccupancyMaxActiveBlocksPerMultiprocessor(&per_cu, (const void*)fwd, 512, LDS_BYTES) != hipSuccess || per_cu < 1) { fprintf(stderr, "kernel_launch: occupancy query says %d\n", per_cu); per_cu = 1; }
        (void)hipGetLastError();
        grid = cus * 1;
        if (grid <= 0) grid = 256;
    }
    if (grid < 0) return;
    if (hipMemsetAsync((unsigned char*)d_ws + WS_CTL, 0, CTL_BYTES, stream) != hipSuccess) { fprintf(stderr, "kernel_launch: memset of barrier words failed\n"); return; }
    Params p{};
    for (int i = 0; i < 16; ++i) p.in[i] = (const float*)d_in[i];
    p.out = (float*)d_out; p.ws = (unsigned char*)d_ws;
#if MK_N_LAUNCHES == 1
    p.ph_lo = 0; p.ph_hi = NPHASE;
    void* args[] = {&p};
    hipError_t e = hipLaunchCooperativeKernel((const void*)fwd, dim3(grid), dim3(512), args, LDS_BYTES, stream);
    if (e != hipSuccess) fprintf(stderr, "kernel_launch: cooperative launch failed: %s (grid %d)\n", hipGetErrorString(e), grid);
#else
    for (int ph = 0; ph < NPHASE; ++ph) {
        p.ph_lo = ph; p.ph_hi = ph + 1;
        hipLaunchKernelGGL(fwd, dim3(grid), dim3(512), LDS_BYTES, stream, p);
    }
#endif
}
```

```cpp
#include <hip/hip_runtime.h>
#include <hip/hip_cooperative_groups.h>
#include <cstdio>
#include <cstdint>
namespace cg = cooperative_groups;
namespace pg8 {
#define PG8_LAS __attribute__((address_space(3)))
typedef unsigned short bf16_t;
typedef short bf16x8 __attribute__((ext_vector_type(8)));
typedef float f32x4 __attribute__((ext_vector_type(4)));
typedef unsigned u32x4 __attribute__((ext_vector_type(4)));
constexpr int BM = 256, BK = 64, HALF = 128, HTB = HALF * BK * 2  , STAGE_BYTES = 8 * HTB, NXCD = 8, WGM = 8;

__host__ __device__ __forceinline__ int lds_byte(int r, int c) { const int st = (r >> 4) * 2 + (c >> 5), rr = r & 15, cc = c & 31, ob = rr * 64 + cc * 2; return st * 1024 + (ob ^ (((ob >> 9) & 1) << 5)); }
__host__ __device__ __forceinline__ void stage_rc(int b, int& R, int& C) { const int st = b / 1024, sb = b % 1024, swz = sb ^ (((sb >> 9) & 1) << 5); R = (st >> 1) * 16 + swz / 64; C = (st & 1) * 32 + (swz % 64) / 2; }
__host__ __device__ __forceinline__ int perm32(int rho) { const int n = rho >> 4, i = rho & 15; return 8 * (i >> 2) + 4 * n + (i & 3); }

struct Unit { int pm, pn; };
struct Gemm { const bf16_t* A; const bf16_t* Bt; int M, N, K; };

struct StaticOrder {
    int nM, nN, nwg, G, c;
    __host__ __device__ void init(int M, int N, int G_, int c_) { nM = M / BM; nN = N / BM; nwg = nM * nN; G = G_; c = c_; }
    __host__ __device__ bool next(int i, Unit& u) const {
        const long L = (long)i * G + c; if (L >= nwg) return false;
        int wgid = (int)L; { const int q = nwg / NXCD, r = nwg % NXCD, xcd = wgid % NXCD, off = wgid / NXCD; wgid = (xcd < r ? xcd * (q + 1) : r * (q + 1) + (xcd - r) * q) + off; }
        const int nig = WGM * nN, gid = wgid / nig, fm = gid * WGM, gsz = (nM - fm) < WGM ? (nM - fm) : WGM;
        u.pm = fm + ((wgid % nig) % gsz); u.pn = (wgid % nig) / gsz; return true;
    }
    __device__ __forceinline__ void a_ready(const Unit&) const {}
    __device__ __forceinline__ void done(const Unit&) const {}
};

template <class Epi, class Sched, bool ALIGN_EPI = false, bool SP2 = false>
__device__ __forceinline__ void gemm_phase(PG8_LAS unsigned char* lds, const Gemm g, const Sched& S, const Epi& E, const int tid_in) {
    const int tid = tid_in, wid = __builtin_amdgcn_readfirstlane(tid >> 6), lane = tid & 63, wr = wid >> 2, wc = wid & 3, fr = lane & 15, fq = lane >> 4;
    const int K = g.K, nt = K / BK;
    unsigned voffA[2], voffB[2];
#pragma unroll
    for (int i = 0; i < 2; ++i) { int R, C; stage_rc(tid * 16 + i * 8192, R, C); const int Rb = Epi::PERM ? ((R & ~31) + perm32(R & 31)) : R;
        voffA[i] = (unsigned)(R * K + C) * 2u; voffB[i] = (unsigned)(Rb * K + C) * 2u; }
    const size_t kstep = (size_t)(BK * 2);
    const size_t hstep = (size_t)HALF * K * 2;
    const size_t tstep = 2 * hstep;
    const unsigned ldsw = (unsigned)wid * 1024u;
    const int aoff = lds_byte(wr * 64 + fr, fq * 8), boff = lds_byte(wc * 32 + fr, fq * 8);
#define PG8_SA(b, h) (((b) * 2 + (h)) * HTB)
#define PG8_SB(b, h) ((4 + (b) * 2 + (h)) * HTB)
#define PG8_STAGE(bufoff, gbase, voff) do { _Pragma("unroll") for (int _i = 0; _i < 2; ++_i) \
        __builtin_amdgcn_global_load_lds((const unsigned*)((const char*)(gbase) + (voff)[_i]), (PG8_LAS unsigned*)(lds + (bufoff) + ldsw + _i * 8192), 16, 0, 0); } while (0)
#define PG8_LDA(dst, b, h) do { _Pragma("unroll") for (int m = 0; m < 4; ++m) _Pragma("unroll") for (int k = 0; k < 2; ++k) dst[m][k] = *(const PG8_LAS bf16x8*)(lds + PG8_SA(b, h) + aoff + m * 2048 + k * 1024); } while (0)
#define PG8_LDB(dst, b, h) do { _Pragma("unroll") for (int n = 0; n < 2; ++n) _Pragma("unroll") for (int k = 0; k < 2; ++k) dst[n][k] = *(const PG8_LAS bf16x8*)(lds + PG8_SB(b, h) + boff + n * 2048 + k * 1024); } while (0)
#define PG8_MMA(ai, bj, At, Bt) do { __builtin_amdgcn_s_setprio(1); _Pragma("unroll") for (int m = 0; m < 4; ++m) _Pragma("unroll") for (int n = 0; n < 2; ++n) _Pragma("unroll") for (int k = 0; k < 2; ++k) \
        acc[ai][bj][m][n] = __builtin_amdgcn_mfma_f32_16x16x32_bf16(Bt[n][k], At[m][k], acc[ai][bj][m][n], 0, 0, 0); __builtin_amdgcn_s_setprio(0); } while (0)
#define PG8_WAIT_V(n) asm volatile("s_waitcnt vmcnt(" #n ")" ::: "memory")
#define PG8_WAIT_L(n) asm volatile("s_waitcnt lgkmcnt(" #n ")" ::: "memory")
#define PG8_BAR __builtin_amdgcn_s_barrier()
#define PG8_SCHED __builtin_amdgcn_sched_barrier(0)
    Unit cur, nxt; int ui = 0;
    if (!S.next(0, cur)) return;
    f32x4 acc[2][2][4][2];
#pragma unroll
    for (int a = 0; a < 2; ++a)
#pragma unroll
        for (int b = 0; b < 2; ++b)
#pragma unroll
            for (int m = 0; m < 4; ++m)
#pragma unroll
                for (int n = 0; n < 2; ++n) acc[a][b][m][n] = (f32x4){0.f, 0.f, 0.f, 0.f};
    bf16x8 At[4][2], B0[2][2], B1[2][2];
    const char* cA = (const char*)g.A + (size_t)cur.pm * tstep; const char* cB = (const char*)g.Bt + (size_t)cur.pn * tstep;
    S.a_ready(cur);
    if constexpr (SP2) {
        PG8_STAGE(PG8_SB(0, 0), cB, voffB); PG8_STAGE(PG8_SB(0, 1), cB + hstep, voffB); PG8_STAGE(PG8_SA(0, 0), cA, voffA); PG8_STAGE(PG8_SA(0, 1), cA + hstep, voffA);
        if (wr == 1) PG8_BAR;
        PG8_WAIT_V(2); PG8_BAR;
        PG8_STAGE(PG8_SB(1, 0), cB + kstep, voffB); PG8_STAGE(PG8_SA(1, 0), cA + kstep, voffA); PG8_STAGE(PG8_SB(1, 1), cB + hstep + kstep, voffB);
        PG8_WAIT_V(6); PG8_BAR;
    } else {
        PG8_STAGE(PG8_SB(0, 0), cB, voffB); PG8_STAGE(PG8_SA(0, 0), cA, voffA); PG8_STAGE(PG8_SB(0, 1), cB + hstep, voffB); PG8_STAGE(PG8_SA(0, 1), cA + hstep, voffA);
        if (wr == 1) PG8_BAR;
        PG8_WAIT_V(4); PG8_BAR;
        PG8_STAGE(PG8_SB(1, 0), cB + kstep, voffB); PG8_STAGE(PG8_SA(1, 0), cA + kstep, voffA); PG8_STAGE(PG8_SB(1, 1), cB + hstep + kstep, voffB);
        PG8_WAIT_V(6); PG8_BAR;
    }
    for (;;) {
        const bool has_next = S.next(ui + 1, nxt);
        const char* nA = has_next ? (const char*)g.A + (size_t)nxt.pm * tstep : cA; const char* nB = has_next ? (const char*)g.Bt + (size_t)nxt.pn * tstep : cB;
        for (int t = 0; t < nt; t += 2) {
            if constexpr (Epi::MID_T > 0) { if (t == Epi::MID_T) E.mid(acc, cur); }
            const bool last = (t == nt - 2);
            const char* a1 = cA + (size_t)(t + 1) * kstep;
            const char* a2 = last ? nA : cA + (size_t)(t + 2) * kstep; const char* b2 = last ? nB : cB + (size_t)(t + 2) * kstep;
            const char* a3 = a2 + kstep; const char* b3 = b2 + kstep;
            if (last && has_next) S.a_ready(nxt);
            if constexpr (SP2) {
            PG8_LDB(B0, 0, 0); PG8_LDB(B1, 0, 1); PG8_SCHED; PG8_LDA(At, 0, 0); PG8_STAGE(PG8_SA(1, 1), a1 + hstep, voffA);
            PG8_WAIT_V(8); PG8_WAIT_L(0); PG8_BAR; PG8_MMA(0, 0, At, B0); PG8_MMA(0, 1, At, B1); PG8_BAR; PG8_SCHED;
            PG8_LDA(At, 0, 1); PG8_STAGE(PG8_SB(0, 0), b2, voffB); PG8_STAGE(PG8_SB(0, 1), b2 + hstep, voffB); PG8_STAGE(PG8_SA(0, 0), a2, voffA);
            PG8_WAIT_V(8); PG8_WAIT_L(0); PG8_BAR; PG8_MMA(1, 0, At, B0); PG8_MMA(1, 1, At, B1); PG8_BAR; PG8_SCHED;
            PG8_LDB(B0, 1, 0); PG8_LDB(B1, 1, 1); PG8_SCHED; PG8_LDA(At, 1, 0); PG8_STAGE(PG8_SA(0, 1), a2 + hstep, voffA);
            PG8_WAIT_V(8); PG8_WAIT_L(0); PG8_BAR; PG8_MMA(0, 0, At, B0); PG8_MMA(0, 1, At, B1); PG8_BAR; PG8_SCHED;
            PG8_LDA(At, 1, 1); PG8_STAGE(PG8_SB(1, 0), b3, voffB); PG8_STAGE(PG8_SB(1, 1), b3 + hstep, voffB); PG8_STAGE(PG8_SA(1, 0), a3, voffA);
            PG8_WAIT_V(8); PG8_WAIT_L(0); PG8_BAR; PG8_MMA(1, 0, At, B0); PG8_MMA(1, 1, At, B1); PG8_BAR; PG8_SCHED;
            } else {
            PG8_LDB(B0, 0, 0); PG8_SCHED; PG8_LDA(At, 0, 0); PG8_STAGE(PG8_SA(1, 1), a1 + hstep, voffA);
            PG8_WAIT_L(8); PG8_BAR; PG8_WAIT_L(0); PG8_MMA(0, 0, At, B0); PG8_BAR; PG8_SCHED;
            PG8_LDB(B1, 0, 1); PG8_STAGE(PG8_SB(0, 0), b2, voffB);
            PG8_BAR; PG8_WAIT_L(0); PG8_MMA(0, 1, At, B1); PG8_BAR;
            PG8_LDA(At, 0, 1); PG8_STAGE(PG8_SA(0, 0), a2, voffA);
            PG8_BAR; PG8_WAIT_L(0); PG8_MMA(1, 0, At, B0); PG8_BAR; PG8_SCHED;
            PG8_STAGE(PG8_SB(0, 1), b2 + hstep, voffB);
            PG8_WAIT_V(6); PG8_BAR; PG8_MMA(1, 1, At, B1); PG8_BAR;
            PG8_LDB(B0, 1, 0); PG8_SCHED; PG8_LDA(At, 1, 0); PG8_STAGE(PG8_SA(0, 1), a2 + hstep, voffA);
            PG8_WAIT_L(8); PG8_BAR; PG8_WAIT_L(0); PG8_MMA(0, 0, At, B0); PG8_BAR; PG8_SCHED;
            PG8_LDB(B1, 1, 1); PG8_STAGE(PG8_SB(1, 0), b3, voffB);
            PG8_BAR; PG8_WAIT_L(0); PG8_MMA(0, 1, At, B1); PG8_BAR;
            PG8_LDA(At, 1, 1); PG8_STAGE(PG8_SA(1, 0), a3, voffA);
            PG8_BAR; PG8_WAIT_L(0); PG8_MMA(1, 0, At, B0); PG8_BAR; PG8_SCHED;
            PG8_STAGE(PG8_SB(1, 1), b3 + hstep, voffB);
            PG8_WAIT_V(6); PG8_BAR; PG8_MMA(1, 1, At, B1); PG8_BAR;
            }
        }
        if constexpr (ALIGN_EPI) { if (wr == 0) PG8_BAR; }
        if constexpr (!Epi::AFTER_DRAIN) { E(acc, cur, wr, wc, fr, fq); S.done(cur); }
        if (!has_next) break;
#pragma unroll
        for (int a = 0; a < 2; ++a)
#pragma unroll
            for (int b = 0; b < 2; ++b)
#pragma unroll
                for (int m = 0; m < 4; ++m)
#pragma unroll
                    for (int n = 0; n < 2; ++n) acc[a][b][m][n] = (f32x4){0.f, 0.f, 0.f, 0.f};
        cur = nxt; cA = nA; cB = nB; ++ui;
        if constexpr (ALIGN_EPI) { if (wr == 1) PG8_BAR; }
    }
    PG8_WAIT_V(0);
    if constexpr (!ALIGN_EPI) { if (wr == 0) PG8_BAR; }
    PG8_BAR;
    if constexpr (Epi::AFTER_DRAIN) { E.fused(acc, cur, wr, wc, fr, fq, lds, wid, lane); S.done(cur); }
#undef PG8_SA
#undef PG8_SB
#undef PG8_STAGE
#undef PG8_LDA
#undef PG8_LDB
#undef PG8_MMA
#undef PG8_WAIT_V
#undef PG8_WAIT_L
#undef PG8_BAR
#undef PG8_SCHED
}
}

#define LAS __attribute__((address_space(3)))
typedef unsigned short bf16_t;
typedef short bf16x8 __attribute__((ext_vector_type(8)));
typedef float f32x4 __attribute__((ext_vector_type(4)));
typedef float f32x2 __attribute__((ext_vector_type(2)));
typedef float f32x16 __attribute__((ext_vector_type(16)));
typedef unsigned u32x4 __attribute__((ext_vector_type(4)));
typedef unsigned u32x2 __attribute__((ext_vector_type(2)));
typedef __bf16 bf16x2_t __attribute__((ext_vector_type(2)));

constexpr int NB = 8, SEQ = 2048, DM = 1024, MT = NB * SEQ, DIN = 3584, NH = 8, HD = 64, CWID = 31, PLE = 256, CD = 512;
constexpr float EPS = 1e-6f;
constexpr float QSCALE = 0.125f * 1.4426950408889634f;

constexpr size_t MiB = 1u << 20;
constexpr size_t W_IN = 0, W_PW = 7340032, W_OUT = W_PW + 524288, W_PG = W_OUT + 2097152, W_PLE = W_PG + 2097152, W_LAYER = 12 * MiB;
static_assert(W_PLE + 524288 == W_LAYER, "weight map");
constexpr int UP = 2560, UQ = 0, UK = 512, USGA = 1024, UGLU = 1536, USGC = 2048;
constexpr size_t WS_PB = 24 * MiB, WS_HB = 40 * MiB, WS_Y = 72 * MiB, WS_VT = 104 * MiB, WS_SSA = 120 * MiB, WS_SSB = 121 * MiB, WS_SSC = 122 * MiB, WS_U = 123 * MiB;
constexpr size_t WS_H1B = WS_U  , WS_C2 = 203 * MiB, WS_EB = 219 * MiB, WS_CTL = 252 * MiB, CTL_BYTES = 16384, WS_END = WS_CTL + CTL_BYTES;
static_assert(WS_U + (size_t)MT * UP * 2 <= WS_C2, "ws map");
constexpr int LDS_BYTES = 147456;
constexpr int NPHASE = 12;
#ifndef PROBE_DUP
#define PROBE_DUP 0
#endif

__device__ __forceinline__ unsigned pk2(float lo, float hi) { f32x2 v = {lo, hi}; bf16x2_t b = __builtin_convertvector(v, bf16x2_t); return __builtin_bit_cast(unsigned, b); }
__device__ __forceinline__ float bflo(unsigned u) { return __builtin_bit_cast(float, u << 16); }
__device__ __forceinline__ float bfhi(unsigned u) { return __builtin_bit_cast(float, u & 0xffff0000u); }
__device__ __forceinline__ float fexp2(float x) { return __builtin_amdgcn_exp2f(x); }
__device__ __forceinline__ float flog2(float x) { return __builtin_amdgcn_logf(x); }
__device__ __forceinline__ float frcp(float x) { return __builtin_amdgcn_rcpf(x); }
__device__ __forceinline__ float frsq(float x) { return __builtin_amdgcn_rsqf(x); }
__device__ __forceinline__ float sigmoidf_(float x) { return frcp(1.0f + fexp2(-1.4426950408889634f * x)); }
__device__ __forceinline__ float siluf_(float x) { return x * sigmoidf_(x); }
#define MFMA32(a, b, c) __builtin_amdgcn_mfma_f32_32x32x16_bf16((a), (b), (c), 0, 0, 0)

__device__ __forceinline__ float shx(float v, int m, int lane) { return __builtin_bit_cast(float, __builtin_amdgcn_ds_bpermute((lane ^ m) << 2, __builtin_bit_cast(int, v))); }
__device__ __forceinline__ float wave_sum(float v, int lane) {
#pragma unroll
    for (int o = 1; o < 64; o <<= 1) v += shx(v, o, lane);
    return v;
}
__device__ __forceinline__ float row_rstd(const float* ss, int row, int fq, int lane) {
    const f32x4 p = *(const f32x4*)(ss + (size_t)row * 16 + fq * 4);
    float s = (p[0] + p[1]) + (p[2] + p[3]);
    s += shx(s, 16, lane); s += shx(s, 32, lane);
    return frsq(s * (1.0f / DM) + EPS);
}

struct EpiIn {
    static constexpr bool PERM = true, AFTER_DRAIN = false; static constexpr int MID_T = 0;
    bf16_t* U; bf16_t* VT; const float* ss;
    __device__ __forceinline__ void operator()(const f32x4 (&acc)[2][2][4][2], const pg8::Unit& u, int, int, int, int) const {
        int t_ = threadIdx.x; asm volatile("" : "+v"(t_));
        const int lane = t_ & 63, fr = lane & 15, fq = lane >> 4, wid_ = __builtin_amdgcn_readfirstlane(t_ >> 6), wr = wid_ >> 2, wc = wid_ & 3;
        const int pn = u.pn;
        f32x4 pp[2][4];
#pragma unroll
        for (int ai = 0; ai < 2; ++ai)
#pragma unroll
            for (int m = 0; m < 4; ++m) pp[ai][m] = *(const f32x4*)(ss + (size_t)(u.pm * 256 + ai * 128 + wr * 64 + m * 16 + fr) * 16 + fq * 4);
#pragma unroll
        for (int ai = 0; ai < 2; ++ai)
#pragma unroll
            for (int m = 0; m < 4; ++m) {
                const int row = u.pm * 256 + ai * 128 + wr * 64 + m * 16 + fr;
                float s_ = (pp[ai][m][0] + pp[ai][m][1]) + (pp[ai][m][2] + pp[ai][m][3]);
                s_ += shx(s_, 16, lane); s_ += shx(s_, 32, lane);
                const float rs = frsq(s_ * (1.0f / DM) + EPS);
#pragma unroll
                for (int bj = 0; bj < 2; ++bj) {
                    const int col0 = pn * 256 + bj * 128 + wc * 32 + 8 * fq;
                    f32x4 v0 = acc[ai][bj][m][0] * rs, v1 = acc[ai][bj][m][1] * rs;
                    if (pn < 4) {
                        const float sc = pn < 2 ? QSCALE : 1.0f;
                        v0 = v0 * sc; v1 = v1 * sc;
                        u32x4 w; w[0] = pk2(v0[0], v0[1]); w[1] = pk2(v0[2], v0[3]); w[2] = pk2(v1[0], v1[1]); w[3] = pk2(v1[2], v1[3]);
                        *(u32x4*)(U + (size_t)row * UP + col0) = w;
                    } else if (pn < 6) {
                        const int vc = col0 - 1024, hh = vc >> 6, d0 = vc & 63, b = row >> 11, s = row & 2047;
                        bf16_t* vp = VT + ((size_t)((b * NH + hh) * HD + d0)) * SEQ + s;
                        const unsigned w0 = pk2(v0[0], v0[1]), w1 = pk2(v0[2], v0[3]), w2 = pk2(v1[0], v1[1]), w3 = pk2(v1[2], v1[3]);
                        vp[0 * SEQ] = (bf16_t)(w0 & 0xffffu); vp[1 * SEQ] = (bf16_t)(w0 >> 16);
                        vp[2 * SEQ] = (bf16_t)(w1 & 0xffffu); vp[3 * SEQ] = (bf16_t)(w1 >> 16);
                        vp[4 * SEQ] = (bf16_t)(w2 & 0xffffu); vp[5 * SEQ] = (bf16_t)(w2 >> 16);
                        vp[6 * SEQ] = (bf16_t)(w3 & 0xffffu); vp[7 * SEQ] = (bf16_t)(w3 >> 16);
                    } else if (pn < 8 || pn >= 12) {
                        u32x4 w; w[0] = pk2(siluf_(v0[0]), siluf_(v0[1])); w[1] = pk2(siluf_(v0[2]), siluf_(v0[3]));
                        w[2] = pk2(siluf_(v1[0]), siluf_(v1[1])); w[3] = pk2(siluf_(v1[2]), siluf_(v1[3]));
                        *(u32x4*)(U + (size_t)row * UP + (pn < 8 ? col0 - 512 : col0 - 1024)) = w;
                    } else {
                        const int ch0 = (col0 - 2048) >> 1;
                        u32x2 w; w[0] = pk2(v0[0] * sigmoidf_(v0[1]), v0[2] * sigmoidf_(v0[3])); w[1] = pk2(v1[0] * sigmoidf_(v1[1]), v1[2] * sigmoidf_(v1[3]));
                        *(u32x2*)(U + (size_t)row * UP + UGLU + ch0) = w;
                    }
                }
                asm volatile("" ::: "memory");
            }
    }
};

struct EpiPw {
    static constexpr bool PERM = true, AFTER_DRAIN = false; static constexpr int MID_T = 0;
    const bf16_t* U; bf16_t* Y; const float* cog; float* ssC;
    __device__ __forceinline__ void operator()(const f32x4 (&acc)[2][2][4][2], const pg8::Unit& u, int, int, int, int) const {
        int t_ = threadIdx.x; asm volatile("" : "+v"(t_));
        const int lane = t_ & 63, fr = lane & 15, fq = lane >> 4, wid_ = __builtin_amdgcn_readfirstlane(t_ >> 6), wr = wid_ >> 2, wc = wid_ & 3;
#pragma unroll
        for (int ai = 0; ai < 2; ++ai)
#pragma unroll
            for (int m = 0; m < 4; ++m) {
                const int row = u.pm * 256 + ai * 128 + wr * 64 + m * 16 + fr;
                float sq = 0.f;
#pragma unroll
                for (int bj = 0; bj < 2; ++bj) {
                    const int col0 = u.pn * 256 + bj * 128 + wc * 32 + 8 * fq;
                    const f32x4 v0 = acc[ai][bj][m][0], v1 = acc[ai][bj][m][1];
                    sq += (v0[0] * v0[0] + v0[1] * v0[1]) + (v0[2] * v0[2] + v0[3] * v0[3]) + (v1[0] * v1[0] + v1[1] * v1[1]) + (v1[2] * v1[2] + v1[3] * v1[3]);
                    const f32x4 g0 = *(const f32x4*)(cog + col0), g1 = *(const f32x4*)(cog + col0 + 4);
                    const u32x4 sg = *(const u32x4*)(U + (size_t)row * UP + USGC + col0);
                    u32x4 w;
                    w[0] = pk2(v0[0] * g0[0] * bflo(sg[0]), v0[1] * g0[1] * bfhi(sg[0])); w[1] = pk2(v0[2] * g0[2] * bflo(sg[1]), v0[3] * g0[3] * bfhi(sg[1]));
                    w[2] = pk2(v1[0] * g1[0] * bflo(sg[2]), v1[1] * g1[1] * bfhi(sg[2])); w[3] = pk2(v1[2] * g1[2] * bflo(sg[3]), v1[3] * g1[3] * bfhi(sg[3]));
                    *(u32x4*)(Y + (size_t)row * DM + col0) = w;
                }
                sq += shx(sq, 16, lane); sq += shx(sq, 32, lane);
                if (fq == 0) ssC[(size_t)row * 8 + u.pn * 4 + wc] = sq;
                asm volatile("" ::: "memory");
            }
    }
};

struct EpiE {
    static constexpr bool PERM = true, AFTER_DRAIN = false; static constexpr int MID_T = 0;
    bf16_t* EB;
    __device__ __forceinline__ void operator()(const f32x4 (&acc)[2][2][4][2], const pg8::Unit& u, int, int, int, int) const {
        int t_ = threadIdx.x; asm volatile("" : "+v"(t_));
        const int lane = t_ & 63, fr = lane & 15, fq = lane >> 4, wid_ = __builtin_amdgcn_readfirstlane(t_ >> 6), wr = wid_ >> 2, wc = wid_ & 3;
#pragma unroll
        for (int ai = 0; ai < 2; ++ai)
#pragma unroll
            for (int m = 0; m < 4; ++m) {
                const int row = u.pm * 256 + ai * 128 + wr * 64 + m * 16 + fr;
#pragma unroll
                for (int bj = 0; bj < 2; ++bj) {
                    const int col0 = u.pn * 256 + bj * 128 + wc * 32 + 8 * fq;
                    const f32x4 v0 = acc[ai][bj][m][0], v1 = acc[ai][bj][m][1];
                    u32x4 w; w[0] = pk2(v0[0], v0[1]); w[1] = pk2(v0[2], v0[3]); w[2] = pk2(v1[0], v1[1]); w[3] = pk2(v1[2], v1[3]);
                    *(u32x4*)(EB + (size_t)row * DM + col0) = w;
                }
                asm volatile("" ::: "memory");
            }
    }
};

struct EpiOut {
    static constexpr bool PERM = true, AFTER_DRAIN = false; static constexpr int MID_T = 8;
    const float* base; float* out; bf16_t* HB; float* ss; const float* ssC;
    __device__ __forceinline__ void mid(f32x4 (&acc)[2][2][4][2], const pg8::Unit& u) const {
        int t_ = threadIdx.x; asm volatile("" : "+v"(t_));
        const int lane = t_ & 63, fr = lane & 15, fq = lane >> 4, wid_ = __builtin_amdgcn_readfirstlane(t_ >> 6), wr = wid_ >> 2;
        f32x2 pc[2][4];
#pragma unroll
        for (int ai = 0; ai < 2; ++ai)
#pragma unroll
            for (int m = 0; m < 4; ++m) pc[ai][m] = *(const f32x2*)(ssC + (size_t)(u.pm * 256 + ai * 128 + wr * 64 + m * 16 + fr) * 8 + fq * 2);
#pragma unroll
        for (int ai = 0; ai < 2; ++ai)
#pragma unroll
            for (int m = 0; m < 4; ++m) {
                const f32x2 p = pc[ai][m];
                float s = p[0] + p[1];
                s += shx(s, 16, lane); s += shx(s, 32, lane);
                const float rs = frsq(s * (1.0f / CD) + EPS);
#pragma unroll
                for (int bj = 0; bj < 2; ++bj)
#pragma unroll
                    for (int n = 0; n < 2; ++n) acc[ai][bj][m][n] = acc[ai][bj][m][n] * rs;
            }
    }
    __device__ __forceinline__ void operator()(const f32x4 (&acc)[2][2][4][2], const pg8::Unit& u, int, int, int, int) const {
        int t_ = threadIdx.x; asm volatile("" : "+v"(t_));
        const int lane = t_ & 63, fr = lane & 15, fq = lane >> 4, wid_ = __builtin_amdgcn_readfirstlane(t_ >> 6), wr = wid_ >> 2, wc = wid_ & 3;
#pragma unroll
        for (int ai = 0; ai < 2; ++ai)
#pragma unroll
            for (int mp = 0; mp < 2; ++mp) {
                f32x4 bs[2][2][2];
#pragma unroll
                for (int mm = 0; mm < 2; ++mm)
#pragma unroll
                    for (int bj = 0; bj < 2; ++bj) {
                        const size_t off = (size_t)(u.pm * 256 + ai * 128 + wr * 64 + (2 * mp + mm) * 16 + fr) * DM + u.pn * 256 + bj * 128 + wc * 32 + 8 * fq;
                        bs[mm][bj][0] = *(const f32x4*)(base + off); bs[mm][bj][1] = *(const f32x4*)(base + off + 4);
                    }
#pragma unroll
                for (int mm = 0; mm < 2; ++mm) {
                    const int m = 2 * mp + mm;
                    const int row = u.pm * 256 + ai * 128 + wr * 64 + m * 16 + fr;
                    float sq = 0.f;
#pragma unroll
                    for (int bj = 0; bj < 2; ++bj) {
                        const size_t off = (size_t)row * DM + u.pn * 256 + bj * 128 + wc * 32 + 8 * fq;
                        const f32x4 h0 = bs[mm][bj][0] + acc[ai][bj][m][0], h1 = bs[mm][bj][1] + acc[ai][bj][m][1];
                        *(f32x4*)(out + off) = h0; *(f32x4*)(out + off + 4) = h1;
                        u32x4 w; w[0] = pk2(h0[0], h0[1]); w[1] = pk2(h0[2], h0[3]); w[2] = pk2(h1[0], h1[1]); w[3] = pk2(h1[2], h1[3]);
                        *(u32x4*)(HB + off) = w;
                        sq += (h0[0] * h0[0] + h0[1] * h0[1]) + (h0[2] * h0[2] + h0[3] * h0[3]) + (h1[0] * h1[0] + h1[1] * h1[1]) + (h1[2] * h1[2] + h1[3] * h1[3]);
                    }
                    sq += shx(sq, 16, lane); sq += shx(sq, 32, lane);
                    if (fq == 0) ss[(size_t)row * 16 + u.pn * 4 + wc] = sq;
                }
                asm volatile("" ::: "memory");
            }
    }
};

struct EpiGate {
    static constexpr bool PERM = true, AFTER_DRAIN = false; static constexpr int MID_T = 0;
    float* out; const bf16_t* EB; bf16_t* HB; const float* ss_in; float* ss_out;
    __device__ __forceinline__ void operator()(const f32x4 (&acc)[2][2][4][2], const pg8::Unit& u, int, int, int, int) const {
        int t_ = threadIdx.x; asm volatile("" : "+v"(t_));
        const int lane = t_ & 63, fr = lane & 15, fq = lane >> 4, wid_ = __builtin_amdgcn_readfirstlane(t_ >> 6), wr = wid_ >> 2, wc = wid_ & 3;
        f32x4 pp[2][4];
#pragma unroll
        for (int ai = 0; ai < 2; ++ai)
#pragma unroll
            for (int m = 0; m < 4; ++m) pp[ai][m] = *(const f32x4*)(ss_in + (size_t)(u.pm * 256 + ai * 128 + wr * 64 + m * 16 + fr) * 16 + fq * 4);
        float rsv[2][4];
#pragma unroll
        for (int ai = 0; ai < 2; ++ai)
#pragma unroll
            for (int m = 0; m < 4; ++m) {
                float s_ = (pp[ai][m][0] + pp[ai][m][1]) + (pp[ai][m][2] + pp[ai][m][3]);
                s_ += shx(s_, 16, lane); s_ += shx(s_, 32, lane);
                rsv[ai][m] = frsq(s_ * (1.0f / DM) + EPS);
            }
        asm volatile("" ::: "memory");
#pragma unroll
        for (int ai = 0; ai < 2; ++ai)
#pragma unroll
            for (int mp = 0; mp < 2; ++mp) {
                f32x4 bs[2][2][2];
#pragma unroll
                for (int mm = 0; mm < 2; ++mm)
#pragma unroll
                    for (int bj = 0; bj < 2; ++bj) {
                        const size_t off = (size_t)(u.pm * 256 + ai * 128 + wr * 64 + (2 * mp + mm) * 16 + fr) * DM + u.pn * 256 + bj * 128 + wc * 32 + 8 * fq;
                        bs[mm][bj][0] = *(const f32x4*)(out + off); bs[mm][bj][1] = *(const f32x4*)(out + off + 4);
                    }
#pragma unroll
                for (int mm = 0; mm < 2; ++mm) {
                    const int m = 2 * mp + mm;
                    const int row = u.pm * 256 + ai * 128 + wr * 64 + m * 16 + fr;
                    const float rs = rsv[ai][m];
                    float sq = 0.f;
#pragma unroll
                    for (int bj = 0; bj < 2; ++bj) {
                        const size_t off = (size_t)row * DM + u.pn * 256 + bj * 128 + wc * 32 + 8 * fq;
                        const f32x4 a0 = acc[ai][bj][m][0] * rs, a1 = acc[ai][bj][m][1] * rs;
                        const u32x4 e = *(const u32x4*)(EB + off);
                        f32x4 h0 = bs[mm][bj][0], h1 = bs[mm][bj][1];
                        h0[0] += bflo(e[0]) * sigmoidf_(a0[0]); h0[1] += bfhi(e[0]) * sigmoidf_(a0[1]); h0[2] += bflo(e[1]) * sigmoidf_(a0[2]); h0[3] += bfhi(e[1]) * sigmoidf_(a0[3]);
                        h1[0] += bflo(e[2]) * sigmoidf_(a1[0]); h1[1] += bfhi(e[2]) * sigmoidf_(a1[1]); h1[2] += bflo(e[3]) * sigmoidf_(a1[2]); h1[3] += bfhi(e[3]) * sigmoidf_(a1[3]);
                        *(f32x4*)(out + off) = h0; *(f32x4*)(out + off + 4) = h1;
                        u32x4 w; w[0] = pk2(h0[0], h0[1]); w[1] = pk2(h0[2], h0[3]); w[2] = pk2(h1[0], h1[1]); w[3] = pk2(h1[2], h1[3]);
                        *(u32x4*)(HB + off) = w;
                        sq += (h0[0] * h0[0] + h0[1] * h0[1]) + (h0[2] * h0[2] + h0[3] * h0[3]) + (h1[0] * h1[0] + h1[1] * h1[1]) + (h1[2] * h1[2] + h1[3] * h1[3]);
                    }
                    sq += shx(sq, 16, lane); sq += shx(sq, 32, lane);
                    if (fq == 0) ss_out[(size_t)row * 16 + u.pn * 4 + wc] = sq;
                }
                asm volatile("" ::: "memory");
            }
    }
};

struct SubOrder {
    int nN, nwg, nb, c;
    __device__ void init(int M, int N, int nb_, int c_) { nN = N / 256; nwg = (M / 256) * nN; nb = nb_; c = c_; }
    __device__ bool next(int i, pg8::Unit& u) const { if (c < 0 || c >= nb) return false; const int L = i * nb + c; if (L >= nwg) return false; u.pm = L / nN; u.pn = L % nN; return true; }
    __device__ __forceinline__ void a_ready(const pg8::Unit&) const {}
    __device__ __forceinline__ void done(const pg8::Unit&) const {}
};

template <bool REMAP>
__device__ __forceinline__ void tr_item(const float* W, int K, int N, bf16_t* WT, const float* g, LAS float* scr, int item, int lane, int kshift = 0) {
    const int nblk = N / 32, kb = item / nblk, nb = item % nblk, k0 = 64 * kb, n0 = 32 * nb;
    int src = n0 + (lane & 31);
    if (REMAP) { if (src >= 2048 && src < 3072) { const int jj = src - 2048; src = (jj & 1) ? 2560 + (jj >> 1) : 2048 + (jj >> 1); } }
    float wv[32];
#pragma unroll
    for (int i = 0; i < 32; ++i) { const int kk = 2 * i + (lane >> 5); wv[i] = W[(size_t)((k0 + kk + kshift) & (K - 1)) * N + src]; }
#pragma unroll
    for (int i = 0; i < 32; ++i) { const int kk = 2 * i + (lane >> 5); float v = wv[i]; if (g) v *= g[k0 + kk]; scr[kk * 33 + (lane & 31)] = v; }
    asm volatile("s_waitcnt lgkmcnt(0)" ::: "memory");
    const int c = lane & 7;
#pragma unroll
    for (int j = 0; j < 4; ++j) { const int n = (lane >> 3) + 8 * j; const LAS float* s = scr + (8 * c) * 33 + n;
        u32x4 o; o[0] = pk2(s[0 * 33], s[1 * 33]); o[1] = pk2(s[2 * 33], s[3 * 33]); o[2] = pk2(s[4 * 33], s[5 * 33]); o[3] = pk2(s[6 * 33], s[7 * 33]);
        *(u32x4*)(WT + (size_t)(n0 + n) * K + k0 + 8 * c) = o; }
    asm volatile("s_waitcnt lgkmcnt(0)" ::: "memory");
}

constexpr int AK_STRIDE = 144, AV_STRIDE = 136, A_KBYTES = 64 * AK_STRIDE, A_VBYTES = 64 * AV_STRIDE, A_BUF = 18432;
static_assert(A_KBYTES + A_VBYTES <= A_BUF, "attention LDS buffer");

__device__ __forceinline__ void attn_unit(const bf16_t* U, const bf16_t* VT, bf16_t* Y, const float* aog, int b, int h, int qb, LAS unsigned char* lds) {
    int tid = threadIdx.x; asm volatile("" : "+v"(tid));
    const int wave = __builtin_amdgcn_readfirstlane(tid >> 6), lane = tid & 63, l31 = lane & 31, hi = lane >> 5;
    const int q0 = qb * 256 + wave * 32, t = q0 + l31;
    const size_t trow = (size_t)(b * SEQ + t);
    bf16x8 qf[4];
    {
        const bf16_t* qp = U + trow * UP + UQ + h * HD + 8 * hi;
#pragma unroll
        for (int s = 0; s < 4; ++s) qf[s] = *(const bf16x8*)(qp + 16 * s);
    }
    f32x16 o0, o1;
#pragma unroll
    for (int i = 0; i < 16; ++i) { o0[i] = 0.f; o1[i] = 0.f; }
    float C = 1.f;
    const int ktmax = 4 * qb + 3, wkt = (q0 + 30) >> 6;
    const int srow = tid >> 3, sch = tid & 7;
    const bf16_t* gk = U + (size_t)(b * SEQ + srow) * UP + UK + h * HD + sch * 8;
    const bf16_t* gv = VT + ((size_t)((b * NH + h) * HD + srow)) * SEQ + sch * 8;
    const int kwoff = srow * AK_STRIDE + sch * 16, vwoff = A_KBYTES + srow * AV_STRIDE + sch * 16;
    __syncthreads();
    {
        const u32x4 kr = *(const u32x4*)(gk + (size_t)ktmax * 64 * UP), vr = *(const u32x4*)(gv + ktmax * 64);
        *(LAS u32x4*)(lds + kwoff) = kr;
        u32x2 a = {vr[0], vr[1]}, c = {vr[2], vr[3]};
        *(LAS u32x2*)(lds + vwoff) = a; *(LAS u32x2*)(lds + vwoff + 8) = c;
    }
    __syncthreads();
    int cur = 0;
    LAS unsigned* dflag = (LAS unsigned*)(lds + 2 * A_BUF);
    bool wdone = false;
    for (int kt = ktmax; kt >= 0; --kt) {
        u32x4 kr = {0u, 0u, 0u, 0u}, vr = {0u, 0u, 0u, 0u};
        if (kt > 0) { kr = *(const u32x4*)(gk + (size_t)(kt - 1) * 64 * UP); vr = *(const u32x4*)(gv + (kt - 1) * 64); }
        if (kt <= wkt && !wdone) {
            const LAS unsigned char* kb = lds + cur * A_BUF;
            const LAS unsigned char* vb = kb + A_KBYTES;
            f32x16 p0, p1;
#pragma unroll
            for (int i = 0; i < 16; ++i) { p0[i] = 0.f; p1[i] = 0.f; }
#pragma unroll
            for (int s = 0; s < 4; ++s) {
                const bf16x8 ka = *(const LAS bf16x8*)(kb + l31 * AK_STRIDE + 32 * s + 16 * hi);
                const bf16x8 kc = *(const LAS bf16x8*)(kb + (32 + l31) * AK_STRIDE + 32 * s + 16 * hi);
                p0 = MFMA32(ka, qf[s], p0); p1 = MFMA32(kc, qf[s], p1);
            }
            const int lim0 = t - (64 * kt + 4 * hi), lim1 = lim0 - 32;
            const bool diag = (64 * kt + 63 >= q0);
            f32x16 m0, m1;
            float G0[4], G1[4];
#pragma unroll
            for (int g = 0; g < 4; ++g) {
                float s0 = 1.f, s1 = 1.f;
#pragma unroll
                for (int i = 0; i < 4; ++i) {
                    const int r = 4 * g + i, cr = i + 8 * g;
                    const float e0 = fexp2(fminf(p0[r], 100.f)), e1 = fexp2(fminf(p1[r], 100.f));
                    float r0 = frcp(1.0f + e0), r1 = frcp(1.0f + e1);
                    float b0 = e0 * r0, b1 = e1 * r1;
                    if (diag) { const bool v0 = cr < lim0, v1 = cr < lim1; r0 = v0 ? r0 : 1.f; b0 = v0 ? b0 : 0.f; r1 = v1 ? r1 : 1.f; b1 = v1 ? b1 : 0.f; }
                    m0[r] = r0; m1[r] = r1; p0[r] = b0; p1[r] = b1; s0 *= r0; s1 *= r1;
                }
                G0[g] = s0; G1[g] = s1;
            }
            float X0[4], X1[4];
#pragma unroll
            for (int g = 0; g < 4; ++g) { X0[g] = shx(G0[g], 32, lane); X1[g] = shx(G1[g], 32, lane); }
            float run = C;
#pragma unroll
            for (int g = 3; g >= 0; --g) {
                float a = hi == 0 ? run * X1[g] : run;
#pragma unroll
                for (int i = 3; i >= 0; --i) { const int r = 4 * g + i; const float w = a * p1[r]; a *= m1[r]; p1[r] = w; }
                run *= G1[g] * X1[g];
            }
#pragma unroll
            for (int g = 3; g >= 0; --g) {
                float a = hi == 0 ? run * X0[g] : run;
#pragma unroll
                for (int i = 3; i >= 0; --i) { const int r = 4 * g + i; const float w = a * p0[r]; a *= m0[r]; p0[r] = w; }
                run *= G0[g] * X0[g];
            }
            C = run;
#pragma unroll
            for (int kh = 0; kh < 2; ++kh)
#pragma unroll
                for (int sh = 0; sh < 2; ++sh) {
                    u32x4 xw;
                    if (kh == 0) { xw[0] = pk2(p0[8 * sh + 0], p0[8 * sh + 1]); xw[1] = pk2(p0[8 * sh + 2], p0[8 * sh + 3]); xw[2] = pk2(p0[8 * sh + 4], p0[8 * sh + 5]); xw[3] = pk2(p0[8 * sh + 6], p0[8 * sh + 7]); }
                    else         { xw[0] = pk2(p1[8 * sh + 0], p1[8 * sh + 1]); xw[1] = pk2(p1[8 * sh + 2], p1[8 * sh + 3]); xw[2] = pk2(p1[8 * sh + 4], p1[8 * sh + 5]); xw[3] = pk2(p1[8 * sh + 6], p1[8 * sh + 7]); }
                    const bf16x8 xf = __builtin_bit_cast(bf16x8, xw);
                    const int koff = 2 * (32 * kh + 16 * sh + 4 * hi);
                    {
                        const LAS unsigned char* vp = vb + l31 * AV_STRIDE + koff;
                        const u32x2 lo = *(const LAS u32x2*)vp, hh = *(const LAS u32x2*)(vp + 16);
                        u32x4 vw = {lo[0], lo[1], hh[0], hh[1]};
                        o0 = MFMA32(__builtin_bit_cast(bf16x8, vw), xf, o0);
                    }
                    {
                        const LAS unsigned char* vp = vb + (32 + l31) * AV_STRIDE + koff;
                        const u32x2 lo = *(const LAS u32x2*)vp, hh = *(const LAS u32x2*)(vp + 16);
                        u32x4 vw = {lo[0], lo[1], hh[0], hh[1]};
                        o1 = MFMA32(__builtin_bit_cast(bf16x8, vw), xf, o1);
                    }
                }
        }
        wdone = (__builtin_amdgcn_ballot_w64(C > 7.5e-37f) == 0ull);
        if (lane == 0) dflag[(kt & 1) * 8 + wave] = wdone ? 1u : 0u;
        if (kt > 0) {
            LAS unsigned char* nb = lds + (cur ^ 1) * A_BUF;
            *(LAS u32x4*)(nb + kwoff) = kr;
            u32x2 a = {vr[0], vr[1]}, c = {vr[2], vr[3]};
            *(LAS u32x2*)(nb + vwoff) = a; *(LAS u32x2*)(nb + vwoff + 8) = c;
        }
        __syncthreads();
        cur ^= 1;
        {
            const LAS u32x4* df = (const LAS u32x4*)(dflag + (kt & 1) * 8);
            const u32x4 f0 = df[0], f1 = df[1];
            if ((f0[0] & f0[1] & f0[2] & f0[3] & f1[0] & f1[1] & f1[2] & f1[3]) != 0u) break;
        }
    }
    float sq = 0.f;
#pragma unroll
    for (int i = 0; i < 16; ++i) sq += o0[i] * o0[i] + o1[i] * o1[i];
    sq += shx(sq, 32, lane);
    const float rs = frsq(sq * (1.0f / HD) + EPS);
    const bf16_t* sgp = U + trow * UP + USGA + h * HD;
    bf16_t* yp = Y + trow * DM + 512 + h * HD;
#pragma unroll
    for (int dt = 0; dt < 2; ++dt)
#pragma unroll
        for (int g = 0; g < 4; ++g) {
            const int d0 = 32 * dt + 8 * g + 4 * hi;
            const f32x4 gn = *(const f32x4*)(aog + d0);
            const u32x2 sg = *(const u32x2*)(sgp + d0);
            float v0, v1, v2, v3;
            if (dt == 0) { v0 = o0[4 * g + 0]; v1 = o0[4 * g + 1]; v2 = o0[4 * g + 2]; v3 = o0[4 * g + 3]; }
            else         { v0 = o1[4 * g + 0]; v1 = o1[4 * g + 1]; v2 = o1[4 * g + 2]; v3 = o1[4 * g + 3]; }
            u32x2 w;
            w[0] = pk2(v0 * rs * gn[0] * bflo(sg[0]), v1 * rs * gn[1] * bfhi(sg[0]));
            w[1] = pk2(v2 * rs * gn[2] * bflo(sg[1]), v3 * rs * gn[3] * bfhi(sg[1]));
            *(u32x2*)(yp + d0) = w;
        }
}

constexpr int CT = 32, C_XH = 0, C_XH_BYTES = (CT + 30) * 1024, C_CO = C_XH_BYTES, C_CO_BYTES = CT * CD * 4;
static_assert(C_CO + C_CO_BYTES <= LDS_BYTES, "conv LDS map");

__device__ __forceinline__ void convpre_unit(const bf16_t* U, bf16_t* C2, const float* dww, const float* dwb, const float* lng, const float* lnb, int cu, LAS unsigned char* lds) {
    int tid = threadIdx.x; asm volatile("" : "+v"(tid));
    const int wave = __builtin_amdgcn_readfirstlane(tid >> 6), lane = tid & 63;
    const int r0 = cu * CT, b = r0 >> 11, s0 = r0 & 2047;
    __syncthreads();
    for (int i = tid; i < (CT + 30) * 64; i += 512) {
        const int row = i >> 6, ch = i & 63, s = s0 - 30 + row;
        u32x4 v = {0u, 0u, 0u, 0u};
        if (s >= 0) v = *(const u32x4*)(U + (size_t)(b * SEQ + s) * UP + UGLU + ch * 8);
        *(LAS u32x4*)(lds + C_XH + row * 1024 + ch * 16) = v;
    }
    __syncthreads();
    {
        const int chp = tid & 255, tg = tid >> 8;
        float w0[CWID], w1[CWID];
#pragma unroll
        for (int j = 0; j < CWID; ++j) { const f32x2 ww = *(const f32x2*)(dww + (size_t)j * CD + 2 * chp); w0[j] = ww[0]; w1[j] = ww[1]; }
        const f32x2 bias = *(const f32x2*)(dwb + 2 * chp);
        const LAS unsigned char* xp = lds + C_XH + chp * 4;
#pragma unroll 1
        for (int tt = 0; tt < 16; ++tt) {
            const int tl = tg * 16 + tt;
            float a0 = bias[0], a1 = bias[1];
#pragma unroll
            for (int j = 0; j < CWID; ++j) { const unsigned xv = *(const LAS unsigned*)(xp + (tl + j) * 1024); a0 += w0[j] * bflo(xv); a1 += w1[j] * bfhi(xv); }
            f32x2 o = {a0, a1};
            *(LAS f32x2*)(lds + C_CO + tl * 2048 + chp * 8) = o;
        }
    }
    __syncthreads();
    {
        const f32x4 g0 = *(const f32x4*)(lng + lane * 4), g1 = *(const f32x4*)(lng + 256 + lane * 4);
        const f32x4 b0 = *(const f32x4*)(lnb + lane * 4), b1 = *(const f32x4*)(lnb + 256 + lane * 4);
#pragma unroll
        for (int tt = 0; tt < 4; ++tt) {
            const int tl = wave * 4 + tt;
            f32x4 v0 = *(const LAS f32x4*)(lds + C_CO + tl * 2048 + lane * 16), v1 = *(const LAS f32x4*)(lds + C_CO + tl * 2048 + 1024 + lane * 16);
            const float mean = wave_sum((v0[0] + v0[1]) + (v0[2] + v0[3]) + (v1[0] + v1[1]) + (v1[2] + v1[3]), lane) * (1.0f / CD);
            v0 = v0 - mean; v1 = v1 - mean;
            const float var = wave_sum((v0[0] * v0[0] + v0[1] * v0[1]) + (v0[2] * v0[2] + v0[3] * v0[3]) + (v1[0] * v1[0] + v1[1] * v1[1]) + (v1[2] * v1[2] + v1[3] * v1[3]), lane) * (1.0f / CD);
            const float rs = frsq(var + EPS);
            v0 = v0 * rs * g0 + b0; v1 = v1 * rs * g1 + b1;
            u32x2 wa, wb;
            wa[0] = pk2(siluf_(v0[0]), siluf_(v0[1])); wa[1] = pk2(siluf_(v0[2]), siluf_(v0[3]));
            wb[0] = pk2(siluf_(v1[0]), siluf_(v1[1])); wb[1] = pk2(siluf_(v1[2]), siluf_(v1[3]));
            bf16_t* cp = C2 + (size_t)(r0 + tl) * CD + lane * 4;
            *(u32x2*)cp = wa; *(u32x2*)(cp + 256) = wb;
        }
    }
}

#define XB_TMO      128
#define XB_XCNT(j)  (256  + 64 * (j))
#define XB_XSUB(j)  (1280 + 64 * (j))
#define XB_XGEN(j)  (2304 + 64 * (j))
#define XB_TOP      3328
#define XB_TOPGEN   3392
#define XCD_BAR_WORDS 3456
#define XB_SPIN_CAP (1u << 18)

__device__ __forceinline__ unsigned xb_ld(unsigned* p)              { return __hip_atomic_load(p, __ATOMIC_RELAXED, __HIP_MEMORY_SCOPE_AGENT); }
__device__ __forceinline__ unsigned xb_add(unsigned* p, unsigned v) { return __hip_atomic_fetch_add(p, v, __ATOMIC_RELAXED, __HIP_MEMORY_SCOPE_AGENT); }
__device__ __forceinline__ unsigned xb_xcc_id() { return (unsigned)__builtin_amdgcn_s_getreg((3 << 11) | 20) & 0xFu; }
#define XB_SPIN(cond, bar) do { unsigned _sp = 0; while (cond) { __builtin_amdgcn_s_sleep(1); \
    if ((++_sp & 255u) == 0u) { if (xb_ld(&(bar)[XB_TMO])) break; if (_sp > XB_SPIN_CAP) { atomicAdd(&(bar)[XB_TMO], 1u); break; } } } } while (0)

struct XcdBarrier {
    unsigned* bar; unsigned x;
    volatile LAS unsigned* st;
};

__device__ __forceinline__ XcdBarrier xcd_barrier_post(unsigned* bar, volatile LAS unsigned* st) {
    XcdBarrier b; b.bar = bar; b.x = xb_xcc_id(); b.st = st;
    if (threadIdx.x == 0) (void)xb_add(&bar[XB_XCNT(b.x)], 1u);
    return b;
}
__device__ __forceinline__ void xcd_barrier_complete(unsigned* bar, unsigned x, unsigned& nloc, unsigned& nx) {
    const unsigned G = gridDim.x * gridDim.y * gridDim.z;
    unsigned sum, cnt, mine, sp = 0u;
    for (;;) {
        sum = 0u; cnt = 0u; mine = 0u;
#pragma unroll
        for (unsigned j = 0; j < 16; ++j) { const unsigned c = xb_ld(&bar[XB_XCNT(j)]); sum += c; cnt += (c > 0u) ? 1u : 0u; mine = (j == x) ? c : mine; }
        if (sum == G) break;
        __builtin_amdgcn_s_sleep(1);
        if ((++sp & 255u) == 0u) { if (xb_ld(&bar[XB_TMO])) break; if (sp > XB_SPIN_CAP) { atomicAdd(&bar[XB_TMO], 1u); break; } }
    }
    nloc = mine > 0u ? mine : 1u; nx = cnt > 0u ? cnt : 1u;
}

__device__ __forceinline__ void xcd_barrier(const XcdBarrier& b) {
    asm volatile("s_waitcnt vmcnt(0)" ::: "memory");
    __syncthreads();
    if (threadIdx.x == 0) {
        unsigned* bar = b.bar;
        __builtin_amdgcn_s_waitcnt(0);
        unsigned nloc = b.st[0], nx = b.st[1];
        if (nloc == 0u) { xcd_barrier_complete(bar, b.x, nloc, nx); b.st[0] = nloc; b.st[1] = nx; }
        const unsigned old = xb_add(&bar[XB_XSUB(b.x)], 1u);
        const unsigned gen = old / nloc;
        if (old + 1u == (gen + 1u) * nloc) {
            __builtin_amdgcn_fence(__ATOMIC_RELEASE, "agent");
            asm volatile("s_waitcnt vmcnt(0)" ::: "memory");
            const unsigned og = xb_add(&bar[XB_TOP], 1u);
            const unsigned tg = og / nx;
            if (og + 1u == (tg + 1u) * nx) xb_add(&bar[XB_TOPGEN], 1u);
            else XB_SPIN(xb_ld(&bar[XB_TOPGEN]) == tg, bar);
            __builtin_amdgcn_fence(__ATOMIC_ACQUIRE, "agent");
            xb_add(&bar[XB_XGEN(b.x)], 1u);
            asm volatile("s_waitcnt vmcnt(0)" ::: "memory");
        } else {
            XB_SPIN(xb_ld(&bar[XB_XGEN(b.x)]) == gen, bar);
            __builtin_amdgcn_fence(__ATOMIC_ACQUIRE, "agent");
            asm volatile("s_waitcnt vmcnt(0)" ::: "memory");
        }
    }
    __syncthreads();
}

struct Params { const float* in[16]; float* out; unsigned char* ws; int ph_lo, ph_hi; };

template <int ph>
__device__ __forceinline__ void run_phase(const Params& P, LAS unsigned char* lds) {
    const int G = gridDim.x, bid = blockIdx.x;
    unsigned char* ws = P.ws;
    const float* x = P.in[0];
    float* out = P.out;
    bf16_t* HB = (bf16_t*)(ws + WS_HB); bf16_t* H1B = (bf16_t*)(ws + WS_H1B); bf16_t* Ub = (bf16_t*)(ws + WS_U); bf16_t* VT = (bf16_t*)(ws + WS_VT); bf16_t* Yb = (bf16_t*)(ws + WS_Y);
    bf16_t* C2 = (bf16_t*)(ws + WS_C2); bf16_t* EB = (bf16_t*)(ws + WS_EB);
    float* ssA = (float*)(ws + WS_SSA); float* ssB = (float*)(ws + WS_SSB); float* ssC = (float*)(ws + WS_SSC);
    int tid = threadIdx.x; asm volatile("" : "+v"(tid));
    const int lane = tid & 63, wave = __builtin_amdgcn_readfirstlane(tid >> 6);
    const int gw = bid * 8 + wave, NGW = G * 8;
    if constexpr (ph == 0) {
        LAS float* scr = (LAS float*)(lds + wave * 16384);
        for (int it = gw; it < 2 * 3072; it += NGW) {
            const int l = it / 3072; int r = it - l * 3072;
            unsigned char* wb = ws + (size_t)l * W_LAYER;
            if (r < 1792) { tr_item<true>(P.in[3] + (size_t)l * DM * DIN, DM, DIN, (bf16_t*)(wb + W_IN), P.in[2] + l * DM, scr, r, lane); continue; } r -= 1792;
            if (r < 128) { tr_item<false>(P.in[9] + (size_t)l * CD * CD, CD, CD, (bf16_t*)(wb + W_PW), nullptr, scr, r, lane); continue; } r -= 128;
            if (r < 512) { tr_item<false>(P.in[11] + (size_t)l * DM * DM, DM, DM, (bf16_t*)(wb + W_OUT), nullptr, scr, r, lane, 512); continue; } r -= 512;
            if (r < 512) { tr_item<false>(P.in[13] + (size_t)l * DM * DM, DM, DM, (bf16_t*)(wb + W_PG), P.in[12] + l * DM, scr, r, lane); continue; } r -= 512;
            tr_item<false>(P.in[14] + (size_t)l * PLE * DM, PLE, DM, (bf16_t*)(wb + W_PLE), nullptr, scr, r, lane);
        }
        for (int row = gw; row < MT; row += 2 * NGW) {
            const int row2 = row + NGW;
            const f32x4* xr = (const f32x4*)(x + (size_t)row * DM) + lane;
            const f32x4* xr2 = (const f32x4*)(x + (size_t)(row2 < MT ? row2 : row) * DM) + lane;
            f32x4 va[4], vb[4];
#pragma unroll
            for (int j = 0; j < 4; ++j) { va[j] = xr[64 * j]; vb[j] = xr2[64 * j]; }
            u32x2* ob = (u32x2*)(HB + (size_t)row * DM) + lane;
            float s = 0.f, s2 = 0.f;
#pragma unroll
            for (int j = 0; j < 4; ++j) { const f32x4 v = va[j]; s += (v[0] * v[0] + v[1] * v[1]) + (v[2] * v[2] + v[3] * v[3]); u32x2 w; w[0] = pk2(v[0], v[1]); w[1] = pk2(v[2], v[3]); ob[64 * j] = w; }
            s = wave_sum(s, lane);
            if (lane < 16) ssA[(size_t)row * 16 + lane] = (lane == 0) ? s : 0.f;
            if (row2 < MT) {
                u32x2* ob2 = (u32x2*)(HB + (size_t)row2 * DM) + lane;
#pragma unroll
                for (int j = 0; j < 4; ++j) { const f32x4 v = vb[j]; s2 += (v[0] * v[0] + v[1] * v[1]) + (v[2] * v[2] + v[3] * v[3]); u32x2 w; w[0] = pk2(v[0], v[1]); w[1] = pk2(v[2], v[3]); ob2[64 * j] = w; }
                s2 = wave_sum(s2, lane);
                if (lane < 16) ssA[(size_t)row2 * 16 + lane] = (lane == 0) ? s2 : 0.f;
            }
        }
        {
            const f32x4* pp = (const f32x4*)P.in[1]; u32x2* pb = (u32x2*)(ws + WS_PB);
            const int NV = 2 * MT * PLE / 4, stp = G * 512;
            for (int i = bid * 512 + tid; i < NV; i += 4 * stp) {
                f32x4 v[4];
#pragma unroll
                for (int j = 0; j < 4; ++j) { const int ii = i + j * stp; v[j] = pp[ii < NV ? ii : i]; }
#pragma unroll
                for (int j = 0; j < 4; ++j) { const int ii = i + j * stp; if (ii < NV) { u32x2 w; w[0] = pk2(v[j][0], v[j][1]); w[1] = pk2(v[j][2], v[j][3]); pb[ii] = w; } }
            }
        }
    } else if constexpr (ph == NPHASE - 1) {
        const float* fg = P.in[15];
        for (int row = gw; row < MT; row += NGW) {
            f32x4* xr = (f32x4*)(out + (size_t)row * DM) + lane;
            f32x4 v[4]; float s = 0.f;
#pragma unroll
            for (int j = 0; j < 4; ++j) { v[j] = xr[64 * j]; s += (v[j][0] * v[j][0] + v[j][1] * v[j][1]) + (v[j][2] * v[j][2] + v[j][3] * v[j][3]); }
            const float rs = frsq(wave_sum(s, lane) * (1.0f / DM) + EPS);
#pragma unroll
            for (int j = 0; j < 4; ++j) { const f32x4 g = *((const f32x4*)fg + lane + 64 * j); xr[64 * j] = v[j] * rs * g; }
        }
    } else {
        constexpr int l = (ph - 1) / 5, k = (ph - 1) % 5;
        unsigned char* wb = ws + (size_t)l * W_LAYER;
        if constexpr (k == 0) {
            pg8::Gemm g{HB, (const bf16_t*)(wb + W_IN), MT, DIN, DM}; pg8::StaticOrder S; S.init(MT, DIN, G, bid);
            EpiIn E{Ub, VT, ssA};
            pg8::gemm_phase<EpiIn, pg8::StaticOrder, true, true>(lds, g, S, E, threadIdx.x);
        } else if constexpr (k == 1) {
            const float* aog = P.in[4] + l * HD;
            const float* dww = P.in[5] + (size_t)l * CWID * CD; const float* dwb = P.in[6] + l * CD;
            const float* lng = P.in[7] + l * CD; const float* lnb = P.in[8] + l * CD;
            for (int it = bid; it < 256; it += G) {
                const int bh = it >> 2, pr = it & 3, b = bh >> 3, h = bh & 7;
#pragma unroll 1
                for (int uu = 0; uu < ((PROBE_DUP & 2) ? 4 : 2); ++uu) attn_unit(Ub, VT, Yb, aog, b, h, (uu & 1) == 0 ? 7 - pr : pr, lds);
#pragma unroll 1
                for (int uu = 0; uu < ((PROBE_DUP & 4) ? 4 : 2); ++uu) convpre_unit(Ub, C2, dww, dwb, lng, lnb, 2 * it + (uu & 1), lds);
            }
            __syncthreads();
        } else if constexpr (k == 2) {
            const int nb0 = G / 2;
            {
                pg8::Gemm g{C2, (const bf16_t*)(wb + W_PW), MT, CD, CD}; SubOrder S; S.init(MT, CD, nb0, bid);
                EpiPw E{Ub, Yb, P.in[10] + l * CD, ssC};
                pg8::gemm_phase<EpiPw, SubOrder, true, true>(lds, g, S, E, threadIdx.x);
            }
            {
                pg8::Gemm g{(const bf16_t*)(ws + WS_PB) + (size_t)l * MT * PLE, (const bf16_t*)(wb + W_PLE), MT, DM, PLE}; SubOrder S; S.init(MT, DM, G - nb0, bid - nb0);
                EpiE E{EB};
                int t2 = threadIdx.x; asm volatile("" : "+v"(t2));
                pg8::gemm_phase<EpiE, SubOrder, true, true>(lds, g, S, E, t2);
            }
        } else if constexpr (k == 3) {
            pg8::Gemm g{Yb, (const bf16_t*)(wb + W_OUT), MT, DM, DM}; pg8::StaticOrder S; S.init(MT, DM, G, bid);
            EpiOut E{l == 0 ? x : out, out, H1B, ssB, ssC};
            pg8::gemm_phase<EpiOut, pg8::StaticOrder, true, true>(lds, g, S, E, threadIdx.x);
        } else {
            pg8::Gemm g{H1B, (const bf16_t*)(wb + W_PG), MT, DM, DM}; pg8::StaticOrder S; S.init(MT, DM, G, bid);
            EpiGate E{out, EB, HB, ssB, ssA};
            pg8::gemm_phase<EpiGate, pg8::StaticOrder, true, true>(lds, g, S, E, threadIdx.x);
        }
    }
}

__global__ void __launch_bounds__(512, 2) fwd(Params P) {
    extern __shared__ __attribute__((aligned(16))) unsigned char lds_raw[];
    LAS unsigned char* lds = (LAS unsigned char*)lds_raw;
    const int lo = P.ph_lo, hi = P.ph_hi;
    volatile LAS unsigned* st = (volatile LAS unsigned*)(lds + LDS_BYTES - 64);
    if (threadIdx.x < 16) st[threadIdx.x] = 0u;
    __syncthreads();
    const XcdBarrier bar = xcd_barrier_post((unsigned*)(P.ws + WS_CTL), st);
#define PROBE_PH(k) ((((PROBE_DUP) & 8) && (k) == 0) || (((PROBE_DUP) & 1) && (k) == 1) || (((PROBE_DUP) & 32) && ((k) == 3 || (k) == 8)) || (((PROBE_DUP) & 16) && (k) == 4))
#define SEAM() do { if (hi > NPHASE) cg::this_grid().sync(); else xcd_barrier(bar); } while (0)
#define PHASE(k) if (lo <= (k) && (k) < hi) { run_phase<(k)>(P, lds); if constexpr (PROBE_PH(k)) { __syncthreads(); run_phase<(k)>(P, lds); } \
        if constexpr (((PROBE_DUP) & 64) != 0) { SEAM(); } if ((k) + 1 < hi) SEAM(); }
    PHASE(0) PHASE(1) PHASE(2) PHASE(3) PHASE(4) PHASE(5) PHASE(6) PHASE(7) PHASE(8) PHASE(9) PHASE(10) PHASE(11)
#undef PHASE
#undef SEAM
}

#ifndef MK_N_LAUNCHES
#define MK_N_LAUNCHES 1
#endif
extern "C" void kernel_launch(void* const* d_in, const int* in_sizes, int n_in, void* d_out, int out_size, void* d_ws, size_t ws_size, hipStream_t stream) {
    static int grid = 0;
    if (grid == 0) {
        if (n_in != 16 || out_size != MT * DM || ws_size < WS_END) { fprintf(stderr, "kernel_launch: unexpected shapes (n_in %d, out %d, ws %zu)\n", n_in, out_size, ws_size); grid = -1; return; }
        int dev = 0, cus = 0, per_cu = 0;
        (void)hipGetDevice(&dev);
        (void)hipDeviceGetAttribute(&cus, hipDeviceAttributeMultiprocessorCount, dev);
        if (hipFuncSetAttribute((const void*)fwd, hipFuncAttributeMaxDynamicSharedMemorySize, LDS_BYTES) != hipSuccess) { fprintf(stderr, "kernel_launch: hipFuncSetAttribute failed\n"); grid = -1; return; }
        if (hipOccupancyMaxActiveBlocksPerMultiprocessor(&per_cu, (const void*)fwd, 512, LDS_BYTES) != hipSuccess || per_cu < 1) { fprintf(stderr, "kernel_launch: occupancy query says %d\n", per_cu); per_cu = 1; }
        (void)hipGetLastError();
        grid = cus * 1;
        if (grid <= 0) grid = 256;
    }
    if (grid < 0) return;
    if (hipMemsetAsync((unsigned char*)d_ws + WS_CTL, 0, CTL_BYTES, stream) != hipSuccess) { fprintf(stderr, "kernel_launch: memset of barrier words failed\n"); return; }
    Params p{};
    for (int i = 0; i < 16; ++i) p.in[i] = (const float*)d_in[i];
    p.out = (float*)d_out; p.ws = (unsigned char*)d_ws;
#if MK_N_LAUNCHES == 1
    p.ph_lo = 0; p.ph_hi = NPHASE;
    void* args[] = {&p};
    hipError_t e = hipLaunchCooperativeKernel((const void*)fwd, dim3(grid), dim3(512), args, LDS_BYTES, stream);
    if (e != hipSuccess) fprintf(stderr, "kernel_launch: cooperative launch failed: %s (grid %d)\n", hipGetErrorString(e), grid);
#else
    for (int ph = 0; ph < NPHASE; ++ph) {
        p.ph_lo = ph; p.ph_hi = ph + 1;
        hipLaunchKernelGGL(fwd, dim3(grid), dim3(512), LDS_BYTES, stream, p);
    }
#endif
}
```

```cpp
#include <hip/hip_runtime.h>
#include <hip/hip_cooperative_groups.h>
#include <cstdio>
#include <cstdint>
namespace cg = cooperative_groups;
namespace pg8 {
#define PG8_LAS __attribute__((address_space(3)))
typedef unsigned short bf16_t;
typedef short bf16x8 __attribute__((ext_vector_type(8)));
typedef float f32x4 __attribute__((ext_vector_type(4)));
typedef unsigned u32x4 __attribute__((ext_vector_type(4)));
constexpr int BM = 256, BK = 64, HALF = 128, HTB = HALF * BK * 2  , STAGE_BYTES = 8 * HTB, NXCD = 8, WGM = 8;

__host__ __device__ __forceinline__ int lds_byte(int r, int c) { const int st = (r >> 4) * 2 + (c >> 5), rr = r & 15, cc = c & 31, ob = rr * 64 + cc * 2; return st * 1024 + (ob ^ (((ob >> 9) & 1) << 5)); }
__host__ __device__ __forceinline__ void stage_rc(int b, int& R, int& C) { const int st = b / 1024, sb = b % 1024, swz = sb ^ (((sb >> 9) & 1) << 5); R = (st >> 1) * 16 + swz / 64; C = (st & 1) * 32 + (swz % 64) / 2; }
__host__ __device__ __forceinline__ int perm32(int rho) { const int n = rho >> 4, i = rho & 15; return 8 * (i >> 2) + 4 * n + (i & 3); }

struct Unit { int pm, pn; };
struct Gemm { const bf16_t* A; const bf16_t* Bt; int M, N, K; };

struct StaticOrder {
    int nM, nN, nwg, G, c;
    __host__ __device__ void init(int M, int N, int G_, int c_) { nM = M / BM; nN = N / BM; nwg = nM * nN; G = G_; c = c_; }
    __host__ __device__ bool next(int i, Unit& u) const {
        const long L = (long)i * G + c; if (L >= nwg) return false;
        int wgid = (int)L; { const int q = nwg / NXCD, r = nwg % NXCD, xcd = wgid % NXCD, off = wgid / NXCD; wgid = (xcd < r ? xcd * (q + 1) : r * (q + 1) + (xcd - r) * q) + off; }
        const int nig = WGM * nN, gid = wgid / nig, fm = gid * WGM, gsz = (nM - fm) < WGM ? (nM - fm) : WGM;
        u.pm = fm + ((wgid % nig) % gsz); u.pn = (wgid % nig) / gsz; return true;
    }
    __device__ __forceinline__ void a_ready(const Unit&) const {}
    __device__ __forceinline__ void done(const Unit&) const {}
};

template <class Epi, class Sched, bool ALIGN_EPI = false, bool SP2 = false>
__device__ __forceinline__ void gemm_phase(PG8_LAS unsigned char* lds, const Gemm g, const Sched& S, const Epi& E, const int tid_in) {
    const int tid = tid_in, wid = __builtin_amdgcn_readfirstlane(tid >> 6), lane = tid & 63, wr = wid >> 2, wc = wid & 3, fr = lane & 15, fq = lane >> 4;
    const int K = g.K, nt = K / BK;
    unsigned voffA[2], voffB[2];
#pragma unroll
    for (int i = 0; i < 2; ++i) { int R, C; stage_rc(tid * 16 + i * 8192, R, C); const int Rb = Epi::PERM ? ((R & ~31) + perm32(R & 31)) : R;
        voffA[i] = (unsigned)(R * K + C) * 2u; voffB[i] = (unsigned)(Rb * K + C) * 2u; }
    const size_t kstep = (size_t)(BK * 2);
    const size_t hstep = (size_t)HALF * K * 2;
    const size_t tstep = 2 * hstep;
    const unsigned ldsw = (unsigned)wid * 1024u;
    const int aoff = lds_byte(wr * 64 + fr, fq * 8), boff = lds_byte(wc * 32 + fr, fq * 8);
#define PG8_SA(b, h) (((b) * 2 + (h)) * HTB)
#define PG8_SB(b, h) ((4 + (b) * 2 + (h)) * HTB)
#define PG8_STAGE(bufoff, gbase, voff) do { _Pragma("unroll") for (int _i = 0; _i < 2; ++_i) \
        __builtin_amdgcn_global_load_lds((const unsigned*)((const char*)(gbase) + (voff)[_i]), (PG8_LAS unsigned*)(lds + (bufoff) + ldsw + _i * 8192), 16, 0, 0); } while (0)
#define PG8_LDA(dst, b, h) do { _Pragma("unroll") for (int m = 0; m < 4; ++m) _Pragma("unroll") for (int k = 0; k < 2; ++k) dst[m][k] = *(const PG8_LAS bf16x8*)(lds + PG8_SA(b, h) + aoff + m * 2048 + k * 1024); } while (0)
#define PG8_LDB(dst, b, h) do { _Pragma("unroll") for (int n = 0; n < 2; ++n) _Pragma("unroll") for (int k = 0; k < 2; ++k) dst[n][k] = *(const PG8_LAS bf16x8*)(lds + PG8_SB(b, h) + boff + n * 2048 + k * 1024); } while (0)
#define PG8_MMA(ai, bj, At, Bt) do { __builtin_amdgcn_s_setprio(1); _Pragma("unroll") for (int m = 0; m < 4; ++m) _Pragma("unroll") for (int n = 0; n < 2; ++n) _Pragma("unroll") for (int k = 0; k < 2; ++k) \
        acc[ai][bj][m][n] = __builtin_amdgcn_mfma_f32_16x16x32_bf16(Bt[n][k], At[m][k], acc[ai][bj][m][n], 0, 0, 0); __builtin_amdgcn_s_setprio(0); } while (0)
#define PG8_WAIT_V(n) asm volatile("s_waitcnt vmcnt(" #n ")" ::: "memory")
#define PG8_WAIT_L(n) asm volatile("s_waitcnt lgkmcnt(" #n ")" ::: "memory")
#define PG8_BAR __builtin_amdgcn_s_barrier()
#define PG8_SCHED __builtin_amdgcn_sched_barrier(0)
    Unit cur, nxt; int ui = 0;
    if (!S.next(0, cur)) return;
    f32x4 acc[2][2][4][2];
#pragma unroll
    for (int a = 0; a < 2; ++a)
#pragma unroll
        for (int b = 0; b < 2; ++b)
#pragma unroll
            for (int m = 0; m < 4; ++m)
#pragma unroll
                for (int n = 0; n < 2; ++n) acc[a][b][m][n] = (f32x4){0.f, 0.f, 0.f, 0.f};
    bf16x8 At[4][2], B0[2][2], B1[2][2];
    const char* cA = (const char*)g.A + (size_t)cur.pm * tstep; const char* cB = (const char*)g.Bt + (size_t)cur.pn * tstep;
    S.a_ready(cur);
    if constexpr (SP2) {
        PG8_STAGE(PG8_SB(0, 0), cB, voffB); PG8_STAGE(PG8_SB(0, 1), cB + hstep, voffB); PG8_STAGE(PG8_SA(0, 0), cA, voffA); PG8_STAGE(PG8_SA(0, 1), cA + hstep, voffA);
        if (wr == 1) PG8_BAR;
        PG8_WAIT_V(2); PG8_BAR;
        PG8_STAGE(PG8_SB(1, 0), cB + kstep, voffB); PG8_STAGE(PG8_SA(1, 0), cA + kstep, voffA); PG8_STAGE(PG8_SB(1, 1), cB + hstep + kstep, voffB);
        PG8_WAIT_V(6); PG8_BAR;
    } else {
        PG8_STAGE(PG8_SB(0, 0), cB, voffB); PG8_STAGE(PG8_SA(0, 0), cA, voffA); PG8_STAGE(PG8_SB(0, 1), cB + hstep, voffB); PG8_STAGE(PG8_SA(0, 1), cA + hstep, voffA);
        if (wr == 1) PG8_BAR;
        PG8_WAIT_V(4); PG8_BAR;
        PG8_STAGE(PG8_SB(1, 0), cB + kstep, voffB); PG8_STAGE(PG8_SA(1, 0), cA + kstep, voffA); PG8_STAGE(PG8_SB(1, 1), cB + hstep + kstep, voffB);
        PG8_WAIT_V(6); PG8_BAR;
    }
    for (;;) {
        const bool has_next = S.next(ui + 1, nxt);
        const char* nA = has_next ? (const char*)g.A + (size_t)nxt.pm * tstep : cA; const char* nB = has_next ? (const char*)g.Bt + (size_t)nxt.pn * tstep : cB;
        for (int t = 0; t < nt; t += 2) {
            if constexpr (Epi::MID_T > 0) { if (t == Epi::MID_T) E.mid(acc, cur); }
            const bool last = (t == nt - 2);
            const char* a1 = cA + (size_t)(t + 1) * kstep;
            const char* a2 = last ? nA : cA + (size_t)(t + 2) * kstep; const char* b2 = last ? nB : cB + (size_t)(t + 2) * kstep;
            const char* a3 = a2 + kstep; const char* b3 = b2 + kstep;
            if (last && has_next) S.a_ready(nxt);
            if constexpr (SP2) {
            PG8_LDB(B0, 0, 0); PG8_LDB(B1, 0, 1); PG8_SCHED; PG8_LDA(At, 0, 0); PG8_STAGE(PG8_SA(1, 1), a1 + hstep, voffA);
            PG8_WAIT_V(8); PG8_WAIT_L(0); PG8_BAR; PG8_MMA(0, 0, At, B0); PG8_MMA(0, 1, At, B1); PG8_BAR; PG8_SCHED;
            PG8_LDA(At, 0, 1); PG8_STAGE(PG8_SB(0, 0), b2, voffB); PG8_STAGE(PG8_SB(0, 1), b2 + hstep, voffB); PG8_STAGE(PG8_SA(0, 0), a2, voffA);
            PG8_WAIT_V(8); PG8_WAIT_L(0); PG8_BAR; PG8_MMA(1, 0, At, B0); PG8_MMA(1, 1, At, B1); PG8_BAR; PG8_SCHED;
            PG8_LDB(B0, 1, 0); PG8_LDB(B1, 1, 1); PG8_SCHED; PG8_LDA(At, 1, 0); PG8_STAGE(PG8_SA(0, 1), a2 + hstep, voffA);
            PG8_WAIT_V(8); PG8_WAIT_L(0); PG8_BAR; PG8_MMA(0, 0, At, B0); PG8_MMA(0, 1, At, B1); PG8_BAR; PG8_SCHED;
            PG8_LDA(At, 1, 1); PG8_STAGE(PG8_SB(1, 0), b3, voffB); PG8_STAGE(PG8_SB(1, 1), b3 + hstep, voffB); PG8_STAGE(PG8_SA(1, 0), a3, voffA);
            PG8_WAIT_V(8); PG8_WAIT_L(0); PG8_BAR; PG8_MMA(1, 0, At, B0); PG8_MMA(1, 1, At, B1); PG8_BAR; PG8_SCHED;
            } else {
            PG8_LDB(B0, 0, 0); PG8_SCHED; PG8_LDA(At, 0, 0); PG8_STAGE(PG8_SA(1, 1), a1 + hstep, voffA);
            PG8_WAIT_L(8); PG8_BAR; PG8_WAIT_L(0); PG8_MMA(0, 0, At, B0); PG8_BAR; PG8_SCHED;
            PG8_LDB(B1, 0, 1); PG8_STAGE(PG8_SB(0, 0), b2, voffB);
            PG8_BAR; PG8_WAIT_L(0); PG8_MMA(0, 1, At, B1); PG8_BAR;
            PG8_LDA(At, 0, 1); PG8_STAGE(PG8_SA(0, 0), a2, voffA);
            PG8_BAR; PG8_WAIT_L(0); PG8_MMA(1, 0, At, B0); PG8_BAR; PG8_SCHED;
            PG8_STAGE(PG8_SB(0, 1), b2 + hstep, voffB);
            PG8_WAIT_V(6); PG8_BAR; PG8_MMA(1, 1, At, B1); PG8_BAR;
            PG8_LDB(B0, 1, 0); PG8_SCHED; PG8_LDA(At, 1, 0); PG8_STAGE(PG8_SA(0, 1), a2 + hstep, voffA);
            PG8_WAIT_L(8); PG8_BAR; PG8_WAIT_L(0); PG8_MMA(0, 0, At, B0); PG8_BAR; PG8_SCHED;
            PG8_LDB(B1, 1, 1); PG8_STAGE(PG8_SB(1, 0), b3, voffB);
            PG8_BAR; PG8_WAIT_L(0); PG8_MMA(0, 1, At, B1); PG8_BAR;
            PG8_LDA(At, 1, 1); PG8_STAGE(PG8_SA(1, 0), a3, voffA);
            PG8_BAR; PG8_WAIT_L(0); PG8_MMA(1, 0, At, B0); PG8_BAR; PG8_SCHED;
            PG8_STAGE(PG8_SB(1, 1), b3 + hstep, voffB);
            PG8_WAIT_V(6); PG8_BAR; PG8_MMA(1, 1, At, B1); PG8_BAR;
            }
        }
        if constexpr (ALIGN_EPI) { if (wr == 0) PG8_BAR; }
        if constexpr (!Epi::AFTER_DRAIN) { E(acc, cur, wr, wc, fr, fq); S.done(cur); }
        if (!has_next) break;
#pragma unroll
        for (int a = 0; a < 2; ++a)
#pragma unroll
            for (int b = 0; b < 2; ++b)
#pragma unroll
                for (int m = 0; m < 4; ++m)
#pragma unroll
                    for (int n = 0; n < 2; ++n) acc[a][b][m][n] = (f32x4){0.f, 0.f, 0.f, 0.f};
        cur = nxt; cA = nA; cB = nB; ++ui;
        if constexpr (ALIGN_EPI) { if (wr == 1) PG8_BAR; }
    }
    PG8_WAIT_V(0);
    if constexpr (!ALIGN_EPI) { if (wr == 0) PG8_BAR; }
    PG8_BAR;
    if constexpr (Epi::AFTER_DRAIN) { E.fused(acc, cur, wr, wc, fr, fq, lds, wid, lane); S.done(cur); }
#undef PG8_SA
#undef PG8_SB
#undef PG8_STAGE
#undef PG8_LDA
#undef PG8_LDB
#undef PG8_MMA
#undef PG8_WAIT_V
#undef PG8_WAIT_L
#undef PG8_BAR
#undef PG8_SCHED
}
}

#define LAS __attribute__((address_space(3)))
typedef unsigned short bf16_t;
typedef short bf16x8 __attribute__((ext_vector_type(8)));
typedef float f32x4 __attribute__((ext_vector_type(4)));
typedef float f32x2 __attribute__((ext_vector_type(2)));
typedef float f32x16 __attribute__((ext_vector_type(16)));
typedef unsigned u32x4 __attribute__((ext_vector_type(4)));
typedef unsigned u32x2 __attribute__((ext_vector_type(2)));
typedef __bf16 bf16x2_t __attribute__((ext_vector_type(2)));

constexpr int NB = 8, SEQ = 2048, DM = 1024, MT = NB * SEQ, DIN = 3584, NH = 8, HD = 64, CWID = 31, PLE = 256, CD = 512;
constexpr float EPS = 1e-6f;
constexpr float QSCALE = 0.125f * 1.4426950408889634f;

constexpr size_t MiB = 1u << 20;
constexpr size_t W_IN = 0, W_PW = 7340032, W_OUT = W_PW + 524288, W_PG = W_OUT + 2097152, W_PLE = W_PG + 2097152, W_LAYER = 12 * MiB;
static_assert(W_PLE + 524288 == W_LAYER, "weight map");
constexpr int UP = 2560, UQ = 0, UK = 512, USGA = 1024, UGLU = 1536, USGC = 2048;
constexpr size_t WS_PB = 24 * MiB, WS_HB = 40 * MiB, WS_Y = 72 * MiB, WS_VT = 104 * MiB, WS_SSA = 120 * MiB, WS_SSB = 121 * MiB, WS_SSC = 122 * MiB, WS_U = 123 * MiB;
constexpr size_t WS_H1B = WS_U  , WS_C2 = 203 * MiB, WS_EB = 219 * MiB, WS_CTL = 252 * MiB, CTL_BYTES = 16384, WS_END = WS_CTL + CTL_BYTES;
static_assert(WS_U + (size_t)MT * UP * 2 <= WS_C2, "ws map");
constexpr int LDS_BYTES = 147456;
constexpr int NPHASE = 12;
#ifndef PROBE_DUP
#define PROBE_DUP 0
#endif

__device__ __forceinline__ unsigned pk2(float lo, float hi) { f32x2 v = {lo, hi}; bf16x2_t b = __builtin_convertvector(v, bf16x2_t); return __builtin_bit_cast(unsigned, b); }
__device__ __forceinline__ float bflo(unsigned u) { return __builtin_bit_cast(float, u << 16); }
__device__ __forceinline__ float bfhi(unsigned u) { return __builtin_bit_cast(float, u & 0xffff0000u); }
__device__ __forceinline__ float fexp2(float x) { return __builtin_amdgcn_exp2f(x); }
__device__ __forceinline__ float flog2(float x) { return __builtin_amdgcn_logf(x); }
__device__ __forceinline__ float frcp(float x) { return __builtin_amdgcn_rcpf(x); }
__device__ __forceinline__ float frsq(float x) { return __builtin_amdgcn_rsqf(x); }
__device__ __forceinline__ float sigmoidf_(float x) { return frcp(1.0f + fexp2(-1.4426950408889634f * x)); }
__device__ __forceinline__ float siluf_(float x) { return x * sigmoidf_(x); }
#define MFMA32(a, b, c) __builtin_amdgcn_mfma_f32_32x32x16_bf16((a), (b), (c), 0, 0, 0)

__device__ __forceinline__ float shx(float v, int m, int lane) { return __builtin_bit_cast(float, __builtin_amdgcn_ds_bpermute((lane ^ m) << 2, __builtin_bit_cast(int, v))); }
__device__ __forceinline__ float wave_sum(float v, int lane) {
#pragma unroll
    for (int o = 1; o < 64; o <<= 1) v += shx(v, o, lane);
    return v;
}
__device__ __forceinline__ float row_rstd(const float* ss, int row, int fq, int lane) {
    const f32x4 p = *(const f32x4*)(ss + (size_t)row * 16 + fq * 4);
    float s = (p[0] + p[1]) + (p[2] + p[3]);
    s += shx(s, 16, lane); s += shx(s, 32, lane);
    return frsq(s * (1.0f / DM) + EPS);
}

struct EpiIn {
    static constexpr bool PERM = true, AFTER_DRAIN = false; static constexpr int MID_T = 0;
    bf16_t* U; bf16_t* VT; const float* ss;
    __device__ __forceinline__ void operator()(const f32x4 (&acc)[2][2][4][2], const pg8::Unit& u, int, int, int, int) const {
        int t_ = threadIdx.x; asm volatile("" : "+v"(t_));
        const int lane = t_ & 63, fr = lane & 15, fq = lane >> 4, wid_ = __builtin_amdgcn_readfirstlane(t_ >> 6), wr = wid_ >> 2, wc = wid_ & 3;
        const int pn = u.pn;
        f32x4 pp[2][4];
#pragma unroll
        for (int ai = 0; ai < 2; ++ai)
#pragma unroll
            for (int m = 0; m < 4; ++m) pp[ai][m] = *(const f32x4*)(ss + (size_t)(u.pm * 256 + ai * 128 + wr * 64 + m * 16 + fr) * 16 + fq * 4);
#pragma unroll
        for (int ai = 0; ai < 2; ++ai)
#pragma unroll
            for (int m = 0; m < 4; ++m) {
                const int row = u.pm * 256 + ai * 128 + wr * 64 + m * 16 + fr;
                float s_ = (pp[ai][m][0] + pp[ai][m][1]) + (pp[ai][m][2] + pp[ai][m][3]);
                s_ += shx(s_, 16, lane); s_ += shx(s_, 32, lane);
                const float rs = frsq(s_ * (1.0f / DM) + EPS);
#pragma unroll
                for (int bj = 0; bj < 2; ++bj) {
                    const int col0 = pn * 256 + bj * 128 + wc * 32 + 8 * fq;
                    f32x4 v0 = acc[ai][bj][m][0] * rs, v1 = acc[ai][bj][m][1] * rs;
                    if (pn < 4) {
                        const float sc = pn < 2 ? QSCALE : 1.0f;
                        v0 = v0 * sc; v1 = v1 * sc;
                        u32x4 w; w[0] = pk2(v0[0], v0[1]); w[1] = pk2(v0[2], v0[3]); w[2] = pk2(v1[0], v1[1]); w[3] = pk2(v1[2], v1[3]);
                        *(u32x4*)(U + (size_t)row * UP + col0) = w;
                    } else if (pn < 6) {
                        const int vc = col0 - 1024, hh = vc >> 6, d0 = vc & 63, b = row >> 11, s = row & 2047;
                        bf16_t* vp = VT + ((size_t)((b * NH + hh) * HD + d0)) * SEQ + s;
                        const unsigned w0 = pk2(v0[0], v0[1]), w1 = pk2(v0[2], v0[3]), w2 = pk2(v1[0], v1[1]), w3 = pk2(v1[2], v1[3]);
                        vp[0 * SEQ] = (bf16_t)(w0 & 0xffffu); vp[1 * SEQ] = (bf16_t)(w0 >> 16);
                        vp[2 * SEQ] = (bf16_t)(w1 & 0xffffu); vp[3 * SEQ] = (bf16_t)(w1 >> 16);
                        vp[4 * SEQ] = (bf16_t)(w2 & 0xffffu); vp[5 * SEQ] = (bf16_t)(w2 >> 16);
                        vp[6 * SEQ] = (bf16_t)(w3 & 0xffffu); vp[7 * SEQ] = (bf16_t)(w3 >> 16);
                    } else if (pn < 8 || pn >= 12) {
                        u32x4 w; w[0] = pk2(siluf_(v0[0]), siluf_(v0[1])); w[1] = pk2(siluf_(v0[2]), siluf_(v0[3]));
                        w[2] = pk2(siluf_(v1[0]), siluf_(v1[1])); w[3] = pk2(siluf_(v1[2]), siluf_(v1[3]));
                        *(u32x4*)(U + (size_t)row * UP + (pn < 8 ? col0 - 512 : col0 - 1024)) = w;
                    } else {
                        const int ch0 = (col0 - 2048) >> 1;
                        u32x2 w; w[0] = pk2(v0[0] * sigmoidf_(v0[1]), v0[2] * sigmoidf_(v0[3])); w[1] = pk2(v1[0] * sigmoidf_(v1[1]), v1[2] * sigmoidf_(v1[3]));
                        *(u32x2*)(U + (size_t)row * UP + UGLU + ch0) = w;
                    }
                }
                asm volatile("" ::: "memory");
            }
    }
};

struct EpiPw {
    static constexpr bool PERM = true, AFTER_DRAIN = false; static constexpr int MID_T = 0;
    const bf16_t* U; bf16_t* Y; const float* cog; float* ssC;
    __device__ __forceinline__ void operator()(const f32x4 (&acc)[2][2][4][2], const pg8::Unit& u, int, int, int, int) const {
        int t_ = threadIdx.x; asm volatile("" : "+v"(t_));
        const int lane = t_ & 63, fr = lane & 15, fq = lane >> 4, wid_ = __builtin_amdgcn_readfirstlane(t_ >> 6), wr = wid_ >> 2, wc = wid_ & 3;
#pragma unroll
        for (int ai = 0; ai < 2; ++ai)
#pragma unroll
            for (int m = 0; m < 4; ++m) {
                const int row = u.pm * 256 + ai * 128 + wr * 64 + m * 16 + fr;
                float sq = 0.f;
#pragma unroll
                for (int bj = 0; bj < 2; ++bj) {
                    const int col0 = u.pn * 256 + bj * 128 + wc * 32 + 8 * fq;
                    const f32x4 v0 = acc[ai][bj][m][0], v1 = acc[ai][bj][m][1];
                    sq += (v0[0] * v0[0] + v0[1] * v0[1]) + (v0[2] * v0[2] + v0[3] * v0[3]) + (v1[0] * v1[0] + v1[1] * v1[1]) + (v1[2] * v1[2] + v1[3] * v1[3]);
                    const f32x4 g0 = *(const f32x4*)(cog + col0), g1 = *(const f32x4*)(cog + col0 + 4);
                    const u32x4 sg = *(const u32x4*)(U + (size_t)row * UP + USGC + col0);
                    u32x4 w;
                    w[0] = pk2(v0[0] * g0[0] * bflo(sg[0]), v0[1] * g0[1] * bfhi(sg[0])); w[1] = pk2(v0[2] * g0[2] * bflo(sg[1]), v0[3] * g0[3] * bfhi(sg[1]));
                    w[2] = pk2(v1[0] * g1[0] * bflo(sg[2]), v1[1] * g1[1] * bfhi(sg[2])); w[3] = pk2(v1[2] * g1[2] * bflo(sg[3]), v1[3] * g1[3] * bfhi(sg[3]));
                    *(u32x4*)(Y + (size_t)row * DM + col0) = w;
                }
                sq += shx(sq, 16, lane); sq += shx(sq, 32, lane);
                if (fq == 0) ssC[(size_t)row * 8 + u.pn * 4 + wc] = sq;
                asm volatile("" ::: "memory");
            }
    }
};

struct EpiE {
    static constexpr bool PERM = true, AFTER_DRAIN = false; static constexpr int MID_T = 0;
    bf16_t* EB;
    __device__ __forceinline__ void operator()(const f32x4 (&acc)[2][2][4][2], const pg8::Unit& u, int, int, int, int) const {
        int t_ = threadIdx.x; asm volatile("" : "+v"(t_));
        const int lane = t_ & 63, fr = lane & 15, fq = lane >> 4, wid_ = __builtin_amdgcn_readfirstlane(t_ >> 6), wr = wid_ >> 2, wc = wid_ & 3;
#pragma unroll
        for (int ai = 0; ai < 2; ++ai)
#pragma unroll
            for (int m = 0; m < 4; ++m) {
                const int row = u.pm * 256 + ai * 128 + wr * 64 + m * 16 + fr;
#pragma unroll
                for (int bj = 0; bj < 2; ++bj) {
                    const int col0 = u.pn * 256 + bj * 128 + wc * 32 + 8 * fq;
                    const f32x4 v0 = acc[ai][bj][m][0], v1 = acc[ai][bj][m][1];
                    u32x4 w; w[0] = pk2(v0[0], v0[1]); w[1] = pk2(v0[2], v0[3]); w[2] = pk2(v1[0], v1[1]); w[3] = pk2(v1[2], v1[3]);
                    *(u32x4*)(EB + (size_t)row * DM + col0) = w;
                }
                asm volatile("" ::: "memory");
            }
    }
};

struct EpiOut {
    static constexpr bool PERM = true, AFTER_DRAIN = false; static constexpr int MID_T = 8;
    const float* base; float* out; bf16_t* HB; float* ss; const float* ssC;
    __device__ __forceinline__ void mid(f32x4 (&acc)[2][2][4][2], const pg8::Unit& u) const {
        int t_ = threadIdx.x; asm volatile("" : "+v"(t_));
        const int lane = t_ & 63, fr = lane & 15, fq = lane >> 4, wid_ = __builtin_amdgcn_readfirstlane(t_ >> 6), wr = wid_ >> 2;
        f32x2 pc[2][4];
#pragma unroll
        for (int ai = 0; ai < 2; ++ai)
#pragma unroll
            for (int m = 0; m < 4; ++m) pc[ai][m] = *(const f32x2*)(ssC + (size_t)(u.pm * 256 + ai * 128 + wr * 64 + m * 16 + fr) * 8 + fq * 2);
#pragma unroll
        for (int ai = 0; ai < 2; ++ai)
#pragma unroll
            for (int m = 0; m < 4; ++m) {
                const f32x2 p = pc[ai][m];
                float s = p[0] + p[1];
                s += shx(s, 16, lane); s += shx(s, 32, lane);
                const float rs = frsq(s * (1.0f / CD) + EPS);
#pragma unroll
                for (int bj = 0; bj < 2; ++bj)
#pragma unroll
                    for (int n = 0; n < 2; ++n) acc[ai][bj][m][n] = acc[ai][bj][m][n] * rs;
            }
    }
    __device__ __forceinline__ void operator()(const f32x4 (&acc)[2][2][4][2], const pg8::Unit& u, int, int, int, int) const {
        int t_ = threadIdx.x; asm volatile("" : "+v"(t_));
        const int lane = t_ & 63, fr = lane & 15, fq = lane >> 4, wid_ = __builtin_amdgcn_readfirstlane(t_ >> 6), wr = wid_ >> 2, wc = wid_ & 3;
#pragma unroll
        for (int ai = 0; ai < 2; ++ai)
#pragma unroll
            for (int mp = 0; mp < 2; ++mp) {
                f32x4 bs[2][2][2];
#pragma unroll
                for (int mm = 0; mm < 2; ++mm)
#pragma unroll
                    for (int bj = 0; bj < 2; ++bj) {
                        const size_t off = (size_t)(u.pm * 256 + ai * 128 + wr * 64 + (2 * mp + mm) * 16 + fr) * DM + u.pn * 256 + bj * 128 + wc * 32 + 8 * fq;
                        bs[mm][bj][0] = *(const f32x4*)(base + off); bs[mm][bj][1] = *(const f32x4*)(base + off + 4);
                    }
#pragma unroll
                for (int mm = 0; mm < 2; ++mm) {
                    const int m = 2 * mp + mm;
                    const int row = u.pm * 256 + ai * 128 + wr * 64 + m * 16 + fr;
                    float sq = 0.f;
#pragma unroll
                    for (int bj = 0; bj < 2; ++bj) {
                        const size_t off = (size_t)row * DM + u.pn * 256 + bj * 128 + wc * 32 + 8 * fq;
                        const f32x4 h0 = bs[mm][bj][0] + acc[ai][bj][m][0], h1 = bs[mm][bj][1] + acc[ai][bj][m][1];
                        *(f32x4*)(out + off) = h0; *(f32x4*)(out + off + 4) = h1;
                        u32x4 w; w[0] = pk2(h0[0], h0[1]); w[1] = pk2(h0[2], h0[3]); w[2] = pk2(h1[0], h1[1]); w[3] = pk2(h1[2], h1[3]);
                        *(u32x4*)(HB + off) = w;
                        sq += (h0[0] * h0[0] + h0[1] * h0[1]) + (h0[2] * h0[2] + h0[3] * h0[3]) + (h1[0] * h1[0] + h1[1] * h1[1]) + (h1[2] * h1[2] + h1[3] * h1[3]);
                    }
                    sq += shx(sq, 16, lane); sq += shx(sq, 32, lane);
                    if (fq == 0) ss[(size_t)row * 16 + u.pn * 4 + wc] = sq;
                }
                asm volatile("" ::: "memory");
            }
    }
};

struct EpiGate {
    static constexpr bool PERM = true, AFTER_DRAIN = false; static constexpr int MID_T = 0;
    float* out; const bf16_t* EB; bf16_t* HB; const float* ss_in; float* ss_out;
    __device__ __forceinline__ void operator()(const f32x4 (&acc)[2][2][4][2], const pg8::Unit& u, int, int, int, int) const {
        int t_ = threadIdx.x; asm volatile("" : "+v"(t_));
        const int lane = t_ & 63, fr = lane & 15, fq = lane >> 4, wid_ = __builtin_amdgcn_readfirstlane(t_ >> 6), wr = wid_ >> 2, wc = wid_ & 3;
        f32x4 pp[2][4];
#pragma unroll
        for (int ai = 0; ai < 2; ++ai)
#pragma unroll
            for (int m = 0; m < 4; ++m) pp[ai][m] = *(const f32x4*)(ss_in + (size_t)(u.pm * 256 + ai * 128 + wr * 64 + m * 16 + fr) * 16 + fq * 4);
        float rsv[2][4];
#pragma unroll
        for (int ai = 0; ai < 2; ++ai)
#pragma unroll
            for (int m = 0; m < 4; ++m) {
                float s_ = (pp[ai][m][0] + pp[ai][m][1]) + (pp[ai][m][2] + pp[ai][m][3]);
                s_ += shx(s_, 16, lane); s_ += shx(s_, 32, lane);
                rsv[ai][m] = frsq(s_ * (1.0f / DM) + EPS);
            }
        asm volatile("" ::: "memory");
#pragma unroll
        for (int ai = 0; ai < 2; ++ai)
#pragma unroll
            for (int mp = 0; mp < 2; ++mp) {
                f32x4 bs[2][2][2];
#pragma unroll
                for (int mm = 0; mm < 2; ++mm)
#pragma unroll
                    for (int bj = 0; bj < 2; ++bj) {
                        const size_t off = (size_t)(u.pm * 256 + ai * 128 + wr * 64 + (2 * mp + mm) * 16 + fr) * DM + u.pn * 256 + bj * 128 + wc * 32 + 8 * fq;
                        bs[mm][bj][0] = *(const f32x4*)(out + off); bs[mm][bj][1] = *(const f32x4*)(out + off + 4);
                    }
#pragma unroll
                for (int mm = 0; mm < 2; ++mm) {
                    const int m = 2 * mp + mm;
                    const int row = u.pm * 256 + ai * 128 + wr * 64 + m * 16 + fr;
                    const float rs = rsv[ai][m];
                    float sq = 0.f;
#pragma unroll
                    for (int bj = 0; bj < 2; ++bj) {
                        const size_t off = (size_t)row * DM + u.pn * 256 + bj * 128 + wc * 32 + 8 * fq;
                        const f32x4 a0 = acc[ai][bj][m][0] * rs, a1 = acc[ai][bj][m][1] * rs;
                        const u32x4 e = *(const u32x4*)(EB + off);
                        f32x4 h0 = bs[mm][bj][0], h1 = bs[mm][bj][1];
                        h0[0] += bflo(e[0]) * sigmoidf_(a0[0]); h0[1] += bfhi(e[0]) * sigmoidf_(a0[1]); h0[2] += bflo(e[1]) * sigmoidf_(a0[2]); h0[3] += bfhi(e[1]) * sigmoidf_(a0[3]);
                        h1[0] += bflo(e[2]) * sigmoidf_(a1[0]); h1[1] += bfhi(e[2]) * sigmoidf_(a1[1]); h1[2] += bflo(e[3]) * sigmoidf_(a1[2]); h1[3] += bfhi(e[3]) * sigmoidf_(a1[3]);
                        *(f32x4*)(out + off) = h0; *(f32x4*)(out + off + 4) = h1;
                        u32x4 w; w[0] = pk2(h0[0], h0[1]); w[1] = pk2(h0[2], h0[3]); w[2] = pk2(h1[0], h1[1]); w[3] = pk2(h1[2], h1[3]);
                        *(u32x4*)(HB + off) = w;
                        sq += (h0[0] * h0[0] + h0[1] * h0[1]) + (h0[2] * h0[2] + h0[3] * h0[3]) + (h1[0] * h1[0] + h1[1] * h1[1]) + (h1[2] * h1[2] + h1[3] * h1[3]);
                    }
                    sq += shx(sq, 16, lane); sq += shx(sq, 32, lane);
                    if (fq == 0) ss_out[(size_t)row * 16 + u.pn * 4 + wc] = sq;
                }
                asm volatile("" ::: "memory");
            }
    }
};

struct SubOrder {
    int nN, nwg, nb, c;
    __device__ void init(int M, int N, int nb_, int c_) { nN = N / 256; nwg = (M / 256) * nN; nb = nb_; c = c_; }
    __device__ bool next(int i, pg8::Unit& u) const { if (c < 0 || c >= nb) return false; const int L = i * nb + c; if (L >= nwg) return false; u.pm = L / nN; u.pn = L % nN; return true; }
    __device__ __forceinline__ void a_ready(const pg8::Unit&) const {}
    __device__ __forceinline__ void done(const pg8::Unit&) const {}
};

template <bool REMAP>
__device__ __forceinline__ void tr_item(const float* W, int K, int N, bf16_t* WT, const float* g, LAS float* scr, int item, int lane, int kshift = 0) {
    const int nblk = N / 32, kb = item / nblk, nb = item % nblk, k0 = 64 * kb, n0 = 32 * nb;
    int src = n0 + (lane & 31);
    if (REMAP) { if (src >= 2048 && src < 3072) { const int jj = src - 2048; src = (jj & 1) ? 2560 + (jj >> 1) : 2048 + (jj >> 1); } }
    float wv[32];
#pragma unroll
    for (int i = 0; i < 32; ++i) { const int kk = 2 * i + (lane >> 5); wv[i] = W[(size_t)((k0 + kk + kshift) & (K - 1)) * N + src]; }
#pragma unroll
    for (int i = 0; i < 32; ++i) { const int kk = 2 * i + (lane >> 5); float v = wv[i]; if (g) v *= g[k0 + kk]; scr[kk * 33 + (lane & 31)] = v; }
    asm volatile("s_waitcnt lgkmcnt(0)" ::: "memory");
    const int c = lane & 7;
#pragma unroll
    for (int j = 0; j < 4; ++j) { const int n = (lane >> 3) + 8 * j; const LAS float* s = scr + (8 * c) * 33 + n;
        u32x4 o; o[0] = pk2(s[0 * 33], s[1 * 33]); o[1] = pk2(s[2 * 33], s[3 * 33]); o[2] = pk2(s[4 * 33], s[5 * 33]); o[3] = pk2(s[6 * 33], s[7 * 33]);
        *(u32x4*)(WT + (size_t)(n0 + n) * K + k0 + 8 * c) = o; }
    asm volatile("s_waitcnt lgkmcnt(0)" ::: "memory");
}

constexpr int AK_STRIDE = 144, AV_STRIDE = 136, A_KBYTES = 64 * AK_STRIDE, A_VBYTES = 64 * AV_STRIDE, A_BUF = 18432;
static_assert(A_KBYTES + A_VBYTES <= A_BUF, "attention LDS buffer");

__device__ __forceinline__ void attn_unit(const bf16_t* U, const bf16_t* VT, bf16_t* Y, const float* aog, int b, int h, int qb, LAS unsigned char* lds) {
    int tid = threadIdx.x; asm volatile("" : "+v"(tid));
    const int wave = __builtin_amdgcn_readfirstlane(tid >> 6), lane = tid & 63, l31 = lane & 31, hi = lane >> 5;
    const int q0 = qb * 256 + wave * 32, t = q0 + l31;
    const size_t trow = (size_t)(b * SEQ + t);
    bf16x8 qf[4];
    {
        const bf16_t* qp = U + trow * UP + UQ + h * HD + 8 * hi;
#pragma unroll
        for (int s = 0; s < 4; ++s) qf[s] = *(const bf16x8*)(qp + 16 * s);
    }
    f32x16 o0, o1;
#pragma unroll
    for (int i = 0; i < 16; ++i) { o0[i] = 0.f; o1[i] = 0.f; }
    float C = 1.f;
    const int ktmax = 4 * qb + 3, wkt = (q0 + 30) >> 6;
    const int srow = tid >> 3, sch = tid & 7;
    const bf16_t* gk = U + (size_t)(b * SEQ + srow) * UP + UK + h * HD + sch * 8;
    const bf16_t* gv = VT + ((size_t)((b * NH + h) * HD + srow)) * SEQ + sch * 8;
    const int kwoff = srow * AK_STRIDE + sch * 16, vwoff = A_KBYTES + srow * AV_STRIDE + sch * 16;
    __syncthreads();
    {
        const u32x4 kr = *(const u32x4*)(gk + (size_t)ktmax * 64 * UP), vr = *(const u32x4*)(gv + ktmax * 64);
        *(LAS u32x4*)(lds + kwoff) = kr;
        u32x2 a = {vr[0], vr[1]}, c = {vr[2], vr[3]};
        *(LAS u32x2*)(lds + vwoff) = a; *(LAS u32x2*)(lds + vwoff + 8) = c;
    }
    __syncthreads();
    int cur = 0;
    LAS unsigned* dflag = (LAS unsigned*)(lds + 2 * A_BUF);
    bool wdone = false;
    for (int kt = ktmax; kt >= 0; --kt) {
        u32x4 kr = {0u, 0u, 0u, 0u}, vr = {0u, 0u, 0u, 0u};
        if (kt > 0) { kr = *(const u32x4*)(gk + (size_t)(kt - 1) * 64 * UP); vr = *(const u32x4*)(gv + (kt - 1) * 64); }
        if (kt <= wkt && !wdone) {
            const LAS unsigned char* kb = lds + cur * A_BUF;
            const LAS unsigned char* vb = kb + A_KBYTES;
            f32x16 p0, p1;
#pragma unroll
            for (int i = 0; i < 16; ++i) { p0[i] = 0.f; p1[i] = 0.f; }
#pragma unroll
            for (int s = 0; s < 4; ++s) {
                const bf16x8 ka = *(const LAS bf16x8*)(kb + l31 * AK_STRIDE + 32 * s + 16 * hi);
                const bf16x8 kc = *(const LAS bf16x8*)(kb + (32 + l31) * AK_STRIDE + 32 * s + 16 * hi);
                p0 = MFMA32(ka, qf[s], p0); p1 = MFMA32(kc, qf[s], p1);
            }
            const int lim0 = t - (64 * kt + 4 * hi), lim1 = lim0 - 32;
            const bool diag = (64 * kt + 63 >= q0);
            f32x16 m0, m1;
            float G0[4], G1[4];
#pragma unroll
            for (int g = 0; g < 4; ++g) {
                float s0 = 1.f, s1 = 1.f;
#pragma unroll
                for (int i = 0; i < 4; ++i) {
                    const int r = 4 * g + i, cr = i + 8 * g;
                    const float e0 = fexp2(fminf(p0[r], 100.f)), e1 = fexp2(fminf(p1[r], 100.f));
                    float r0 = frcp(1.0f + e0), r1 = frcp(1.0f + e1);
                    float b0 = e0 * r0, b1 = e1 * r1;
                    if (diag) { const bool v0 = cr < lim0, v1 = cr < lim1; r0 = v0 ? r0 : 1.f; b0 = v0 ? b0 : 0.f; r1 = v1 ? r1 : 1.f; b1 = v1 ? b1 : 0.f; }
                    m0[r] = r0; m1[r] = r1; p0[r] = b0; p1[r] = b1; s0 *= r0; s1 *= r1;
                }
                G0[g] = s0; G1[g] = s1;
            }
            float X0[4], X1[4];
#pragma unroll
            for (int g = 0; g < 4; ++g) { X0[g] = shx(G0[g], 32, lane); X1[g] = shx(G1[g], 32, lane); }
            float run = C;
#pragma unroll
            for (int g = 3; g >= 0; --g) {
                float a = hi == 0 ? run * X1[g] : run;
#pragma unroll
                for (int i = 3; i >= 0; --i) { const int r = 4 * g + i; const float w = a * p1[r]; a *= m1[r]; p1[r] = w; }
                run *= G1[g] * X1[g];
            }
#pragma unroll
            for (int g = 3; g >= 0; --g) {
                float a = hi == 0 ? run * X0[g] : run;
#pragma unroll
                for (int i = 3; i >= 0; --i) { const int r = 4 * g + i; const float w = a * p0[r]; a *= m0[r]; p0[r] = w; }
                run *= G0[g] * X0[g];
            }
            C = run;
#pragma unroll
            for (int kh = 0; kh < 2; ++kh)
#pragma unroll
                for (int sh = 0; sh < 2; ++sh) {
                    u32x4 xw;
                    if (kh == 0) { xw[0] = pk2(p0[8 * sh + 0], p0[8 * sh + 1]); xw[1] = pk2(p0[8 * sh + 2], p0[8 * sh + 3]); xw[2] = pk2(p0[8 * sh + 4], p0[8 * sh + 5]); xw[3] = pk2(p0[8 * sh + 6], p0[8 * sh + 7]); }
                    else         { xw[0] = pk2(p1[8 * sh + 0], p1[8 * sh + 1]); xw[1] = pk2(p1[8 * sh + 2], p1[8 * sh + 3]); xw[2] = pk2(p1[8 * sh + 4], p1[8 * sh + 5]); xw[3] = pk2(p1[8 * sh + 6], p1[8 * sh + 7]); }
                    const bf16x8 xf = __builtin_bit_cast(bf16x8, xw);
                    const int koff = 2 * (32 * kh + 16 * sh + 4 * hi);
                    {
                        const LAS unsigned char* vp = vb + l31 * AV_STRIDE + koff;
                        const u32x2 lo = *(const LAS u32x2*)vp, hh = *(const LAS u32x2*)(vp + 16);
                        u32x4 vw = {lo[0], lo[1], hh[0], hh[1]};
                        o0 = MFMA32(__builtin_bit_cast(bf16x8, vw), xf, o0);
                    }
                    {
                        const LAS unsigned char* vp = vb + (32 + l31) * AV_STRIDE + koff;
                        const u32x2 lo = *(const LAS u32x2*)vp, hh = *(const LAS u32x2*)(vp + 16);
                        u32x4 vw = {lo[0], lo[1], hh[0], hh[1]};
                        o1 = MFMA32(__builtin_bit_cast(bf16x8, vw), xf, o1);
                    }
                }
        }
        wdone = (__builtin_amdgcn_ballot_w64(C > 7.5e-37f) == 0ull);
        if (lane == 0) dflag[(kt & 1) * 8 + wave] = wdone ? 1u : 0u;
        if (kt > 0) {
            LAS unsigned char* nb = lds + (cur ^ 1) * A_BUF;
            *(LAS u32x4*)(nb + kwoff) = kr;
            u32x2 a = {vr[0], vr[1]}, c = {vr[2], vr[3]};
            *(LAS u32x2*)(nb + vwoff) = a; *(LAS u32x2*)(nb + vwoff + 8) = c;
        }
        __syncthreads();
        cur ^= 1;
        {
            const LAS u32x4* df = (const LAS u32x4*)(dflag + (kt & 1) * 8);
            const u32x4 f0 = df[0], f1 = df[1];
            if ((f0[0] & f0[1] & f0[2] & f0[3] & f1[0] & f1[1] & f1[2] & f1[3]) != 0u) break;
        }
    }
    float sq = 0.f;
#pragma unroll
    for (int i = 0; i < 16; ++i) sq += o0[i] * o0[i] + o1[i] * o1[i];
    sq += shx(sq, 32, lane);
    const float rs = frsq(sq * (1.0f / HD) + EPS);
    const bf16_t* sgp = U + trow * UP + USGA + h * HD;
    bf16_t* yp = Y + trow * DM + 512 + h * HD;
#pragma unroll
    for (int dt = 0; dt < 2; ++dt)
#pragma unroll
        for (int g = 0; g < 4; ++g) {
            const int d0 = 32 * dt + 8 * g + 4 * hi;
            const f32x4 gn = *(const f32x4*)(aog + d0);
            const u32x2 sg = *(const u32x2*)(sgp + d0);
            float v0, v1, v2, v3;
            if (dt == 0) { v0 = o0[4 * g + 0]; v1 = o0[4 * g + 1]; v2 = o0[4 * g + 2]; v3 = o0[4 * g + 3]; }
            else         { v0 = o1[4 * g + 0]; v1 = o1[4 * g + 1]; v2 = o1[4 * g + 2]; v3 = o1[4 * g + 3]; }
            u32x2 w;
            w[0] = pk2(v0 * rs * gn[0] * bflo(sg[0]), v1 * rs * gn[1] * bfhi(sg[0]));
            w[1] = pk2(v2 * rs * gn[2] * bflo(sg[1]), v3 * rs * gn[3] * bfhi(sg[1]));
            *(u32x2*)(yp + d0) = w;
        }
}

constexpr int CT = 32, C_XH = 0, C_XH_BYTES = (CT + 30) * 1024, C_CO = C_XH_BYTES, C_CO_BYTES = CT * CD * 4;
static_assert(C_CO + C_CO_BYTES <= LDS_BYTES, "conv LDS map");

__device__ __forceinline__ void convpre_unit(const bf16_t* U, bf16_t* C2, const float* dww, const float* dwb, const float* lng, const float* lnb, int cu, LAS unsigned char* lds) {
    int tid = threadIdx.x; asm volatile("" : "+v"(tid));
    const int wave = __builtin_amdgcn_readfirstlane(tid >> 6), lane = tid & 63;
    const int r0 = cu * CT, b = r0 >> 11, s0 = r0 & 2047;
    __syncthreads();
    for (int i = tid; i < (CT + 30) * 64; i += 512) {
        const int row = i >> 6, ch = i & 63, s = s0 - 30 + row;
        u32x4 v = {0u, 0u, 0u, 0u};
        if (s >= 0) v = *(const u32x4*)(U + (size_t)(b * SEQ + s) * UP + UGLU + ch * 8);
        *(LAS u32x4*)(lds + C_XH + row * 1024 + ch * 16) = v;
    }
    __syncthreads();
    {
        const int chp = tid & 255, tg = tid >> 8;
        f32x2 w2[CWID];
#pragma unroll
        for (int j = 0; j < CWID; ++j) w2[j] = *(const f32x2*)(dww + (size_t)j * CD + 2 * chp);
        const f32x2 bias = *(const f32x2*)(dwb + 2 * chp);
        const LAS unsigned char* xp = lds + C_XH + (tg * 16) * 1024 + chp * 4;
        f32x2 xv[16 + CWID - 1];
#pragma unroll
        for (int i = 0; i < 16 + CWID - 1; ++i) { const unsigned xu = *(const LAS unsigned*)(xp + i * 1024); f32x2 t2 = {bflo(xu), bfhi(xu)}; xv[i] = t2; }
#pragma unroll
        for (int tt = 0; tt < 16; ++tt) {
            f32x2 a = bias;
#pragma unroll
            for (int j = 0; j < CWID; ++j) a = a + w2[j] * xv[tt + j];
            *(LAS f32x2*)(lds + C_CO + (tg * 16 + tt) * 2048 + chp * 8) = a;
        }
    }
    __syncthreads();
    {
        const f32x4 g0 = *(const f32x4*)(lng + lane * 4), g1 = *(const f32x4*)(lng + 256 + lane * 4);
        const f32x4 b0 = *(const f32x4*)(lnb + lane * 4), b1 = *(const f32x4*)(lnb + 256 + lane * 4);
#pragma unroll
        for (int tt = 0; tt < 4; ++tt) {
            const int tl = wave * 4 + tt;
            f32x4 v0 = *(const LAS f32x4*)(lds + C_CO + tl * 2048 + lane * 16), v1 = *(const LAS f32x4*)(lds + C_CO + tl * 2048 + 1024 + lane * 16);
            const float mean = wave_sum((v0[0] + v0[1]) + (v0[2] + v0[3]) + (v1[0] + v1[1]) + (v1[2] + v1[3]), lane) * (1.0f / CD);
            v0 = v0 - mean; v1 = v1 - mean;
            const float var = wave_sum((v0[0] * v0[0] + v0[1] * v0[1]) + (v0[2] * v0[2] + v0[3] * v0[3]) + (v1[0] * v1[0] + v1[1] * v1[1]) + (v1[2] * v1[2] + v1[3] * v1[3]), lane) * (1.0f / CD);
            const float rs = frsq(var + EPS);
            v0 = v0 * rs * g0 + b0; v1 = v1 * rs * g1 + b1;
            u32x2 wa, wb;
            wa[0] = pk2(siluf_(v0[0]), siluf_(v0[1])); wa[1] = pk2(siluf_(v0[2]), siluf_(v0[3]));
            wb[0] = pk2(siluf_(v1[0]), siluf_(v1[1])); wb[1] = pk2(siluf_(v1[2]), siluf_(v1[3]));
            bf16_t* cp = C2 + (size_t)(r0 + tl) * CD + lane * 4;
            *(u32x2*)cp = wa; *(u32x2*)(cp + 256) = wb;
        }
    }
}

#define XB_TMO      128
#define XB_XCNT(j)  (256  + 64 * (j))
#define XB_XSUB(j)  (1280 + 64 * (j))
#define XB_XGEN(j)  (2304 + 64 * (j))
#define XB_TOP      3328
#define XB_TOPGEN   3392
#define XCD_BAR_WORDS 3456
#define XB_SPIN_CAP (1u << 18)

__device__ __forceinline__ unsigned xb_ld(unsigned* p)              { return __hip_atomic_load(p, __ATOMIC_RELAXED, __HIP_MEMORY_SCOPE_AGENT); }
__device__ __forceinline__ unsigned xb_add(unsigned* p, unsigned v) { return __hip_atomic_fetch_add(p, v, __ATOMIC_RELAXED, __HIP_MEMORY_SCOPE_AGENT); }
__device__ __forceinline__ unsigned xb_xcc_id() { return (unsigned)__builtin_amdgcn_s_getreg((3 << 11) | 20) & 0xFu; }
#define XB_SPIN(cond, bar) do { unsigned _sp = 0; while (cond) { __builtin_amdgcn_s_sleep(1); \
    if ((++_sp & 255u) == 0u) { if (xb_ld(&(bar)[XB_TMO])) break; if (_sp > XB_SPIN_CAP) { atomicAdd(&(bar)[XB_TMO], 1u); break; } } } } while (0)

struct XcdBarrier {
    unsigned* bar; unsigned x;
    volatile LAS unsigned* st;
};

__device__ __forceinline__ XcdBarrier xcd_barrier_post(unsigned* bar, volatile LAS unsigned* st) {
    XcdBarrier b; b.bar = bar; b.x = xb_xcc_id(); b.st = st;
    if (threadIdx.x == 0) (void)xb_add(&bar[XB_XCNT(b.x)], 1u);
    return b;
}
__device__ __forceinline__ void xcd_barrier_complete(unsigned* bar, unsigned x, unsigned& nloc, unsigned& nx) {
    const unsigned G = gridDim.x * gridDim.y * gridDim.z;
    unsigned sum, cnt, mine, sp = 0u;
    for (;;) {
        sum = 0u; cnt = 0u; mine = 0u;
#pragma unroll
        for (unsigned j = 0; j < 16; ++j) { const unsigned c = xb_ld(&bar[XB_XCNT(j)]); sum += c; cnt += (c > 0u) ? 1u : 0u; mine = (j == x) ? c : mine; }
        if (sum == G) break;
        __builtin_amdgcn_s_sleep(1);
        if ((++sp & 255u) == 0u) { if (xb_ld(&bar[XB_TMO])) break; if (sp > XB_SPIN_CAP) { atomicAdd(&bar[XB_TMO], 1u); break; } }
    }
    nloc = mine > 0u ? mine : 1u; nx = cnt > 0u ? cnt : 1u;
}

__device__ __forceinline__ void xcd_barrier(const XcdBarrier& b) {
    asm volatile("s_waitcnt vmcnt(0)" ::: "memory");
    __syncthreads();
    if (threadIdx.x == 0) {
        unsigned* bar = b.bar;
        __builtin_amdgcn_s_waitcnt(0);
        unsigned nloc = b.st[0], nx = b.st[1];
        if (nloc == 0u) { xcd_barrier_complete(bar, b.x, nloc, nx); b.st[0] = nloc; b.st[1] = nx; }
        const unsigned old = xb_add(&bar[XB_XSUB(b.x)], 1u);
        const unsigned gen = old / nloc;
        if (old + 1u == (gen + 1u) * nloc) {
            __builtin_amdgcn_fence(__ATOMIC_RELEASE, "agent");
            asm volatile("s_waitcnt vmcnt(0)" ::: "memory");
            const unsigned og = xb_add(&bar[XB_TOP], 1u);
            const unsigned tg = og / nx;
            if (og + 1u == (tg + 1u) * nx) xb_add(&bar[XB_TOPGEN], 1u);
            else XB_SPIN(xb_ld(&bar[XB_TOPGEN]) == tg, bar);
            __builtin_amdgcn_fence(__ATOMIC_ACQUIRE, "agent");
            xb_add(&bar[XB_XGEN(b.x)], 1u);
            asm volatile("s_waitcnt vmcnt(0)" ::: "memory");
        } else {
            XB_SPIN(xb_ld(&bar[XB_XGEN(b.x)]) == gen, bar);
            __builtin_amdgcn_fence(__ATOMIC_ACQUIRE, "agent");
            asm volatile("s_waitcnt vmcnt(0)" ::: "memory");
        }
    }
    __syncthreads();
}

struct Params { const float* in[16]; float* out; unsigned char* ws; int ph_lo, ph_hi; };

template <int ph>
__device__ __forceinline__ void run_phase(const Params& P, LAS unsigned char* lds) {
    const int G = gridDim.x, bid = blockIdx.x;
    unsigned char* ws = P.ws;
    const float* x = P.in[0];
    float* out = P.out;
    bf16_t* HB = (bf16_t*)(ws + WS_HB); bf16_t* H1B = (bf16_t*)(ws + WS_H1B); bf16_t* Ub = (bf16_t*)(ws + WS_U); bf16_t* VT = (bf16_t*)(ws + WS_VT); bf16_t* Yb = (bf16_t*)(ws + WS_Y);
    bf16_t* C2 = (bf16_t*)(ws + WS_C2); bf16_t* EB = (bf16_t*)(ws + WS_EB);
    float* ssA = (float*)(ws + WS_SSA); float* ssB = (float*)(ws + WS_SSB); float* ssC = (float*)(ws + WS_SSC);
    int tid = threadIdx.x; asm volatile("" : "+v"(tid));
    const int lane = tid & 63, wave = __builtin_amdgcn_readfirstlane(tid >> 6);
    const int gw = bid * 8 + wave, NGW = G * 8;
    if constexpr (ph == 0) {
        LAS float* scr = (LAS float*)(lds + wave * 16384);
        for (int it = gw; it < 2 * 3072; it += NGW) {
            const int l = it / 3072; int r = it - l * 3072;
            unsigned char* wb = ws + (size_t)l * W_LAYER;
            if (r < 1792) { tr_item<true>(P.in[3] + (size_t)l * DM * DIN, DM, DIN, (bf16_t*)(wb + W_IN), P.in[2] + l * DM, scr, r, lane); continue; } r -= 1792;
            if (r < 128) { tr_item<false>(P.in[9] + (size_t)l * CD * CD, CD, CD, (bf16_t*)(wb + W_PW), nullptr, scr, r, lane); continue; } r -= 128;
            if (r < 512) { tr_item<false>(P.in[11] + (size_t)l * DM * DM, DM, DM, (bf16_t*)(wb + W_OUT), nullptr, scr, r, lane, 512); continue; } r -= 512;
            if (r < 512) { tr_item<false>(P.in[13] + (size_t)l * DM * DM, DM, DM, (bf16_t*)(wb + W_PG), P.in[12] + l * DM, scr, r, lane); continue; } r -= 512;
            tr_item<false>(P.in[14] + (size_t)l * PLE * DM, PLE, DM, (bf16_t*)(wb + W_PLE), nullptr, scr, r, lane);
        }
        for (int row = gw; row < MT; row += 2 * NGW) {
            const int row2 = row + NGW;
            const f32x4* xr = (const f32x4*)(x + (size_t)row * DM) + lane;
            const f32x4* xr2 = (const f32x4*)(x + (size_t)(row2 < MT ? row2 : row) * DM) + lane;
            f32x4 va[4], vb[4];
#pragma unroll
            for (int j = 0; j < 4; ++j) { va[j] = xr[64 * j]; vb[j] = xr2[64 * j]; }
            u32x2* ob = (u32x2*)(HB + (size_t)row * DM) + lane;
            float s = 0.f, s2 = 0.f;
#pragma unroll
            for (int j = 0; j < 4; ++j) { const f32x4 v = va[j]; s += (v[0] * v[0] + v[1] * v[1]) + (v[2] * v[2] + v[3] * v[3]); u32x2 w; w[0] = pk2(v[0], v[1]); w[1] = pk2(v[2], v[3]); ob[64 * j] = w; }
            s = wave_sum(s, lane);
            if (lane < 16) ssA[(size_t)row * 16 + lane] = (lane == 0) ? s : 0.f;
            if (row2 < MT) {
                u32x2* ob2 = (u32x2*)(HB + (size_t)row2 * DM) + lane;
#pragma unroll
                for (int j = 0; j < 4; ++j) { const f32x4 v = vb[j]; s2 += (v[0] * v[0] + v[1] * v[1]) + (v[2] * v[2] + v[3] * v[3]); u32x2 w; w[0] = pk2(v[0], v[1]); w[1] = pk2(v[2], v[3]); ob2[64 * j] = w; }
                s2 = wave_sum(s2, lane);
                if (lane < 16) ssA[(size_t)row2 * 16 + lane] = (lane == 0) ? s2 : 0.f;
            }
        }
        {
            const f32x4* pp = (const f32x4*)P.in[1]; u32x2* pb = (u32x2*)(ws + WS_PB);
            const int NV = 2 * MT * PLE / 4, stp = G * 512;
            for (int i = bid * 512 + tid; i < NV; i += 4 * stp) {
                f32x4 v[4];
#pragma unroll
                for (int j = 0; j < 4; ++j) { const int ii = i + j * stp; v[j] = pp[ii < NV ? ii : i]; }
#pragma unroll
                for (int j = 0; j < 4; ++j) { const int ii = i + j * stp; if (ii < NV) { u32x2 w; w[0] = pk2(v[j][0], v[j][1]); w[1] = pk2(v[j][2], v[j][3]); pb[ii] = w; } }
            }
        }
    } else if constexpr (ph == NPHASE - 1) {
        const float* fg = P.in[15];
        for (int row = gw; row < MT; row += 2 * NGW) {
            const int row2 = row + NGW; const bool has2 = row2 < MT;
            f32x4* xr = (f32x4*)(out + (size_t)row * DM) + lane;
            f32x4* xr2 = (f32x4*)(out + (size_t)(has2 ? row2 : row) * DM) + lane;
            f32x4 v[4], v2[4], gg[4]; float s = 0.f, s2 = 0.f;
#pragma unroll
            for (int j = 0; j < 4; ++j) { v[j] = xr[64 * j]; v2[j] = xr2[64 * j]; gg[j] = *((const f32x4*)fg + lane + 64 * j); }
#pragma unroll
            for (int j = 0; j < 4; ++j) { s += (v[j][0] * v[j][0] + v[j][1] * v[j][1]) + (v[j][2] * v[j][2] + v[j][3] * v[j][3]); s2 += (v2[j][0] * v2[j][0] + v2[j][1] * v2[j][1]) + (v2[j][2] * v2[j][2] + v2[j][3] * v2[j][3]); }
            const float rs = frsq(wave_sum(s, lane) * (1.0f / DM) + EPS), rs2 = frsq(wave_sum(s2, lane) * (1.0f / DM) + EPS);
#pragma unroll
            for (int j = 0; j < 4; ++j) xr[64 * j] = v[j] * rs * gg[j];
            if (has2) {
#pragma unroll
                for (int j = 0; j < 4; ++j) xr2[64 * j] = v2[j] * rs2 * gg[j];
            }
        }
    } else {
        constexpr int l = (ph - 1) / 5, k = (ph - 1) % 5;
        unsigned char* wb = ws + (size_t)l * W_LAYER;
        if constexpr (k == 0) {
            pg8::Gemm g{HB, (const bf16_t*)(wb + W_IN), MT, DIN, DM}; pg8::StaticOrder S; S.init(MT, DIN, G, bid);
            EpiIn E{Ub, VT, ssA};
            pg8::gemm_phase<EpiIn, pg8::StaticOrder, true, true>(lds, g, S, E, threadIdx.x);
        } else if constexpr (k == 1) {
            const float* aog = P.in[4] + l * HD;
            const float* dww = P.in[5] + (size_t)l * CWID * CD; const float* dwb = P.in[6] + l * CD;
            const float* lng = P.in[7] + l * CD; const float* lnb = P.in[8] + l * CD;
            for (int it = bid; it < 256; it += G) {
                const int bh = it >> 2, pr = it & 3, b = bh >> 3, h = bh & 7;
#pragma unroll 1
                for (int uu = 0; uu < ((PROBE_DUP & 2) ? 4 : 2); ++uu) attn_unit(Ub, VT, Yb, aog, b, h, (uu & 1) == 0 ? 7 - pr : pr, lds);
#pragma unroll 1
                for (int uu = 0; uu < ((PROBE_DUP & 4) ? 4 : 2); ++uu) convpre_unit(Ub, C2, dww, dwb, lng, lnb, 2 * it + (uu & 1), lds);
            }
            __syncthreads();
        } else if constexpr (k == 2) {
            const int nb0 = G / 2;
            {
                pg8::Gemm g{C2, (const bf16_t*)(wb + W_PW), MT, CD, CD}; SubOrder S; S.init(MT, CD, nb0, bid);
                EpiPw E{Ub, Yb, P.in[10] + l * CD, ssC};
                pg8::gemm_phase<EpiPw, SubOrder, true, true>(lds, g, S, E, threadIdx.x);
            }
            {
                pg8::Gemm g{(const bf16_t*)(ws + WS_PB) + (size_t)l * MT * PLE, (const bf16_t*)(wb + W_PLE), MT, DM, PLE}; SubOrder S; S.init(MT, DM, G - nb0, bid - nb0);
                EpiE E{EB};
                int t2 = threadIdx.x; asm volatile("" : "+v"(t2));
                pg8::gemm_phase<EpiE, SubOrder, true, true>(lds, g, S, E, t2);
            }
        } else if constexpr (k == 3) {
            pg8::Gemm g{Yb, (const bf16_t*)(wb + W_OUT), MT, DM, DM}; pg8::StaticOrder S; S.init(MT, DM, G, bid);
            EpiOut E{l == 0 ? x : out, out, H1B, ssB, ssC};
            pg8::gemm_phase<EpiOut, pg8::StaticOrder, true, true>(lds, g, S, E, threadIdx.x);
        } else {
            pg8::Gemm g{H1B, (const bf16_t*)(wb + W_PG), MT, DM, DM}; pg8::StaticOrder S; S.init(MT, DM, G, bid);
            EpiGate E{out, EB, HB, ssB, ssA};
            pg8::gemm_phase<EpiGate, pg8::StaticOrder, true, true>(lds, g, S, E, threadIdx.x);
        }
    }
}

__global__ void __launch_bounds__(512, 2) fwd(Params P) {
    extern __shared__ __attribute__((aligned(16))) unsigned char lds_raw[];
    LAS unsigned char* lds = (LAS unsigned char*)lds_raw;
    const int lo = P.ph_lo, hi = P.ph_hi;
    volatile LAS unsigned* st = (volatile LAS unsigned*)(lds + LDS_BYTES - 64);
    if (threadIdx.x < 16) st[threadIdx.x] = 0u;
    __syncthreads();
    const XcdBarrier bar = xcd_barrier_post((unsigned*)(P.ws + WS_CTL), st);
#define PROBE_PH(k) ((((PROBE_DUP) & 8) && (k) == 0) || (((PROBE_DUP) & 1) && (k) == 1) || (((PROBE_DUP) & 32) && ((k) == 3 || (k) == 8)) || (((PROBE_DUP) & 16) && (k) == 4))
#define SEAM() do { if (hi > NPHASE) cg::this_grid().sync(); else xcd_barrier(bar); } while (0)
#define PHASE(k) if (lo <= (k) && (k) < hi) { run_phase<(k)>(P, lds); if constexpr (PROBE_PH(k)) { __syncthreads(); run_phase<(k)>(P, lds); } \
        if constexpr (((PROBE_DUP) & 64) != 0) { SEAM(); } if ((k) + 1 < hi) SEAM(); }
    PHASE(0) PHASE(1) PHASE(2) PHASE(3) PHASE(4) PHASE(5) PHASE(6) PHASE(7) PHASE(8) PHASE(9) PHASE(10) PHASE(11)
#undef PHASE
#undef SEAM
}

#ifndef MK_N_LAUNCHES
#define MK_N_LAUNCHES 1
#endif
extern "C" void kernel_launch(void* const* d_in, const int* in_sizes, int n_in, void* d_out, int out_size, void* d_ws, size_t ws_size, hipStream_t stream) {
    static int grid = 0;
    if (grid == 0) {
        if (n_in != 16 || out_size != MT * DM || ws_size < WS_END) { fprintf(stderr, "kernel_launch: unexpected shapes (n_in %d, out %d, ws %zu)\n", n_in, out_size, ws_size); grid = -1; return; }
        int dev = 0, cus = 0, per_cu = 0;
        (void)hipGetDevice(&dev);
        (void)hipDeviceGetAttribute(&cus, hipDeviceAttributeMultiprocessorCount, dev);
        if (hipFuncSetAttribute((const void*)fwd, hipFuncAttributeMaxDynamicSharedMemorySize, LDS_BYTES) != hipSuccess) { fprintf(stderr, "kernel_launch: hipFuncSetAttribute failed\n"); grid = -1; return; }
        if (hipOccupancyMaxActiveBlocksPerMultiprocessor(&per_cu, (const void*)fwd, 512, LDS_BYTES) != hipSuccess || per_cu < 1) { fprintf(stderr, "kernel_launch: occupancy query says %d\n", per_cu); per_cu = 1; }
        (void)hipGetLastError();
        grid = cus * 1;
        if (grid <= 0) grid = 256;
    }
    if (grid < 0) return;
    if (hipMemsetAsync((unsigned char*)d_ws + WS_CTL, 0, CTL_BYTES, stream) != hipSuccess) { fprintf(stderr, "kernel_launch: memset of barrier words failed\n"); return; }
    Params p{};
    for (int i = 0; i < 16; ++i) p.in[i] = (const float*)d_in[i];
    p.out = (float*)d_out; p.ws = (unsigned char*)d_ws;
#if MK_N_LAUNCHES == 1
    p.ph_lo = 0; p.ph_hi = NPHASE;
    void* args[] = {&p};
    hipError_t e = hipLaunchCooperativeKernel((const void*)fwd, dim3(grid), dim3(512), args, LDS_BYTES, stream);
    if (e != hipSuccess) fprintf(stderr, "kernel_launch: cooperative launch failed: %s (grid %d)\n", hipGetErrorString(e), grid);
#else
    for (int ph = 0; ph < NPHASE; ++ph) {
        p.ph_lo = ph; p.ph_hi = ph + 1;
        hipLaunchKernelGGL(fwd, dim3(grid), dim3(512), LDS_BYTES, stream, p);
    }
#endif
}
```

```cpp
#include <hip/hip_runtime.h>
#include <hip/hip_cooperative_groups.h>
#include <cstdio>
#include <cstdint>
namespace cg = cooperative_groups;
namespace pg8 {
#define PG8_LAS __attribute__((address_space(3)))
typedef unsigned short bf16_t;
typedef short bf16x8 __attribute__((ext_vector_type(8)));
typedef float f32x4 __attribute__((ext_vector_type(4)));
typedef unsigned u32x4 __attribute__((ext_vector_type(4)));
constexpr int BM = 256, BK = 64, HALF = 128, HTB = HALF * BK * 2  , STAGE_BYTES = 8 * HTB, NXCD = 8, WGM = 8;

__host__ __device__ __forceinline__ int lds_byte(int r, int c) { const int st = (r >> 4) * 2 + (c >> 5), rr = r & 15, cc = c & 31, ob = rr * 64 + cc * 2; return st * 1024 + (ob ^ (((ob >> 9) & 1) << 5)); }
__host__ __device__ __forceinline__ void stage_rc(int b, int& R, int& C) { const int st = b / 1024, sb = b % 1024, swz = sb ^ (((sb >> 9) & 1) << 5); R = (st >> 1) * 16 + swz / 64; C = (st & 1) * 32 + (swz % 64) / 2; }
__host__ __device__ __forceinline__ int perm32(int rho) { const int n = rho >> 4, i = rho & 15; return 8 * (i >> 2) + 4 * n + (i & 3); }

struct Unit { int pm, pn; };
struct Gemm { const bf16_t* A; const bf16_t* Bt; int M, N, K; };

struct StaticOrder {
    int nM, nN, nwg, G, c;
    __host__ __device__ void init(int M, int N, int G_, int c_) { nM = M / BM; nN = N / BM; nwg = nM * nN; G = G_; c = c_; }
    __host__ __device__ bool next(int i, Unit& u) const {
        const long L = (long)i * G + c; if (L >= nwg) return false;
        int wgid = (int)L; { const int q = nwg / NXCD, r = nwg % NXCD, xcd = wgid % NXCD, off = wgid / NXCD; wgid = (xcd < r ? xcd * (q + 1) : r * (q + 1) + (xcd - r) * q) + off; }
        const int nig = WGM * nN, gid = wgid / nig, fm = gid * WGM, gsz = (nM - fm) < WGM ? (nM - fm) : WGM;
        u.pm = fm + ((wgid % nig) % gsz); u.pn = (wgid % nig) / gsz; return true;
    }
    __device__ __forceinline__ void a_ready(const Unit&) const {}
    __device__ __forceinline__ void done(const Unit&) const {}
};

template <class Epi, class Sched, bool ALIGN_EPI = false, bool SP2 = false>
__device__ __forceinline__ void gemm_phase(PG8_LAS unsigned char* lds, const Gemm g, const Sched& S, const Epi& E, const int tid_in) {
    const int tid = tid_in, wid = __builtin_amdgcn_readfirstlane(tid >> 6), lane = tid & 63, wr = wid >> 2, wc = wid & 3, fr = lane & 15, fq = lane >> 4;
    const int K = g.K, nt = K / BK;
    unsigned voffA[2], voffB[2];
#pragma unroll
    for (int i = 0; i < 2; ++i) { int R, C; stage_rc(tid * 16 + i * 8192, R, C); const int Rb = Epi::PERM ? ((R & ~31) + perm32(R & 31)) : R;
        voffA[i] = (unsigned)(R * K + C) * 2u; voffB[i] = (unsigned)(Rb * K + C) * 2u; }
    const size_t kstep = (size_t)(BK * 2);
    const size_t hstep = (size_t)HALF * K * 2;
    const size_t tstep = 2 * hstep;
    const unsigned ldsw = (unsigned)wid * 1024u;
    const int aoff = lds_byte(wr * 64 + fr, fq * 8), boff = lds_byte(wc * 32 + fr, fq * 8);
#define PG8_SA(b, h) (((b) * 2 + (h)) * HTB)
#define PG8_SB(b, h) ((4 + (b) * 2 + (h)) * HTB)
#define PG8_STAGE(bufoff, gbase, voff) do { _Pragma("unroll") for (int _i = 0; _i < 2; ++_i) \
        __builtin_amdgcn_global_load_lds((const unsigned*)((const char*)(gbase) + (voff)[_i]), (PG8_LAS unsigned*)(lds + (bufoff) + ldsw + _i * 8192), 16, 0, 0); } while (0)
#define PG8_LDA(dst, b, h) do { _Pragma("unroll") for (int m = 0; m < 4; ++m) _Pragma("unroll") for (int k = 0; k < 2; ++k) dst[m][k] = *(const PG8_LAS bf16x8*)(lds + PG8_SA(b, h) + aoff + m * 2048 + k * 1024); } while (0)
#define PG8_LDB(dst, b, h) do { _Pragma("unroll") for (int n = 0; n < 2; ++n) _Pragma("unroll") for (int k = 0; k < 2; ++k) dst[n][k] = *(const PG8_LAS bf16x8*)(lds + PG8_SB(b, h) + boff + n * 2048 + k * 1024); } while (0)
#define PG8_MMA(ai, bj, At, Bt) do { __builtin_amdgcn_s_setprio(1); _Pragma("unroll") for (int m = 0; m < 4; ++m) _Pragma("unroll") for (int n = 0; n < 2; ++n) _Pragma("unroll") for (int k = 0; k < 2; ++k) \
        acc[ai][bj][m][n] = __builtin_amdgcn_mfma_f32_16x16x32_bf16(Bt[n][k], At[m][k], acc[ai][bj][m][n], 0, 0, 0); __builtin_amdgcn_s_setprio(0); } while (0)
#define PG8_WAIT_V(n) asm volatile("s_waitcnt vmcnt(" #n ")" ::: "memory")
#define PG8_WAIT_L(n) asm volatile("s_waitcnt lgkmcnt(" #n ")" ::: "memory")
#define PG8_BAR __builtin_amdgcn_s_barrier()
#define PG8_SCHED __builtin_amdgcn_sched_barrier(0)
    Unit cur, nxt; int ui = 0;
    if (!S.next(0, cur)) return;
    f32x4 acc[2][2][4][2];
#pragma unroll
    for (int a = 0; a < 2; ++a)
#pragma unroll
        for (int b = 0; b < 2; ++b)
#pragma unroll
            for (int m = 0; m < 4; ++m)
#pragma unroll
                for (int n = 0; n < 2; ++n) acc[a][b][m][n] = (f32x4){0.f, 0.f, 0.f, 0.f};
    bf16x8 At[4][2], B0[2][2], B1[2][2];
    const char* cA = (const char*)g.A + (size_t)cur.pm * tstep; const char* cB = (const char*)g.Bt + (size_t)cur.pn * tstep;
    S.a_ready(cur);
    if constexpr (SP2) {
        PG8_STAGE(PG8_SB(0, 0), cB, voffB); PG8_STAGE(PG8_SB(0, 1), cB + hstep, voffB); PG8_STAGE(PG8_SA(0, 0), cA, voffA); PG8_STAGE(PG8_SA(0, 1), cA + hstep, voffA);
        if (wr == 1) PG8_BAR;
        PG8_WAIT_V(2); PG8_BAR;
        PG8_STAGE(PG8_SB(1, 0), cB + kstep, voffB); PG8_STAGE(PG8_SA(1, 0), cA + kstep, voffA); PG8_STAGE(PG8_SB(1, 1), cB + hstep + kstep, voffB);
        PG8_WAIT_V(6); PG8_BAR;
    } else {
        PG8_STAGE(PG8_SB(0, 0), cB, voffB); PG8_STAGE(PG8_SA(0, 0), cA, voffA); PG8_STAGE(PG8_SB(0, 1), cB + hstep, voffB); PG8_STAGE(PG8_SA(0, 1), cA + hstep, voffA);
        if (wr == 1) PG8_BAR;
        PG8_WAIT_V(4); PG8_BAR;
        PG8_STAGE(PG8_SB(1, 0), cB + kstep, voffB); PG8_STAGE(PG8_SA(1, 0), cA + kstep, voffA); PG8_STAGE(PG8_SB(1, 1), cB + hstep + kstep, voffB);
        PG8_WAIT_V(6); PG8_BAR;
    }
    for (;;) {
        const bool has_next = S.next(ui + 1, nxt);
        const char* nA = has_next ? (const char*)g.A + (size_t)nxt.pm * tstep : cA; const char* nB = has_next ? (const char*)g.Bt + (size_t)nxt.pn * tstep : cB;
        for (int t = 0; t < nt; t += 2) {
            if constexpr (Epi::MID_T > 0) { if (t == Epi::MID_T) E.mid(acc, cur); }
            const bool last = (t == nt - 2);
            const char* a1 = cA + (size_t)(t + 1) * kstep;
            const char* a2 = last ? nA : cA + (size_t)(t + 2) * kstep; const char* b2 = last ? nB : cB + (size_t)(t + 2) * kstep;
            const char* a3 = a2 + kstep; const char* b3 = b2 + kstep;
            if (last && has_next) S.a_ready(nxt);
            if constexpr (SP2) {
            PG8_LDB(B0, 0, 0); PG8_LDB(B1, 0, 1); PG8_SCHED; PG8_LDA(At, 0, 0); PG8_STAGE(PG8_SA(1, 1), a1 + hstep, voffA);
            PG8_WAIT_V(8); PG8_WAIT_L(0); PG8_BAR; PG8_MMA(0, 0, At, B0); PG8_MMA(0, 1, At, B1); PG8_BAR; PG8_SCHED;
            PG8_LDA(At, 0, 1); PG8_STAGE(PG8_SB(0, 0), b2, voffB); PG8_STAGE(PG8_SB(0, 1), b2 + hstep, voffB); PG8_STAGE(PG8_SA(0, 0), a2, voffA);
            PG8_WAIT_V(8); PG8_WAIT_L(0); PG8_BAR; PG8_MMA(1, 0, At, B0); PG8_MMA(1, 1, At, B1); PG8_BAR; PG8_SCHED;
            PG8_LDB(B0, 1, 0); PG8_LDB(B1, 1, 1); PG8_SCHED; PG8_LDA(At, 1, 0); PG8_STAGE(PG8_SA(0, 1), a2 + hstep, voffA);
            PG8_WAIT_V(8); PG8_WAIT_L(0); PG8_BAR; PG8_MMA(0, 0, At, B0); PG8_MMA(0, 1, At, B1); PG8_BAR; PG8_SCHED;
            PG8_LDA(At, 1, 1); PG8_STAGE(PG8_SB(1, 0), b3, voffB); PG8_STAGE(PG8_SB(1, 1), b3 + hstep, voffB); PG8_STAGE(PG8_SA(1, 0), a3, voffA);
            PG8_WAIT_V(8); PG8_WAIT_L(0); PG8_BAR; PG8_MMA(1, 0, At, B0); PG8_MMA(1, 1, At, B1); PG8_BAR; PG8_SCHED;
            } else {
            PG8_LDB(B0, 0, 0); PG8_SCHED; PG8_LDA(At, 0, 0); PG8_STAGE(PG8_SA(1, 1), a1 + hstep, voffA);
            PG8_WAIT_L(8); PG8_BAR; PG8_WAIT_L(0); PG8_MMA(0, 0, At, B0); PG8_BAR; PG8_SCHED;
            PG8_LDB(B1, 0, 1); PG8_STAGE(PG8_SB(0, 0), b2, voffB);
            PG8_BAR; PG8_WAIT_L(0); PG8_MMA(0, 1, At, B1); PG8_BAR;
            PG8_LDA(At, 0, 1); PG8_STAGE(PG8_SA(0, 0), a2, voffA);
            PG8_BAR; PG8_WAIT_L(0); PG8_MMA(1, 0, At, B0); PG8_BAR; PG8_SCHED;
            PG8_STAGE(PG8_SB(0, 1), b2 + hstep, voffB);
            PG8_WAIT_V(6); PG8_BAR; PG8_MMA(1, 1, At, B1); PG8_BAR;
            PG8_LDB(B0, 1, 0); PG8_SCHED; PG8_LDA(At, 1, 0); PG8_STAGE(PG8_SA(0, 1), a2 + hstep, voffA);
            PG8_WAIT_L(8); PG8_BAR; PG8_WAIT_L(0); PG8_MMA(0, 0, At, B0); PG8_BAR; PG8_SCHED;
            PG8_LDB(B1, 1, 1); PG8_STAGE(PG8_SB(1, 0), b3, voffB);
            PG8_BAR; PG8_WAIT_L(0); PG8_MMA(0, 1, At, B1); PG8_BAR;
            PG8_LDA(At, 1, 1); PG8_STAGE(PG8_SA(1, 0), a3, voffA);
            PG8_BAR; PG8_WAIT_L(0); PG8_MMA(1, 0, At, B0); PG8_BAR; PG8_SCHED;
            PG8_STAGE(PG8_SB(1, 1), b3 + hstep, voffB);
            PG8_WAIT_V(6); PG8_BAR; PG8_MMA(1, 1, At, B1); PG8_BAR;
            }
        }
        if constexpr (ALIGN_EPI) { if (wr == 0) PG8_BAR; }
        if constexpr (!Epi::AFTER_DRAIN) { E(acc, cur, wr, wc, fr, fq); S.done(cur); }
        if (!has_next) break;
#pragma unroll
        for (int a = 0; a < 2; ++a)
#pragma unroll
            for (int b = 0; b < 2; ++b)
#pragma unroll
                for (int m = 0; m < 4; ++m)
#pragma unroll
                    for (int n = 0; n < 2; ++n) acc[a][b][m][n] = (f32x4){0.f, 0.f, 0.f, 0.f};
        cur = nxt; cA = nA; cB = nB; ++ui;
        if constexpr (ALIGN_EPI) { if (wr == 1) PG8_BAR; }
    }
    PG8_WAIT_V(0);
    if constexpr (!ALIGN_EPI) { if (wr == 0) PG8_BAR; }
    PG8_BAR;
    if constexpr (Epi::AFTER_DRAIN) { E.fused(acc, cur, wr, wc, fr, fq, lds, wid, lane); S.done(cur); }
#undef PG8_SA
#undef PG8_SB
#undef PG8_STAGE
#undef PG8_LDA
#undef PG8_LDB
#undef PG8_MMA
#undef PG8_WAIT_V
#undef PG8_WAIT_L
#undef PG8_BAR
#undef PG8_SCHED
}
}

#define LAS __attribute__((address_space(3)))
typedef unsigned short bf16_t;
typedef short bf16x8 __attribute__((ext_vector_type(8)));
typedef float f32x4 __attribute__((ext_vector_type(4)));
typedef float f32x2 __attribute__((ext_vector_type(2)));
typedef float f32x16 __attribute__((ext_vector_type(16)));
typedef unsigned u32x4 __attribute__((ext_vector_type(4)));
typedef unsigned u32x2 __attribute__((ext_vector_type(2)));
typedef __bf16 bf16x2_t __attribute__((ext_vector_type(2)));

constexpr int NB = 8, SEQ = 2048, DM = 1024, MT = NB * SEQ, DIN = 3584, NH = 8, HD = 64, CWID = 31, PLE = 256, CD = 512;
constexpr float EPS = 1e-6f;
constexpr float QSCALE = 0.125f * 1.4426950408889634f;

constexpr size_t MiB = 1u << 20;
constexpr size_t W_IN = 0, W_PW = 7340032, W_OUT = W_PW + 524288, W_PG = W_OUT + 2097152, W_PLE = W_PG + 2097152, W_LAYER = 12 * MiB;
static_assert(W_PLE + 524288 == W_LAYER, "weight map");
constexpr int UP = 2560, UQ = 0, UK = 512, USGA = 1024, UGLU = 1536, USGC = 2048;
constexpr size_t WS_PB = 24 * MiB, WS_HB = 40 * MiB, WS_Y = 72 * MiB, WS_VT = 104 * MiB, WS_SSA = 120 * MiB, WS_SSB = 121 * MiB, WS_SSC = 122 * MiB, WS_U = 123 * MiB;
constexpr size_t WS_H1B = WS_U  , WS_C2 = 203 * MiB, WS_EB = 219 * MiB, WS_CTL = 252 * MiB, CTL_BYTES = 16384, WS_END = WS_CTL + CTL_BYTES;
static_assert(WS_U + (size_t)MT * UP * 2 <= WS_C2, "ws map");
constexpr int LDS_BYTES = 147456;
constexpr int NPHASE = 12;
#ifndef PROBE_DUP
#define PROBE_DUP 0
#endif

__device__ __forceinline__ unsigned pk2(float lo, float hi) { f32x2 v = {lo, hi}; bf16x2_t b = __builtin_convertvector(v, bf16x2_t); return __builtin_bit_cast(unsigned, b); }
__device__ __forceinline__ float bflo(unsigned u) { return __builtin_bit_cast(float, u << 16); }
__device__ __forceinline__ float bfhi(unsigned u) { return __builtin_bit_cast(float, u & 0xffff0000u); }
__device__ __forceinline__ float fexp2(float x) { return __builtin_amdgcn_exp2f(x); }
__device__ __forceinline__ float flog2(float x) { return __builtin_amdgcn_logf(x); }
__device__ __forceinline__ float frcp(float x) { return __builtin_amdgcn_rcpf(x); }
__device__ __forceinline__ float frsq(float x) { return __builtin_amdgcn_rsqf(x); }
__device__ __forceinline__ float sigmoidf_(float x) { return frcp(1.0f + fexp2(-1.4426950408889634f * x)); }
__device__ __forceinline__ float siluf_(float x) { return x * sigmoidf_(x); }
#define MFMA32(a, b, c) __builtin_amdgcn_mfma_f32_32x32x16_bf16((a), (b), (c), 0, 0, 0)

__device__ __forceinline__ float shx(float v, int m, int lane) { return __builtin_bit_cast(float, __builtin_amdgcn_ds_bpermute((lane ^ m) << 2, __builtin_bit_cast(int, v))); }
__device__ __forceinline__ float wave_sum(float v, int lane) {
#pragma unroll
    for (int o = 1; o < 64; o <<= 1) v += shx(v, o, lane);
    return v;
}
__device__ __forceinline__ float row_rstd(const float* ss, int row, int fq, int lane) {
    const f32x4 p = *(const f32x4*)(ss + (size_t)row * 16 + fq * 4);
    float s = (p[0] + p[1]) + (p[2] + p[3]);
    s += shx(s, 16, lane); s += shx(s, 32, lane);
    return frsq(s * (1.0f / DM) + EPS);
}

struct EpiIn {
    static constexpr bool PERM = true, AFTER_DRAIN = false; static constexpr int MID_T = 0;
    bf16_t* U; bf16_t* VT; const float* ss;
    __device__ __forceinline__ void operator()(const f32x4 (&acc)[2][2][4][2], const pg8::Unit& u, int, int, int, int) const {
        int t_ = threadIdx.x; asm volatile("" : "+v"(t_));
        const int lane = t_ & 63, fr = lane & 15, fq = lane >> 4, wid_ = __builtin_amdgcn_readfirstlane(t_ >> 6), wr = wid_ >> 2, wc = wid_ & 3;
        const int pn = u.pn;
        f32x4 pp[2][4];
#pragma unroll
        for (int ai = 0; ai < 2; ++ai)
#pragma unroll
            for (int m = 0; m < 4; ++m) pp[ai][m] = *(const f32x4*)(ss + (size_t)(u.pm * 256 + ai * 128 + wr * 64 + m * 16 + fr) * 16 + fq * 4);
#pragma unroll
        for (int ai = 0; ai < 2; ++ai)
#pragma unroll
            for (int m = 0; m < 4; ++m) {
                const int row = u.pm * 256 + ai * 128 + wr * 64 + m * 16 + fr;
                float s_ = (pp[ai][m][0] + pp[ai][m][1]) + (pp[ai][m][2] + pp[ai][m][3]);
                s_ += shx(s_, 16, lane); s_ += shx(s_, 32, lane);
                const float rs = frsq(s_ * (1.0f / DM) + EPS);
#pragma unroll
                for (int bj = 0; bj < 2; ++bj) {
                    const int col0 = pn * 256 + bj * 128 + wc * 32 + 8 * fq;
                    f32x4 v0 = acc[ai][bj][m][0] * rs, v1 = acc[ai][bj][m][1] * rs;
                    if (pn < 4) {
                        const float sc = pn < 2 ? QSCALE : 1.0f;
                        v0 = v0 * sc; v1 = v1 * sc;
                        u32x4 w; w[0] = pk2(v0[0], v0[1]); w[1] = pk2(v0[2], v0[3]); w[2] = pk2(v1[0], v1[1]); w[3] = pk2(v1[2], v1[3]);
                        *(u32x4*)(U + (size_t)row * UP + col0) = w;
                    } else if (pn < 6) {
                        const int vc = col0 - 1024, hh = vc >> 6, d0 = vc & 63, b = row >> 11, s = row & 2047;
                        bf16_t* vp = VT + ((size_t)((b * NH + hh) * HD + d0)) * SEQ + s;
                        const unsigned w0 = pk2(v0[0], v0[1]), w1 = pk2(v0[2], v0[3]), w2 = pk2(v1[0], v1[1]), w3 = pk2(v1[2], v1[3]);
                        vp[0 * SEQ] = (bf16_t)(w0 & 0xffffu); vp[1 * SEQ] = (bf16_t)(w0 >> 16);
                        vp[2 * SEQ] = (bf16_t)(w1 & 0xffffu); vp[3 * SEQ] = (bf16_t)(w1 >> 16);
                        vp[4 * SEQ] = (bf16_t)(w2 & 0xffffu); vp[5 * SEQ] = (bf16_t)(w2 >> 16);
                        vp[6 * SEQ] = (bf16_t)(w3 & 0xffffu); vp[7 * SEQ] = (bf16_t)(w3 >> 16);
                    } else if (pn < 8 || pn >= 12) {
                        u32x4 w; w[0] = pk2(siluf_(v0[0]), siluf_(v0[1])); w[1] = pk2(siluf_(v0[2]), siluf_(v0[3]));
                        w[2] = pk2(siluf_(v1[0]), siluf_(v1[1])); w[3] = pk2(siluf_(v1[2]), siluf_(v1[3]));
                        *(u32x4*)(U + (size_t)row * UP + (pn < 8 ? col0 - 512 : col0 - 1024)) = w;
                    } else {
                        const int ch0 = (col0 - 2048) >> 1;
                        u32x2 w; w[0] = pk2(v0[0] * sigmoidf_(v0[1]), v0[2] * sigmoidf_(v0[3])); w[1] = pk2(v1[0] * sigmoidf_(v1[1]), v1[2] * sigmoidf_(v1[3]));
                        *(u32x2*)(U + (size_t)row * UP + UGLU + ch0) = w;
                    }
                }
                asm volatile("" ::: "memory");
            }
    }
};

struct EpiPw {
    static constexpr bool PERM = true, AFTER_DRAIN = false; static constexpr int MID_T = 0;
    const bf16_t* U; bf16_t* Y; const float* cog; float* ssC;
    __device__ __forceinline__ void operator()(const f32x4 (&acc)[2][2][4][2], const pg8::Unit& u, int, int, int, int) const {
        int t_ = threadIdx.x; asm volatile("" : "+v"(t_));
        const int lane = t_ & 63, fr = lane & 15, fq = lane >> 4, wid_ = __builtin_amdgcn_readfirstlane(t_ >> 6), wr = wid_ >> 2, wc = wid_ & 3;
#pragma unroll
        for (int ai = 0; ai < 2; ++ai)
#pragma unroll
            for (int m = 0; m < 4; ++m) {
                const int row = u.pm * 256 + ai * 128 + wr * 64 + m * 16 + fr;
                float sq = 0.f;
#pragma unroll
                for (int bj = 0; bj < 2; ++bj) {
                    const int col0 = u.pn * 256 + bj * 128 + wc * 32 + 8 * fq;
                    const f32x4 v0 = acc[ai][bj][m][0], v1 = acc[ai][bj][m][1];
                    sq += (v0[0] * v0[0] + v0[1] * v0[1]) + (v0[2] * v0[2] + v0[3] * v0[3]) + (v1[0] * v1[0] + v1[1] * v1[1]) + (v1[2] * v1[2] + v1[3] * v1[3]);
                    const f32x4 g0 = *(const f32x4*)(cog + col0), g1 = *(const f32x4*)(cog + col0 + 4);
                    const u32x4 sg = *(const u32x4*)(U + (size_t)row * UP + USGC + col0);
                    u32x4 w;
                    w[0] = pk2(v0[0] * g0[0] * bflo(sg[0]), v0[1] * g0[1] * bfhi(sg[0])); w[1] = pk2(v0[2] * g0[2] * bflo(sg[1]), v0[3] * g0[3] * bfhi(sg[1]));
                    w[2] = pk2(v1[0] * g1[0] * bflo(sg[2]), v1[1] * g1[1] * bfhi(sg[2])); w[3] = pk2(v1[2] * g1[2] * bflo(sg[3]), v1[3] * g1[3] * bfhi(sg[3]));
                    *(u32x4*)(Y + (size_t)row * DM + col0) = w;
                }
                sq += shx(sq, 16, lane); sq += shx(sq, 32, lane);
                if (fq == 0) ssC[(size_t)row * 8 + u.pn * 4 + wc] = sq;
                asm volatile("" ::: "memory");
            }
    }
};

struct EpiE {
    static constexpr bool PERM = true, AFTER_DRAIN = false; static constexpr int MID_T = 0;
    bf16_t* EB;
    __device__ __forceinline__ void operator()(const f32x4 (&acc)[2][2][4][2], const pg8::Unit& u, int, int, int, int) const {
        int t_ = threadIdx.x; asm volatile("" : "+v"(t_));
        const int lane = t_ & 63, fr = lane & 15, fq = lane >> 4, wid_ = __builtin_amdgcn_readfirstlane(t_ >> 6), wr = wid_ >> 2, wc = wid_ & 3;
#pragma unroll
        for (int ai = 0; ai < 2; ++ai)
#pragma unroll
            for (int m = 0; m < 4; ++m) {
                const int row = u.pm * 256 + ai * 128 + wr * 64 + m * 16 + fr;
#pragma unroll
                for (int bj = 0; bj < 2; ++bj) {
                    const int col0 = u.pn * 256 + bj * 128 + wc * 32 + 8 * fq;
                    const f32x4 v0 = acc[ai][bj][m][0], v1 = acc[ai][bj][m][1];
                    u32x4 w; w[0] = pk2(v0[0], v0[1]); w[1] = pk2(v0[2], v0[3]); w[2] = pk2(v1[0], v1[1]); w[3] = pk2(v1[2], v1[3]);
                    *(u32x4*)(EB + (size_t)row * DM + col0) = w;
                }
                asm volatile("" ::: "memory");
            }
    }
};

struct EpiOut {
    static constexpr bool PERM = true, AFTER_DRAIN = false; static constexpr int MID_T = 8;
    const float* base; float* out; bf16_t* HB; float* ss; const float* ssC;
    __device__ __forceinline__ void mid(f32x4 (&acc)[2][2][4][2], const pg8::Unit& u) const {
        int t_ = threadIdx.x; asm volatile("" : "+v"(t_));
        const int lane = t_ & 63, fr = lane & 15, fq = lane >> 4, wid_ = __builtin_amdgcn_readfirstlane(t_ >> 6), wr = wid_ >> 2;
        f32x2 pc[2][4];
#pragma unroll
        for (int ai = 0; ai < 2; ++ai)
#pragma unroll
            for (int m = 0; m < 4; ++m) pc[ai][m] = *(const f32x2*)(ssC + (size_t)(u.pm * 256 + ai * 128 + wr * 64 + m * 16 + fr) * 8 + fq * 2);
#pragma unroll
        for (int ai = 0; ai < 2; ++ai)
#pragma unroll
            for (int m = 0; m < 4; ++m) {
                const f32x2 p = pc[ai][m];
                float s = p[0] + p[1];
                s += shx(s, 16, lane); s += shx(s, 32, lane);
                const float rs = frsq(s * (1.0f / CD) + EPS);
#pragma unroll
                for (int bj = 0; bj < 2; ++bj)
#pragma unroll
                    for (int n = 0; n < 2; ++n) acc[ai][bj][m][n] = acc[ai][bj][m][n] * rs;
            }
    }
    __device__ __forceinline__ void operator()(const f32x4 (&acc)[2][2][4][2], const pg8::Unit& u, int, int, int, int) const {
        int t_ = threadIdx.x; asm volatile("" : "+v"(t_));
        const int lane = t_ & 63, fr = lane & 15, fq = lane >> 4, wid_ = __builtin_amdgcn_readfirstlane(t_ >> 6), wr = wid_ >> 2, wc = wid_ & 3;
#pragma unroll
        for (int ai = 0; ai < 2; ++ai)
#pragma unroll
            for (int mp = 0; mp < 2; ++mp) {
                f32x4 bs[2][2][2];
#pragma unroll
                for (int mm = 0; mm < 2; ++mm)
#pragma unroll
                    for (int bj = 0; bj < 2; ++bj) {
                        const size_t off = (size_t)(u.pm * 256 + ai * 128 + wr * 64 + (2 * mp + mm) * 16 + fr) * DM + u.pn * 256 + bj * 128 + wc * 32 + 8 * fq;
                        bs[mm][bj][0] = *(const f32x4*)(base + off); bs[mm][bj][1] = *(const f32x4*)(base + off + 4);
                    }
#pragma unroll
                for (int mm = 0; mm < 2; ++mm) {
                    const int m = 2 * mp + mm;
                    const int row = u.pm * 256 + ai * 128 + wr * 64 + m * 16 + fr;
                    float sq = 0.f;
#pragma unroll
                    for (int bj = 0; bj < 2; ++bj) {
                        const size_t off = (size_t)row * DM + u.pn * 256 + bj * 128 + wc * 32 + 8 * fq;
                        const f32x4 h0 = bs[mm][bj][0] + acc[ai][bj][m][0], h1 = bs[mm][bj][1] + acc[ai][bj][m][1];
                        u32x4 w; w[0] = pk2(h0[0], h0[1]); w[1] = pk2(h0[2], h0[3]); w[2] = pk2(h1[0], h1[1]); w[3] = pk2(h1[2], h1[3]);
                        *(u32x4*)(HB + off) = w;
                        sq += (h0[0] * h0[0] + h0[1] * h0[1]) + (h0[2] * h0[2] + h0[3] * h0[3]) + (h1[0] * h1[0] + h1[1] * h1[1]) + (h1[2] * h1[2] + h1[3] * h1[3]);
                    }
                    sq += shx(sq, 16, lane); sq += shx(sq, 32, lane);
                    if (fq == 0) ss[(size_t)row * 16 + u.pn * 4 + wc] = sq;
                }
                asm volatile("" ::: "memory");
            }
    }
};

struct EpiGate {
    static constexpr bool PERM = true, AFTER_DRAIN = false; static constexpr int MID_T = 0;
    float* out; const bf16_t* H1; const bf16_t* EB; bf16_t* HB; const float* ss_in; float* ss_out; int dummy;
    __device__ __forceinline__ void operator()(const f32x4 (&acc)[2][2][4][2], const pg8::Unit& u, int, int, int, int) const {
        int t_ = threadIdx.x; asm volatile("" : "+v"(t_));
        const int lane = t_ & 63, fr = lane & 15, fq = lane >> 4, wid_ = __builtin_amdgcn_readfirstlane(t_ >> 6), wr = wid_ >> 2, wc = wid_ & 3;
        f32x4 pp[2][4];
#pragma unroll
        for (int ai = 0; ai < 2; ++ai)
#pragma unroll
            for (int m = 0; m < 4; ++m) pp[ai][m] = *(const f32x4*)(ss_in + (size_t)(u.pm * 256 + ai * 128 + wr * 64 + m * 16 + fr) * 16 + fq * 4);
        float rsv[2][4];
#pragma unroll
        for (int ai = 0; ai < 2; ++ai)
#pragma unroll
            for (int m = 0; m < 4; ++m) {
                float s_ = (pp[ai][m][0] + pp[ai][m][1]) + (pp[ai][m][2] + pp[ai][m][3]);
                s_ += shx(s_, 16, lane); s_ += shx(s_, 32, lane);
                rsv[ai][m] = frsq(s_ * (1.0f / DM) + EPS);
            }
        asm volatile("" ::: "memory");
#pragma unroll
        for (int ai = 0; ai < 2; ++ai)
#pragma unroll
            for (int mp = 0; mp < 2; ++mp) {
                u32x4 bs[2][2], es[2][2];
#pragma unroll
                for (int mm = 0; mm < 2; ++mm)
#pragma unroll
                    for (int bj = 0; bj < 2; ++bj) {
                        const size_t off = (size_t)(u.pm * 256 + ai * 128 + wr * 64 + (2 * mp + mm) * 16 + fr) * DM + u.pn * 256 + bj * 128 + wc * 32 + 8 * fq;
                        bs[mm][bj] = *(const u32x4*)(H1 + off); es[mm][bj] = *(const u32x4*)(EB + off);
                    }
#pragma unroll
                for (int mm = 0; mm < 2; ++mm) {
                    const int m = 2 * mp + mm;
                    const int row = u.pm * 256 + ai * 128 + wr * 64 + m * 16 + fr;
                    const float rs = rsv[ai][m];
                    float sq = 0.f;
#pragma unroll
                    for (int bj = 0; bj < 2; ++bj) {
                        const size_t off = (size_t)row * DM + u.pn * 256 + bj * 128 + wc * 32 + 8 * fq;
                        const f32x4 a0 = acc[ai][bj][m][0] * rs, a1 = acc[ai][bj][m][1] * rs;
                        const u32x4 e = es[mm][bj]; const u32x4 r1 = bs[mm][bj];
                        f32x4 h0 = {bflo(r1[0]), bfhi(r1[0]), bflo(r1[1]), bfhi(r1[1])}, h1 = {bflo(r1[2]), bfhi(r1[2]), bflo(r1[3]), bfhi(r1[3])};
                        h0[0] += bflo(e[0]) * sigmoidf_(a0[0]); h0[1] += bfhi(e[0]) * sigmoidf_(a0[1]); h0[2] += bflo(e[1]) * sigmoidf_(a0[2]); h0[3] += bfhi(e[1]) * sigmoidf_(a0[3]);
                        h1[0] += bflo(e[2]) * sigmoidf_(a1[0]); h1[1] += bfhi(e[2]) * sigmoidf_(a1[1]); h1[2] += bflo(e[3]) * sigmoidf_(a1[2]); h1[3] += bfhi(e[3]) * sigmoidf_(a1[3]);
                        *(f32x4*)(out + off) = h0; *(f32x4*)(out + off + 4) = h1;
                        u32x4 w; w[0] = pk2(h0[0], h0[1]); w[1] = pk2(h0[2], h0[3]); w[2] = pk2(h1[0], h1[1]); w[3] = pk2(h1[2], h1[3]);
                        *(u32x4*)(HB + off) = w;
                        sq += (h0[0] * h0[0] + h0[1] * h0[1]) + (h0[2] * h0[2] + h0[3] * h0[3]) + (h1[0] * h1[0] + h1[1] * h1[1]) + (h1[2] * h1[2] + h1[3] * h1[3]);
                    }
                    sq += shx(sq, 16, lane); sq += shx(sq, 32, lane);
                    if (fq == 0) ss_out[(size_t)row * 16 + u.pn * 4 + wc] = sq;
                }
                asm volatile("" ::: "memory");
            }
    }
};

struct SubOrder {
    int nN, nwg, nb, c;
    __device__ void init(int M, int N, int nb_, int c_) { nN = N / 256; nwg = (M / 256) * nN; nb = nb_; c = c_; }
    __device__ bool next(int i, pg8::Unit& u) const { if (c < 0 || c >= nb) return false; const int L = i * nb + c; if (L >= nwg) return false; u.pm = L / nN; u.pn = L % nN; return true; }
    __device__ __forceinline__ void a_ready(const pg8::Unit&) const {}
    __device__ __forceinline__ void done(const pg8::Unit&) const {}
};

template <bool REMAP>
__device__ __forceinline__ void tr_item(const float* W, int K, int N, bf16_t* WT, const float* g, LAS float* scr, int item, int lane, int kshift = 0) {
    const int nblk = N / 32, kb = item / nblk, nb = item % nblk, k0 = 64 * kb, n0 = 32 * nb;
    int src = n0 + (lane & 31);
    if (REMAP) { if (src >= 2048 && src < 3072) { const int jj = src - 2048; src = (jj & 1) ? 2560 + (jj >> 1) : 2048 + (jj >> 1); } }
    float wv[32];
#pragma unroll
    for (int i = 0; i < 32; ++i) { const int kk = 2 * i + (lane >> 5); wv[i] = W[(size_t)((k0 + kk + kshift) & (K - 1)) * N + src]; }
#pragma unroll
    for (int i = 0; i < 32; ++i) { const int kk = 2 * i + (lane >> 5); float v = wv[i]; if (g) v *= g[k0 + kk]; scr[kk * 33 + (lane & 31)] = v; }
    asm volatile("s_waitcnt lgkmcnt(0)" ::: "memory");
    const int c = lane & 7;
#pragma unroll
    for (int j = 0; j < 4; ++j) { const int n = (lane >> 3) + 8 * j; const LAS float* s = scr + (8 * c) * 33 + n;
        u32x4 o; o[0] = pk2(s[0 * 33], s[1 * 33]); o[1] = pk2(s[2 * 33], s[3 * 33]); o[2] = pk2(s[4 * 33], s[5 * 33]); o[3] = pk2(s[6 * 33], s[7 * 33]);
        *(u32x4*)(WT + (size_t)(n0 + n) * K + k0 + 8 * c) = o; }
    asm volatile("s_waitcnt lgkmcnt(0)" ::: "memory");
}

constexpr int AK_STRIDE = 144, AV_STRIDE = 136, A_KBYTES = 64 * AK_STRIDE, A_VBYTES = 64 * AV_STRIDE, A_BUF = 18432;
static_assert(A_KBYTES + A_VBYTES <= A_BUF, "attention LDS buffer");

__device__ __forceinline__ void attn_unit(const bf16_t* U, const bf16_t* VT, bf16_t* Y, const float* aog, int b, int h, int qb, LAS unsigned char* lds) {
    int tid = threadIdx.x; asm volatile("" : "+v"(tid));
    const int wave = __builtin_amdgcn_readfirstlane(tid >> 6), lane = tid & 63, l31 = lane & 31, hi = lane >> 5;
    const int q0 = qb * 256 + wave * 32, t = q0 + l31;
    const size_t trow = (size_t)(b * SEQ + t);
    bf16x8 qf[4];
    {
        const bf16_t* qp = U + trow * UP + UQ + h * HD + 8 * hi;
#pragma unroll
        for (int s = 0; s < 4; ++s) qf[s] = *(const bf16x8*)(qp + 16 * s);
    }
    f32x16 o0, o1;
#pragma unroll
    for (int i = 0; i < 16; ++i) { o0[i] = 0.f; o1[i] = 0.f; }
    float C = 1.f;
    const int ktmax = 4 * qb + 3, wkt = (q0 + 30) >> 6;
    const int srow = tid >> 3, sch = tid & 7;
    const bf16_t* gk = U + (size_t)(b * SEQ + srow) * UP + UK + h * HD + sch * 8;
    const bf16_t* gv = VT + ((size_t)((b * NH + h) * HD + srow)) * SEQ + sch * 8;
    const int kwoff = srow * AK_STRIDE + sch * 16, vwoff = A_KBYTES + srow * AV_STRIDE + sch * 16;
    __syncthreads();
    {
        const u32x4 kr = *(const u32x4*)(gk + (size_t)ktmax * 64 * UP), vr = *(const u32x4*)(gv + ktmax * 64);
        *(LAS u32x4*)(lds + kwoff) = kr;
        u32x2 a = {vr[0], vr[1]}, c = {vr[2], vr[3]};
        *(LAS u32x2*)(lds + vwoff) = a; *(LAS u32x2*)(lds + vwoff + 8) = c;
    }
    __syncthreads();
    int cur = 0;
    LAS unsigned* dflag = (LAS unsigned*)(lds + 2 * A_BUF);
    bool wdone = false;
    for (int kt = ktmax; kt >= 0; --kt) {
        u32x4 kr = {0u, 0u, 0u, 0u}, vr = {0u, 0u, 0u, 0u};
        if (kt > 0) { kr = *(const u32x4*)(gk + (size_t)(kt - 1) * 64 * UP); vr = *(const u32x4*)(gv + (kt - 1) * 64); }
        if (kt <= wkt && !wdone) {
            const LAS unsigned char* kb = lds + cur * A_BUF;
            const LAS unsigned char* vb = kb + A_KBYTES;
            f32x16 p0, p1;
#pragma unroll
            for (int i = 0; i < 16; ++i) { p0[i] = 0.f; p1[i] = 0.f; }
#pragma unroll
            for (int s = 0; s < 4; ++s) {
                const bf16x8 ka = *(const LAS bf16x8*)(kb + l31 * AK_STRIDE + 32 * s + 16 * hi);
                const bf16x8 kc = *(const LAS bf16x8*)(kb + (32 + l31) * AK_STRIDE + 32 * s + 16 * hi);
                p0 = MFMA32(ka, qf[s], p0); p1 = MFMA32(kc, qf[s], p1);
            }
            const int lim0 = t - (64 * kt + 4 * hi), lim1 = lim0 - 32;
            const bool diag = (64 * kt + 63 >= q0);
            f32x16 m0, m1;
            float G0[4], G1[4];
#pragma unroll
            for (int g = 0; g < 4; ++g) {
                float s0 = 1.f, s1 = 1.f;
#pragma unroll
                for (int i = 0; i < 4; ++i) {
                    const int r = 4 * g + i, cr = i + 8 * g;
                    const float e0 = fexp2(fminf(p0[r], 100.f)), e1 = fexp2(fminf(p1[r], 100.f));
                    float r0 = frcp(1.0f + e0), r1 = frcp(1.0f + e1);
                    float b0 = e0 * r0, b1 = e1 * r1;
                    if (diag) { const bool v0 = cr < lim0, v1 = cr < lim1; r0 = v0 ? r0 : 1.f; b0 = v0 ? b0 : 0.f; r1 = v1 ? r1 : 1.f; b1 = v1 ? b1 : 0.f; }
                    m0[r] = r0; m1[r] = r1; p0[r] = b0; p1[r] = b1; s0 *= r0; s1 *= r1;
                }
                G0[g] = s0; G1[g] = s1;
            }
            float X0[4], X1[4];
#pragma unroll
            for (int g = 0; g < 4; ++g) { X0[g] = shx(G0[g], 32, lane); X1[g] = shx(G1[g], 32, lane); }
            float run = C;
#pragma unroll
            for (int g = 3; g >= 0; --g) {
                float a = hi == 0 ? run * X1[g] : run;
#pragma unroll
                for (int i = 3; i >= 0; --i) { const int r = 4 * g + i; const float w = a * p1[r]; a *= m1[r]; p1[r] = w; }
                run *= G1[g] * X1[g];
            }
#pragma unroll
            for (int g = 3; g >= 0; --g) {
                float a = hi == 0 ? run * X0[g] : run;
#pragma unroll
                for (int i = 3; i >= 0; --i) { const int r = 4 * g + i; const float w = a * p0[r]; a *= m0[r]; p0[r] = w; }
                run *= G0[g] * X0[g];
            }
            C = run;
#pragma unroll
            for (int kh = 0; kh < 2; ++kh)
#pragma unroll
                for (int sh = 0; sh < 2; ++sh) {
                    u32x4 xw;
                    if (kh == 0) { xw[0] = pk2(p0[8 * sh + 0], p0[8 * sh + 1]); xw[1] = pk2(p0[8 * sh + 2], p0[8 * sh + 3]); xw[2] = pk2(p0[8 * sh + 4], p0[8 * sh + 5]); xw[3] = pk2(p0[8 * sh + 6], p0[8 * sh + 7]); }
                    else         { xw[0] = pk2(p1[8 * sh + 0], p1[8 * sh + 1]); xw[1] = pk2(p1[8 * sh + 2], p1[8 * sh + 3]); xw[2] = pk2(p1[8 * sh + 4], p1[8 * sh + 5]); xw[3] = pk2(p1[8 * sh + 6], p1[8 * sh + 7]); }
                    const bf16x8 xf = __builtin_bit_cast(bf16x8, xw);
                    const int koff = 2 * (32 * kh + 16 * sh + 4 * hi);
                    {
                        const LAS unsigned char* vp = vb + l31 * AV_STRIDE + koff;
                        const u32x2 lo = *(const LAS u32x2*)vp, hh = *(const LAS u32x2*)(vp + 16);
                        u32x4 vw = {lo[0], lo[1], hh[0], hh[1]};
                        o0 = MFMA32(__builtin_bit_cast(bf16x8, vw), xf, o0);
                    }
                    {
                        const LAS unsigned char* vp = vb + (32 + l31) * AV_STRIDE + koff;
                        const u32x2 lo = *(const LAS u32x2*)vp, hh = *(const LAS u32x2*)(vp + 16);
                        u32x4 vw = {lo[0], lo[1], hh[0], hh[1]};
                        o1 = MFMA32(__builtin_bit_cast(bf16x8, vw), xf, o1);
                    }
                }
        }
        wdone = (__builtin_amdgcn_ballot_w64(C > 7.5e-37f) == 0ull);
        if (lane == 0) dflag[(kt & 1) * 8 + wave] = wdone ? 1u : 0u;
        if (kt > 0) {
            LAS unsigned char* nb = lds + (cur ^ 1) * A_BUF;
            *(LAS u32x4*)(nb + kwoff) = kr;
            u32x2 a = {vr[0], vr[1]}, c = {vr[2], vr[3]};
            *(LAS u32x2*)(nb + vwoff) = a; *(LAS u32x2*)(nb + vwoff + 8) = c;
        }
        __syncthreads();
        cur ^= 1;
        {
            const LAS u32x4* df = (const LAS u32x4*)(dflag + (kt & 1) * 8);
            const u32x4 f0 = df[0], f1 = df[1];
            if ((f0[0] & f0[1] & f0[2] & f0[3] & f1[0] & f1[1] & f1[2] & f1[3]) != 0u) break;
        }
    }
    float sq = 0.f;
#pragma unroll
    for (int i = 0; i < 16; ++i) sq += o0[i] * o0[i] + o1[i] * o1[i];
    sq += shx(sq, 32, lane);
    const float rs = frsq(sq * (1.0f / HD) + EPS);
    const bf16_t* sgp = U + trow * UP + USGA + h * HD;
    bf16_t* yp = Y + trow * DM + 512 + h * HD;
#pragma unroll
    for (int dt = 0; dt < 2; ++dt)
#pragma unroll
        for (int g = 0; g < 4; ++g) {
            const int d0 = 32 * dt + 8 * g + 4 * hi;
            const f32x4 gn = *(const f32x4*)(aog + d0);
            const u32x2 sg = *(const u32x2*)(sgp + d0);
            float v0, v1, v2, v3;
            if (dt == 0) { v0 = o0[4 * g + 0]; v1 = o0[4 * g + 1]; v2 = o0[4 * g + 2]; v3 = o0[4 * g + 3]; }
            else         { v0 = o1[4 * g + 0]; v1 = o1[4 * g + 1]; v2 = o1[4 * g + 2]; v3 = o1[4 * g + 3]; }
            u32x2 w;
            w[0] = pk2(v0 * rs * gn[0] * bflo(sg[0]), v1 * rs * gn[1] * bfhi(sg[0]));
            w[1] = pk2(v2 * rs * gn[2] * bflo(sg[1]), v3 * rs * gn[3] * bfhi(sg[1]));
            *(u32x2*)(yp + d0) = w;
        }
}

constexpr int CT = 32, C_XH = 0, C_XH_BYTES = (CT + 30) * 1024, C_CO = C_XH_BYTES, C_CO_BYTES = CT * CD * 4;
static_assert(C_CO + C_CO_BYTES <= LDS_BYTES, "conv LDS map");

__device__ __forceinline__ void convpre_unit(const bf16_t* U, bf16_t* C2, const float* dww, const float* dwb, const float* lng, const float* lnb, int cu, LAS unsigned char* lds) {
    int tid = threadIdx.x; asm volatile("" : "+v"(tid));
    const int wave = __builtin_amdgcn_readfirstlane(tid >> 6), lane = tid & 63;
    const int r0 = cu * CT, b = r0 >> 11, s0 = r0 & 2047;
    __syncthreads();
    for (int i = tid; i < (CT + 30) * 64; i += 512) {
        const int row = i >> 6, ch = i & 63, s = s0 - 30 + row;
        u32x4 v = {0u, 0u, 0u, 0u};
        if (s >= 0) v = *(const u32x4*)(U + (size_t)(b * SEQ + s) * UP + UGLU + ch * 8);
        *(LAS u32x4*)(lds + C_XH + row * 1024 + ch * 16) = v;
    }
    __syncthreads();
    {
        const int chp = tid & 255, tg = tid >> 8;
        f32x2 w2[CWID];
#pragma unroll
        for (int j = 0; j < CWID; ++j) w2[j] = *(const f32x2*)(dww + (size_t)j * CD + 2 * chp);
        const f32x2 bias = *(const f32x2*)(dwb + 2 * chp);
        const LAS unsigned char* xp = lds + C_XH + (tg * 16) * 1024 + chp * 4;
        f32x2 xv[16 + CWID - 1];
#pragma unroll
        for (int i = 0; i < 16 + CWID - 1; ++i) { const unsigned xu = *(const LAS unsigned*)(xp + i * 1024); f32x2 t2 = {bflo(xu), bfhi(xu)}; xv[i] = t2; }
#pragma unroll
        for (int tt = 0; tt < 16; ++tt) {
            f32x2 a = bias;
#pragma unroll
            for (int j = 0; j < CWID; ++j) a = a + w2[j] * xv[tt + j];
            *(LAS f32x2*)(lds + C_CO + (tg * 16 + tt) * 2048 + chp * 8) = a;
        }
    }
    __syncthreads();
    {
        const f32x4 g0 = *(const f32x4*)(lng + lane * 4), g1 = *(const f32x4*)(lng + 256 + lane * 4);
        const f32x4 b0 = *(const f32x4*)(lnb + lane * 4), b1 = *(const f32x4*)(lnb + 256 + lane * 4);
#pragma unroll
        for (int tt = 0; tt < 4; ++tt) {
            const int tl = wave * 4 + tt;
            f32x4 v0 = *(const LAS f32x4*)(lds + C_CO + tl * 2048 + lane * 16), v1 = *(const LAS f32x4*)(lds + C_CO + tl * 2048 + 1024 + lane * 16);
            const float mean = wave_sum((v0[0] + v0[1]) + (v0[2] + v0[3]) + (v1[0] + v1[1]) + (v1[2] + v1[3]), lane) * (1.0f / CD);
            v0 = v0 - mean; v1 = v1 - mean;
            const float var = wave_sum((v0[0] * v0[0] + v0[1] * v0[1]) + (v0[2] * v0[2] + v0[3] * v0[3]) + (v1[0] * v1[0] + v1[1] * v1[1]) + (v1[2] * v1[2] + v1[3] * v1[3]), lane) * (1.0f / CD);
            const float rs = frsq(var + EPS);
            v0 = v0 * rs * g0 + b0; v1 = v1 * rs * g1 + b1;
            u32x2 wa, wb;
            wa[0] = pk2(siluf_(v0[0]), siluf_(v0[1])); wa[1] = pk2(siluf_(v0[2]), siluf_(v0[3]));
            wb[0] = pk2(siluf_(v1[0]), siluf_(v1[1])); wb[1] = pk2(siluf_(v1[2]), siluf_(v1[3]));
            bf16_t* cp = C2 + (size_t)(r0 + tl) * CD + lane * 4;
            *(u32x2*)cp = wa; *(u32x2*)(cp + 256) = wb;
        }
    }
}

#define XB_TMO      128
#define XB_XCNT(j)  (256  + 64 * (j))
#define XB_XSUB(j)  (1280 + 64 * (j))
#define XB_XGEN(j)  (2304 + 64 * (j))
#define XB_TOP      3328
#define XB_TOPGEN   3392
#define XCD_BAR_WORDS 3456
#define XB_SPIN_CAP (1u << 18)

__device__ __forceinline__ unsigned xb_ld(unsigned* p)              { return __hip_atomic_load(p, __ATOMIC_RELAXED, __HIP_MEMORY_SCOPE_AGENT); }
__device__ __forceinline__ unsigned xb_add(unsigned* p, unsigned v) { return __hip_atomic_fetch_add(p, v, __ATOMIC_RELAXED, __HIP_MEMORY_SCOPE_AGENT); }
__device__ __forceinline__ unsigned xb_xcc_id() { return (unsigned)__builtin_amdgcn_s_getreg((3 << 11) | 20) & 0xFu; }
#define XB_SPIN(cond, bar) do { unsigned _sp = 0; while (cond) { __builtin_amdgcn_s_sleep(1); \
    if ((++_sp & 255u) == 0u) { if (xb_ld(&(bar)[XB_TMO])) break; if (_sp > XB_SPIN_CAP) { atomicAdd(&(bar)[XB_TMO], 1u); break; } } } } while (0)

struct XcdBarrier {
    unsigned* bar; unsigned x;
    volatile LAS unsigned* st;
};

__device__ __forceinline__ XcdBarrier xcd_barrier_post(unsigned* bar, volatile LAS unsigned* st) {
    XcdBarrier b; b.bar = bar; b.x = xb_xcc_id(); b.st = st;
    if (threadIdx.x == 0) (void)xb_add(&bar[XB_XCNT(b.x)], 1u);
    return b;
}
__device__ __forceinline__ void xcd_barrier_complete(unsigned* bar, unsigned x, unsigned& nloc, unsigned& nx) {
    const unsigned G = gridDim.x * gridDim.y * gridDim.z;
    unsigned sum, cnt, mine, sp = 0u;
    for (;;) {
        sum = 0u; cnt = 0u; mine = 0u;
#pragma unroll
        for (unsigned j = 0; j < 16; ++j) { const unsigned c = xb_ld(&bar[XB_XCNT(j)]); sum += c; cnt += (c > 0u) ? 1u : 0u; mine = (j == x) ? c : mine; }
        if (sum == G) break;
        __builtin_amdgcn_s_sleep(1);
        if ((++sp & 255u) == 0u) { if (xb_ld(&bar[XB_TMO])) break; if (sp > XB_SPIN_CAP) { atomicAdd(&bar[XB_TMO], 1u); break; } }
    }
    nloc = mine > 0u ? mine : 1u; nx = cnt > 0u ? cnt : 1u;
}

__device__ __forceinline__ void xcd_barrier(const XcdBarrier& b) {
    asm volatile("s_waitcnt vmcnt(0)" ::: "memory");
    __syncthreads();
    if (threadIdx.x == 0) {
        unsigned* bar = b.bar;
        __builtin_amdgcn_s_waitcnt(0);
        unsigned nloc = b.st[0], nx = b.st[1];
        if (nloc == 0u) { xcd_barrier_complete(bar, b.x, nloc, nx); b.st[0] = nloc; b.st[1] = nx; }
        const unsigned old = xb_add(&bar[XB_XSUB(b.x)], 1u);
        const unsigned gen = old / nloc;
        if (old + 1u == (gen + 1u) * nloc) {
            __builtin_amdgcn_fence(__ATOMIC_RELEASE, "agent");
            asm volatile("s_waitcnt vmcnt(0)" ::: "memory");
            const unsigned og = xb_add(&bar[XB_TOP], 1u);
            const unsigned tg = og / nx;
            if (og + 1u == (tg + 1u) * nx) xb_add(&bar[XB_TOPGEN], 1u);
            else XB_SPIN(xb_ld(&bar[XB_TOPGEN]) == tg, bar);
            __builtin_amdgcn_fence(__ATOMIC_ACQUIRE, "agent");
            xb_add(&bar[XB_XGEN(b.x)], 1u);
            asm volatile("s_waitcnt vmcnt(0)" ::: "memory");
        } else {
            XB_SPIN(xb_ld(&bar[XB_XGEN(b.x)]) == gen, bar);
            __builtin_amdgcn_fence(__ATOMIC_ACQUIRE, "agent");
            asm volatile("s_waitcnt vmcnt(0)" ::: "memory");
        }
    }
    __syncthreads();
}

struct Params { const float* in[16]; float* out; unsigned char* ws; int ph_lo, ph_hi; };

template <int ph>
__device__ __forceinline__ void run_phase(const Params& P, LAS unsigned char* lds) {
    const int G = gridDim.x, bid = blockIdx.x;
    unsigned char* ws = P.ws;
    const float* x = P.in[0];
    float* out = P.out;
    bf16_t* HB = (bf16_t*)(ws + WS_HB); bf16_t* H1B = (bf16_t*)(ws + WS_H1B); bf16_t* Ub = (bf16_t*)(ws + WS_U); bf16_t* VT = (bf16_t*)(ws + WS_VT); bf16_t* Yb = (bf16_t*)(ws + WS_Y);
    bf16_t* C2 = (bf16_t*)(ws + WS_C2); bf16_t* EB = (bf16_t*)(ws + WS_EB);
    float* ssA = (float*)(ws + WS_SSA); float* ssB = (float*)(ws + WS_SSB); float* ssC = (float*)(ws + WS_SSC);
    int tid = threadIdx.x; asm volatile("" : "+v"(tid));
    const int lane = tid & 63, wave = __builtin_amdgcn_readfirstlane(tid >> 6);
    const int gw = bid * 8 + wave, NGW = G * 8;
    if constexpr (ph == 0) {
        LAS float* scr = (LAS float*)(lds + wave * 16384);
        for (int it = gw; it < 2 * 3072; it += NGW) {
            const int l = it / 3072; int r = it - l * 3072;
            unsigned char* wb = ws + (size_t)l * W_LAYER;
            if (r < 1792) { tr_item<true>(P.in[3] + (size_t)l * DM * DIN, DM, DIN, (bf16_t*)(wb + W_IN), P.in[2] + l * DM, scr, r, lane); continue; } r -= 1792;
            if (r < 128) { tr_item<false>(P.in[9] + (size_t)l * CD * CD, CD, CD, (bf16_t*)(wb + W_PW), nullptr, scr, r, lane); continue; } r -= 128;
            if (r < 512) { tr_item<false>(P.in[11] + (size_t)l * DM * DM, DM, DM, (bf16_t*)(wb + W_OUT), nullptr, scr, r, lane, 512); continue; } r -= 512;
            if (r < 512) { tr_item<false>(P.in[13] + (size_t)l * DM * DM, DM, DM, (bf16_t*)(wb + W_PG), P.in[12] + l * DM, scr, r, lane); continue; } r -= 512;
            tr_item<false>(P.in[14] + (size_t)l * PLE * DM, PLE, DM, (bf16_t*)(wb + W_PLE), nullptr, scr, r, lane);
        }
        for (int row = gw; row < MT; row += 2 * NGW) {
            const int row2 = row + NGW;
            const f32x4* xr = (const f32x4*)(x + (size_t)row * DM) + lane;
            const f32x4* xr2 = (const f32x4*)(x + (size_t)(row2 < MT ? row2 : row) * DM) + lane;
            f32x4 va[4], vb[4];
#pragma unroll
            for (int j = 0; j < 4; ++j) { va[j] = xr[64 * j]; vb[j] = xr2[64 * j]; }
            u32x2* ob = (u32x2*)(HB + (size_t)row * DM) + lane;
            float s = 0.f, s2 = 0.f;
#pragma unroll
            for (int j = 0; j < 4; ++j) { const f32x4 v = va[j]; s += (v[0] * v[0] + v[1] * v[1]) + (v[2] * v[2] + v[3] * v[3]); u32x2 w; w[0] = pk2(v[0], v[1]); w[1] = pk2(v[2], v[3]); ob[64 * j] = w; }
            s = wave_sum(s, lane);
            if (lane < 16) ssA[(size_t)row * 16 + lane] = (lane == 0) ? s : 0.f;
            if (row2 < MT) {
                u32x2* ob2 = (u32x2*)(HB + (size_t)row2 * DM) + lane;
#pragma unroll
                for (int j = 0; j < 4; ++j) { const f32x4 v = vb[j]; s2 += (v[0] * v[0] + v[1] * v[1]) + (v[2] * v[2] + v[3] * v[3]); u32x2 w; w[0] = pk2(v[0], v[1]); w[1] = pk2(v[2], v[3]); ob2[64 * j] = w; }
                s2 = wave_sum(s2, lane);
                if (lane < 16) ssA[(size_t)row2 * 16 + lane] = (lane == 0) ? s2 : 0.f;
            }
        }
        {
            const f32x4* pp = (const f32x4*)P.in[1]; u32x2* pb = (u32x2*)(ws + WS_PB);
            const int NV = 2 * MT * PLE / 4, stp = G * 512;
            for (int i = bid * 512 + tid; i < NV; i += 4 * stp) {
                f32x4 v[4];
#pragma unroll
                for (int j = 0; j < 4; ++j) { const int ii = i + j * stp; v[j] = pp[ii < NV ? ii : i]; }
#pragma unroll
                for (int j = 0; j < 4; ++j) { const int ii = i + j * stp; if (ii < NV) { u32x2 w; w[0] = pk2(v[j][0], v[j][1]); w[1] = pk2(v[j][2], v[j][3]); pb[ii] = w; } }
            }
        }
    } else if constexpr (ph == NPHASE - 1) {
        const float* fg = P.in[15];
        for (int row = gw; row < MT; row += 2 * NGW) {
            const int row2 = row + NGW; const bool has2 = row2 < MT;
            f32x4* xr = (f32x4*)(out + (size_t)row * DM) + lane;
            f32x4* xr2 = (f32x4*)(out + (size_t)(has2 ? row2 : row) * DM) + lane;
            f32x4 v[4], v2[4], gg[4]; float s = 0.f, s2 = 0.f;
#pragma unroll
            for (int j = 0; j < 4; ++j) { v[j] = xr[64 * j]; v2[j] = xr2[64 * j]; gg[j] = *((const f32x4*)fg + lane + 64 * j); }
#pragma unroll
            for (int j = 0; j < 4; ++j) { s += (v[j][0] * v[j][0] + v[j][1] * v[j][1]) + (v[j][2] * v[j][2] + v[j][3] * v[j][3]); s2 += (v2[j][0] * v2[j][0] + v2[j][1] * v2[j][1]) + (v2[j][2] * v2[j][2] + v2[j][3] * v2[j][3]); }
            const float rs = frsq(wave_sum(s, lane) * (1.0f / DM) + EPS), rs2 = frsq(wave_sum(s2, lane) * (1.0f / DM) + EPS);
#pragma unroll
            for (int j = 0; j < 4; ++j) xr[64 * j] = v[j] * rs * gg[j];
            if (has2) {
#pragma unroll
                for (int j = 0; j < 4; ++j) xr2[64 * j] = v2[j] * rs2 * gg[j];
            }
        }
    } else {
        constexpr int l = (ph - 1) / 5, k = (ph - 1) % 5;
        unsigned char* wb = ws + (size_t)l * W_LAYER;
        if constexpr (k == 0) {
            pg8::Gemm g{HB, (const bf16_t*)(wb + W_IN), MT, DIN, DM}; pg8::StaticOrder S; S.init(MT, DIN, G, bid);
            EpiIn E{Ub, VT, ssA};
            pg8::gemm_phase<EpiIn, pg8::StaticOrder, true, true>(lds, g, S, E, threadIdx.x);
        } else if constexpr (k == 1) {
            const float* aog = P.in[4] + l * HD;
            const float* dww = P.in[5] + (size_t)l * CWID * CD; const float* dwb = P.in[6] + l * CD;
            const float* lng = P.in[7] + l * CD; const float* lnb = P.in[8] + l * CD;
            for (int it = bid; it < 256; it += G) {
                const int bh = it >> 2, pr = it & 3, b = bh >> 3, h = bh & 7;
#pragma unroll 1
                for (int uu = 0; uu < ((PROBE_DUP & 2) ? 4 : 2); ++uu) attn_unit(Ub, VT, Yb, aog, b, h, (uu & 1) == 0 ? 7 - pr : pr, lds);
#pragma unroll 1
                for (int uu = 0; uu < ((PROBE_DUP & 4) ? 4 : 2); ++uu) convpre_unit(Ub, C2, dww, dwb, lng, lnb, 2 * it + (uu & 1), lds);
            }
            __syncthreads();
        } else if constexpr (k == 2) {
            const int nb0 = G / 2;
            {
                pg8::Gemm g{C2, (const bf16_t*)(wb + W_PW), MT, CD, CD}; SubOrder S; S.init(MT, CD, nb0, bid);
                EpiPw E{Ub, Yb, P.in[10] + l * CD, ssC};
                pg8::gemm_phase<EpiPw, SubOrder, true, true>(lds, g, S, E, threadIdx.x);
            }
            {
                pg8::Gemm g{(const bf16_t*)(ws + WS_PB) + (size_t)l * MT * PLE, (const bf16_t*)(wb + W_PLE), MT, DM, PLE}; SubOrder S; S.init(MT, DM, G - nb0, bid - nb0);
                EpiE E{EB};
                int t2 = threadIdx.x; asm volatile("" : "+v"(t2));
                pg8::gemm_phase<EpiE, SubOrder, true, true>(lds, g, S, E, t2);
            }
        } else if constexpr (k == 3) {
            pg8::Gemm g{Yb, (const bf16_t*)(wb + W_OUT), MT, DM, DM}; pg8::StaticOrder S; S.init(MT, DM, G, bid);
            EpiOut E{l == 0 ? x : out, out, H1B, ssB, ssC};
            pg8::gemm_phase<EpiOut, pg8::StaticOrder, true, true>(lds, g, S, E, threadIdx.x);
        } else {
            pg8::Gemm g{H1B, (const bf16_t*)(wb + W_PG), MT, DM, DM}; pg8::StaticOrder S; S.init(MT, DM, G, bid);
            if constexpr ((PROBE_DUP & 128) != 0) { EpiGate E0{out, H1B, EB, HB, ssB, ssA, 1}; int t3 = threadIdx.x; asm volatile("" : "+v"(t3)); pg8::gemm_phase<EpiGate, pg8::StaticOrder, true, true>(lds, g, S, E0, t3); __syncthreads(); }
            EpiGate E{out, H1B, EB, HB, ssB, ssA, 0};
            pg8::gemm_phase<EpiGate, pg8::StaticOrder, true, true>(lds, g, S, E, threadIdx.x);
        }
    }
}

__global__ void __launch_bounds__(512, 2) fwd(Params P) {
    extern __shared__ __attribute__((aligned(16))) unsigned char lds_raw[];
    LAS unsigned char* lds = (LAS unsigned char*)lds_raw;
    const int lo = P.ph_lo, hi = P.ph_hi;
    volatile LAS unsigned* st = (volatile LAS unsigned*)(lds + LDS_BYTES - 64);
    if (threadIdx.x < 16) st[threadIdx.x] = 0u;
    __syncthreads();
    const XcdBarrier bar = xcd_barrier_post((unsigned*)(P.ws + WS_CTL), st);
#define PROBE_PH(k) ((((PROBE_DUP) & 8) && (k) == 0) || (((PROBE_DUP) & 1) && (k) == 1) || (((PROBE_DUP) & 32) && ((k) == 3 || (k) == 8)) || (((PROBE_DUP) & 16) && (k) == 4))
#define SEAM() do { if (hi > NPHASE) cg::this_grid().sync(); else xcd_barrier(bar); } while (0)
#define PHASE(k) if (lo <= (k) && (k) < hi) { run_phase<(k)>(P, lds); if constexpr (PROBE_PH(k)) { __syncthreads(); run_phase<(k)>(P, lds); } \
        if constexpr (((PROBE_DUP) & 64) != 0) { SEAM(); } if ((k) + 1 < hi) SEAM(); }
    PHASE(0) PHASE(1) PHASE(2) PHASE(3) PHASE(4) PHASE(5) PHASE(6) PHASE(7) PHASE(8) PHASE(9) PHASE(10) PHASE(11)
#undef PHASE
#undef SEAM
}

#ifndef MK_N_LAUNCHES
#define MK_N_LAUNCHES 1
#endif
extern "C" void kernel_launch(void* const* d_in, const int* in_sizes, int n_in, void* d_out, int out_size, void* d_ws, size_t ws_size, hipStream_t stream) {
    static int grid = 0;
    if (grid == 0) {
        if (n_in != 16 || out_size != MT * DM || ws_size < WS_END) { fprintf(stderr, "kernel_launch: unexpected shapes (n_in %d, out %d, ws %zu)\n", n_in, out_size, ws_size); grid = -1; return; }
        int dev = 0, cus = 0, per_cu = 0;
        (void)hipGetDevice(&dev);
        (void)hipDeviceGetAttribute(&cus, hipDeviceAttributeMultiprocessorCount, dev);
        if (hipFuncSetAttribute((const void*)fwd, hipFuncAttributeMaxDynamicSharedMemorySize, LDS_BYTES) != hipSuccess) { fprintf(stderr, "kernel_launch: hipFuncSetAttribute failed\n"); grid = -1; return; }
        if (hipOccupancyMaxActiveBlocksPerMultiprocessor(&per_cu, (const void*)fwd, 512, LDS_BYTES) != hipSuccess || per_cu < 1) { fprintf(stderr, "kernel_launch: occupancy query says %d\n", per_cu); per_cu = 1; }
        (void)hipGetLastError();
        grid = cus * 1;
        if (grid <= 0) grid = 256;
    }
    if (grid < 0) return;
    if (hipMemsetAsync((unsigned char*)d_ws + WS_CTL, 0, CTL_BYTES, stream) != hipSuccess) { fprintf(stderr, "kernel_launch: memset of barrier words failed\n"); return; }
    Params p{};
    for (int i = 0; i < 16; ++i) p.in[i] = (const float*)d_in[i];
    p.out = (float*)d_out; p.ws = (unsigned char*)d_ws;
#if MK_N_LAUNCHES == 1
    p.ph_lo = 0; p.ph_hi = NPHASE;
    void* args[] = {&p};
    hipError_t e = hipLaunchCooperativeKernel((const void*)fwd, dim3(grid), dim3(512), args, LDS_BYTES, stream);
    if (e != hipSuccess) fprintf(stderr, "kernel_launch: cooperative launch failed: %s (grid %d)\n", hipGetErrorString(e), grid);
#else
    for (int ph = 0; ph < NPHASE; ++ph) {
        p.ph_lo = ph; p.ph_hi = ph + 1;
        hipLaunchKernelGGL(fwd, dim3(grid), dim3(512), LDS_BYTES, stream, p);
    }
#endif
}
```

```cpp
#include <hip/hip_runtime.h>
#include <hip/hip_cooperative_groups.h>
#include <cstdio>
#include <cstdint>
namespace cg = cooperative_groups;
namespace pg8 {
#define PG8_LAS __attribute__((address_space(3)))
typedef unsigned short bf16_t;
typedef short bf16x8 __attribute__((ext_vector_type(8)));
typedef float f32x4 __attribute__((ext_vector_type(4)));
typedef unsigned u32x4 __attribute__((ext_vector_type(4)));
constexpr int BM = 256, BK = 64, HALF = 128, HTB = HALF * BK * 2  , STAGE_BYTES = 8 * HTB, NXCD = 8, WGM = 8;

__host__ __device__ __forceinline__ int lds_byte(int r, int c) { const int st = (r >> 4) * 2 + (c >> 5), rr = r & 15, cc = c & 31, ob = rr * 64 + cc * 2; return st * 1024 + (ob ^ (((ob >> 9) & 1) << 5)); }
__host__ __device__ __forceinline__ void stage_rc(int b, int& R, int& C) { const int st = b / 1024, sb = b % 1024, swz = sb ^ (((sb >> 9) & 1) << 5); R = (st >> 1) * 16 + swz / 64; C = (st & 1) * 32 + (swz % 64) / 2; }
__host__ __device__ __forceinline__ int perm32(int rho) { const int n = rho >> 4, i = rho & 15; return 8 * (i >> 2) + 4 * n + (i & 3); }

struct Unit { int pm, pn; };
struct Gemm { const bf16_t* A; const bf16_t* Bt; int M, N, K; };

struct StaticOrder {
    int nM, nN, nwg, G, c;
    __host__ __device__ void init(int M, int N, int G_, int c_) { nM = M / BM; nN = N / BM; nwg = nM * nN; G = G_; c = c_; }
    __host__ __device__ bool next(int i, Unit& u) const {
        const long L = (long)i * G + c; if (L >= nwg) return false;
        int wgid = (int)L; { const int q = nwg / NXCD, r = nwg % NXCD, xcd = wgid % NXCD, off = wgid / NXCD; wgid = (xcd < r ? xcd * (q + 1) : r * (q + 1) + (xcd - r) * q) + off; }
        const int nig = WGM * nN, gid = wgid / nig, fm = gid * WGM, gsz = (nM - fm) < WGM ? (nM - fm) : WGM;
        u.pm = fm + ((wgid % nig) % gsz); u.pn = (wgid % nig) / gsz; return true;
    }
    __device__ __forceinline__ void a_ready(const Unit&) const {}
    __device__ __forceinline__ void done(const Unit&) const {}
};

template <class Epi, class Sched, bool ALIGN_EPI = false, bool SP2 = false>
__device__ __forceinline__ void gemm_phase(PG8_LAS unsigned char* lds, const Gemm g, const Sched& S, const Epi& E, const int tid_in) {
    const int tid = tid_in, wid = __builtin_amdgcn_readfirstlane(tid >> 6), lane = tid & 63, wr = wid >> 2, wc = wid & 3, fr = lane & 15, fq = lane >> 4;
    const int K = g.K, nt = K / BK;
    unsigned voffA[2], voffB[2];
#pragma unroll
    for (int i = 0; i < 2; ++i) { int R, C; stage_rc(tid * 16 + i * 8192, R, C); const int Rb = Epi::PERM ? ((R & ~31) + perm32(R & 31)) : R;
        voffA[i] = (unsigned)(R * K + C) * 2u; voffB[i] = (unsigned)(Rb * K + C) * 2u; }
    const size_t kstep = (size_t)(BK * 2);
    const size_t hstep = (size_t)HALF * K * 2;
    const size_t tstep = 2 * hstep;
    const unsigned ldsw = (unsigned)wid * 1024u;
    const int aoff = lds_byte(wr * 64 + fr, fq * 8), boff = lds_byte(wc * 32 + fr, fq * 8);
#define PG8_SA(b, h) (((b) * 2 + (h)) * HTB)
#define PG8_SB(b, h) ((4 + (b) * 2 + (h)) * HTB)
#define PG8_STAGE(bufoff, gbase, voff) do { _Pragma("unroll") for (int _i = 0; _i < 2; ++_i) \
        __builtin_amdgcn_global_load_lds((const unsigned*)((const char*)(gbase) + (voff)[_i]), (PG8_LAS unsigned*)(lds + (bufoff) + ldsw + _i * 8192), 16, 0, 0); } while (0)
#define PG8_LDA(dst, b, h) do { _Pragma("unroll") for (int m = 0; m < 4; ++m) _Pragma("unroll") for (int k = 0; k < 2; ++k) dst[m][k] = *(const PG8_LAS bf16x8*)(lds + PG8_SA(b, h) + aoff + m * 2048 + k * 1024); } while (0)
#define PG8_LDB(dst, b, h) do { _Pragma("unroll") for (int n = 0; n < 2; ++n) _Pragma("unroll") for (int k = 0; k < 2; ++k) dst[n][k] = *(const PG8_LAS bf16x8*)(lds + PG8_SB(b, h) + boff + n * 2048 + k * 1024); } while (0)
#define PG8_MMA(ai, bj, At, Bt) do { __builtin_amdgcn_s_setprio(1); _Pragma("unroll") for (int m = 0; m < 4; ++m) _Pragma("unroll") for (int n = 0; n < 2; ++n) _Pragma("unroll") for (int k = 0; k < 2; ++k) \
        acc[ai][bj][m][n] = __builtin_amdgcn_mfma_f32_16x16x32_bf16(Bt[n][k], At[m][k], acc[ai][bj][m][n], 0, 0, 0); __builtin_amdgcn_s_setprio(0); } while (0)
#define PG8_WAIT_V(n) asm volatile("s_waitcnt vmcnt(" #n ")" ::: "memory")
#define PG8_WAIT_L(n) asm volatile("s_waitcnt lgkmcnt(" #n ")" ::: "memory")
#define PG8_BAR __builtin_amdgcn_s_barrier()
#define PG8_SCHED __builtin_amdgcn_sched_barrier(0)
    Unit cur, nxt; int ui = 0;
    if (!S.next(0, cur)) return;
    f32x4 acc[2][2][4][2];
#pragma unroll
    for (int a = 0; a < 2; ++a)
#pragma unroll
        for (int b = 0; b < 2; ++b)
#pragma unroll
            for (int m = 0; m < 4; ++m)
#pragma unroll
                for (int n = 0; n < 2; ++n) acc[a][b][m][n] = (f32x4){0.f, 0.f, 0.f, 0.f};
    bf16x8 At[4][2], B0[2][2], B1[2][2];
    const char* cA = (const char*)g.A + (size_t)cur.pm * tstep; const char* cB = (const char*)g.Bt + (size_t)cur.pn * tstep;
    S.a_ready(cur);
    if constexpr (SP2) {
        PG8_STAGE(PG8_SB(0, 0), cB, voffB); PG8_STAGE(PG8_SB(0, 1), cB + hstep, voffB); PG8_STAGE(PG8_SA(0, 0), cA, voffA); PG8_STAGE(PG8_SA(0, 1), cA + hstep, voffA);
        if (wr == 1) PG8_BAR;
        PG8_WAIT_V(2); PG8_BAR;
        PG8_STAGE(PG8_SB(1, 0), cB + kstep, voffB); PG8_STAGE(PG8_SA(1, 0), cA + kstep, voffA); PG8_STAGE(PG8_SB(1, 1), cB + hstep + kstep, voffB);
        PG8_WAIT_V(6); PG8_BAR;
    } else {
        PG8_STAGE(PG8_SB(0, 0), cB, voffB); PG8_STAGE(PG8_SA(0, 0), cA, voffA); PG8_STAGE(PG8_SB(0, 1), cB + hstep, voffB); PG8_STAGE(PG8_SA(0, 1), cA + hstep, voffA);
        if (wr == 1) PG8_BAR;
        PG8_WAIT_V(4); PG8_BAR;
        PG8_STAGE(PG8_SB(1, 0), cB + kstep, voffB); PG8_STAGE(PG8_SA(1, 0), cA + kstep, voffA); PG8_STAGE(PG8_SB(1, 1), cB + hstep + kstep, voffB);
        PG8_WAIT_V(6); PG8_BAR;
    }
    for (;;) {
        const bool has_next = S.next(ui + 1, nxt);
        const char* nA = has_next ? (const char*)g.A + (size_t)nxt.pm * tstep : cA; const char* nB = has_next ? (const char*)g.Bt + (size_t)nxt.pn * tstep : cB;
        for (int t = 0; t < nt; t += 2) {
            if constexpr (Epi::MID_T > 0) { if (t == Epi::MID_T) E.mid(acc, cur); }
            const bool last = (t == nt - 2);
            const char* a1 = cA + (size_t)(t + 1) * kstep;
            const char* a2 = last ? nA : cA + (size_t)(t + 2) * kstep; const char* b2 = last ? nB : cB + (size_t)(t + 2) * kstep;
            const char* a3 = a2 + kstep; const char* b3 = b2 + kstep;
            if (last && has_next) S.a_ready(nxt);
            if constexpr (SP2) {
            PG8_LDB(B0, 0, 0); PG8_LDB(B1, 0, 1); PG8_SCHED; PG8_LDA(At, 0, 0); PG8_STAGE(PG8_SA(1, 1), a1 + hstep, voffA);
            PG8_WAIT_V(8); PG8_WAIT_L(0); PG8_BAR; PG8_MMA(0, 0, At, B0); PG8_MMA(0, 1, At, B1); PG8_BAR; PG8_SCHED;
            PG8_LDA(At, 0, 1); PG8_STAGE(PG8_SB(0, 0), b2, voffB); PG8_STAGE(PG8_SB(0, 1), b2 + hstep, voffB); PG8_STAGE(PG8_SA(0, 0), a2, voffA);
            PG8_WAIT_V(8); PG8_WAIT_L(0); PG8_BAR; PG8_MMA(1, 0, At, B0); PG8_MMA(1, 1, At, B1); PG8_BAR; PG8_SCHED;
            PG8_LDB(B0, 1, 0); PG8_LDB(B1, 1, 1); PG8_SCHED; PG8_LDA(At, 1, 0); PG8_STAGE(PG8_SA(0, 1), a2 + hstep, voffA);
            PG8_WAIT_V(8); PG8_WAIT_L(0); PG8_BAR; PG8_MMA(0, 0, At, B0); PG8_MMA(0, 1, At, B1); PG8_BAR; PG8_SCHED;
            PG8_LDA(At, 1, 1); PG8_STAGE(PG8_SB(1, 0), b3, voffB); PG8_STAGE(PG8_SB(1, 1), b3 + hstep, voffB); PG8_STAGE(PG8_SA(1, 0), a3, voffA);
            PG8_WAIT_V(8); PG8_WAIT_L(0); PG8_BAR; PG8_MMA(1, 0, At, B0); PG8_MMA(1, 1, At, B1); PG8_BAR; PG8_SCHED;
            } else {
            PG8_LDB(B0, 0, 0); PG8_SCHED; PG8_LDA(At, 0, 0); PG8_STAGE(PG8_SA(1, 1), a1 + hstep, voffA);
            PG8_WAIT_L(8); PG8_BAR; PG8_WAIT_L(0); PG8_MMA(0, 0, At, B0); PG8_BAR; PG8_SCHED;
            PG8_LDB(B1, 0, 1); PG8_STAGE(PG8_SB(0, 0), b2, voffB);
            PG8_BAR; PG8_WAIT_L(0); PG8_MMA(0, 1, At, B1); PG8_BAR;
            PG8_LDA(At, 0, 1); PG8_STAGE(PG8_SA(0, 0), a2, voffA);
            PG8_BAR; PG8_WAIT_L(0); PG8_MMA(1, 0, At, B0); PG8_BAR; PG8_SCHED;
            PG8_STAGE(PG8_SB(0, 1), b2 + hstep, voffB);
            PG8_WAIT_V(6); PG8_BAR; PG8_MMA(1, 1, At, B1); PG8_BAR;
            PG8_LDB(B0, 1, 0); PG8_SCHED; PG8_LDA(At, 1, 0); PG8_STAGE(PG8_SA(0, 1), a2 + hstep, voffA);
            PG8_WAIT_L(8); PG8_BAR; PG8_WAIT_L(0); PG8_MMA(0, 0, At, B0); PG8_BAR; PG8_SCHED;
            PG8_LDB(B1, 1, 1); PG8_STAGE(PG8_SB(1, 0), b3, voffB);
            PG8_BAR; PG8_WAIT_L(0); PG8_MMA(0, 1, At, B1); PG8_BAR;
            PG8_LDA(At, 1, 1); PG8_STAGE(PG8_SA(1, 0), a3, voffA);
            PG8_BAR; PG8_WAIT_L(0); PG8_MMA(1, 0, At, B0); PG8_BAR; PG8_SCHED;
            PG8_STAGE(PG8_SB(1, 1), b3 + hstep, voffB);
            PG8_WAIT_V(6); PG8_BAR; PG8_MMA(1, 1, At, B1); PG8_BAR;
            }
        }
        if constexpr (ALIGN_EPI) { if (wr == 0) PG8_BAR; }
        if constexpr (!Epi::AFTER_DRAIN) { E(acc, cur, wr, wc, fr, fq); S.done(cur); }
        if (!has_next) break;
#pragma unroll
        for (int a = 0; a < 2; ++a)
#pragma unroll
            for (int b = 0; b < 2; ++b)
#pragma unroll
                for (int m = 0; m < 4; ++m)
#pragma unroll
                    for (int n = 0; n < 2; ++n) acc[a][b][m][n] = (f32x4){0.f, 0.f, 0.f, 0.f};
        cur = nxt; cA = nA; cB = nB; ++ui;
        if constexpr (ALIGN_EPI) { if (wr == 1) PG8_BAR; }
    }
    PG8_WAIT_V(0);
    if constexpr (!ALIGN_EPI) { if (wr == 0) PG8_BAR; }
    PG8_BAR;
    if constexpr (Epi::AFTER_DRAIN) { E.fused(acc, cur, wr, wc, fr, fq, lds, wid, lane); S.done(cur); }
#undef PG8_SA
#undef PG8_SB
#undef PG8_STAGE
#undef PG8_LDA
#undef PG8_LDB
#undef PG8_MMA
#undef PG8_WAIT_V
#undef PG8_WAIT_L
#undef PG8_BAR
#undef PG8_SCHED
}
}

#define LAS __attribute__((address_space(3)))
typedef unsigned short bf16_t;
typedef short bf16x8 __attribute__((ext_vector_type(8)));
typedef float f32x4 __attribute__((ext_vector_type(4)));
typedef float f32x2 __attribute__((ext_vector_type(2)));
typedef float f32x16 __attribute__((ext_vector_type(16)));
typedef unsigned u32x4 __attribute__((ext_vector_type(4)));
typedef unsigned u32x2 __attribute__((ext_vector_type(2)));
typedef __bf16 bf16x2_t __attribute__((ext_vector_type(2)));

constexpr int NB = 8, SEQ = 2048, DM = 1024, MT = NB * SEQ, DIN = 3584, NH = 8, HD = 64, CWID = 31, PLE = 256, CD = 512;
constexpr float EPS = 1e-6f;
constexpr float QSCALE = 0.125f * 1.4426950408889634f;

constexpr size_t MiB = 1u << 20;
constexpr size_t W_IN = 0, W_PW = 7340032, W_OUT = W_PW + 524288, W_PG = W_OUT + 2097152, W_PLE = W_PG + 2097152, W_LAYER = 12 * MiB;
static_assert(W_PLE + 524288 == W_LAYER, "weight map");
constexpr int UP = 2560, UQ = 0, UK = 512, USGA = 1024, UGLU = 1536, USGC = 2048;
constexpr size_t WS_PB = 24 * MiB, WS_HB = 40 * MiB, WS_Y = 72 * MiB, WS_VT = 104 * MiB, WS_SSA = 120 * MiB, WS_SSB = 121 * MiB, WS_SSC = 122 * MiB, WS_U = 123 * MiB;
constexpr size_t WS_H1B = WS_U  , WS_C2 = 203 * MiB, WS_EB = 219 * MiB, WS_CTL = 252 * MiB, CTL_BYTES = 16384, WS_END = WS_CTL + CTL_BYTES;
static_assert(WS_U + (size_t)MT * UP * 2 <= WS_C2, "ws map");
constexpr int LDS_BYTES = 147456;
constexpr int NPHASE = 12;
#ifndef PROBE_DUP
#define PROBE_DUP 0
#endif

__device__ __forceinline__ unsigned pk2(float lo, float hi) { f32x2 v = {lo, hi}; bf16x2_t b = __builtin_convertvector(v, bf16x2_t); return __builtin_bit_cast(unsigned, b); }
__device__ __forceinline__ float bflo(unsigned u) { return __builtin_bit_cast(float, u << 16); }
__device__ __forceinline__ float bfhi(unsigned u) { return __builtin_bit_cast(float, u & 0xffff0000u); }
__device__ __forceinline__ float fexp2(float x) { return __builtin_amdgcn_exp2f(x); }
__device__ __forceinline__ float flog2(float x) { return __builtin_amdgcn_logf(x); }
__device__ __forceinline__ float frcp(float x) { return __builtin_amdgcn_rcpf(x); }
__device__ __forceinline__ float frsq(float x) { return __builtin_amdgcn_rsqf(x); }
__device__ __forceinline__ float sigmoidf_(float x) { return frcp(1.0f + fexp2(-1.4426950408889634f * x)); }
__device__ __forceinline__ float siluf_(float x) { return x * sigmoidf_(x); }
#define MFMA32(a, b, c) __builtin_amdgcn_mfma_f32_32x32x16_bf16((a), (b), (c), 0, 0, 0)

__device__ __forceinline__ float shx(float v, int m, int lane) { return __builtin_bit_cast(float, __builtin_amdgcn_ds_bpermute((lane ^ m) << 2, __builtin_bit_cast(int, v))); }
__device__ __forceinline__ float wave_sum(float v, int lane) {
#pragma unroll
    for (int o = 1; o < 64; o <<= 1) v += shx(v, o, lane);
    return v;
}
__device__ __forceinline__ float row_rstd(const float* ss, int row, int fq, int lane) {
    const f32x4 p = *(const f32x4*)(ss + (size_t)row * 16 + fq * 4);
    float s = (p[0] + p[1]) + (p[2] + p[3]);
    s += shx(s, 16, lane); s += shx(s, 32, lane);
    return frsq(s * (1.0f / DM) + EPS);
}

struct EpiIn {
    static constexpr bool PERM = true, AFTER_DRAIN = false; static constexpr int MID_T = 0;
    bf16_t* U; bf16_t* VT; const float* ss;
    __device__ __forceinline__ void operator()(const f32x4 (&acc)[2][2][4][2], const pg8::Unit& u, int, int, int, int) const {
        int t_ = threadIdx.x; asm volatile("" : "+v"(t_));
        const int lane = t_ & 63, fr = lane & 15, fq = lane >> 4, wid_ = __builtin_amdgcn_readfirstlane(t_ >> 6), wr = wid_ >> 2, wc = wid_ & 3;
        const int pn = u.pn;
        f32x4 pp[2][4];
#pragma unroll
        for (int ai = 0; ai < 2; ++ai)
#pragma unroll
            for (int m = 0; m < 4; ++m) pp[ai][m] = *(const f32x4*)(ss + (size_t)(u.pm * 256 + ai * 128 + wr * 64 + m * 16 + fr) * 16 + fq * 4);
#pragma unroll
        for (int ai = 0; ai < 2; ++ai)
#pragma unroll
            for (int m = 0; m < 4; ++m) {
                const int row = u.pm * 256 + ai * 128 + wr * 64 + m * 16 + fr;
                float s_ = (pp[ai][m][0] + pp[ai][m][1]) + (pp[ai][m][2] + pp[ai][m][3]);
                s_ += shx(s_, 16, lane); s_ += shx(s_, 32, lane);
                const float rs = frsq(s_ * (1.0f / DM) + EPS);
#pragma unroll
                for (int bj = 0; bj < 2; ++bj) {
                    const int col0 = pn * 256 + bj * 128 + wc * 32 + 8 * fq;
                    f32x4 v0 = acc[ai][bj][m][0] * rs, v1 = acc[ai][bj][m][1] * rs;
                    if (pn < 4) {
                        const float sc = pn < 2 ? QSCALE : 1.0f;
                        v0 = v0 * sc; v1 = v1 * sc;
                        u32x4 w; w[0] = pk2(v0[0], v0[1]); w[1] = pk2(v0[2], v0[3]); w[2] = pk2(v1[0], v1[1]); w[3] = pk2(v1[2], v1[3]);
                        *(u32x4*)(U + (size_t)row * UP + col0) = w;
                    } else if (pn < 6) {
                        const int vc = col0 - 1024, hh = vc >> 6, d0 = vc & 63, b = row >> 11, s = row & 2047;
                        bf16_t* vp = VT + ((size_t)((b * NH + hh) * HD + d0)) * SEQ + s;
                        const unsigned w0 = pk2(v0[0], v0[1]), w1 = pk2(v0[2], v0[3]), w2 = pk2(v1[0], v1[1]), w3 = pk2(v1[2], v1[3]);
                        vp[0 * SEQ] = (bf16_t)(w0 & 0xffffu); vp[1 * SEQ] = (bf16_t)(w0 >> 16);
                        vp[2 * SEQ] = (bf16_t)(w1 & 0xffffu); vp[3 * SEQ] = (bf16_t)(w1 >> 16);
                        vp[4 * SEQ] = (bf16_t)(w2 & 0xffffu); vp[5 * SEQ] = (bf16_t)(w2 >> 16);
                        vp[6 * SEQ] = (bf16_t)(w3 & 0xffffu); vp[7 * SEQ] = (bf16_t)(w3 >> 16);
                    } else if (pn < 8 || pn >= 12) {
                        u32x4 w; w[0] = pk2(siluf_(v0[0]), siluf_(v0[1])); w[1] = pk2(siluf_(v0[2]), siluf_(v0[3]));
                        w[2] = pk2(siluf_(v1[0]), siluf_(v1[1])); w[3] = pk2(siluf_(v1[2]), siluf_(v1[3]));
                        *(u32x4*)(U + (size_t)row * UP + (pn < 8 ? col0 - 512 : col0 - 1024)) = w;
                    } else {
                        const int ch0 = (col0 - 2048) >> 1;
                        u32x2 w; w[0] = pk2(v0[0] * sigmoidf_(v0[1]), v0[2] * sigmoidf_(v0[3])); w[1] = pk2(v1[0] * sigmoidf_(v1[1]), v1[2] * sigmoidf_(v1[3]));
                        *(u32x2*)(U + (size_t)row * UP + UGLU + ch0) = w;
                    }
                }
                asm volatile("" ::: "memory");
            }
    }
};

struct EpiPw {
    static constexpr bool PERM = true, AFTER_DRAIN = false; static constexpr int MID_T = 0;
    const bf16_t* U; bf16_t* Y; const float* cog; float* ssC;
    __device__ __forceinline__ void operator()(const f32x4 (&acc)[2][2][4][2], const pg8::Unit& u, int, int, int, int) const {
        int t_ = threadIdx.x; asm volatile("" : "+v"(t_));
        const int lane = t_ & 63, fr = lane & 15, fq = lane >> 4, wid_ = __builtin_amdgcn_readfirstlane(t_ >> 6), wr = wid_ >> 2, wc = wid_ & 3;
#pragma unroll
        for (int ai = 0; ai < 2; ++ai)
#pragma unroll
            for (int m = 0; m < 4; ++m) {
                const int row = u.pm * 256 + ai * 128 + wr * 64 + m * 16 + fr;
                float sq = 0.f;
#pragma unroll
                for (int bj = 0; bj < 2; ++bj) {
                    const int col0 = u.pn * 256 + bj * 128 + wc * 32 + 8 * fq;
                    const f32x4 v0 = acc[ai][bj][m][0], v1 = acc[ai][bj][m][1];
                    sq += (v0[0] * v0[0] + v0[1] * v0[1]) + (v0[2] * v0[2] + v0[3] * v0[3]) + (v1[0] * v1[0] + v1[1] * v1[1]) + (v1[2] * v1[2] + v1[3] * v1[3]);
                    const f32x4 g0 = *(const f32x4*)(cog + col0), g1 = *(const f32x4*)(cog + col0 + 4);
                    const u32x4 sg = *(const u32x4*)(U + (size_t)row * UP + USGC + col0);
                    u32x4 w;
                    w[0] = pk2(v0[0] * g0[0] * bflo(sg[0]), v0[1] * g0[1] * bfhi(sg[0])); w[1] = pk2(v0[2] * g0[2] * bflo(sg[1]), v0[3] * g0[3] * bfhi(sg[1]));
                    w[2] = pk2(v1[0] * g1[0] * bflo(sg[2]), v1[1] * g1[1] * bfhi(sg[2])); w[3] = pk2(v1[2] * g1[2] * bflo(sg[3]), v1[3] * g1[3] * bfhi(sg[3]));
                    *(u32x4*)(Y + (size_t)row * DM + col0) = w;
                }
                sq += shx(sq, 16, lane); sq += shx(sq, 32, lane);
                if (fq == 0) ssC[(size_t)row * 8 + u.pn * 4 + wc] = sq;
                asm volatile("" ::: "memory");
            }
    }
};

struct EpiE {
    static constexpr bool PERM = true, AFTER_DRAIN = false; static constexpr int MID_T = 0;
    bf16_t* EB;
    __device__ __forceinline__ void operator()(const f32x4 (&acc)[2][2][4][2], const pg8::Unit& u, int, int, int, int) const {
        int t_ = threadIdx.x; asm volatile("" : "+v"(t_));
        const int lane = t_ & 63, fr = lane & 15, fq = lane >> 4, wid_ = __builtin_amdgcn_readfirstlane(t_ >> 6), wr = wid_ >> 2, wc = wid_ & 3;
#pragma unroll
        for (int ai = 0; ai < 2; ++ai)
#pragma unroll
            for (int m = 0; m < 4; ++m) {
                const int row = u.pm * 256 + ai * 128 + wr * 64 + m * 16 + fr;
#pragma unroll
                for (int bj = 0; bj < 2; ++bj) {
                    const int col0 = u.pn * 256 + bj * 128 + wc * 32 + 8 * fq;
                    const f32x4 v0 = acc[ai][bj][m][0], v1 = acc[ai][bj][m][1];
                    u32x4 w; w[0] = pk2(v0[0], v0[1]); w[1] = pk2(v0[2], v0[3]); w[2] = pk2(v1[0], v1[1]); w[3] = pk2(v1[2], v1[3]);
                    *(u32x4*)(EB + (size_t)row * DM + col0) = w;
                }
                asm volatile("" ::: "memory");
            }
    }
};

template <bool BB> struct EpiOut {
    static constexpr bool PERM = true, AFTER_DRAIN = false; static constexpr int MID_T = 8;
    const float* base; const bf16_t* baseb; bf16_t* HB; float* ss; const float* ssC;
    __device__ __forceinline__ void mid(f32x4 (&acc)[2][2][4][2], const pg8::Unit& u) const {
        int t_ = threadIdx.x; asm volatile("" : "+v"(t_));
        const int lane = t_ & 63, fr = lane & 15, fq = lane >> 4, wid_ = __builtin_amdgcn_readfirstlane(t_ >> 6), wr = wid_ >> 2;
        f32x2 pc[2][4];
#pragma unroll
        for (int ai = 0; ai < 2; ++ai)
#pragma unroll
            for (int m = 0; m < 4; ++m) pc[ai][m] = *(const f32x2*)(ssC + (size_t)(u.pm * 256 + ai * 128 + wr * 64 + m * 16 + fr) * 8 + fq * 2);
#pragma unroll
        for (int ai = 0; ai < 2; ++ai)
#pragma unroll
            for (int m = 0; m < 4; ++m) {
                const f32x2 p = pc[ai][m];
                float s = p[0] + p[1];
                s += shx(s, 16, lane); s += shx(s, 32, lane);
                const float rs = frsq(s * (1.0f / CD) + EPS);
#pragma unroll
                for (int bj = 0; bj < 2; ++bj)
#pragma unroll
                    for (int n = 0; n < 2; ++n) acc[ai][bj][m][n] = acc[ai][bj][m][n] * rs;
            }
    }
    __device__ __forceinline__ void operator()(const f32x4 (&acc)[2][2][4][2], const pg8::Unit& u, int, int, int, int) const {
        int t_ = threadIdx.x; asm volatile("" : "+v"(t_));
        const int lane = t_ & 63, fr = lane & 15, fq = lane >> 4, wid_ = __builtin_amdgcn_readfirstlane(t_ >> 6), wr = wid_ >> 2, wc = wid_ & 3;
#pragma unroll
        for (int ai = 0; ai < 2; ++ai)
#pragma unroll
            for (int mp = 0; mp < 2; ++mp) {
                f32x4 bs[2][2][2];
#pragma unroll
                for (int mm = 0; mm < 2; ++mm)
#pragma unroll
                    for (int bj = 0; bj < 2; ++bj) {
                        const size_t off = (size_t)(u.pm * 256 + ai * 128 + wr * 64 + (2 * mp + mm) * 16 + fr) * DM + u.pn * 256 + bj * 128 + wc * 32 + 8 * fq;
                        if constexpr (BB) { const u32x4 r1 = *(const u32x4*)(baseb + off); f32x4 t0 = {bflo(r1[0]), bfhi(r1[0]), bflo(r1[1]), bfhi(r1[1])}, t1 = {bflo(r1[2]), bfhi(r1[2]), bflo(r1[3]), bfhi(r1[3])}; bs[mm][bj][0] = t0; bs[mm][bj][1] = t1; }
                        else { bs[mm][bj][0] = *(const f32x4*)(base + off); bs[mm][bj][1] = *(const f32x4*)(base + off + 4); }
                    }
#pragma unroll
                for (int mm = 0; mm < 2; ++mm) {
                    const int m = 2 * mp + mm;
                    const int row = u.pm * 256 + ai * 128 + wr * 64 + m * 16 + fr;
                    float sq = 0.f;
#pragma unroll
                    for (int bj = 0; bj < 2; ++bj) {
                        const size_t off = (size_t)row * DM + u.pn * 256 + bj * 128 + wc * 32 + 8 * fq;
                        const f32x4 h0 = bs[mm][bj][0] + acc[ai][bj][m][0], h1 = bs[mm][bj][1] + acc[ai][bj][m][1];
                        u32x4 w; w[0] = pk2(h0[0], h0[1]); w[1] = pk2(h0[2], h0[3]); w[2] = pk2(h1[0], h1[1]); w[3] = pk2(h1[2], h1[3]);
                        *(u32x4*)(HB + off) = w;
                        sq += (h0[0] * h0[0] + h0[1] * h0[1]) + (h0[2] * h0[2] + h0[3] * h0[3]) + (h1[0] * h1[0] + h1[1] * h1[1]) + (h1[2] * h1[2] + h1[3] * h1[3]);
                    }
                    sq += shx(sq, 16, lane); sq += shx(sq, 32, lane);
                    if (fq == 0) ss[(size_t)row * 16 + u.pn * 4 + wc] = sq;
                }
                asm volatile("" ::: "memory");
            }
    }
};

template <bool WF> struct EpiGate {
    static constexpr bool PERM = true, AFTER_DRAIN = false; static constexpr int MID_T = 0;
    float* out; const bf16_t* H1; const bf16_t* EB; bf16_t* HB; const float* ss_in; float* ss_out; int dummy;
    __device__ __forceinline__ void operator()(const f32x4 (&acc)[2][2][4][2], const pg8::Unit& u, int, int, int, int) const {
        int t_ = threadIdx.x; asm volatile("" : "+v"(t_));
        const int lane = t_ & 63, fr = lane & 15, fq = lane >> 4, wid_ = __builtin_amdgcn_readfirstlane(t_ >> 6), wr = wid_ >> 2, wc = wid_ & 3;
        f32x4 pp[2][4];
#pragma unroll
        for (int ai = 0; ai < 2; ++ai)
#pragma unroll
            for (int m = 0; m < 4; ++m) pp[ai][m] = *(const f32x4*)(ss_in + (size_t)(u.pm * 256 + ai * 128 + wr * 64 + m * 16 + fr) * 16 + fq * 4);
        float rsv[2][4];
#pragma unroll
        for (int ai = 0; ai < 2; ++ai)
#pragma unroll
            for (int m = 0; m < 4; ++m) {
                float s_ = (pp[ai][m][0] + pp[ai][m][1]) + (pp[ai][m][2] + pp[ai][m][3]);
                s_ += shx(s_, 16, lane); s_ += shx(s_, 32, lane);
                rsv[ai][m] = frsq(s_ * (1.0f / DM) + EPS);
            }
        asm volatile("" ::: "memory");
#pragma unroll
        for (int ai = 0; ai < 2; ++ai)
#pragma unroll
            for (int mp = 0; mp < 2; ++mp) {
                u32x4 bs[2][2], es[2][2];
#pragma unroll
                for (int mm = 0; mm < 2; ++mm)
#pragma unroll
                    for (int bj = 0; bj < 2; ++bj) {
                        const size_t off = (size_t)(u.pm * 256 + ai * 128 + wr * 64 + (2 * mp + mm) * 16 + fr) * DM + u.pn * 256 + bj * 128 + wc * 32 + 8 * fq;
                        bs[mm][bj] = *(const u32x4*)(H1 + off); es[mm][bj] = *(const u32x4*)(EB + off);
                    }
#pragma unroll
                for (int mm = 0; mm < 2; ++mm) {
                    const int m = 2 * mp + mm;
                    const int row = u.pm * 256 + ai * 128 + wr * 64 + m * 16 + fr;
                    const float rs = rsv[ai][m];
                    float sq = 0.f;
#pragma unroll
                    for (int bj = 0; bj < 2; ++bj) {
                        const size_t off = (size_t)row * DM + u.pn * 256 + bj * 128 + wc * 32 + 8 * fq;
                        const f32x4 a0 = acc[ai][bj][m][0] * rs, a1 = acc[ai][bj][m][1] * rs;
                        const u32x4 e = es[mm][bj]; const u32x4 r1 = bs[mm][bj];
                        f32x4 h0 = {bflo(r1[0]), bfhi(r1[0]), bflo(r1[1]), bfhi(r1[1])}, h1 = {bflo(r1[2]), bfhi(r1[2]), bflo(r1[3]), bfhi(r1[3])};
                        h0[0] += bflo(e[0]) * sigmoidf_(a0[0]); h0[1] += bfhi(e[0]) * sigmoidf_(a0[1]); h0[2] += bflo(e[1]) * sigmoidf_(a0[2]); h0[3] += bfhi(e[1]) * sigmoidf_(a0[3]);
                        h1[0] += bflo(e[2]) * sigmoidf_(a1[0]); h1[1] += bfhi(e[2]) * sigmoidf_(a1[1]); h1[2] += bflo(e[3]) * sigmoidf_(a1[2]); h1[3] += bfhi(e[3]) * sigmoidf_(a1[3]);
                        if constexpr (WF) { *(f32x4*)(out + off) = h0; *(f32x4*)(out + off + 4) = h1; }
                        u32x4 w; w[0] = pk2(h0[0], h0[1]); w[1] = pk2(h0[2], h0[3]); w[2] = pk2(h1[0], h1[1]); w[3] = pk2(h1[2], h1[3]);
                        *(u32x4*)(HB + off) = w;
                        sq += (h0[0] * h0[0] + h0[1] * h0[1]) + (h0[2] * h0[2] + h0[3] * h0[3]) + (h1[0] * h1[0] + h1[1] * h1[1]) + (h1[2] * h1[2] + h1[3] * h1[3]);
                    }
                    sq += shx(sq, 16, lane); sq += shx(sq, 32, lane);
                    if (fq == 0) ss_out[(size_t)row * 16 + u.pn * 4 + wc] = sq;
                }
                asm volatile("" ::: "memory");
            }
    }
};

struct SubOrder {
    int nN, nwg, nb, c;
    __device__ void init(int M, int N, int nb_, int c_) { nN = N / 256; nwg = (M / 256) * nN; nb = nb_; c = c_; }
    __device__ bool next(int i, pg8::Unit& u) const { if (c < 0 || c >= nb) return false; const int L = i * nb + c; if (L >= nwg) return false; u.pm = L / nN; u.pn = L % nN; return true; }
    __device__ __forceinline__ void a_ready(const pg8::Unit&) const {}
    __device__ __forceinline__ void done(const pg8::Unit&) const {}
};

template <bool REMAP>
__device__ __forceinline__ void tr_item(const float* W, int K, int N, bf16_t* WT, const float* g, LAS float* scr, int item, int lane, int kshift = 0) {
    const int nblk = N / 32, kb = item / nblk, nb = item % nblk, k0 = 64 * kb, n0 = 32 * nb;
    int src = n0 + (lane & 31);
    if (REMAP) { if (src >= 2048 && src < 3072) { const int jj = src - 2048; src = (jj & 1) ? 2560 + (jj >> 1) : 2048 + (jj >> 1); } }
    float wv[32];
#pragma unroll
    for (int i = 0; i < 32; ++i) { const int kk = 2 * i + (lane >> 5); wv[i] = W[(size_t)((k0 + kk + kshift) & (K - 1)) * N + src]; }
#pragma unroll
    for (int i = 0; i < 32; ++i) { const int kk = 2 * i + (lane >> 5); float v = wv[i]; if (g) v *= g[k0 + kk]; scr[kk * 33 + (lane & 31)] = v; }
    asm volatile("s_waitcnt lgkmcnt(0)" ::: "memory");
    const int c = lane & 7;
#pragma unroll
    for (int j = 0; j < 4; ++j) { const int n = (lane >> 3) + 8 * j; const LAS float* s = scr + (8 * c) * 33 + n;
        u32x4 o; o[0] = pk2(s[0 * 33], s[1 * 33]); o[1] = pk2(s[2 * 33], s[3 * 33]); o[2] = pk2(s[4 * 33], s[5 * 33]); o[3] = pk2(s[6 * 33], s[7 * 33]);
        *(u32x4*)(WT + (size_t)(n0 + n) * K + k0 + 8 * c) = o; }
    asm volatile("s_waitcnt lgkmcnt(0)" ::: "memory");
}

constexpr int AK_STRIDE = 144, AV_STRIDE = 136, A_KBYTES = 64 * AK_STRIDE, A_VBYTES = 64 * AV_STRIDE, A_BUF = 18432;
static_assert(A_KBYTES + A_VBYTES <= A_BUF, "attention LDS buffer");

__device__ __forceinline__ void attn_unit(const bf16_t* U, const bf16_t* VT, bf16_t* Y, const float* aog, int b, int h, int qb, LAS unsigned char* lds) {
    int tid = threadIdx.x; asm volatile("" : "+v"(tid));
    const int wave = __builtin_amdgcn_readfirstlane(tid >> 6), lane = tid & 63, l31 = lane & 31, hi = lane >> 5;
    const int q0 = qb * 256 + wave * 32, t = q0 + l31;
    const size_t trow = (size_t)(b * SEQ + t);
    bf16x8 qf[4];
    {
        const bf16_t* qp = U + trow * UP + UQ + h * HD + 8 * hi;
#pragma unroll
        for (int s = 0; s < 4; ++s) qf[s] = *(const bf16x8*)(qp + 16 * s);
    }
    f32x16 o0, o1;
#pragma unroll
    for (int i = 0; i < 16; ++i) { o0[i] = 0.f; o1[i] = 0.f; }
    float C = 1.f;
    const int ktmax = 4 * qb + 3, wkt = (q0 + 30) >> 6;
    const int srow = tid >> 3, sch = tid & 7;
    const bf16_t* gk = U + (size_t)(b * SEQ + srow) * UP + UK + h * HD + sch * 8;
    const bf16_t* gv = VT + ((size_t)((b * NH + h) * HD + srow)) * SEQ + sch * 8;
    const int kwoff = srow * AK_STRIDE + sch * 16, vwoff = A_KBYTES + srow * AV_STRIDE + sch * 16;
    __syncthreads();
    {
        const u32x4 kr = *(const u32x4*)(gk + (size_t)ktmax * 64 * UP), vr = *(const u32x4*)(gv + ktmax * 64);
        *(LAS u32x4*)(lds + kwoff) = kr;
        u32x2 a = {vr[0], vr[1]}, c = {vr[2], vr[3]};
        *(LAS u32x2*)(lds + vwoff) = a; *(LAS u32x2*)(lds + vwoff + 8) = c;
    }
    __syncthreads();
    int cur = 0;
    LAS unsigned* dflag = (LAS unsigned*)(lds + 2 * A_BUF);
    bool wdone = false;
    for (int kt = ktmax; kt >= 0; --kt) {
        u32x4 kr = {0u, 0u, 0u, 0u}, vr = {0u, 0u, 0u, 0u};
        if (kt > 0) { kr = *(const u32x4*)(gk + (size_t)(kt - 1) * 64 * UP); vr = *(const u32x4*)(gv + (kt - 1) * 64); }
        if (kt <= wkt && !wdone) {
            const LAS unsigned char* kb = lds + cur * A_BUF;
            const LAS unsigned char* vb = kb + A_KBYTES;
            f32x16 p0, p1;
#pragma unroll
            for (int i = 0; i < 16; ++i) { p0[i] = 0.f; p1[i] = 0.f; }
#pragma unroll
            for (int s = 0; s < 4; ++s) {
                const bf16x8 ka = *(const LAS bf16x8*)(kb + l31 * AK_STRIDE + 32 * s + 16 * hi);
                const bf16x8 kc = *(const LAS bf16x8*)(kb + (32 + l31) * AK_STRIDE + 32 * s + 16 * hi);
                p0 = MFMA32(ka, qf[s], p0); p1 = MFMA32(kc, qf[s], p1);
            }
            const int lim0 = t - (64 * kt + 4 * hi), lim1 = lim0 - 32;
            const bool diag = (64 * kt + 63 >= q0);
            f32x16 m0, m1;
            float G0[4], G1[4];
#pragma unroll
            for (int g = 0; g < 4; ++g) {
                float s0 = 1.f, s1 = 1.f;
#pragma unroll
                for (int i = 0; i < 4; ++i) {
                    const int r = 4 * g + i, cr = i + 8 * g;
                    const float e0 = fexp2(fminf(p0[r], 100.f)), e1 = fexp2(fminf(p1[r], 100.f));
                    float r0 = frcp(1.0f + e0), r1 = frcp(1.0f + e1);
                    float b0 = e0 * r0, b1 = e1 * r1;
                    if (diag) { const bool v0 = cr < lim0, v1 = cr < lim1; r0 = v0 ? r0 : 1.f; b0 = v0 ? b0 : 0.f; r1 = v1 ? r1 : 1.f; b1 = v1 ? b1 : 0.f; }
                    m0[r] = r0; m1[r] = r1; p0[r] = b0; p1[r] = b1; s0 *= r0; s1 *= r1;
                }
                G0[g] = s0; G1[g] = s1;
            }
            float X0[4], X1[4];
#pragma unroll
            for (int g = 0; g < 4; ++g) { X0[g] = shx(G0[g], 32, lane); X1[g] = shx(G1[g], 32, lane); }
            float run = C;
#pragma unroll
            for (int g = 3; g >= 0; --g) {
                float a = hi == 0 ? run * X1[g] : run;
#pragma unroll
                for (int i = 3; i >= 0; --i) { const int r = 4 * g + i; const float w = a * p1[r]; a *= m1[r]; p1[r] = w; }
                run *= G1[g] * X1[g];
            }
#pragma unroll
            for (int g = 3; g >= 0; --g) {
                float a = hi == 0 ? run * X0[g] : run;
#pragma unroll
                for (int i = 3; i >= 0; --i) { const int r = 4 * g + i; const float w = a * p0[r]; a *= m0[r]; p0[r] = w; }
                run *= G0[g] * X0[g];
            }
            C = run;
#pragma unroll
            for (int kh = 0; kh < 2; ++kh)
#pragma unroll
                for (int sh = 0; sh < 2; ++sh) {
                    u32x4 xw;
                    if (kh == 0) { xw[0] = pk2(p0[8 * sh + 0], p0[8 * sh + 1]); xw[1] = pk2(p0[8 * sh + 2], p0[8 * sh + 3]); xw[2] = pk2(p0[8 * sh + 4], p0[8 * sh + 5]); xw[3] = pk2(p0[8 * sh + 6], p0[8 * sh + 7]); }
                    else         { xw[0] = pk2(p1[8 * sh + 0], p1[8 * sh + 1]); xw[1] = pk2(p1[8 * sh + 2], p1[8 * sh + 3]); xw[2] = pk2(p1[8 * sh + 4], p1[8 * sh + 5]); xw[3] = pk2(p1[8 * sh + 6], p1[8 * sh + 7]); }
                    const bf16x8 xf = __builtin_bit_cast(bf16x8, xw);
                    const int koff = 2 * (32 * kh + 16 * sh + 4 * hi);
                    {
                        const LAS unsigned char* vp = vb + l31 * AV_STRIDE + koff;
                        const u32x2 lo = *(const LAS u32x2*)vp, hh = *(const LAS u32x2*)(vp + 16);
                        u32x4 vw = {lo[0], lo[1], hh[0], hh[1]};
                        o0 = MFMA32(__builtin_bit_cast(bf16x8, vw), xf, o0);
                    }
                    {
                        const LAS unsigned char* vp = vb + (32 + l31) * AV_STRIDE + koff;
                        const u32x2 lo = *(const LAS u32x2*)vp, hh = *(const LAS u32x2*)(vp + 16);
                        u32x4 vw = {lo[0], lo[1], hh[0], hh[1]};
                        o1 = MFMA32(__builtin_bit_cast(bf16x8, vw), xf, o1);
                    }
                }
        }
        wdone = (__builtin_amdgcn_ballot_w64(C > 7.5e-37f) == 0ull);
        if (lane == 0) dflag[(kt & 1) * 8 + wave] = wdone ? 1u : 0u;
        if (kt > 0) {
            LAS unsigned char* nb = lds + (cur ^ 1) * A_BUF;
            *(LAS u32x4*)(nb + kwoff) = kr;
            u32x2 a = {vr[0], vr[1]}, c = {vr[2], vr[3]};
            *(LAS u32x2*)(nb + vwoff) = a; *(LAS u32x2*)(nb + vwoff + 8) = c;
        }
        __syncthreads();
        cur ^= 1;
        {
            const LAS u32x4* df = (const LAS u32x4*)(dflag + (kt & 1) * 8);
            const u32x4 f0 = df[0], f1 = df[1];
            if ((f0[0] & f0[1] & f0[2] & f0[3] & f1[0] & f1[1] & f1[2] & f1[3]) != 0u) break;
        }
    }
    float sq = 0.f;
#pragma unroll
    for (int i = 0; i < 16; ++i) sq += o0[i] * o0[i] + o1[i] * o1[i];
    sq += shx(sq, 32, lane);
    const float rs = frsq(sq * (1.0f / HD) + EPS);
    const bf16_t* sgp = U + trow * UP + USGA + h * HD;
    bf16_t* yp = Y + trow * DM + 512 + h * HD;
#pragma unroll
    for (int dt = 0; dt < 2; ++dt)
#pragma unroll
        for (int g = 0; g < 4; ++g) {
            const int d0 = 32 * dt + 8 * g + 4 * hi;
            const f32x4 gn = *(const f32x4*)(aog + d0);
            const u32x2 sg = *(const u32x2*)(sgp + d0);
            float v0, v1, v2, v3;
            if (dt == 0) { v0 = o0[4 * g + 0]; v1 = o0[4 * g + 1]; v2 = o0[4 * g + 2]; v3 = o0[4 * g + 3]; }
            else         { v0 = o1[4 * g + 0]; v1 = o1[4 * g + 1]; v2 = o1[4 * g + 2]; v3 = o1[4 * g + 3]; }
            u32x2 w;
            w[0] = pk2(v0 * rs * gn[0] * bflo(sg[0]), v1 * rs * gn[1] * bfhi(sg[0]));
            w[1] = pk2(v2 * rs * gn[2] * bflo(sg[1]), v3 * rs * gn[3] * bfhi(sg[1]));
            *(u32x2*)(yp + d0) = w;
        }
}

constexpr int CT = 32, C_XH = 0, C_XH_BYTES = (CT + 30) * 1024, C_CO = C_XH_BYTES, C_CO_BYTES = CT * CD * 4;
static_assert(C_CO + C_CO_BYTES <= LDS_BYTES, "conv LDS map");

__device__ __forceinline__ void convpre_unit(const bf16_t* U, bf16_t* C2, const float* dww, const float* dwb, const float* lng, const float* lnb, int cu, LAS unsigned char* lds) {
    int tid = threadIdx.x; asm volatile("" : "+v"(tid));
    const int wave = __builtin_amdgcn_readfirstlane(tid >> 6), lane = tid & 63;
    const int r0 = cu * CT, b = r0 >> 11, s0 = r0 & 2047;
    __syncthreads();
    for (int i = tid; i < (CT + 30) * 64; i += 512) {
        const int row = i >> 6, ch = i & 63, s = s0 - 30 + row;
        u32x4 v = {0u, 0u, 0u, 0u};
        if (s >= 0) v = *(const u32x4*)(U + (size_t)(b * SEQ + s) * UP + UGLU + ch * 8);
        *(LAS u32x4*)(lds + C_XH + row * 1024 + ch * 16) = v;
    }
    __syncthreads();
    {
        const int chp = tid & 255, tg = tid >> 8;
        f32x2 w2[CWID];
#pragma unroll
        for (int j = 0; j < CWID; ++j) w2[j] = *(const f32x2*)(dww + (size_t)j * CD + 2 * chp);
        const f32x2 bias = *(const f32x2*)(dwb + 2 * chp);
        const LAS unsigned char* xp = lds + C_XH + (tg * 16) * 1024 + chp * 4;
        f32x2 xv[16 + CWID - 1];
#pragma unroll
        for (int i = 0; i < 16 + CWID - 1; ++i) { const unsigned xu = *(const LAS unsigned*)(xp + i * 1024); f32x2 t2 = {bflo(xu), bfhi(xu)}; xv[i] = t2; }
#pragma unroll
        for (int tt = 0; tt < 16; ++tt) {
            f32x2 a = bias;
#pragma unroll
            for (int j = 0; j < CWID; ++j) a = a + w2[j] * xv[tt + j];
            *(LAS f32x2*)(lds + C_CO + (tg * 16 + tt) * 2048 + chp * 8) = a;
        }
    }
    __syncthreads();
    {
        const f32x4 g0 = *(const f32x4*)(lng + lane * 4), g1 = *(const f32x4*)(lng + 256 + lane * 4);
        const f32x4 b0 = *(const f32x4*)(lnb + lane * 4), b1 = *(const f32x4*)(lnb + 256 + lane * 4);
#pragma unroll
        for (int tt = 0; tt < 4; ++tt) {
            const int tl = wave * 4 + tt;
            f32x4 v0 = *(const LAS f32x4*)(lds + C_CO + tl * 2048 + lane * 16), v1 = *(const LAS f32x4*)(lds + C_CO + tl * 2048 + 1024 + lane * 16);
            const float mean = wave_sum((v0[0] + v0[1]) + (v0[2] + v0[3]) + (v1[0] + v1[1]) + (v1[2] + v1[3]), lane) * (1.0f / CD);
            v0 = v0 - mean; v1 = v1 - mean;
            const float var = wave_sum((v0[0] * v0[0] + v0[1] * v0[1]) + (v0[2] * v0[2] + v0[3] * v0[3]) + (v1[0] * v1[0] + v1[1] * v1[1]) + (v1[2] * v1[2] + v1[3] * v1[3]), lane) * (1.0f / CD);
            const float rs = frsq(var + EPS);
            v0 = v0 * rs * g0 + b0; v1 = v1 * rs * g1 + b1;
            u32x2 wa, wb;
            wa[0] = pk2(siluf_(v0[0]), siluf_(v0[1])); wa[1] = pk2(siluf_(v0[2]), siluf_(v0[3]));
            wb[0] = pk2(siluf_(v1[0]), siluf_(v1[1])); wb[1] = pk2(siluf_(v1[2]), siluf_(v1[3]));
            bf16_t* cp = C2 + (size_t)(r0 + tl) * CD + lane * 4;
            *(u32x2*)cp = wa; *(u32x2*)(cp + 256) = wb;
        }
    }
}

#define XB_TMO      128
#define XB_XCNT(j)  (256  + 64 * (j))
#define XB_XSUB(j)  (1280 + 64 * (j))
#define XB_XGEN(j)  (2304 + 64 * (j))
#define XB_TOP      3328
#define XB_TOPGEN   3392
#define XCD_BAR_WORDS 3456
#define XB_SPIN_CAP (1u << 18)

__device__ __forceinline__ unsigned xb_ld(unsigned* p)              { return __hip_atomic_load(p, __ATOMIC_RELAXED, __HIP_MEMORY_SCOPE_AGENT); }
__device__ __forceinline__ unsigned xb_add(unsigned* p, unsigned v) { return __hip_atomic_fetch_add(p, v, __ATOMIC_RELAXED, __HIP_MEMORY_SCOPE_AGENT); }
__device__ __forceinline__ unsigned xb_xcc_id() { return (unsigned)__builtin_amdgcn_s_getreg((3 << 11) | 20) & 0xFu; }
#define XB_SPIN(cond, bar) do { unsigned _sp = 0; while (cond) { __builtin_amdgcn_s_sleep(1); \
    if ((++_sp & 255u) == 0u) { if (xb_ld(&(bar)[XB_TMO])) break; if (_sp > XB_SPIN_CAP) { atomicAdd(&(bar)[XB_TMO], 1u); break; } } } } while (0)

struct XcdBarrier {
    unsigned* bar; unsigned x;
    volatile LAS unsigned* st;
};

__device__ __forceinline__ XcdBarrier xcd_barrier_post(unsigned* bar, volatile LAS unsigned* st) {
    XcdBarrier b; b.bar = bar; b.x = xb_xcc_id(); b.st = st;
    if (threadIdx.x == 0) (void)xb_add(&bar[XB_XCNT(b.x)], 1u);
    return b;
}
__device__ __forceinline__ void xcd_barrier_complete(unsigned* bar, unsigned x, unsigned& nloc, unsigned& nx) {
    const unsigned G = gridDim.x * gridDim.y * gridDim.z;
    unsigned sum, cnt, mine, sp = 0u;
    for (;;) {
        sum = 0u; cnt = 0u; mine = 0u;
#pragma unroll
        for (unsigned j = 0; j < 16; ++j) { const unsigned c = xb_ld(&bar[XB_XCNT(j)]); sum += c; cnt += (c > 0u) ? 1u : 0u; mine = (j == x) ? c : mine; }
        if (sum == G) break;
        __builtin_amdgcn_s_sleep(1);
        if ((++sp & 255u) == 0u) { if (xb_ld(&bar[XB_TMO])) break; if (sp > XB_SPIN_CAP) { atomicAdd(&bar[XB_TMO], 1u); break; } }
    }
    nloc = mine > 0u ? mine : 1u; nx = cnt > 0u ? cnt : 1u;
}

__device__ __forceinline__ void xcd_barrier(const XcdBarrier& b) {
    asm volatile("s_waitcnt vmcnt(0)" ::: "memory");
    __syncthreads();
    if (threadIdx.x == 0) {
        unsigned* bar = b.bar;
        __builtin_amdgcn_s_waitcnt(0);
        unsigned nloc = b.st[0], nx = b.st[1];
        if (nloc == 0u) { xcd_barrier_complete(bar, b.x, nloc, nx); b.st[0] = nloc; b.st[1] = nx; }
        const unsigned old = xb_add(&bar[XB_XSUB(b.x)], 1u);
        const unsigned gen = old / nloc;
        if (old + 1u == (gen + 1u) * nloc) {
            __builtin_amdgcn_fence(__ATOMIC_RELEASE, "agent");
            asm volatile("s_waitcnt vmcnt(0)" ::: "memory");
            const unsigned og = xb_add(&bar[XB_TOP], 1u);
            const unsigned tg = og / nx;
            if (og + 1u == (tg + 1u) * nx) xb_add(&bar[XB_TOPGEN], 1u);
            else XB_SPIN(xb_ld(&bar[XB_TOPGEN]) == tg, bar);
            __builtin_amdgcn_fence(__ATOMIC_ACQUIRE, "agent");
            xb_add(&bar[XB_XGEN(b.x)], 1u);
            asm volatile("s_waitcnt vmcnt(0)" ::: "memory");
        } else {
            XB_SPIN(xb_ld(&bar[XB_XGEN(b.x)]) == gen, bar);
            __builtin_amdgcn_fence(__ATOMIC_ACQUIRE, "agent");
            asm volatile("s_waitcnt vmcnt(0)" ::: "memory");
        }
    }
    __syncthreads();
}

struct Params { const float* in[16]; float* out; unsigned char* ws; int ph_lo, ph_hi; };

template <int ph>
__device__ __forceinline__ void run_phase(const Params& P, LAS unsigned char* lds) {
    const int G = gridDim.x, bid = blockIdx.x;
    unsigned char* ws = P.ws;
    const float* x = P.in[0];
    float* out = P.out;
    bf16_t* HB = (bf16_t*)(ws + WS_HB); bf16_t* H1B = (bf16_t*)(ws + WS_H1B); bf16_t* Ub = (bf16_t*)(ws + WS_U); bf16_t* VT = (bf16_t*)(ws + WS_VT); bf16_t* Yb = (bf16_t*)(ws + WS_Y);
    bf16_t* C2 = (bf16_t*)(ws + WS_C2); bf16_t* EB = (bf16_t*)(ws + WS_EB);
    float* ssA = (float*)(ws + WS_SSA); float* ssB = (float*)(ws + WS_SSB); float* ssC = (float*)(ws + WS_SSC);
    int tid = threadIdx.x; asm volatile("" : "+v"(tid));
    const int lane = tid & 63, wave = __builtin_amdgcn_readfirstlane(tid >> 6);
    const int gw = bid * 8 + wave, NGW = G * 8;
    if constexpr (ph == 0) {
        LAS float* scr = (LAS float*)(lds + wave * 16384);
        for (int it = gw; it < 2 * 3072; it += NGW) {
            const int l = it / 3072; int r = it - l * 3072;
            unsigned char* wb = ws + (size_t)l * W_LAYER;
            if (r < 1792) { tr_item<true>(P.in[3] + (size_t)l * DM * DIN, DM, DIN, (bf16_t*)(wb + W_IN), P.in[2] + l * DM, scr, r, lane); continue; } r -= 1792;
            if (r < 128) { tr_item<false>(P.in[9] + (size_t)l * CD * CD, CD, CD, (bf16_t*)(wb + W_PW), nullptr, scr, r, lane); continue; } r -= 128;
            if (r < 512) { tr_item<false>(P.in[11] + (size_t)l * DM * DM, DM, DM, (bf16_t*)(wb + W_OUT), nullptr, scr, r, lane, 512); continue; } r -= 512;
            if (r < 512) { tr_item<false>(P.in[13] + (size_t)l * DM * DM, DM, DM, (bf16_t*)(wb + W_PG), P.in[12] + l * DM, scr, r, lane); continue; } r -= 512;
            tr_item<false>(P.in[14] + (size_t)l * PLE * DM, PLE, DM, (bf16_t*)(wb + W_PLE), nullptr, scr, r, lane);
        }
        for (int row = gw; row < MT; row += 2 * NGW) {
            const int row2 = row + NGW;
            const f32x4* xr = (const f32x4*)(x + (size_t)row * DM) + lane;
            const f32x4* xr2 = (const f32x4*)(x + (size_t)(row2 < MT ? row2 : row) * DM) + lane;
            f32x4 va[4], vb[4];
#pragma unroll
            for (int j = 0; j < 4; ++j) { va[j] = xr[64 * j]; vb[j] = xr2[64 * j]; }
            u32x2* ob = (u32x2*)(HB + (size_t)row * DM) + lane;
            float s = 0.f, s2 = 0.f;
#pragma unroll
            for (int j = 0; j < 4; ++j) { const f32x4 v = va[j]; s += (v[0] * v[0] + v[1] * v[1]) + (v[2] * v[2] + v[3] * v[3]); u32x2 w; w[0] = pk2(v[0], v[1]); w[1] = pk2(v[2], v[3]); ob[64 * j] = w; }
            s = wave_sum(s, lane);
            if (lane < 16) ssA[(size_t)row * 16 + lane] = (lane == 0) ? s : 0.f;
            if (row2 < MT) {
                u32x2* ob2 = (u32x2*)(HB + (size_t)row2 * DM) + lane;
#pragma unroll
                for (int j = 0; j < 4; ++j) { const f32x4 v = vb[j]; s2 += (v[0] * v[0] + v[1] * v[1]) + (v[2] * v[2] + v[3] * v[3]); u32x2 w; w[0] = pk2(v[0], v[1]); w[1] = pk2(v[2], v[3]); ob2[64 * j] = w; }
                s2 = wave_sum(s2, lane);
                if (lane < 16) ssA[(size_t)row2 * 16 + lane] = (lane == 0) ? s2 : 0.f;
            }
        }
        {
            const f32x4* pp = (const f32x4*)P.in[1]; u32x2* pb = (u32x2*)(ws + WS_PB);
            const int NV = 2 * MT * PLE / 4, stp = G * 512;
            for (int i = bid * 512 + tid; i < NV; i += 4 * stp) {
                f32x4 v[4];
#pragma unroll
                for (int j = 0; j < 4; ++j) { const int ii = i + j * stp; v[j] = pp[ii < NV ? ii : i]; }
#pragma unroll
                for (int j = 0; j < 4; ++j) { const int ii = i + j * stp; if (ii < NV) { u32x2 w; w[0] = pk2(v[j][0], v[j][1]); w[1] = pk2(v[j][2], v[j][3]); pb[ii] = w; } }
            }
        }
    } else if constexpr (ph == NPHASE - 1) {
        const float* fg = P.in[15];
        for (int row = gw; row < MT; row += 2 * NGW) {
            const int row2 = row + NGW; const bool has2 = row2 < MT;
            f32x4* xr = (f32x4*)(out + (size_t)row * DM) + lane;
            f32x4* xr2 = (f32x4*)(out + (size_t)(has2 ? row2 : row) * DM) + lane;
            f32x4 v[4], v2[4], gg[4]; float s = 0.f, s2 = 0.f;
#pragma unroll
            for (int j = 0; j < 4; ++j) { v[j] = xr[64 * j]; v2[j] = xr2[64 * j]; gg[j] = *((const f32x4*)fg + lane + 64 * j); }
#pragma unroll
            for (int j = 0; j < 4; ++j) { s += (v[j][0] * v[j][0] + v[j][1] * v[j][1]) + (v[j][2] * v[j][2] + v[j][3] * v[j][3]); s2 += (v2[j][0] * v2[j][0] + v2[j][1] * v2[j][1]) + (v2[j][2] * v2[j][2] + v2[j][3] * v2[j][3]); }
            const float rs = frsq(wave_sum(s, lane) * (1.0f / DM) + EPS), rs2 = frsq(wave_sum(s2, lane) * (1.0f / DM) + EPS);
#pragma unroll
            for (int j = 0; j < 4; ++j) xr[64 * j] = v[j] * rs * gg[j];
            if (has2) {
#pragma unroll
                for (int j = 0; j < 4; ++j) xr2[64 * j] = v2[j] * rs2 * gg[j];
            }
        }
    } else {
        constexpr int l = (ph - 1) / 5, k = (ph - 1) % 5;
        unsigned char* wb = ws + (size_t)l * W_LAYER;
        if constexpr (k == 0) {
            pg8::Gemm g{HB, (const bf16_t*)(wb + W_IN), MT, DIN, DM}; pg8::StaticOrder S; S.init(MT, DIN, G, bid);
            EpiIn E{Ub, VT, ssA};
            pg8::gemm_phase<EpiIn, pg8::StaticOrder, true, true>(lds, g, S, E, threadIdx.x);
        } else if constexpr (k == 1) {
            const float* aog = P.in[4] + l * HD;
            const float* dww = P.in[5] + (size_t)l * CWID * CD; const float* dwb = P.in[6] + l * CD;
            const float* lng = P.in[7] + l * CD; const float* lnb = P.in[8] + l * CD;
            for (int it = bid; it < 256; it += G) {
                const int bh = it >> 2, pr = it & 3, b = bh >> 3, h = bh & 7;
#pragma unroll 1
                for (int uu = 0; uu < ((PROBE_DUP & 2) ? 4 : 2); ++uu) attn_unit(Ub, VT, Yb, aog, b, h, (uu & 1) == 0 ? 7 - pr : pr, lds);
#pragma unroll 1
                for (int uu = 0; uu < ((PROBE_DUP & 4) ? 4 : 2); ++uu) convpre_unit(Ub, C2, dww, dwb, lng, lnb, 2 * it + (uu & 1), lds);
            }
            __syncthreads();
        } else if constexpr (k == 2) {
            const int nb0 = G / 2;
            {
                pg8::Gemm g{C2, (const bf16_t*)(wb + W_PW), MT, CD, CD}; SubOrder S; S.init(MT, CD, nb0, bid);
                EpiPw E{Ub, Yb, P.in[10] + l * CD, ssC};
                pg8::gemm_phase<EpiPw, SubOrder, true, true>(lds, g, S, E, threadIdx.x);
            }
            {
                pg8::Gemm g{(const bf16_t*)(ws + WS_PB) + (size_t)l * MT * PLE, (const bf16_t*)(wb + W_PLE), MT, DM, PLE}; SubOrder S; S.init(MT, DM, G - nb0, bid - nb0);
                EpiE E{EB};
                int t2 = threadIdx.x; asm volatile("" : "+v"(t2));
                pg8::gemm_phase<EpiE, SubOrder, true, true>(lds, g, S, E, t2);
            }
        } else if constexpr (k == 3) {
            pg8::Gemm g{Yb, (const bf16_t*)(wb + W_OUT), MT, DM, DM}; pg8::StaticOrder S; S.init(MT, DM, G, bid);
            EpiOut<(l > 0)> E{x, HB, H1B, ssB, ssC};
            pg8::gemm_phase<EpiOut<(l > 0)>, pg8::StaticOrder, true, true>(lds, g, S, E, threadIdx.x);
        } else {
            pg8::Gemm g{H1B, (const bf16_t*)(wb + W_PG), MT, DM, DM}; pg8::StaticOrder S; S.init(MT, DM, G, bid);
            EpiGate<(l == 1)> E{out, H1B, EB, HB, ssB, ssA, 0};
            pg8::gemm_phase<EpiGate<(l == 1)>, pg8::StaticOrder, true, true>(lds, g, S, E, threadIdx.x);
            if constexpr ((PROBE_DUP & 128) != 0) { int t3 = threadIdx.x; asm volatile("" : "+v"(t3)); pg8::gemm_phase<EpiGate<(l == 1)>, pg8::StaticOrder, true, true>(lds, g, S, E, t3); }
        }
    }
}

__global__ void __launch_bounds__(512, 2) fwd(Params P) {
    extern __shared__ __attribute__((aligned(16))) unsigned char lds_raw[];
    LAS unsigned char* lds = (LAS unsigned char*)lds_raw;
    const int lo = P.ph_lo, hi = P.ph_hi;
    volatile LAS unsigned* st = (volatile LAS unsigned*)(lds + LDS_BYTES - 64);
    if (threadIdx.x < 16) st[threadIdx.x] = 0u;
    __syncthreads();
    const XcdBarrier bar = xcd_barrier_post((unsigned*)(P.ws + WS_CTL), st);
#define PROBE_PH(k) ((((PROBE_DUP) & 8) && (k) == 0) || (((PROBE_DUP) & 1) && (k) == 1) || (((PROBE_DUP) & 32) && ((k) == 3 || (k) == 8)) || (((PROBE_DUP) & 16) && (k) == 4))
#define SEAM() do { if (hi > NPHASE) cg::this_grid().sync(); else xcd_barrier(bar); } while (0)
#define PHASE(k) if (lo <= (k) && (k) < hi) { run_phase<(k)>(P, lds); if constexpr (PROBE_PH(k)) { __syncthreads(); run_phase<(k)>(P, lds); } \
        if constexpr (((PROBE_DUP) & 64) != 0) { SEAM(); } if ((k) + 1 < hi) SEAM(); }
    PHASE(0) PHASE(1) PHASE(2) PHASE(3) PHASE(4) PHASE(5) PHASE(6) PHASE(7) PHASE(8) PHASE(9) PHASE(10) PHASE(11)
#undef PHASE
#undef SEAM
}

#ifndef MK_N_LAUNCHES
#define MK_N_LAUNCHES 1
#endif
extern "C" void kernel_launch(void* const* d_in, const int* in_sizes, int n_in, void* d_out, int out_size, void* d_ws, size_t ws_size, hipStream_t stream) {
    static int grid = 0;
    if (grid == 0) {
        if (n_in != 16 || out_size != MT * DM || ws_size < WS_END) { fprintf(stderr, "kernel_launch: unexpected shapes (n_in %d, out %d, ws %zu)\n", n_in, out_size, ws_size); grid = -1; return; }
        int dev = 0, cus = 0, per_cu = 0;
        (void)hipGetDevice(&dev);
        (void)hipDeviceGetAttribute(&cus, hipDeviceAttributeMultiprocessorCount, dev);
        if (hipFuncSetAttribute((const void*)fwd, hipFuncAttributeMaxDynamicSharedMemorySize, LDS_BYTES) != hipSuccess) { fprintf(stderr, "kernel_launch: hipFuncSetAttribute failed\n"); grid = -1; return; }
        if (hipOccupancyMaxActiveBlocksPerMultiprocessor(&per_cu, (const void*)fwd, 512, LDS_BYTES) != hipSuccess || per_cu < 1) { fprintf(stderr, "kernel_launch: occupancy query says %d\n", per_cu); per_cu = 1; }
        (void)hipGetLastError();
        grid = cus * 1;
        if (grid <= 0) grid = 256;
    }
    if (grid < 0) return;
    if (hipMemsetAsync((unsigned char*)d_ws + WS_CTL, 0, CTL_BYTES, stream) != hipSuccess) { fprintf(stderr, "kernel_launch: memset of barrier words failed\n"); return; }
    Params p{};
    for (int i = 0; i < 16; ++i) p.in[i] = (const float*)d_in[i];
    p.out = (float*)d_out; p.ws = (unsigned char*)d_ws;
#if MK_N_LAUNCHES == 1
    p.ph_lo = 0; p.ph_hi = NPHASE;
    void* args[] = {&p};
    hipError_t e = hipLaunchCooperativeKernel((const void*)fwd, dim3(grid), dim3(512), args, LDS_BYTES, stream);
    if (e != hipSuccess) fprintf(stderr, "kernel_launch: cooperative launch failed: %s (grid %d)\n", hipGetErrorString(e), grid);
#else
    for (int ph = 0; ph < NPHASE; ++ph) {
        p.ph_lo = ph; p.ph_hi = ph + 1;
        hipLaunchKernelGGL(fwd, dim3(grid), dim3(512), LDS_BYTES, stream, p);
    }
#endif
}
```

```cpp
#include <hip/hip_runtime.h>
#include <hip/hip_cooperative_groups.h>
#include <cstdio>
#include <cstdint>
namespace cg = cooperative_groups;
namespace pg8 {
#define PG8_LAS __attribute__((address_space(3)))
typedef unsigned short bf16_t;
typedef short bf16x8 __attribute__((ext_vector_type(8)));
typedef float f32x4 __attribute__((ext_vector_type(4)));
typedef unsigned u32x4 __attribute__((ext_vector_type(4)));
constexpr int BM = 256, BK = 64, HALF = 128, HTB = HALF * BK * 2  , STAGE_BYTES = 8 * HTB, NXCD = 8, WGM = 8;

__host__ __device__ __forceinline__ int lds_byte(int r, int c) { const int st = (r >> 4) * 2 + (c >> 5), rr = r & 15, cc = c & 31, ob = rr * 64 + cc * 2; return st * 1024 + (ob ^ (((ob >> 9) & 1) << 5)); }
__host__ __device__ __forceinline__ void stage_rc(int b, int& R, int& C) { const int st = b / 1024, sb = b % 1024, swz = sb ^ (((sb >> 9) & 1) << 5); R = (st >> 1) * 16 + swz / 64; C = (st & 1) * 32 + (swz % 64) / 2; }
__host__ __device__ __forceinline__ int perm32(int rho) { const int n = rho >> 4, i = rho & 15; return 8 * (i >> 2) + 4 * n + (i & 3); }

struct Unit { int pm, pn; };
struct Gemm { const bf16_t* A; const bf16_t* Bt; int M, N, K; };

struct StaticOrder {
    int nM, nN, nwg, G, c;
    __host__ __device__ void init(int M, int N, int G_, int c_) { nM = M / BM; nN = N / BM; nwg = nM * nN; G = G_; c = c_; }
    __host__ __device__ bool next(int i, Unit& u) const {
        const long L = (long)i * G + c; if (L >= nwg) return false;
        int wgid = (int)L; { const int q = nwg / NXCD, r = nwg % NXCD, xcd = wgid % NXCD, off = wgid / NXCD; wgid = (xcd < r ? xcd * (q + 1) : r * (q + 1) + (xcd - r) * q) + off; }
        const int nig = WGM * nN, gid = wgid / nig, fm = gid * WGM, gsz = (nM - fm) < WGM ? (nM - fm) : WGM;
        u.pm = fm + ((wgid % nig) % gsz); u.pn = (wgid % nig) / gsz; return true;
    }
    __device__ __forceinline__ void a_ready(const Unit&) const {}
    __device__ __forceinline__ void done(const Unit&) const {}
};

template <class Epi, class Sched, bool ALIGN_EPI = false, bool SP2 = false>
__device__ __forceinline__ void gemm_phase(PG8_LAS unsigned char* lds, const Gemm g, const Sched& S, const Epi& E, const int tid_in) {
    const int tid = tid_in, wid = __builtin_amdgcn_readfirstlane(tid >> 6), lane = tid & 63, wr = wid >> 2, wc = wid & 3, fr = lane & 15, fq = lane >> 4;
    const int K = g.K, nt = K / BK;
    unsigned voffA[2], voffB[2];
#pragma unroll
    for (int i = 0; i < 2; ++i) { int R, C; stage_rc(tid * 16 + i * 8192, R, C); const int Rb = Epi::PERM ? ((R & ~31) + perm32(R & 31)) : R;
        voffA[i] = (unsigned)(R * K + C) * 2u; voffB[i] = (unsigned)(Rb * K + C) * 2u; }
    const size_t kstep = (size_t)(BK * 2);
    const size_t hstep = (size_t)HALF * K * 2;
    const size_t tstep = 2 * hstep;
    const unsigned ldsw = (unsigned)wid * 1024u;
    const int aoff = lds_byte(wr * 64 + fr, fq * 8), boff = lds_byte(wc * 32 + fr, fq * 8);
#define PG8_SA(b, h) (((b) * 2 + (h)) * HTB)
#define PG8_SB(b, h) ((4 + (b) * 2 + (h)) * HTB)
#define PG8_STAGE(bufoff, gbase, voff) do { _Pragma("unroll") for (int _i = 0; _i < 2; ++_i) \
        __builtin_amdgcn_global_load_lds((const unsigned*)((const char*)(gbase) + (voff)[_i]), (PG8_LAS unsigned*)(lds + (bufoff) + ldsw + _i * 8192), 16, 0, 0); } while (0)
#define PG8_LDA(dst, b, h) do { _Pragma("unroll") for (int m = 0; m < 4; ++m) _Pragma("unroll") for (int k = 0; k < 2; ++k) dst[m][k] = *(const PG8_LAS bf16x8*)(lds + PG8_SA(b, h) + aoff + m * 2048 + k * 1024); } while (0)
#define PG8_LDB(dst, b, h) do { _Pragma("unroll") for (int n = 0; n < 2; ++n) _Pragma("unroll") for (int k = 0; k < 2; ++k) dst[n][k] = *(const PG8_LAS bf16x8*)(lds + PG8_SB(b, h) + boff + n * 2048 + k * 1024); } while (0)
#define PG8_MMA(ai, bj, At, Bt) do { __builtin_amdgcn_s_setprio(1); _Pragma("unroll") for (int m = 0; m < 4; ++m) _Pragma("unroll") for (int n = 0; n < 2; ++n) _Pragma("unroll") for (int k = 0; k < 2; ++k) \
        acc[ai][bj][m][n] = __builtin_amdgcn_mfma_f32_16x16x32_bf16(Bt[n][k], At[m][k], acc[ai][bj][m][n], 0, 0, 0); __builtin_amdgcn_s_setprio(0); } while (0)
#define PG8_WAIT_V(n) asm volatile("s_waitcnt vmcnt(" #n ")" ::: "memory")
#define PG8_WAIT_L(n) asm volatile("s_waitcnt lgkmcnt(" #n ")" ::: "memory")
#define PG8_BAR __builtin_amdgcn_s_barrier()
#define PG8_SCHED __builtin_amdgcn_sched_barrier(0)
    Unit cur, nxt; int ui = 0;
    if (!S.next(0, cur)) return;
    f32x4 acc[2][2][4][2];
#pragma unroll
    for (int a = 0; a < 2; ++a)
#pragma unroll
        for (int b = 0; b < 2; ++b)
#pragma unroll
            for (int m = 0; m < 4; ++m)
#pragma unroll
                for (int n = 0; n < 2; ++n) acc[a][b][m][n] = (f32x4){0.f, 0.f, 0.f, 0.f};
    bf16x8 At[4][2], B0[2][2], B1[2][2];
    const char* cA = (const char*)g.A + (size_t)cur.pm * tstep; const char* cB = (const char*)g.Bt + (size_t)cur.pn * tstep;
    S.a_ready(cur);
    if constexpr (SP2) {
        PG8_STAGE(PG8_SB(0, 0), cB, voffB); PG8_STAGE(PG8_SB(0, 1), cB + hstep, voffB); PG8_STAGE(PG8_SA(0, 0), cA, voffA); PG8_STAGE(PG8_SA(0, 1), cA + hstep, voffA);
        if (wr == 1) PG8_BAR;
        PG8_WAIT_V(2); PG8_BAR;
        PG8_STAGE(PG8_SB(1, 0), cB + kstep, voffB); PG8_STAGE(PG8_SA(1, 0), cA + kstep, voffA); PG8_STAGE(PG8_SB(1, 1), cB + hstep + kstep, voffB);
        PG8_WAIT_V(6); PG8_BAR;
    } else {
        PG8_STAGE(PG8_SB(0, 0), cB, voffB); PG8_STAGE(PG8_SA(0, 0), cA, voffA); PG8_STAGE(PG8_SB(0, 1), cB + hstep, voffB); PG8_STAGE(PG8_SA(0, 1), cA + hstep, voffA);
        if (wr == 1) PG8_BAR;
        PG8_WAIT_V(4); PG8_BAR;
        PG8_STAGE(PG8_SB(1, 0), cB + kstep, voffB); PG8_STAGE(PG8_SA(1, 0), cA + kstep, voffA); PG8_STAGE(PG8_SB(1, 1), cB + hstep + kstep, voffB);
        PG8_WAIT_V(6); PG8_BAR;
    }
    for (;;) {
        const bool has_next = S.next(ui + 1, nxt);
        const char* nA = has_next ? (const char*)g.A + (size_t)nxt.pm * tstep : cA; const char* nB = has_next ? (const char*)g.Bt + (size_t)nxt.pn * tstep : cB;
        for (int t = 0; t < nt; t += 2) {
            if constexpr (Epi::MID_T > 0) { if (t == Epi::MID_T) E.mid(acc, cur); }
            const bool last = (t == nt - 2);
            const char* a1 = cA + (size_t)(t + 1) * kstep;
            const char* a2 = last ? nA : cA + (size_t)(t + 2) * kstep; const char* b2 = last ? nB : cB + (size_t)(t + 2) * kstep;
            const char* a3 = a2 + kstep; const char* b3 = b2 + kstep;
            if (last && has_next) S.a_ready(nxt);
            if constexpr (SP2) {
            PG8_LDB(B0, 0, 0); PG8_LDB(B1, 0, 1); PG8_SCHED; PG8_LDA(At, 0, 0); PG8_STAGE(PG8_SA(1, 1), a1 + hstep, voffA);
            PG8_WAIT_V(8); PG8_WAIT_L(0); PG8_BAR; PG8_MMA(0, 0, At, B0); PG8_MMA(0, 1, At, B1); PG8_BAR; PG8_SCHED;
            PG8_LDA(At, 0, 1); PG8_STAGE(PG8_SB(0, 0), b2, voffB); PG8_STAGE(PG8_SB(0, 1), b2 + hstep, voffB); PG8_STAGE(PG8_SA(0, 0), a2, voffA);
            PG8_WAIT_V(8); PG8_WAIT_L(0); PG8_BAR; PG8_MMA(1, 0, At, B0); PG8_MMA(1, 1, At, B1); PG8_BAR; PG8_SCHED;
            PG8_LDB(B0, 1, 0); PG8_LDB(B1, 1, 1); PG8_SCHED; PG8_LDA(At, 1, 0); PG8_STAGE(PG8_SA(0, 1), a2 + hstep, voffA);
            PG8_WAIT_V(8); PG8_WAIT_L(0); PG8_BAR; PG8_MMA(0, 0, At, B0); PG8_MMA(0, 1, At, B1); PG8_BAR; PG8_SCHED;
            PG8_LDA(At, 1, 1); PG8_STAGE(PG8_SB(1, 0), b3, voffB); PG8_STAGE(PG8_SB(1, 1), b3 + hstep, voffB); PG8_STAGE(PG8_SA(1, 0), a3, voffA);
            PG8_WAIT_V(8); PG8_WAIT_L(0); PG8_BAR; PG8_MMA(1, 0, At, B0); PG8_MMA(1, 1, At, B1); PG8_BAR; PG8_SCHED;
            } else {
            PG8_LDB(B0, 0, 0); PG8_SCHED; PG8_LDA(At, 0, 0); PG8_STAGE(PG8_SA(1, 1), a1 + hstep, voffA);
            PG8_WAIT_L(8); PG8_BAR; PG8_WAIT_L(0); PG8_MMA(0, 0, At, B0); PG8_BAR; PG8_SCHED;
            PG8_LDB(B1, 0, 1); PG8_STAGE(PG8_SB(0, 0), b2, voffB);
            PG8_BAR; PG8_WAIT_L(0); PG8_MMA(0, 1, At, B1); PG8_BAR;
            PG8_LDA(At, 0, 1); PG8_STAGE(PG8_SA(0, 0), a2, voffA);
            PG8_BAR; PG8_WAIT_L(0); PG8_MMA(1, 0, At, B0); PG8_BAR; PG8_SCHED;
            PG8_STAGE(PG8_SB(0, 1), b2 + hstep, voffB);
            PG8_WAIT_V(6); PG8_BAR; PG8_MMA(1, 1, At, B1); PG8_BAR;
            PG8_LDB(B0, 1, 0); PG8_SCHED; PG8_LDA(At, 1, 0); PG8_STAGE(PG8_SA(0, 1), a2 + hstep, voffA);
            PG8_WAIT_L(8); PG8_BAR; PG8_WAIT_L(0); PG8_MMA(0, 0, At, B0); PG8_BAR; PG8_SCHED;
            PG8_LDB(B1, 1, 1); PG8_STAGE(PG8_SB(1, 0), b3, voffB);
            PG8_BAR; PG8_WAIT_L(0); PG8_MMA(0, 1, At, B1); PG8_BAR;
            PG8_LDA(At, 1, 1); PG8_STAGE(PG8_SA(1, 0), a3, voffA);
            PG8_BAR; PG8_WAIT_L(0); PG8_MMA(1, 0, At, B0); PG8_BAR; PG8_SCHED;
            PG8_STAGE(PG8_SB(1, 1), b3 + hstep, voffB);
            PG8_WAIT_V(6); PG8_BAR; PG8_MMA(1, 1, At, B1); PG8_BAR;
            }
        }
        if constexpr (ALIGN_EPI) { if (wr == 0) PG8_BAR; }
        if constexpr (!Epi::AFTER_DRAIN) { E(acc, cur, wr, wc, fr, fq); S.done(cur); }
        if (!has_next) break;
#pragma unroll
        for (int a = 0; a < 2; ++a)
#pragma unroll
            for (int b = 0; b < 2; ++b)
#pragma unroll
                for (int m = 0; m < 4; ++m)
#pragma unroll
                    for (int n = 0; n < 2; ++n) acc[a][b][m][n] = (f32x4){0.f, 0.f, 0.f, 0.f};
        cur = nxt; cA = nA; cB = nB; ++ui;
        if constexpr (ALIGN_EPI) { if (wr == 1) PG8_BAR; }
    }
    PG8_WAIT_V(0);
    if constexpr (!ALIGN_EPI) { if (wr == 0) PG8_BAR; }
    PG8_BAR;
    if constexpr (Epi::AFTER_DRAIN) { E.fused(acc, cur, wr, wc, fr, fq, lds, wid, lane); S.done(cur); }
#undef PG8_SA
#undef PG8_SB
#undef PG8_STAGE
#undef PG8_LDA
#undef PG8_LDB
#undef PG8_MMA
#undef PG8_WAIT_V
#undef PG8_WAIT_L
#undef PG8_BAR
#undef PG8_SCHED
}
}

#define LAS __attribute__((address_space(3)))
typedef unsigned short bf16_t;
typedef short bf16x8 __attribute__((ext_vector_type(8)));
typedef float f32x4 __attribute__((ext_vector_type(4)));
typedef float f32x2 __attribute__((ext_vector_type(2)));
typedef float f32x16 __attribute__((ext_vector_type(16)));
typedef unsigned u32x4 __attribute__((ext_vector_type(4)));
typedef unsigned u32x2 __attribute__((ext_vector_type(2)));
typedef __bf16 bf16x2_t __attribute__((ext_vector_type(2)));

constexpr int NB = 8, SEQ = 2048, DM = 1024, MT = NB * SEQ, DIN = 3584, NH = 8, HD = 64, CWID = 31, PLE = 256, CD = 512;
constexpr float EPS = 1e-6f;
constexpr float QSCALE = 0.125f * 1.4426950408889634f;

constexpr size_t MiB = 1u << 20;
constexpr size_t W_IN = 0, W_PW = 7340032, W_OUT = W_PW + 524288, W_PG = W_OUT + 2097152, W_PLE = W_PG + 2097152, W_LAYER = 12 * MiB;
static_assert(W_PLE + 524288 == W_LAYER, "weight map");
constexpr int UP = 2560, UQ = 0, UK = 512, USGA = 1024, UGLU = 1536, USGC = 2048;
constexpr size_t WS_PB = 24 * MiB, WS_HB = 40 * MiB, WS_Y = 72 * MiB, WS_VT = 104 * MiB, WS_SSA = 120 * MiB, WS_SSB = 121 * MiB, WS_SSC = 122 * MiB, WS_U = 123 * MiB;
constexpr size_t WS_H1B = WS_U  , WS_C2 = 203 * MiB, WS_EB = 219 * MiB, WS_CTL = 252 * MiB, CTL_BYTES = 16384, WS_END = WS_CTL + CTL_BYTES;
static_assert(WS_U + (size_t)MT * UP * 2 <= WS_C2, "ws map");
constexpr int LDS_BYTES = 147456;
constexpr int NPHASE = 12;
#ifndef PROBE_DUP
#define PROBE_DUP 0
#endif

__device__ __forceinline__ unsigned pk2(float lo, float hi) { f32x2 v = {lo, hi}; bf16x2_t b = __builtin_convertvector(v, bf16x2_t); return __builtin_bit_cast(unsigned, b); }
__device__ __forceinline__ float bflo(unsigned u) { return __builtin_bit_cast(float, u << 16); }
__device__ __forceinline__ float bfhi(unsigned u) { return __builtin_bit_cast(float, u & 0xffff0000u); }
__device__ __forceinline__ float fexp2(float x) { return __builtin_amdgcn_exp2f(x); }
__device__ __forceinline__ float flog2(float x) { return __builtin_amdgcn_logf(x); }
__device__ __forceinline__ float frcp(float x) { return __builtin_amdgcn_rcpf(x); }
__device__ __forceinline__ float frsq(float x) { return __builtin_amdgcn_rsqf(x); }
__device__ __forceinline__ float sigmoidf_(float x) { return frcp(1.0f + fexp2(-1.4426950408889634f * x)); }
__device__ __forceinline__ float siluf_(float x) { return x * sigmoidf_(x); }
#define MFMA32(a, b, c) __builtin_amdgcn_mfma_f32_32x32x16_bf16((a), (b), (c), 0, 0, 0)

__device__ __forceinline__ float shx(float v, int m, int lane) { return __builtin_bit_cast(float, __builtin_amdgcn_ds_bpermute((lane ^ m) << 2, __builtin_bit_cast(int, v))); }
__device__ __forceinline__ float wave_sum(float v, int lane) {
#pragma unroll
    for (int o = 1; o < 64; o <<= 1) v += shx(v, o, lane);
    return v;
}
__device__ __forceinline__ float row_rstd(const float* ss, int row, int fq, int lane) {
    const f32x4 p = *(const f32x4*)(ss + (size_t)row * 16 + fq * 4);
    float s = (p[0] + p[1]) + (p[2] + p[3]);
    s += shx(s, 16, lane); s += shx(s, 32, lane);
    return frsq(s * (1.0f / DM) + EPS);
}

struct EpiIn {
    static constexpr bool PERM = true, AFTER_DRAIN = false; static constexpr int MID_T = 0;
    bf16_t* U; bf16_t* VT; const float* ss;
    __device__ __forceinline__ void operator()(const f32x4 (&acc)[2][2][4][2], const pg8::Unit& u, int, int, int, int) const {
        int t_ = threadIdx.x; asm volatile("" : "+v"(t_));
        const int lane = t_ & 63, fr = lane & 15, fq = lane >> 4, wid_ = __builtin_amdgcn_readfirstlane(t_ >> 6), wr = wid_ >> 2, wc = wid_ & 3;
        const int pn = u.pn;
        f32x4 pp[2][4];
#pragma unroll
        for (int ai = 0; ai < 2; ++ai)
#pragma unroll
            for (int m = 0; m < 4; ++m) pp[ai][m] = *(const f32x4*)(ss + (size_t)(u.pm * 256 + ai * 128 + wr * 64 + m * 16 + fr) * 16 + fq * 4);
#pragma unroll
        for (int ai = 0; ai < 2; ++ai)
#pragma unroll
            for (int m = 0; m < 4; ++m) {
                const int row = u.pm * 256 + ai * 128 + wr * 64 + m * 16 + fr;
                float s_ = (pp[ai][m][0] + pp[ai][m][1]) + (pp[ai][m][2] + pp[ai][m][3]);
                s_ += shx(s_, 16, lane); s_ += shx(s_, 32, lane);
                const float rs = frsq(s_ * (1.0f / DM) + EPS);
#pragma unroll
                for (int bj = 0; bj < 2; ++bj) {
                    const int col0 = pn * 256 + bj * 128 + wc * 32 + 8 * fq;
                    f32x4 v0 = acc[ai][bj][m][0] * rs, v1 = acc[ai][bj][m][1] * rs;
                    if (pn < 4) {
                        const float sc = pn < 2 ? QSCALE : 1.0f;
                        v0 = v0 * sc; v1 = v1 * sc;
                        u32x4 w; w[0] = pk2(v0[0], v0[1]); w[1] = pk2(v0[2], v0[3]); w[2] = pk2(v1[0], v1[1]); w[3] = pk2(v1[2], v1[3]);
                        *(u32x4*)(U + (size_t)row * UP + col0) = w;
                    } else if (pn < 6) {
                        const int vc = col0 - 1024, hh = vc >> 6, d0 = vc & 63, b = row >> 11, s = row & 2047;
                        bf16_t* vp = VT + ((size_t)((b * NH + hh) * HD + d0)) * SEQ + s;
                        const unsigned w0 = pk2(v0[0], v0[1]), w1 = pk2(v0[2], v0[3]), w2 = pk2(v1[0], v1[1]), w3 = pk2(v1[2], v1[3]);
                        vp[0 * SEQ] = (bf16_t)(w0 & 0xffffu); vp[1 * SEQ] = (bf16_t)(w0 >> 16);
                        vp[2 * SEQ] = (bf16_t)(w1 & 0xffffu); vp[3 * SEQ] = (bf16_t)(w1 >> 16);
                        vp[4 * SEQ] = (bf16_t)(w2 & 0xffffu); vp[5 * SEQ] = (bf16_t)(w2 >> 16);
                        vp[6 * SEQ] = (bf16_t)(w3 & 0xffffu); vp[7 * SEQ] = (bf16_t)(w3 >> 16);
                    } else if (pn < 8 || pn >= 12) {
                        u32x4 w; w[0] = pk2(siluf_(v0[0]), siluf_(v0[1])); w[1] = pk2(siluf_(v0[2]), siluf_(v0[3]));
                        w[2] = pk2(siluf_(v1[0]), siluf_(v1[1])); w[3] = pk2(siluf_(v1[2]), siluf_(v1[3]));
                        *(u32x4*)(U + (size_t)row * UP + (pn < 8 ? col0 - 512 : col0 - 1024)) = w;
                    } else {
                        const int ch0 = (col0 - 2048) >> 1;
                        u32x2 w; w[0] = pk2(v0[0] * sigmoidf_(v0[1]), v0[2] * sigmoidf_(v0[3])); w[1] = pk2(v1[0] * sigmoidf_(v1[1]), v1[2] * sigmoidf_(v1[3]));
                        *(u32x2*)(U + (size_t)row * UP + UGLU + ch0) = w;
                    }
                }
                asm volatile("" ::: "memory");
            }
    }
};

struct EpiPw {
    static constexpr bool PERM = true, AFTER_DRAIN = false; static constexpr int MID_T = 0;
    const bf16_t* U; bf16_t* Y; const float* cog; float* ssC;
    __device__ __forceinline__ void operator()(const f32x4 (&acc)[2][2][4][2], const pg8::Unit& u, int, int, int, int) const {
        int t_ = threadIdx.x; asm volatile("" : "+v"(t_));
        const int lane = t_ & 63, fr = lane & 15, fq = lane >> 4, wid_ = __builtin_amdgcn_readfirstlane(t_ >> 6), wr = wid_ >> 2, wc = wid_ & 3;
#pragma unroll
        for (int ai = 0; ai < 2; ++ai)
#pragma unroll
            for (int m = 0; m < 4; ++m) {
                const int row = u.pm * 256 + ai * 128 + wr * 64 + m * 16 + fr;
                float sq = 0.f;
#pragma unroll
                for (int bj = 0; bj < 2; ++bj) {
                    const int col0 = u.pn * 256 + bj * 128 + wc * 32 + 8 * fq;
                    const f32x4 v0 = acc[ai][bj][m][0], v1 = acc[ai][bj][m][1];
                    sq += (v0[0] * v0[0] + v0[1] * v0[1]) + (v0[2] * v0[2] + v0[3] * v0[3]) + (v1[0] * v1[0] + v1[1] * v1[1]) + (v1[2] * v1[2] + v1[3] * v1[3]);
                    const f32x4 g0 = *(const f32x4*)(cog + col0), g1 = *(const f32x4*)(cog + col0 + 4);
                    const u32x4 sg = *(const u32x4*)(U + (size_t)row * UP + USGC + col0);
                    u32x4 w;
                    w[0] = pk2(v0[0] * g0[0] * bflo(sg[0]), v0[1] * g0[1] * bfhi(sg[0])); w[1] = pk2(v0[2] * g0[2] * bflo(sg[1]), v0[3] * g0[3] * bfhi(sg[1]));
                    w[2] = pk2(v1[0] * g1[0] * bflo(sg[2]), v1[1] * g1[1] * bfhi(sg[2])); w[3] = pk2(v1[2] * g1[2] * bflo(sg[3]), v1[3] * g1[3] * bfhi(sg[3]));
                    *(u32x4*)(Y + (size_t)row * DM + col0) = w;
                }
                sq += shx(sq, 16, lane); sq += shx(sq, 32, lane);
                if (fq == 0) ssC[(size_t)row * 8 + u.pn * 4 + wc] = sq;
                asm volatile("" ::: "memory");
            }
    }
};

struct EpiE {
    static constexpr bool PERM = true, AFTER_DRAIN = false; static constexpr int MID_T = 0;
    bf16_t* EB;
    __device__ __forceinline__ void operator()(const f32x4 (&acc)[2][2][4][2], const pg8::Unit& u, int, int, int, int) const {
        int t_ = threadIdx.x; asm volatile("" : "+v"(t_));
        const int lane = t_ & 63, fr = lane & 15, fq = lane >> 4, wid_ = __builtin_amdgcn_readfirstlane(t_ >> 6), wr = wid_ >> 2, wc = wid_ & 3;
#pragma unroll
        for (int ai = 0; ai < 2; ++ai)
#pragma unroll
            for (int m = 0; m < 4; ++m) {
                const int row = u.pm * 256 + ai * 128 + wr * 64 + m * 16 + fr;
#pragma unroll
                for (int bj = 0; bj < 2; ++bj) {
                    const int col0 = u.pn * 256 + bj * 128 + wc * 32 + 8 * fq;
                    const f32x4 v0 = acc[ai][bj][m][0], v1 = acc[ai][bj][m][1];
                    u32x4 w; w[0] = pk2(v0[0], v0[1]); w[1] = pk2(v0[2], v0[3]); w[2] = pk2(v1[0], v1[1]); w[3] = pk2(v1[2], v1[3]);
                    *(u32x4*)(EB + (size_t)row * DM + col0) = w;
                }
                asm volatile("" ::: "memory");
            }
    }
};

template <bool BB> struct EpiOut {
    static constexpr bool PERM = true, AFTER_DRAIN = false; static constexpr int MID_T = 8;
    const float* base; const bf16_t* baseb; bf16_t* HB; float* ss; const float* ssC;
    __device__ __forceinline__ void mid(f32x4 (&acc)[2][2][4][2], const pg8::Unit& u) const {
        int t_ = threadIdx.x; asm volatile("" : "+v"(t_));
        const int lane = t_ & 63, fr = lane & 15, fq = lane >> 4, wid_ = __builtin_amdgcn_readfirstlane(t_ >> 6), wr = wid_ >> 2;
        f32x2 pc[2][4];
#pragma unroll
        for (int ai = 0; ai < 2; ++ai)
#pragma unroll
            for (int m = 0; m < 4; ++m) pc[ai][m] = *(const f32x2*)(ssC + (size_t)(u.pm * 256 + ai * 128 + wr * 64 + m * 16 + fr) * 8 + fq * 2);
#pragma unroll
        for (int ai = 0; ai < 2; ++ai)
#pragma unroll
            for (int m = 0; m < 4; ++m) {
                const f32x2 p = pc[ai][m];
                float s = p[0] + p[1];
                s += shx(s, 16, lane); s += shx(s, 32, lane);
                const float rs = frsq(s * (1.0f / CD) + EPS);
#pragma unroll
                for (int bj = 0; bj < 2; ++bj)
#pragma unroll
                    for (int n = 0; n < 2; ++n) acc[ai][bj][m][n] = acc[ai][bj][m][n] * rs;
            }
    }
    __device__ __forceinline__ void operator()(const f32x4 (&acc)[2][2][4][2], const pg8::Unit& u, int, int, int, int) const {
        int t_ = threadIdx.x; asm volatile("" : "+v"(t_));
        const int lane = t_ & 63, fr = lane & 15, fq = lane >> 4, wid_ = __builtin_amdgcn_readfirstlane(t_ >> 6), wr = wid_ >> 2, wc = wid_ & 3;
#pragma unroll
        for (int ai = 0; ai < 2; ++ai)
#pragma unroll
            for (int mp = 0; mp < 2; ++mp) {
                f32x4 bs[2][2][2];
#pragma unroll
                for (int mm = 0; mm < 2; ++mm)
#pragma unroll
                    for (int bj = 0; bj < 2; ++bj) {
                        const size_t off = (size_t)(u.pm * 256 + ai * 128 + wr * 64 + (2 * mp + mm) * 16 + fr) * DM + u.pn * 256 + bj * 128 + wc * 32 + 8 * fq;
                        if constexpr (BB) { const u32x4 r1 = *(const u32x4*)(baseb + off); f32x4 t0 = {bflo(r1[0]), bfhi(r1[0]), bflo(r1[1]), bfhi(r1[1])}, t1 = {bflo(r1[2]), bfhi(r1[2]), bflo(r1[3]), bfhi(r1[3])}; bs[mm][bj][0] = t0; bs[mm][bj][1] = t1; }
                        else { bs[mm][bj][0] = *(const f32x4*)(base + off); bs[mm][bj][1] = *(const f32x4*)(base + off + 4); }
                    }
#pragma unroll
                for (int mm = 0; mm < 2; ++mm) {
                    const int m = 2 * mp + mm;
                    const int row = u.pm * 256 + ai * 128 + wr * 64 + m * 16 + fr;
                    float sq = 0.f;
#pragma unroll
                    for (int bj = 0; bj < 2; ++bj) {
                        const size_t off = (size_t)row * DM + u.pn * 256 + bj * 128 + wc * 32 + 8 * fq;
                        const f32x4 h0 = bs[mm][bj][0] + acc[ai][bj][m][0], h1 = bs[mm][bj][1] + acc[ai][bj][m][1];
                        u32x4 w; w[0] = pk2(h0[0], h0[1]); w[1] = pk2(h0[2], h0[3]); w[2] = pk2(h1[0], h1[1]); w[3] = pk2(h1[2], h1[3]);
                        *(u32x4*)(HB + off) = w;
                        sq += (h0[0] * h0[0] + h0[1] * h0[1]) + (h0[2] * h0[2] + h0[3] * h0[3]) + (h1[0] * h1[0] + h1[1] * h1[1]) + (h1[2] * h1[2] + h1[3] * h1[3]);
                    }
                    sq += shx(sq, 16, lane); sq += shx(sq, 32, lane);
                    if (fq == 0) ss[(size_t)row * 16 + u.pn * 4 + wc] = sq;
                }
                asm volatile("" ::: "memory");
            }
    }
};

template <bool WF> struct EpiGate {
    static constexpr bool PERM = true, AFTER_DRAIN = false; static constexpr int MID_T = 0;
    float* out; const bf16_t* H1; const bf16_t* EB; bf16_t* HB; const float* ss_in; float* ss_out; int dummy;
    __device__ __forceinline__ void operator()(const f32x4 (&acc)[2][2][4][2], const pg8::Unit& u, int, int, int, int) const {
        int t_ = threadIdx.x; asm volatile("" : "+v"(t_));
        const int lane = t_ & 63, fr = lane & 15, fq = lane >> 4, wid_ = __builtin_amdgcn_readfirstlane(t_ >> 6), wr = wid_ >> 2, wc = wid_ & 3;
        f32x4 pp[2][4];
#pragma unroll
        for (int ai = 0; ai < 2; ++ai)
#pragma unroll
            for (int m = 0; m < 4; ++m) pp[ai][m] = *(const f32x4*)(ss_in + (size_t)(u.pm * 256 + ai * 128 + wr * 64 + m * 16 + fr) * 16 + fq * 4);
        float rsv[2][4];
#pragma unroll
        for (int ai = 0; ai < 2; ++ai)
#pragma unroll
            for (int m = 0; m < 4; ++m) {
                float s_ = (pp[ai][m][0] + pp[ai][m][1]) + (pp[ai][m][2] + pp[ai][m][3]);
                s_ += shx(s_, 16, lane); s_ += shx(s_, 32, lane);
                rsv[ai][m] = frsq(s_ * (1.0f / DM) + EPS);
            }
        asm volatile("" ::: "memory");
#pragma unroll
        for (int ai = 0; ai < 2; ++ai)
#pragma unroll
            for (int mp = 0; mp < 2; ++mp) {
                u32x4 bs[2][2], es[2][2];
#pragma unroll
                for (int mm = 0; mm < 2; ++mm)
#pragma unroll
                    for (int bj = 0; bj < 2; ++bj) {
                        const size_t off = (size_t)(u.pm * 256 + ai * 128 + wr * 64 + (2 * mp + mm) * 16 + fr) * DM + u.pn * 256 + bj * 128 + wc * 32 + 8 * fq;
                        bs[mm][bj] = *(const u32x4*)(H1 + off); es[mm][bj] = *(const u32x4*)(EB + off);
                    }
#pragma unroll
                for (int mm = 0; mm < 2; ++mm) {
                    const int m = 2 * mp + mm;
                    const int row = u.pm * 256 + ai * 128 + wr * 64 + m * 16 + fr;
                    const float rs = rsv[ai][m];
                    float sq = 0.f;
#pragma unroll
                    for (int bj = 0; bj < 2; ++bj) {
                        const size_t off = (size_t)row * DM + u.pn * 256 + bj * 128 + wc * 32 + 8 * fq;
                        const f32x4 a0 = acc[ai][bj][m][0] * rs, a1 = acc[ai][bj][m][1] * rs;
                        const u32x4 e = es[mm][bj]; const u32x4 r1 = bs[mm][bj];
                        f32x4 h0 = {bflo(r1[0]), bfhi(r1[0]), bflo(r1[1]), bfhi(r1[1])}, h1 = {bflo(r1[2]), bfhi(r1[2]), bflo(r1[3]), bfhi(r1[3])};
                        h0[0] += bflo(e[0]) * sigmoidf_(a0[0]); h0[1] += bfhi(e[0]) * sigmoidf_(a0[1]); h0[2] += bflo(e[1]) * sigmoidf_(a0[2]); h0[3] += bfhi(e[1]) * sigmoidf_(a0[3]);
                        h1[0] += bflo(e[2]) * sigmoidf_(a1[0]); h1[1] += bfhi(e[2]) * sigmoidf_(a1[1]); h1[2] += bflo(e[3]) * sigmoidf_(a1[2]); h1[3] += bfhi(e[3]) * sigmoidf_(a1[3]);
                        if constexpr (WF) { *(f32x4*)(out + off) = h0; *(f32x4*)(out + off + 4) = h1; }
                        u32x4 w; w[0] = pk2(h0[0], h0[1]); w[1] = pk2(h0[2], h0[3]); w[2] = pk2(h1[0], h1[1]); w[3] = pk2(h1[2], h1[3]);
                        *(u32x4*)(HB + off) = w;
                        sq += (h0[0] * h0[0] + h0[1] * h0[1]) + (h0[2] * h0[2] + h0[3] * h0[3]) + (h1[0] * h1[0] + h1[1] * h1[1]) + (h1[2] * h1[2] + h1[3] * h1[3]);
                    }
                    sq += shx(sq, 16, lane); sq += shx(sq, 32, lane);
                    if (fq == 0) ss_out[(size_t)row * 16 + u.pn * 4 + wc] = sq;
                }
                asm volatile("" ::: "memory");
            }
    }
};

struct SubOrder {
    int nN, nwg, nb, c;
    __device__ void init(int M, int N, int nb_, int c_) { nN = N / 256; nwg = (M / 256) * nN; nb = nb_; c = c_; }
    __device__ bool next(int i, pg8::Unit& u) const { if (c < 0 || c >= nb) return false; const int L = i * nb + c; if (L >= nwg) return false; u.pm = L / nN; u.pn = L % nN; return true; }
    __device__ __forceinline__ void a_ready(const pg8::Unit&) const {}
    __device__ __forceinline__ void done(const pg8::Unit&) const {}
};

template <bool REMAP>
__device__ __forceinline__ void tr_item(const float* W, int K, int N, bf16_t* WT, const float* g, LAS float* scr, int item, int lane, int kshift = 0) {
    const int nblk = N / 32, kb = item / nblk, nb = item % nblk, k0 = 64 * kb, n0 = 32 * nb;
    int src = n0 + (lane & 31);
    if (REMAP) { if (src >= 2048 && src < 3072) { const int jj = src - 2048; src = (jj & 1) ? 2560 + (jj >> 1) : 2048 + (jj >> 1); } }
    float wv[32];
#pragma unroll
    for (int i = 0; i < 32; ++i) { const int kk = 2 * i + (lane >> 5); wv[i] = W[(size_t)((k0 + kk + kshift) & (K - 1)) * N + src]; }
#pragma unroll
    for (int i = 0; i < 32; ++i) { const int kk = 2 * i + (lane >> 5); float v = wv[i]; if (g) v *= g[k0 + kk]; scr[kk * 33 + (lane & 31)] = v; }
    asm volatile("s_waitcnt lgkmcnt(0)" ::: "memory");
    const int c = lane & 7;
#pragma unroll
    for (int j = 0; j < 4; ++j) { const int n = (lane >> 3) + 8 * j; const LAS float* s = scr + (8 * c) * 33 + n;
        u32x4 o; o[0] = pk2(s[0 * 33], s[1 * 33]); o[1] = pk2(s[2 * 33], s[3 * 33]); o[2] = pk2(s[4 * 33], s[5 * 33]); o[3] = pk2(s[6 * 33], s[7 * 33]);
        *(u32x4*)(WT + (size_t)(n0 + n) * K + k0 + 8 * c) = o; }
    asm volatile("s_waitcnt lgkmcnt(0)" ::: "memory");
}

constexpr int AK_STRIDE = 144, AV_STRIDE = 136, A_KBYTES = 64 * AK_STRIDE, A_VBYTES = 64 * AV_STRIDE, A_BUF = 18432;
static_assert(A_KBYTES + A_VBYTES <= A_BUF, "attention LDS buffer");

__device__ __forceinline__ void attn_unit(const bf16_t* U, const bf16_t* VT, bf16_t* Y, const float* aog, int b, int h, int qb, LAS unsigned char* lds) {
    int tid = threadIdx.x; asm volatile("" : "+v"(tid));
    const int wave = __builtin_amdgcn_readfirstlane(tid >> 6), lane = tid & 63, l31 = lane & 31, hi = lane >> 5;
    const int q0 = qb * 256 + wave * 32, t = q0 + l31;
    const size_t trow = (size_t)(b * SEQ + t);
    bf16x8 qf[4];
    {
        const bf16_t* qp = U + trow * UP + UQ + h * HD + 8 * hi;
#pragma unroll
        for (int s = 0; s < 4; ++s) qf[s] = *(const bf16x8*)(qp + 16 * s);
    }
    f32x16 o0, o1;
#pragma unroll
    for (int i = 0; i < 16; ++i) { o0[i] = 0.f; o1[i] = 0.f; }
    float C = 1.f;
    const int ktmax = 4 * qb + 3, wkt = (q0 + 30) >> 6;
    const int srow = tid >> 3, sch = tid & 7;
    const bf16_t* gk = U + (size_t)(b * SEQ + srow) * UP + UK + h * HD + sch * 8;
    const bf16_t* gv = VT + ((size_t)((b * NH + h) * HD + srow)) * SEQ + sch * 8;
    const int kwoff = srow * AK_STRIDE + sch * 16, vwoff = A_KBYTES + srow * AV_STRIDE + sch * 16;
    __syncthreads();
    {
        const u32x4 kr = *(const u32x4*)(gk + (size_t)ktmax * 64 * UP), vr = *(const u32x4*)(gv + ktmax * 64);
        *(LAS u32x4*)(lds + kwoff) = kr;
        u32x2 a = {vr[0], vr[1]}, c = {vr[2], vr[3]};
        *(LAS u32x2*)(lds + vwoff) = a; *(LAS u32x2*)(lds + vwoff + 8) = c;
    }
    __syncthreads();
    int cur = 0;
    LAS unsigned* dflag = (LAS unsigned*)(lds + 2 * A_BUF);
    bool wdone = false;
    for (int kt = ktmax; kt >= 0; --kt) {
        u32x4 kr = {0u, 0u, 0u, 0u}, vr = {0u, 0u, 0u, 0u};
        if (kt > 0) { kr = *(const u32x4*)(gk + (size_t)(kt - 1) * 64 * UP); vr = *(const u32x4*)(gv + (kt - 1) * 64); }
        if (kt <= wkt && !wdone) {
            const LAS unsigned char* kb = lds + cur * A_BUF;
            const LAS unsigned char* vb = kb + A_KBYTES;
            f32x16 p0, p1;
#pragma unroll
            for (int i = 0; i < 16; ++i) { p0[i] = 0.f; p1[i] = 0.f; }
#pragma unroll
            for (int s = 0; s < 4; ++s) {
                const bf16x8 ka = *(const LAS bf16x8*)(kb + l31 * AK_STRIDE + 32 * s + 16 * hi);
                const bf16x8 kc = *(const LAS bf16x8*)(kb + (32 + l31) * AK_STRIDE + 32 * s + 16 * hi);
                p0 = MFMA32(ka, qf[s], p0); p1 = MFMA32(kc, qf[s], p1);
            }
            const int lim0 = t - (64 * kt + 4 * hi), lim1 = lim0 - 32;
            const bool diag = (64 * kt + 63 >= q0);
            f32x16 m0, m1;
            float G0[4], G1[4];
#pragma unroll
            for (int g = 0; g < 4; ++g) {
                float s0 = 1.f, s1 = 1.f;
#pragma unroll
                for (int i = 0; i < 4; ++i) {
                    const int r = 4 * g + i, cr = i + 8 * g;
                    const float e0 = fexp2(fminf(p0[r], 100.f)), e1 = fexp2(fminf(p1[r], 100.f));
                    float r0 = frcp(1.0f + e0), r1 = frcp(1.0f + e1);
                    float b0 = e0 * r0, b1 = e1 * r1;
                    if (diag) { const bool v0 = cr < lim0, v1 = cr < lim1; r0 = v0 ? r0 : 1.f; b0 = v0 ? b0 : 0.f; r1 = v1 ? r1 : 1.f; b1 = v1 ? b1 : 0.f; }
                    m0[r] = r0; m1[r] = r1; p0[r] = b0; p1[r] = b1; s0 *= r0; s1 *= r1;
                }
                G0[g] = s0; G1[g] = s1;
            }
            float X0[4], X1[4];
#pragma unroll
            for (int g = 0; g < 4; ++g) { X0[g] = shx(G0[g], 32, lane); X1[g] = shx(G1[g], 32, lane); }
            float run = C;
#pragma unroll
            for (int g = 3; g >= 0; --g) {
                float a = hi == 0 ? run * X1[g] : run;
#pragma unroll
                for (int i = 3; i >= 0; --i) { const int r = 4 * g + i; const float w = a * p1[r]; a *= m1[r]; p1[r] = w; }
                run *= G1[g] * X1[g];
            }
#pragma unroll
            for (int g = 3; g >= 0; --g) {
                float a = hi == 0 ? run * X0[g] : run;
#pragma unroll
                for (int i = 3; i >= 0; --i) { const int r = 4 * g + i; const float w = a * p0[r]; a *= m0[r]; p0[r] = w; }
                run *= G0[g] * X0[g];
            }
            C = run;
#pragma unroll
            for (int kh = 0; kh < 2; ++kh)
#pragma unroll
                for (int sh = 0; sh < 2; ++sh) {
                    u32x4 xw;
                    if (kh == 0) { xw[0] = pk2(p0[8 * sh + 0], p0[8 * sh + 1]); xw[1] = pk2(p0[8 * sh + 2], p0[8 * sh + 3]); xw[2] = pk2(p0[8 * sh + 4], p0[8 * sh + 5]); xw[3] = pk2(p0[8 * sh + 6], p0[8 * sh + 7]); }
                    else         { xw[0] = pk2(p1[8 * sh + 0], p1[8 * sh + 1]); xw[1] = pk2(p1[8 * sh + 2], p1[8 * sh + 3]); xw[2] = pk2(p1[8 * sh + 4], p1[8 * sh + 5]); xw[3] = pk2(p1[8 * sh + 6], p1[8 * sh + 7]); }
                    const bf16x8 xf = __builtin_bit_cast(bf16x8, xw);
                    const int koff = 2 * (32 * kh + 16 * sh + 4 * hi);
                    {
                        const LAS unsigned char* vp = vb + l31 * AV_STRIDE + koff;
                        const u32x2 lo = *(const LAS u32x2*)vp, hh = *(const LAS u32x2*)(vp + 16);
                        u32x4 vw = {lo[0], lo[1], hh[0], hh[1]};
                        o0 = MFMA32(__builtin_bit_cast(bf16x8, vw), xf, o0);
                    }
                    {
                        const LAS unsigned char* vp = vb + (32 + l31) * AV_STRIDE + koff;
                        const u32x2 lo = *(const LAS u32x2*)vp, hh = *(const LAS u32x2*)(vp + 16);
                        u32x4 vw = {lo[0], lo[1], hh[0], hh[1]};
                        o1 = MFMA32(__builtin_bit_cast(bf16x8, vw), xf, o1);
                    }
                }
        }
        wdone = (__builtin_amdgcn_ballot_w64(C > 7.5e-37f) == 0ull);
        if (lane == 0) dflag[(kt & 1) * 8 + wave] = wdone ? 1u : 0u;
        if (kt > 0) {
            LAS unsigned char* nb = lds + (cur ^ 1) * A_BUF;
            *(LAS u32x4*)(nb + kwoff) = kr;
            u32x2 a = {vr[0], vr[1]}, c = {vr[2], vr[3]};
            *(LAS u32x2*)(nb + vwoff) = a; *(LAS u32x2*)(nb + vwoff + 8) = c;
        }
        __syncthreads();
        cur ^= 1;
        {
            const LAS u32x4* df = (const LAS u32x4*)(dflag + (kt & 1) * 8);
            const u32x4 f0 = df[0], f1 = df[1];
            if ((f0[0] & f0[1] & f0[2] & f0[3] & f1[0] & f1[1] & f1[2] & f1[3]) != 0u) break;
        }
    }
    float sq = 0.f;
#pragma unroll
    for (int i = 0; i < 16; ++i) sq += o0[i] * o0[i] + o1[i] * o1[i];
    sq += shx(sq, 32, lane);
    const float rs = frsq(sq * (1.0f / HD) + EPS);
    const bf16_t* sgp = U + trow * UP + USGA + h * HD;
    bf16_t* yp = Y + trow * DM + 512 + h * HD;
#pragma unroll
    for (int dt = 0; dt < 2; ++dt)
#pragma unroll
        for (int g = 0; g < 4; ++g) {
            const int d0 = 32 * dt + 8 * g + 4 * hi;
            const f32x4 gn = *(const f32x4*)(aog + d0);
            const u32x2 sg = *(const u32x2*)(sgp + d0);
            float v0, v1, v2, v3;
            if (dt == 0) { v0 = o0[4 * g + 0]; v1 = o0[4 * g + 1]; v2 = o0[4 * g + 2]; v3 = o0[4 * g + 3]; }
            else         { v0 = o1[4 * g + 0]; v1 = o1[4 * g + 1]; v2 = o1[4 * g + 2]; v3 = o1[4 * g + 3]; }
            u32x2 w;
            w[0] = pk2(v0 * rs * gn[0] * bflo(sg[0]), v1 * rs * gn[1] * bfhi(sg[0]));
            w[1] = pk2(v2 * rs * gn[2] * bflo(sg[1]), v3 * rs * gn[3] * bfhi(sg[1]));
            *(u32x2*)(yp + d0) = w;
        }
}

constexpr int CT = 32, C_XH = 0, C_XH_BYTES = (CT + 30) * 1024, C_CO = C_XH_BYTES, C_CO_BYTES = CT * CD * 4;
static_assert(C_CO + C_CO_BYTES <= LDS_BYTES, "conv LDS map");

__device__ __forceinline__ void convpre_unit(const bf16_t* U, bf16_t* C2, const float* dww, const float* dwb, const float* lng, const float* lnb, int cu, LAS unsigned char* lds) {
    int tid = threadIdx.x; asm volatile("" : "+v"(tid));
    const int wave = __builtin_amdgcn_readfirstlane(tid >> 6), lane = tid & 63;
    const int r0 = cu * CT, b = r0 >> 11, s0 = r0 & 2047;
    __syncthreads();
    for (int i = tid; i < (CT + 30) * 64; i += 512) {
        const int row = i >> 6, ch = i & 63, s = s0 - 30 + row;
        u32x4 v = {0u, 0u, 0u, 0u};
        if (s >= 0) v = *(const u32x4*)(U + (size_t)(b * SEQ + s) * UP + UGLU + ch * 8);
        *(LAS u32x4*)(lds + C_XH + row * 1024 + ch * 16) = v;
    }
    __syncthreads();
    {
        const int chp = tid & 255, tg = tid >> 8;
        f32x2 w2[CWID];
#pragma unroll
        for (int j = 0; j < CWID; ++j) w2[j] = *(const f32x2*)(dww + (size_t)j * CD + 2 * chp);
        const f32x2 bias = *(const f32x2*)(dwb + 2 * chp);
        const LAS unsigned char* xp = lds + C_XH + (tg * 16) * 1024 + chp * 4;
        f32x2 xv[16 + CWID - 1];
#pragma unroll
        for (int i = 0; i < 16 + CWID - 1; ++i) { const unsigned xu = *(const LAS unsigned*)(xp + i * 1024); f32x2 t2 = {bflo(xu), bfhi(xu)}; xv[i] = t2; }
#pragma unroll
        for (int tt = 0; tt < 16; ++tt) {
            f32x2 a = bias;
#pragma unroll
            for (int j = 0; j < CWID; ++j) a = a + w2[j] * xv[tt + j];
            *(LAS f32x2*)(lds + C_CO + (tg * 16 + tt) * 2048 + chp * 8) = a;
        }
    }
    __syncthreads();
    {
        const f32x4 g0 = *(const f32x4*)(lng + lane * 4), g1 = *(const f32x4*)(lng + 256 + lane * 4);
        const f32x4 b0 = *(const f32x4*)(lnb + lane * 4), b1 = *(const f32x4*)(lnb + 256 + lane * 4);
#pragma unroll
        for (int tt = 0; tt < 4; ++tt) {
            const int tl = wave * 4 + tt;
            f32x4 v0 = *(const LAS f32x4*)(lds + C_CO + tl * 2048 + lane * 16), v1 = *(const LAS f32x4*)(lds + C_CO + tl * 2048 + 1024 + lane * 16);
            const float mean = wave_sum((v0[0] + v0[1]) + (v0[2] + v0[3]) + (v1[0] + v1[1]) + (v1[2] + v1[3]), lane) * (1.0f / CD);
            v0 = v0 - mean; v1 = v1 - mean;
            const float var = wave_sum((v0[0] * v0[0] + v0[1] * v0[1]) + (v0[2] * v0[2] + v0[3] * v0[3]) + (v1[0] * v1[0] + v1[1] * v1[1]) + (v1[2] * v1[2] + v1[3] * v1[3]), lane) * (1.0f / CD);
            const float rs = frsq(var + EPS);
            v0 = v0 * rs * g0 + b0; v1 = v1 * rs * g1 + b1;
            u32x2 wa, wb;
            wa[0] = pk2(siluf_(v0[0]), siluf_(v0[1])); wa[1] = pk2(siluf_(v0[2]), siluf_(v0[3]));
            wb[0] = pk2(siluf_(v1[0]), siluf_(v1[1])); wb[1] = pk2(siluf_(v1[2]), siluf_(v1[3]));
            bf16_t* cp = C2 + (size_t)(r0 + tl) * CD + lane * 4;
            *(u32x2*)cp = wa; *(u32x2*)(cp + 256) = wb;
        }
    }
}

#define XB_TMO      128
#define XB_XCNT(j)  (256  + 64 * (j))
#define XB_XSUB(j)  (1280 + 64 * (j))
#define XB_XGEN(j)  (2304 + 64 * (j))
#define XB_TOP      3328
#define XB_TOPGEN   3392
#define XCD_BAR_WORDS 3456
#define XB_SPIN_CAP (1u << 18)

__device__ __forceinline__ unsigned xb_ld(unsigned* p)              { return __hip_atomic_load(p, __ATOMIC_RELAXED, __HIP_MEMORY_SCOPE_AGENT); }
__device__ __forceinline__ unsigned xb_add(unsigned* p, unsigned v) { return __hip_atomic_fetch_add(p, v, __ATOMIC_RELAXED, __HIP_MEMORY_SCOPE_AGENT); }
__device__ __forceinline__ unsigned xb_xcc_id() { return (unsigned)__builtin_amdgcn_s_getreg((3 << 11) | 20) & 0xFu; }
#define XB_SPIN(cond, bar) do { unsigned _sp = 0; while (cond) { __builtin_amdgcn_s_sleep(1); \
    if ((++_sp & 255u) == 0u) { if (xb_ld(&(bar)[XB_TMO])) break; if (_sp > XB_SPIN_CAP) { atomicAdd(&(bar)[XB_TMO], 1u); break; } } } } while (0)

struct XcdBarrier {
    unsigned* bar; unsigned x;
    volatile LAS unsigned* st;
};

__device__ __forceinline__ XcdBarrier xcd_barrier_post(unsigned* bar, volatile LAS unsigned* st) {
    XcdBarrier b; b.bar = bar; b.x = xb_xcc_id(); b.st = st;
    if (threadIdx.x == 0) (void)xb_add(&bar[XB_XCNT(b.x)], 1u);
    return b;
}
__device__ __forceinline__ void xcd_barrier_complete(unsigned* bar, unsigned x, unsigned& nloc, unsigned& nx) {
    const unsigned G = gridDim.x * gridDim.y * gridDim.z;
    unsigned sum, cnt, mine, sp = 0u;
    for (;;) {
        sum = 0u; cnt = 0u; mine = 0u;
#pragma unroll
        for (unsigned j = 0; j < 16; ++j) { const unsigned c = xb_ld(&bar[XB_XCNT(j)]); sum += c; cnt += (c > 0u) ? 1u : 0u; mine = (j == x) ? c : mine; }
        if (sum == G) break;
        __builtin_amdgcn_s_sleep(1);
        if ((++sp & 255u) == 0u) { if (xb_ld(&bar[XB_TMO])) break; if (sp > XB_SPIN_CAP) { atomicAdd(&bar[XB_TMO], 1u); break; } }
    }
    nloc = mine > 0u ? mine : 1u; nx = cnt > 0u ? cnt : 1u;
}

__device__ __forceinline__ void xcd_barrier(const XcdBarrier& b) {
    asm volatile("s_waitcnt vmcnt(0)" ::: "memory");
    __syncthreads();
    if (threadIdx.x == 0) {
        unsigned* bar = b.bar;
        __builtin_amdgcn_s_waitcnt(0);
        unsigned nloc = b.st[0], nx = b.st[1];
        if (nloc == 0u) { xcd_barrier_complete(bar, b.x, nloc, nx); b.st[0] = nloc; b.st[1] = nx; }
        const unsigned old = xb_add(&bar[XB_XSUB(b.x)], 1u);
        const unsigned gen = old / nloc;
        if (old + 1u == (gen + 1u) * nloc) {
            __builtin_amdgcn_fence(__ATOMIC_RELEASE, "agent");
            asm volatile("s_waitcnt vmcnt(0)" ::: "memory");
            const unsigned og = xb_add(&bar[XB_TOP], 1u);
            const unsigned tg = og / nx;
            if (og + 1u == (tg + 1u) * nx) xb_add(&bar[XB_TOPGEN], 1u);
            else XB_SPIN(xb_ld(&bar[XB_TOPGEN]) == tg, bar);
            __builtin_amdgcn_fence(__ATOMIC_ACQUIRE, "agent");
            xb_add(&bar[XB_XGEN(b.x)], 1u);
            asm volatile("s_waitcnt vmcnt(0)" ::: "memory");
        } else {
            XB_SPIN(xb_ld(&bar[XB_XGEN(b.x)]) == gen, bar);
            __builtin_amdgcn_fence(__ATOMIC_ACQUIRE, "agent");
            asm volatile("s_waitcnt vmcnt(0)" ::: "memory");
        }
    }
    __syncthreads();
}

struct Params { const float* in[16]; float* out; unsigned char* ws; int ph_lo, ph_hi; };

template <int ph>
__device__ __forceinline__ void run_phase(const Params& P, LAS unsigned char* lds) {
    const int G = gridDim.x, bid = blockIdx.x;
    unsigned char* ws = P.ws;
    const float* x = P.in[0];
    float* out = P.out;
    bf16_t* HB = (bf16_t*)(ws + WS_HB); bf16_t* H1B = (bf16_t*)(ws + WS_H1B); bf16_t* Ub = (bf16_t*)(ws + WS_U); bf16_t* VT = (bf16_t*)(ws + WS_VT); bf16_t* Yb = (bf16_t*)(ws + WS_Y);
    bf16_t* C2 = (bf16_t*)(ws + WS_C2); bf16_t* EB = (bf16_t*)(ws + WS_EB);
    float* ssA = (float*)(ws + WS_SSA); float* ssB = (float*)(ws + WS_SSB); float* ssC = (float*)(ws + WS_SSC);
    int tid = threadIdx.x; asm volatile("" : "+v"(tid));
    const int lane = tid & 63, wave = __builtin_amdgcn_readfirstlane(tid >> 6);
    const int gw = bid * 8 + wave, NGW = G * 8;
    if constexpr (ph == 0) {
        LAS float* scr = (LAS float*)(lds + wave * 16384);
        for (int it = gw; it < 2 * 3072; it += NGW) {
            const int l = it / 3072; int r = it - l * 3072;
            unsigned char* wb = ws + (size_t)l * W_LAYER;
            if (r < 1792) { tr_item<true>(P.in[3] + (size_t)l * DM * DIN, DM, DIN, (bf16_t*)(wb + W_IN), P.in[2] + l * DM, scr, r, lane); continue; } r -= 1792;
            if (r < 128) { tr_item<false>(P.in[9] + (size_t)l * CD * CD, CD, CD, (bf16_t*)(wb + W_PW), nullptr, scr, r, lane); continue; } r -= 128;
            if (r < 512) { tr_item<false>(P.in[11] + (size_t)l * DM * DM, DM, DM, (bf16_t*)(wb + W_OUT), nullptr, scr, r, lane, 512); continue; } r -= 512;
            if (r < 512) { tr_item<false>(P.in[13] + (size_t)l * DM * DM, DM, DM, (bf16_t*)(wb + W_PG), P.in[12] + l * DM, scr, r, lane); continue; } r -= 512;
            tr_item<false>(P.in[14] + (size_t)l * PLE * DM, PLE, DM, (bf16_t*)(wb + W_PLE), nullptr, scr, r, lane);
        }
        for (int row = gw; row < MT; row += 2 * NGW) {
            const int row2 = row + NGW;
            const f32x4* xr = (const f32x4*)(x + (size_t)row * DM) + lane;
            const f32x4* xr2 = (const f32x4*)(x + (size_t)(row2 < MT ? row2 : row) * DM) + lane;
            f32x4 va[4], vb[4];
#pragma unroll
            for (int j = 0; j < 4; ++j) { va[j] = xr[64 * j]; vb[j] = xr2[64 * j]; }
            u32x2* ob = (u32x2*)(HB + (size_t)row * DM) + lane;
            float s = 0.f, s2 = 0.f;
#pragma unroll
            for (int j = 0; j < 4; ++j) { const f32x4 v = va[j]; s += (v[0] * v[0] + v[1] * v[1]) + (v[2] * v[2] + v[3] * v[3]); u32x2 w; w[0] = pk2(v[0], v[1]); w[1] = pk2(v[2], v[3]); ob[64 * j] = w; }
            s = wave_sum(s, lane);
            if (lane < 16) ssA[(size_t)row * 16 + lane] = (lane == 0) ? s : 0.f;
            if (row2 < MT) {
                u32x2* ob2 = (u32x2*)(HB + (size_t)row2 * DM) + lane;
#pragma unroll
                for (int j = 0; j < 4; ++j) { const f32x4 v = vb[j]; s2 += (v[0] * v[0] + v[1] * v[1]) + (v[2] * v[2] + v[3] * v[3]); u32x2 w; w[0] = pk2(v[0], v[1]); w[1] = pk2(v[2], v[3]); ob2[64 * j] = w; }
                s2 = wave_sum(s2, lane);
                if (lane < 16) ssA[(size_t)row2 * 16 + lane] = (lane == 0) ? s2 : 0.f;
            }
        }
        {
            const f32x4* pp = (const f32x4*)P.in[1]; u32x2* pb = (u32x2*)(ws + WS_PB);
            const int NV = 2 * MT * PLE / 4, stp = G * 512;
            for (int i = bid * 512 + tid; i < NV; i += 4 * stp) {
                f32x4 v[4];
#pragma unroll
                for (int j = 0; j < 4; ++j) { const int ii = i + j * stp; v[j] = pp[ii < NV ? ii : i]; }
#pragma unroll
                for (int j = 0; j < 4; ++j) { const int ii = i + j * stp; if (ii < NV) { u32x2 w; w[0] = pk2(v[j][0], v[j][1]); w[1] = pk2(v[j][2], v[j][3]); pb[ii] = w; } }
            }
        }
    } else if constexpr (ph == NPHASE - 1) {
        const float* fg = P.in[15];
        for (int row = gw; row < MT; row += 2 * NGW) {
            const int row2 = row + NGW; const bool has2 = row2 < MT; const int r2 = has2 ? row2 : row;
            const u32x4* hr = (const u32x4*)(HB + (size_t)row * DM) + lane; const u32x4* hr2 = (const u32x4*)(HB + (size_t)r2 * DM) + lane;
            const u32x4 a0 = hr[0], a1 = hr[64], b0 = hr2[0], b1 = hr2[64];
            const float p1 = (lane < 16) ? ssA[(size_t)row * 16 + lane] : 0.f, p2 = (lane < 16) ? ssA[(size_t)r2 * 16 + lane] : 0.f;
            const f32x4 g0 = *(const f32x4*)(fg + 8 * lane), g1 = *(const f32x4*)(fg + 8 * lane + 4), g2 = *(const f32x4*)(fg + 512 + 8 * lane), g3 = *(const f32x4*)(fg + 512 + 8 * lane + 4);
            const float rs = frsq(wave_sum(p1, lane) * (1.0f / DM) + EPS), rs2 = frsq(wave_sum(p2, lane) * (1.0f / DM) + EPS);
            float* o = out + (size_t)row * DM + 8 * lane;
            { f32x4 t0 = {bflo(a0[0]), bfhi(a0[0]), bflo(a0[1]), bfhi(a0[1])}, t1 = {bflo(a0[2]), bfhi(a0[2]), bflo(a0[3]), bfhi(a0[3])}, t2 = {bflo(a1[0]), bfhi(a1[0]), bflo(a1[1]), bfhi(a1[1])}, t3 = {bflo(a1[2]), bfhi(a1[2]), bflo(a1[3]), bfhi(a1[3])};
              *(f32x4*)o = t0 * rs * g0; *(f32x4*)(o + 4) = t1 * rs * g1; *(f32x4*)(o + 512) = t2 * rs * g2; *(f32x4*)(o + 516) = t3 * rs * g3; }
            if (has2) {
                float* o2 = out + (size_t)row2 * DM + 8 * lane;
                f32x4 t0 = {bflo(b0[0]), bfhi(b0[0]), bflo(b0[1]), bfhi(b0[1])}, t1 = {bflo(b0[2]), bfhi(b0[2]), bflo(b0[3]), bfhi(b0[3])}, t2 = {bflo(b1[0]), bfhi(b1[0]), bflo(b1[1]), bfhi(b1[1])}, t3 = {bflo(b1[2]), bfhi(b1[2]), bflo(b1[3]), bfhi(b1[3])};
                *(f32x4*)o2 = t0 * rs2 * g0; *(f32x4*)(o2 + 4) = t1 * rs2 * g1; *(f32x4*)(o2 + 512) = t2 * rs2 * g2; *(f32x4*)(o2 + 516) = t3 * rs2 * g3;
            }
        }
    } else {
        constexpr int l = (ph - 1) / 5, k = (ph - 1) % 5;
        unsigned char* wb = ws + (size_t)l * W_LAYER;
        if constexpr (k == 0) {
            pg8::Gemm g{HB, (const bf16_t*)(wb + W_IN), MT, DIN, DM}; pg8::StaticOrder S; S.init(MT, DIN, G, bid);
            EpiIn E{Ub, VT, ssA};
            pg8::gemm_phase<EpiIn, pg8::StaticOrder, true, true>(lds, g, S, E, threadIdx.x);
        } else if constexpr (k == 1) {
            const float* aog = P.in[4] + l * HD;
            const float* dww = P.in[5] + (size_t)l * CWID * CD; const float* dwb = P.in[6] + l * CD;
            const float* lng = P.in[7] + l * CD; const float* lnb = P.in[8] + l * CD;
            for (int it = bid; it < 256; it += G) {
                const int bh = it >> 2, pr = it & 3, b = bh >> 3, h = bh & 7;
#pragma unroll 1
                for (int uu = 0; uu < ((PROBE_DUP & 2) ? 4 : 2); ++uu) attn_unit(Ub, VT, Yb, aog, b, h, (uu & 1) == 0 ? 7 - pr : pr, lds);
#pragma unroll 1
                for (int uu = 0; uu < ((PROBE_DUP & 4) ? 4 : 2); ++uu) convpre_unit(Ub, C2, dww, dwb, lng, lnb, 2 * it + (uu & 1), lds);
            }
            __syncthreads();
        } else if constexpr (k == 2) {
            const int nb0 = G / 2;
            {
                pg8::Gemm g{C2, (const bf16_t*)(wb + W_PW), MT, CD, CD}; SubOrder S; S.init(MT, CD, nb0, bid);
                EpiPw E{Ub, Yb, P.in[10] + l * CD, ssC};
                pg8::gemm_phase<EpiPw, SubOrder, true, true>(lds, g, S, E, threadIdx.x);
            }
            {
                pg8::Gemm g{(const bf16_t*)(ws + WS_PB) + (size_t)l * MT * PLE, (const bf16_t*)(wb + W_PLE), MT, DM, PLE}; SubOrder S; S.init(MT, DM, G - nb0, bid - nb0);
                EpiE E{EB};
                int t2 = threadIdx.x; asm volatile("" : "+v"(t2));
                pg8::gemm_phase<EpiE, SubOrder, true, true>(lds, g, S, E, t2);
            }
        } else if constexpr (k == 3) {
            pg8::Gemm g{Yb, (const bf16_t*)(wb + W_OUT), MT, DM, DM}; pg8::StaticOrder S; S.init(MT, DM, G, bid);
            EpiOut<(l > 0)> E{x, HB, H1B, ssB, ssC};
            pg8::gemm_phase<EpiOut<(l > 0)>, pg8::StaticOrder, true, true>(lds, g, S, E, threadIdx.x);
        } else {
            pg8::Gemm g{H1B, (const bf16_t*)(wb + W_PG), MT, DM, DM}; pg8::StaticOrder S; S.init(MT, DM, G, bid);
            EpiGate<false> E{out, H1B, EB, HB, ssB, ssA, 0};
            pg8::gemm_phase<EpiGate<false>, pg8::StaticOrder, true, true>(lds, g, S, E, threadIdx.x);
            if constexpr ((PROBE_DUP & 128) != 0) { int t3 = threadIdx.x; asm volatile("" : "+v"(t3)); pg8::gemm_phase<EpiGate<false>, pg8::StaticOrder, true, true>(lds, g, S, E, t3); }
        }
    }
}

__global__ void __launch_bounds__(512, 2) fwd(Params P) {
    extern __shared__ __attribute__((aligned(16))) unsigned char lds_raw[];
    LAS unsigned char* lds = (LAS unsigned char*)lds_raw;
    const int lo = P.ph_lo, hi = P.ph_hi;
    volatile LAS unsigned* st = (volatile LAS unsigned*)(lds + LDS_BYTES - 64);
    if (threadIdx.x < 16) st[threadIdx.x] = 0u;
    __syncthreads();
    const XcdBarrier bar = xcd_barrier_post((unsigned*)(P.ws + WS_CTL), st);
#define PROBE_PH(k) ((((PROBE_DUP) & 8) && (k) == 0) || (((PROBE_DUP) & 1) && (k) == 1) || (((PROBE_DUP) & 32) && ((k) == 3 || (k) == 8)) || (((PROBE_DUP) & 16) && (k) == 4))
#define SEAM() do { if (hi > NPHASE) cg::this_grid().sync(); else xcd_barrier(bar); } while (0)
#define PHASE(k) if (lo <= (k) && (k) < hi) { run_phase<(k)>(P, lds); if constexpr (PROBE_PH(k)) { __syncthreads(); run_phase<(k)>(P, lds); } \
        if constexpr (((PROBE_DUP) & 64) != 0) { SEAM(); } if ((k) + 1 < hi) SEAM(); }
    PHASE(0) PHASE(1) PHASE(2) PHASE(3) PHASE(4) PHASE(5) PHASE(6) PHASE(7) PHASE(8) PHASE(9) PHASE(10) PHASE(11)
#undef PHASE
#undef SEAM
}

#ifndef MK_N_LAUNCHES
#define MK_N_LAUNCHES 1
#endif
extern "C" void kernel_launch(void* const* d_in, const int* in_sizes, int n_in, void* d_out, int out_size, void* d_ws, size_t ws_size, hipStream_t stream) {
    static int grid = 0;
    if (grid == 0) {
        if (n_in != 16 || out_size != MT * DM || ws_size < WS_END) { fprintf(stderr, "kernel_launch: unexpected shapes (n_in %d, out %d, ws %zu)\n", n_in, out_size, ws_size); grid = -1; return; }
        int dev = 0, cus = 0, per_cu = 0;
        (void)hipGetDevice(&dev);
        (void)hipDeviceGetAttribute(&cus, hipDeviceAttributeMultiprocessorCount, dev);
        if (hipFuncSetAttribute((const void*)fwd, hipFuncAttributeMaxDynamicSharedMemorySize, LDS_BYTES) != hipSuccess) { fprintf(stderr, "kernel_launch: hipFuncSetAttribute failed\n"); grid = -1; return; }
        if (hipOccupancyMaxActiveBlocksPerMultiprocessor(&per_cu, (const void*)fwd, 512, LDS_BYTES) != hipSuccess || per_cu < 1) { fprintf(stderr, "kernel_launch: occupancy query says %d\n", per_cu); per_cu = 1; }
        (void)hipGetLastError();
        grid = cus * 1;
        if (grid <= 0) grid = 256;
    }
    if (grid < 0) return;
    if (hipMemsetAsync((unsigned char*)d_ws + WS_CTL, 0, CTL_BYTES, stream) != hipSuccess) { fprintf(stderr, "kernel_launch: memset of barrier words failed\n"); return; }
    Params p{};
    for (int i = 0; i < 16; ++i) p.in[i] = (const float*)d_in[i];
    p.out = (float*)d_out; p.ws = (unsigned char*)d_ws;
#if MK_N_LAUNCHES == 1
    p.ph_lo = 0; p.ph_hi = NPHASE;
    void* args[] = {&p};
    hipError_t e = hipLaunchCooperativeKernel((const void*)fwd, dim3(grid), dim3(512), args, LDS_BYTES, stream);
    if (e != hipSuccess) fprintf(stderr, "kernel_launch: cooperative launch failed: %s (grid %d)\n", hipGetErrorString(e), grid);
#else
    for (int ph = 0; ph < NPHASE; ++ph) {
        p.ph_lo = ph; p.ph_hi = ph + 1;
        hipLaunchKernelGGL(fwd, dim3(grid), dim3(512), LDS_BYTES, stream, p);
    }
#endif
}
```

```cpp
#include <hip/hip_runtime.h>
#include <hip/hip_cooperative_groups.h>
#include <cstdio>
#include <cstdint>
namespace cg = cooperative_groups;
namespace pg8 {
#define PG8_LAS __attribute__((address_space(3)))
typedef unsigned short bf16_t;
typedef short bf16x8 __attribute__((ext_vector_type(8)));
typedef float f32x4 __attribute__((ext_vector_type(4)));
typedef unsigned u32x4 __attribute__((ext_vector_type(4)));
constexpr int BM = 256, BK = 64, HALF = 128, HTB = HALF * BK * 2  , STAGE_BYTES = 8 * HTB, NXCD = 8, WGM = 8;

__host__ __device__ __forceinline__ int lds_byte(int r, int c) { const int st = (r >> 4) * 2 + (c >> 5), rr = r & 15, cc = c & 31, ob = rr * 64 + cc * 2; return st * 1024 + (ob ^ (((ob >> 9) & 1) << 5)); }
__host__ __device__ __forceinline__ void stage_rc(int b, int& R, int& C) { const int st = b / 1024, sb = b % 1024, swz = sb ^ (((sb >> 9) & 1) << 5); R = (st >> 1) * 16 + swz / 64; C = (st & 1) * 32 + (swz % 64) / 2; }
__host__ __device__ __forceinline__ int perm32(int rho) { const int n = rho >> 4, i = rho & 15; return 8 * (i >> 2) + 4 * n + (i & 3); }

struct Unit { int pm, pn; };
struct Gemm { const bf16_t* A; const bf16_t* Bt; int M, N, K; };

struct StaticOrder {
    int nM, nN, nwg, G, c;
    __host__ __device__ void init(int M, int N, int G_, int c_) { nM = M / BM; nN = N / BM; nwg = nM * nN; G = G_; c = c_; }
    __host__ __device__ bool next(int i, Unit& u) const {
        const long L = (long)i * G + c; if (L >= nwg) return false;
        int wgid = (int)L; { const int q = nwg / NXCD, r = nwg % NXCD, xcd = wgid % NXCD, off = wgid / NXCD; wgid = (xcd < r ? xcd * (q + 1) : r * (q + 1) + (xcd - r) * q) + off; }
        const int nig = WGM * nN, gid = wgid / nig, fm = gid * WGM, gsz = (nM - fm) < WGM ? (nM - fm) : WGM;
        u.pm = fm + ((wgid % nig) % gsz); u.pn = (wgid % nig) / gsz; return true;
    }
    __device__ __forceinline__ void a_ready(const Unit&) const {}
    __device__ __forceinline__ void done(const Unit&) const {}
};

template <class Epi, class Sched, bool ALIGN_EPI = false, bool SP2 = false>
__device__ __forceinline__ void gemm_phase(PG8_LAS unsigned char* lds, const Gemm g, const Sched& S, const Epi& E, const int tid_in) {
    const int tid = tid_in, wid = __builtin_amdgcn_readfirstlane(tid >> 6), lane = tid & 63, wr = wid >> 2, wc = wid & 3, fr = lane & 15, fq = lane >> 4;
    const int K = g.K, nt = K / BK;
    unsigned voffA[2], voffB[2];
#pragma unroll
    for (int i = 0; i < 2; ++i) { int R, C; stage_rc(tid * 16 + i * 8192, R, C); const int Rb = Epi::PERM ? ((R & ~31) + perm32(R & 31)) : R;
        voffA[i] = (unsigned)(R * K + C) * 2u; voffB[i] = (unsigned)(Rb * K + C) * 2u; }
    const size_t kstep = (size_t)(BK * 2);
    const size_t hstep = (size_t)HALF * K * 2;
    const size_t tstep = 2 * hstep;
    const unsigned ldsw = (unsigned)wid * 1024u;
    const int aoff = lds_byte(wr * 64 + fr, fq * 8), boff = lds_byte(wc * 32 + fr, fq * 8);
#define PG8_SA(b, h) (((b) * 2 + (h)) * HTB)
#define PG8_SB(b, h) ((4 + (b) * 2 + (h)) * HTB)
#define PG8_STAGE(bufoff, gbase, voff) do { _Pragma("unroll") for (int _i = 0; _i < 2; ++_i) \
        __builtin_amdgcn_global_load_lds((const unsigned*)((const char*)(gbase) + (voff)[_i]), (PG8_LAS unsigned*)(lds + (bufoff) + ldsw + _i * 8192), 16, 0, 0); } while (0)
#define PG8_LDA(dst, b, h) do { _Pragma("unroll") for (int m = 0; m < 4; ++m) _Pragma("unroll") for (int k = 0; k < 2; ++k) dst[m][k] = *(const PG8_LAS bf16x8*)(lds + PG8_SA(b, h) + aoff + m * 2048 + k * 1024); } while (0)
#define PG8_LDB(dst, b, h) do { _Pragma("unroll") for (int n = 0; n < 2; ++n) _Pragma("unroll") for (int k = 0; k < 2; ++k) dst[n][k] = *(const PG8_LAS bf16x8*)(lds + PG8_SB(b, h) + boff + n * 2048 + k * 1024); } while (0)
#define PG8_MMA(ai, bj, At, Bt) do { __builtin_amdgcn_s_setprio(1); _Pragma("unroll") for (int m = 0; m < 4; ++m) _Pragma("unroll") for (int n = 0; n < 2; ++n) _Pragma("unroll") for (int k = 0; k < 2; ++k) \
        acc[ai][bj][m][n] = __builtin_amdgcn_mfma_f32_16x16x32_bf16(Bt[n][k], At[m][k], acc[ai][bj][m][n], 0, 0, 0); __builtin_amdgcn_s_setprio(0); } while (0)
#define PG8_WAIT_V(n) asm volatile("s_waitcnt vmcnt(" #n ")" ::: "memory")
#define PG8_WAIT_L(n) asm volatile("s_waitcnt lgkmcnt(" #n ")" ::: "memory")
#define PG8_BAR __builtin_amdgcn_s_barrier()
#define PG8_SCHED __builtin_amdgcn_sched_barrier(0)
    Unit cur, nxt; int ui = 0;
    if (!S.next(0, cur)) return;
    f32x4 acc[2][2][4][2];
#pragma unroll
    for (int a = 0; a < 2; ++a)
#pragma unroll
        for (int b = 0; b < 2; ++b)
#pragma unroll
            for (int m = 0; m < 4; ++m)
#pragma unroll
                for (int n = 0; n < 2; ++n) acc[a][b][m][n] = (f32x4){0.f, 0.f, 0.f, 0.f};
    bf16x8 At[4][2], B0[2][2], B1[2][2];
    const char* cA = (const char*)g.A + (size_t)cur.pm * tstep; const char* cB = (const char*)g.Bt + (size_t)cur.pn * tstep;
    S.a_ready(cur);
    if constexpr (SP2) {
        PG8_STAGE(PG8_SB(0, 0), cB, voffB); PG8_STAGE(PG8_SB(0, 1), cB + hstep, voffB); PG8_STAGE(PG8_SA(0, 0), cA, voffA); PG8_STAGE(PG8_SA(0, 1), cA + hstep, voffA);
        if (wr == 1) PG8_BAR;
        PG8_WAIT_V(2); PG8_BAR;
        PG8_STAGE(PG8_SB(1, 0), cB + kstep, voffB); PG8_STAGE(PG8_SA(1, 0), cA + kstep, voffA); PG8_STAGE(PG8_SB(1, 1), cB + hstep + kstep, voffB);
        PG8_WAIT_V(6); PG8_BAR;
    } else {
        PG8_STAGE(PG8_SB(0, 0), cB, voffB); PG8_STAGE(PG8_SA(0, 0), cA, voffA); PG8_STAGE(PG8_SB(0, 1), cB + hstep, voffB); PG8_STAGE(PG8_SA(0, 1), cA + hstep, voffA);
        if (wr == 1) PG8_BAR;
        PG8_WAIT_V(4); PG8_BAR;
        PG8_STAGE(PG8_SB(1, 0), cB + kstep, voffB); PG8_STAGE(PG8_SA(1, 0), cA + kstep, voffA); PG8_STAGE(PG8_SB(1, 1), cB + hstep + kstep, voffB);
        PG8_WAIT_V(6); PG8_BAR;
    }
    for (;;) {
        const bool has_next = S.next(ui + 1, nxt);
        const char* nA = has_next ? (const char*)g.A + (size_t)nxt.pm * tstep : cA; const char* nB = has_next ? (const char*)g.Bt + (size_t)nxt.pn * tstep : cB;
        for (int t = 0; t < nt; t += 2) {
            if constexpr (Epi::MID_T > 0) { if (t == Epi::MID_T) E.mid(acc, cur); }
            const bool last = (t == nt - 2);
            const char* a1 = cA + (size_t)(t + 1) * kstep;
            const char* a2 = last ? nA : cA + (size_t)(t + 2) * kstep; const char* b2 = last ? nB : cB + (size_t)(t + 2) * kstep;
            const char* a3 = a2 + kstep; const char* b3 = b2 + kstep;
            if (last && has_next) S.a_ready(nxt);
            if constexpr (SP2) {
            PG8_LDB(B0, 0, 0); PG8_LDB(B1, 0, 1); PG8_SCHED; PG8_LDA(At, 0, 0); PG8_STAGE(PG8_SA(1, 1), a1 + hstep, voffA);
            PG8_WAIT_V(8); PG8_WAIT_L(0); PG8_BAR; PG8_MMA(0, 0, At, B0); PG8_MMA(0, 1, At, B1); PG8_BAR; PG8_SCHED;
            PG8_LDA(At, 0, 1); PG8_STAGE(PG8_SB(0, 0), b2, voffB); PG8_STAGE(PG8_SB(0, 1), b2 + hstep, voffB); PG8_STAGE(PG8_SA(0, 0), a2, voffA);
            PG8_WAIT_V(8); PG8_WAIT_L(0); PG8_BAR; PG8_MMA(1, 0, At, B0); PG8_MMA(1, 1, At, B1); PG8_BAR; PG8_SCHED;
            PG8_LDB(B0, 1, 0); PG8_LDB(B1, 1, 1); PG8_SCHED; PG8_LDA(At, 1, 0); PG8_STAGE(PG8_SA(0, 1), a2 + hstep, voffA);
            PG8_WAIT_V(8); PG8_WAIT_L(0); PG8_BAR; PG8_MMA(0, 0, At, B0); PG8_MMA(0, 1, At, B1); PG8_BAR; PG8_SCHED;
            PG8_LDA(At, 1, 1); PG8_STAGE(PG8_SB(1, 0), b3, voffB); PG8_STAGE(PG8_SB(1, 1), b3 + hstep, voffB); PG8_STAGE(PG8_SA(1, 0), a3, voffA);
            PG8_WAIT_V(8); PG8_WAIT_L(0); PG8_BAR; PG8_MMA(1, 0, At, B0); PG8_MMA(1, 1, At, B1); PG8_BAR; PG8_SCHED;
            } else {
            PG8_LDB(B0, 0, 0); PG8_SCHED; PG8_LDA(At, 0, 0); PG8_STAGE(PG8_SA(1, 1), a1 + hstep, voffA);
            PG8_WAIT_L(8); PG8_BAR; PG8_WAIT_L(0); PG8_MMA(0, 0, At, B0); PG8_BAR; PG8_SCHED;
            PG8_LDB(B1, 0, 1); PG8_STAGE(PG8_SB(0, 0), b2, voffB);
            PG8_BAR; PG8_WAIT_L(0); PG8_MMA(0, 1, At, B1); PG8_BAR;
            PG8_LDA(At, 0, 1); PG8_STAGE(PG8_SA(0, 0), a2, voffA);
            PG8_BAR; PG8_WAIT_L(0); PG8_MMA(1, 0, At, B0); PG8_BAR; PG8_SCHED;
            PG8_STAGE(PG8_SB(0, 1), b2 + hstep, voffB);
            PG8_WAIT_V(6); PG8_BAR; PG8_MMA(1, 1, At, B1); PG8_BAR;
            PG8_LDB(B0, 1, 0); PG8_SCHED; PG8_LDA(At, 1, 0); PG8_STAGE(PG8_SA(0, 1), a2 + hstep, voffA);
            PG8_WAIT_L(8); PG8_BAR; PG8_WAIT_L(0); PG8_MMA(0, 0, At, B0); PG8_BAR; PG8_SCHED;
            PG8_LDB(B1, 1, 1); PG8_STAGE(PG8_SB(1, 0), b3, voffB);
            PG8_BAR; PG8_WAIT_L(0); PG8_MMA(0, 1, At, B1); PG8_BAR;
            PG8_LDA(At, 1, 1); PG8_STAGE(PG8_SA(1, 0), a3, voffA);
            PG8_BAR; PG8_WAIT_L(0); PG8_MMA(1, 0, At, B0); PG8_BAR; PG8_SCHED;
            PG8_STAGE(PG8_SB(1, 1), b3 + hstep, voffB);
            PG8_WAIT_V(6); PG8_BAR; PG8_MMA(1, 1, At, B1); PG8_BAR;
            }
        }
        if constexpr (ALIGN_EPI) { if (wr == 0) PG8_BAR; }
        if constexpr (!Epi::AFTER_DRAIN) { E(acc, cur, wr, wc, fr, fq); S.done(cur); }
        if (!has_next) break;
#pragma unroll
        for (int a = 0; a < 2; ++a)
#pragma unroll
            for (int b = 0; b < 2; ++b)
#pragma unroll
                for (int m = 0; m < 4; ++m)
#pragma unroll
                    for (int n = 0; n < 2; ++n) acc[a][b][m][n] = (f32x4){0.f, 0.f, 0.f, 0.f};
        cur = nxt; cA = nA; cB = nB; ++ui;
        if constexpr (ALIGN_EPI) { if (wr == 1) PG8_BAR; }
    }
    PG8_WAIT_V(0);
    if constexpr (!ALIGN_EPI) { if (wr == 0) PG8_BAR; }
    PG8_BAR;
    if constexpr (Epi::AFTER_DRAIN) { E.fused(acc, cur, wr, wc, fr, fq, lds, wid, lane); S.done(cur); }
#undef PG8_SA
#undef PG8_SB
#undef PG8_STAGE
#undef PG8_LDA
#undef PG8_LDB
#undef PG8_MMA
#undef PG8_WAIT_V
#undef PG8_WAIT_L
#undef PG8_BAR
#undef PG8_SCHED
}
}

#define LAS __attribute__((address_space(3)))
typedef unsigned short bf16_t;
typedef short bf16x8 __attribute__((ext_vector_type(8)));
typedef float f32x4 __attribute__((ext_vector_type(4)));
typedef float f32x2 __attribute__((ext_vector_type(2)));
typedef float f32x16 __attribute__((ext_vector_type(16)));
typedef unsigned u32x4 __attribute__((ext_vector_type(4)));
typedef unsigned u32x2 __attribute__((ext_vector_type(2)));
typedef __bf16 bf16x2_t __attribute__((ext_vector_type(2)));

constexpr int NB = 8, SEQ = 2048, DM = 1024, MT = NB * SEQ, DIN = 3584, NH = 8, HD = 64, CWID = 31, PLE = 256, CD = 512;
constexpr float EPS = 1e-6f;
constexpr float QSCALE = 0.125f * 1.4426950408889634f;

constexpr size_t MiB = 1u << 20;
constexpr size_t W_IN = 0, W_PW = 7340032, W_OUT = W_PW + 524288, W_PG = W_OUT + 2097152, W_PLE = W_PG + 2097152, W_LAYER = 12 * MiB;
static_assert(W_PLE + 524288 == W_LAYER, "weight map");
constexpr int UP = 2560, UQ = 0, UK = 512, USGA = 1024, UGLU = 1536, USGC = 2048;
constexpr size_t WS_PB = 24 * MiB, WS_HB = 40 * MiB, WS_Y = 72 * MiB, WS_VT = 104 * MiB, WS_SSA = 120 * MiB, WS_SSB = 121 * MiB, WS_SSC = 122 * MiB, WS_U = 123 * MiB;
constexpr size_t WS_H1B = WS_U  , WS_C2 = 203 * MiB, WS_EB = 219 * MiB, WS_CTL = 252 * MiB, CTL_BYTES = 16384, WS_END = WS_CTL + CTL_BYTES;
static_assert(WS_U + (size_t)MT * UP * 2 <= WS_C2, "ws map");
constexpr int LDS_BYTES = 147456;
constexpr int NPHASE = 12;
#ifndef PROBE_DUP
#define PROBE_DUP 0
#endif

__device__ __forceinline__ unsigned pk2(float lo, float hi) { f32x2 v = {lo, hi}; bf16x2_t b = __builtin_convertvector(v, bf16x2_t); return __builtin_bit_cast(unsigned, b); }
__device__ __forceinline__ float bflo(unsigned u) { return __builtin_bit_cast(float, u << 16); }
__device__ __forceinline__ float bfhi(unsigned u) { return __builtin_bit_cast(float, u & 0xffff0000u); }
__device__ __forceinline__ float fexp2(float x) { return __builtin_amdgcn_exp2f(x); }
__device__ __forceinline__ float flog2(float x) { return __builtin_amdgcn_logf(x); }
__device__ __forceinline__ float frcp(float x) { return __builtin_amdgcn_rcpf(x); }
__device__ __forceinline__ float frsq(float x) { return __builtin_amdgcn_rsqf(x); }
__device__ __forceinline__ float sigmoidf_(float x) { return frcp(1.0f + fexp2(-1.4426950408889634f * x)); }
__device__ __forceinline__ float siluf_(float x) { return x * sigmoidf_(x); }
#define MFMA32(a, b, c) __builtin_amdgcn_mfma_f32_32x32x16_bf16((a), (b), (c), 0, 0, 0)

__device__ __forceinline__ float shx(float v, int m, int lane) { return __builtin_bit_cast(float, __builtin_amdgcn_ds_bpermute((lane ^ m) << 2, __builtin_bit_cast(int, v))); }
__device__ __forceinline__ float wave_sum(float v, int lane) {
#pragma unroll
    for (int o = 1; o < 64; o <<= 1) v += shx(v, o, lane);
    return v;
}
__device__ __forceinline__ float row_rstd(const float* ss, int row, int fq, int lane) {
    const f32x4 p = *(const f32x4*)(ss + (size_t)row * 16 + fq * 4);
    float s = (p[0] + p[1]) + (p[2] + p[3]);
    s += shx(s, 16, lane); s += shx(s, 32, lane);
    return frsq(s * (1.0f / DM) + EPS);
}

struct EpiIn {
    static constexpr bool PERM = true, AFTER_DRAIN = false; static constexpr int MID_T = 0;
    bf16_t* U; bf16_t* VT; const float* ss;
    __device__ __forceinline__ void operator()(const f32x4 (&acc)[2][2][4][2], const pg8::Unit& u, int, int, int, int) const {
        int t_ = threadIdx.x; asm volatile("" : "+v"(t_));
        const int lane = t_ & 63, fr = lane & 15, fq = lane >> 4, wid_ = __builtin_amdgcn_readfirstlane(t_ >> 6), wr = wid_ >> 2, wc = wid_ & 3;
        const int pn = u.pn;
        f32x4 pp[2][4];
#pragma unroll
        for (int ai = 0; ai < 2; ++ai)
#pragma unroll
            for (int m = 0; m < 4; ++m) pp[ai][m] = *(const f32x4*)(ss + (size_t)(u.pm * 256 + ai * 128 + wr * 64 + m * 16 + fr) * 16 + fq * 4);
#pragma unroll
        for (int ai = 0; ai < 2; ++ai)
#pragma unroll
            for (int m = 0; m < 4; ++m) {
                const int row = u.pm * 256 + ai * 128 + wr * 64 + m * 16 + fr;
                float s_ = (pp[ai][m][0] + pp[ai][m][1]) + (pp[ai][m][2] + pp[ai][m][3]);
                s_ += shx(s_, 16, lane); s_ += shx(s_, 32, lane);
                const float rs = frsq(s_ * (1.0f / DM) + EPS);
#pragma unroll
                for (int bj = 0; bj < 2; ++bj) {
                    const int col0 = pn * 256 + bj * 128 + wc * 32 + 8 * fq;
                    f32x4 v0 = acc[ai][bj][m][0] * rs, v1 = acc[ai][bj][m][1] * rs;
                    if (pn < 4) {
                        const float sc = pn < 2 ? QSCALE : 1.0f;
                        v0 = v0 * sc; v1 = v1 * sc;
                        u32x4 w; w[0] = pk2(v0[0], v0[1]); w[1] = pk2(v0[2], v0[3]); w[2] = pk2(v1[0], v1[1]); w[3] = pk2(v1[2], v1[3]);
                        *(u32x4*)(U + (size_t)row * UP + col0) = w;
                    } else if (pn < 6) {
                        const int vc = col0 - 1024, hh = vc >> 6, d0 = vc & 63, b = row >> 11, s = row & 2047;
                        bf16_t* vp = VT + ((size_t)((b * NH + hh) * HD + d0)) * SEQ + s;
                        const unsigned w0 = pk2(v0[0], v0[1]), w1 = pk2(v0[2], v0[3]), w2 = pk2(v1[0], v1[1]), w3 = pk2(v1[2], v1[3]);
                        vp[0 * SEQ] = (bf16_t)(w0 & 0xffffu); vp[1 * SEQ] = (bf16_t)(w0 >> 16);
                        vp[2 * SEQ] = (bf16_t)(w1 & 0xffffu); vp[3 * SEQ] = (bf16_t)(w1 >> 16);
                        vp[4 * SEQ] = (bf16_t)(w2 & 0xffffu); vp[5 * SEQ] = (bf16_t)(w2 >> 16);
                        vp[6 * SEQ] = (bf16_t)(w3 & 0xffffu); vp[7 * SEQ] = (bf16_t)(w3 >> 16);
                    } else if (pn < 8 || pn >= 12) {
                        u32x4 w; w[0] = pk2(siluf_(v0[0]), siluf_(v0[1])); w[1] = pk2(siluf_(v0[2]), siluf_(v0[3]));
                        w[2] = pk2(siluf_(v1[0]), siluf_(v1[1])); w[3] = pk2(siluf_(v1[2]), siluf_(v1[3]));
                        *(u32x4*)(U + (size_t)row * UP + (pn < 8 ? col0 - 512 : col0 - 1024)) = w;
                    } else {
                        const int ch0 = (col0 - 2048) >> 1;
                        u32x2 w; w[0] = pk2(v0[0] * sigmoidf_(v0[1]), v0[2] * sigmoidf_(v0[3])); w[1] = pk2(v1[0] * sigmoidf_(v1[1]), v1[2] * sigmoidf_(v1[3]));
                        *(u32x2*)(U + (size_t)row * UP + UGLU + ch0) = w;
                    }
                }
                asm volatile("" ::: "memory");
            }
    }
};

struct EpiPw {
    static constexpr bool PERM = true, AFTER_DRAIN = false; static constexpr int MID_T = 0;
    const bf16_t* U; bf16_t* Y; const float* cog; float* ssC;
    __device__ __forceinline__ void operator()(const f32x4 (&acc)[2][2][4][2], const pg8::Unit& u, int, int, int, int) const {
        int t_ = threadIdx.x; asm volatile("" : "+v"(t_));
        const int lane = t_ & 63, fr = lane & 15, fq = lane >> 4, wid_ = __builtin_amdgcn_readfirstlane(t_ >> 6), wr = wid_ >> 2, wc = wid_ & 3;
#pragma unroll
        for (int ai = 0; ai < 2; ++ai)
#pragma unroll
            for (int m = 0; m < 4; ++m) {
                const int row = u.pm * 256 + ai * 128 + wr * 64 + m * 16 + fr;
                float sq = 0.f;
#pragma unroll
                for (int bj = 0; bj < 2; ++bj) {
                    const int col0 = u.pn * 256 + bj * 128 + wc * 32 + 8 * fq;
                    const f32x4 v0 = acc[ai][bj][m][0], v1 = acc[ai][bj][m][1];
                    sq += (v0[0] * v0[0] + v0[1] * v0[1]) + (v0[2] * v0[2] + v0[3] * v0[3]) + (v1[0] * v1[0] + v1[1] * v1[1]) + (v1[2] * v1[2] + v1[3] * v1[3]);
                    const f32x4 g0 = *(const f32x4*)(cog + col0), g1 = *(const f32x4*)(cog + col0 + 4);
                    const u32x4 sg = *(const u32x4*)(U + (size_t)row * UP + USGC + col0);
                    u32x4 w;
                    w[0] = pk2(v0[0] * g0[0] * bflo(sg[0]), v0[1] * g0[1] * bfhi(sg[0])); w[1] = pk2(v0[2] * g0[2] * bflo(sg[1]), v0[3] * g0[3] * bfhi(sg[1]));
                    w[2] = pk2(v1[0] * g1[0] * bflo(sg[2]), v1[1] * g1[1] * bfhi(sg[2])); w[3] = pk2(v1[2] * g1[2] * bflo(sg[3]), v1[3] * g1[3] * bfhi(sg[3]));
                    *(u32x4*)(Y + (size_t)row * DM + col0) = w;
                }
                sq += shx(sq, 16, lane); sq += shx(sq, 32, lane);
                if (fq == 0) ssC[(size_t)row * 8 + u.pn * 4 + wc] = sq;
                asm volatile("" ::: "memory");
            }
    }
};

struct EpiE {
    static constexpr bool PERM = true, AFTER_DRAIN = false; static constexpr int MID_T = 0;
    bf16_t* EB;
    __device__ __forceinline__ void operator()(const f32x4 (&acc)[2][2][4][2], const pg8::Unit& u, int, int, int, int) const {
        int t_ = threadIdx.x; asm volatile("" : "+v"(t_));
        const int lane = t_ & 63, fr = lane & 15, fq = lane >> 4, wid_ = __builtin_amdgcn_readfirstlane(t_ >> 6), wr = wid_ >> 2, wc = wid_ & 3;
#pragma unroll
        for (int ai = 0; ai < 2; ++ai)
#pragma unroll
            for (int m = 0; m < 4; ++m) {
                const int row = u.pm * 256 + ai * 128 + wr * 64 + m * 16 + fr;
#pragma unroll
                for (int bj = 0; bj < 2; ++bj) {
                    const int col0 = u.pn * 256 + bj * 128 + wc * 32 + 8 * fq;
                    const f32x4 v0 = acc[ai][bj][m][0], v1 = acc[ai][bj][m][1];
                    u32x4 w; w[0] = pk2(v0[0], v0[1]); w[1] = pk2(v0[2], v0[3]); w[2] = pk2(v1[0], v1[1]); w[3] = pk2(v1[2], v1[3]);
                    *(u32x4*)(EB + (size_t)row * DM + col0) = w;
                }
                asm volatile("" ::: "memory");
            }
    }
};

template <bool BB> struct EpiOut {
    static constexpr bool PERM = true, AFTER_DRAIN = false; static constexpr int MID_T = 8;
    const float* base; const bf16_t* baseb; bf16_t* HB; float* ss; const float* ssC;
    __device__ __forceinline__ void mid(f32x4 (&acc)[2][2][4][2], const pg8::Unit& u) const {
        int t_ = threadIdx.x; asm volatile("" : "+v"(t_));
        const int lane = t_ & 63, fr = lane & 15, fq = lane >> 4, wid_ = __builtin_amdgcn_readfirstlane(t_ >> 6), wr = wid_ >> 2;
        f32x2 pc[2][4];
#pragma unroll
        for (int ai = 0; ai < 2; ++ai)
#pragma unroll
            for (int m = 0; m < 4; ++m) pc[ai][m] = *(const f32x2*)(ssC + (size_t)(u.pm * 256 + ai * 128 + wr * 64 + m * 16 + fr) * 8 + fq * 2);
#pragma unroll
        for (int ai = 0; ai < 2; ++ai)
#pragma unroll
            for (int m = 0; m < 4; ++m) {
                const f32x2 p = pc[ai][m];
                float s = p[0] + p[1];
                s += shx(s, 16, lane); s += shx(s, 32, lane);
                const float rs = frsq(s * (1.0f / CD) + EPS);
#pragma unroll
                for (int bj = 0; bj < 2; ++bj)
#pragma unroll
                    for (int n = 0; n < 2; ++n) acc[ai][bj][m][n] = acc[ai][bj][m][n] * rs;
            }
    }
    __device__ __forceinline__ void operator()(const f32x4 (&acc)[2][2][4][2], const pg8::Unit& u, int, int, int, int) const {
        int t_ = threadIdx.x; asm volatile("" : "+v"(t_));
        const int lane = t_ & 63, fr = lane & 15, fq = lane >> 4, wid_ = __builtin_amdgcn_readfirstlane(t_ >> 6), wr = wid_ >> 2, wc = wid_ & 3;
#pragma unroll
        for (int ai = 0; ai < 2; ++ai)
#pragma unroll
            for (int mp = 0; mp < 2; ++mp) {
                f32x4 bs[2][2][2];
#pragma unroll
                for (int mm = 0; mm < 2; ++mm)
#pragma unroll
                    for (int bj = 0; bj < 2; ++bj) {
                        const size_t off = (size_t)(u.pm * 256 + ai * 128 + wr * 64 + (2 * mp + mm) * 16 + fr) * DM + u.pn * 256 + bj * 128 + wc * 32 + 8 * fq;
                        if constexpr (BB) { const u32x4 r1 = *(const u32x4*)(baseb + off); f32x4 t0 = {bflo(r1[0]), bfhi(r1[0]), bflo(r1[1]), bfhi(r1[1])}, t1 = {bflo(r1[2]), bfhi(r1[2]), bflo(r1[3]), bfhi(r1[3])}; bs[mm][bj][0] = t0; bs[mm][bj][1] = t1; }
                        else { bs[mm][bj][0] = *(const f32x4*)(base + off); bs[mm][bj][1] = *(const f32x4*)(base + off + 4); }
                    }
#pragma unroll
                for (int mm = 0; mm < 2; ++mm) {
                    const int m = 2 * mp + mm;
                    const int row = u.pm * 256 + ai * 128 + wr * 64 + m * 16 + fr;
                    float sq = 0.f;
#pragma unroll
                    for (int bj = 0; bj < 2; ++bj) {
                        const size_t off = (size_t)row * DM + u.pn * 256 + bj * 128 + wc * 32 + 8 * fq;
                        const f32x4 h0 = bs[mm][bj][0] + acc[ai][bj][m][0], h1 = bs[mm][bj][1] + acc[ai][bj][m][1];
                        u32x4 w; w[0] = pk2(h0[0], h0[1]); w[1] = pk2(h0[2], h0[3]); w[2] = pk2(h1[0], h1[1]); w[3] = pk2(h1[2], h1[3]);
                        *(u32x4*)(HB + off) = w;
                        sq += (h0[0] * h0[0] + h0[1] * h0[1]) + (h0[2] * h0[2] + h0[3] * h0[3]) + (h1[0] * h1[0] + h1[1] * h1[1]) + (h1[2] * h1[2] + h1[3] * h1[3]);
                    }
                    sq += shx(sq, 16, lane); sq += shx(sq, 32, lane);
                    if (fq == 0) ss[(size_t)row * 16 + u.pn * 4 + wc] = sq;
                }
                asm volatile("" ::: "memory");
            }
    }
};

template <bool WF> struct EpiGate {
    static constexpr bool PERM = true, AFTER_DRAIN = false; static constexpr int MID_T = 0;
    float* out; const bf16_t* H1; const bf16_t* EB; bf16_t* HB; const float* ss_in; float* ss_out; int dummy;
    __device__ __forceinline__ void operator()(const f32x4 (&acc)[2][2][4][2], const pg8::Unit& u, int, int, int, int) const {
        int t_ = threadIdx.x; asm volatile("" : "+v"(t_));
        const int lane = t_ & 63, fr = lane & 15, fq = lane >> 4, wid_ = __builtin_amdgcn_readfirstlane(t_ >> 6), wr = wid_ >> 2, wc = wid_ & 3;
        f32x4 pp[2][4];
#pragma unroll
        for (int ai = 0; ai < 2; ++ai)
#pragma unroll
            for (int m = 0; m < 4; ++m) pp[ai][m] = *(const f32x4*)(ss_in + (size_t)(u.pm * 256 + ai * 128 + wr * 64 + m * 16 + fr) * 16 + fq * 4);
        float rsv[2][4];
#pragma unroll
        for (int ai = 0; ai < 2; ++ai)
#pragma unroll
            for (int m = 0; m < 4; ++m) {
                float s_ = (pp[ai][m][0] + pp[ai][m][1]) + (pp[ai][m][2] + pp[ai][m][3]);
                s_ += shx(s_, 16, lane); s_ += shx(s_, 32, lane);
                rsv[ai][m] = frsq(s_ * (1.0f / DM) + EPS);
            }
        asm volatile("" ::: "memory");
#pragma unroll
        for (int ai = 0; ai < 2; ++ai)
#pragma unroll
            for (int mp = 0; mp < 2; ++mp) {
                u32x4 bs[2][2], es[2][2];
#pragma unroll
                for (int mm = 0; mm < 2; ++mm)
#pragma unroll
                    for (int bj = 0; bj < 2; ++bj) {
                        const size_t off = (size_t)(u.pm * 256 + ai * 128 + wr * 64 + (2 * mp + mm) * 16 + fr) * DM + u.pn * 256 + bj * 128 + wc * 32 + 8 * fq;
                        bs[mm][bj] = *(const u32x4*)(H1 + off); es[mm][bj] = *(const u32x4*)(EB + off);
                    }
#pragma unroll
                for (int mm = 0; mm < 2; ++mm) {
                    const int m = 2 * mp + mm;
                    const int row = u.pm * 256 + ai * 128 + wr * 64 + m * 16 + fr;
                    const float rs = rsv[ai][m];
                    float sq = 0.f;
#pragma unroll
                    for (int bj = 0; bj < 2; ++bj) {
                        const size_t off = (size_t)row * DM + u.pn * 256 + bj * 128 + wc * 32 + 8 * fq;
                        const f32x4 a0 = acc[ai][bj][m][0] * rs, a1 = acc[ai][bj][m][1] * rs;
                        const u32x4 e = es[mm][bj]; const u32x4 r1 = bs[mm][bj];
                        f32x4 h0 = {bflo(r1[0]), bfhi(r1[0]), bflo(r1[1]), bfhi(r1[1])}, h1 = {bflo(r1[2]), bfhi(r1[2]), bflo(r1[3]), bfhi(r1[3])};
                        h0[0] += bflo(e[0]) * sigmoidf_(a0[0]); h0[1] += bfhi(e[0]) * sigmoidf_(a0[1]); h0[2] += bflo(e[1]) * sigmoidf_(a0[2]); h0[3] += bfhi(e[1]) * sigmoidf_(a0[3]);
                        h1[0] += bflo(e[2]) * sigmoidf_(a1[0]); h1[1] += bfhi(e[2]) * sigmoidf_(a1[1]); h1[2] += bflo(e[3]) * sigmoidf_(a1[2]); h1[3] += bfhi(e[3]) * sigmoidf_(a1[3]);
                        if constexpr (WF) { *(f32x4*)(out + off) = h0; *(f32x4*)(out + off + 4) = h1; }
                        u32x4 w; w[0] = pk2(h0[0], h0[1]); w[1] = pk2(h0[2], h0[3]); w[2] = pk2(h1[0], h1[1]); w[3] = pk2(h1[2], h1[3]);
                        *(u32x4*)(HB + off) = w;
                        sq += (h0[0] * h0[0] + h0[1] * h0[1]) + (h0[2] * h0[2] + h0[3] * h0[3]) + (h1[0] * h1[0] + h1[1] * h1[1]) + (h1[2] * h1[2] + h1[3] * h1[3]);
                    }
                    sq += shx(sq, 16, lane); sq += shx(sq, 32, lane);
                    if (fq == 0) ss_out[(size_t)row * 16 + u.pn * 4 + wc] = sq;
                }
                asm volatile("" ::: "memory");
            }
    }
};

struct SubOrder {
    int nN, nwg, nb, c;
    __device__ void init(int M, int N, int nb_, int c_) { nN = N / 256; nwg = (M / 256) * nN; nb = nb_; c = c_; }
    __device__ bool next(int i, pg8::Unit& u) const { if (c < 0 || c >= nb) return false; const int L = i * nb + c; if (L >= nwg) return false; u.pm = L / nN; u.pn = L % nN; return true; }
    __device__ __forceinline__ void a_ready(const pg8::Unit&) const {}
    __device__ __forceinline__ void done(const pg8::Unit&) const {}
};

template <bool REMAP>
__device__ __forceinline__ void tr_item(const float* W, int K, int N, bf16_t* WT, const float* g, LAS float* scr, int item, int lane, int kshift = 0) {
    const int nblk = N / 32, kb = item / nblk, nb = item % nblk, k0 = 64 * kb, n0 = 32 * nb;
    int src = n0 + (lane & 31);
    if (REMAP) { if (src >= 2048 && src < 3072) { const int jj = src - 2048; src = (jj & 1) ? 2560 + (jj >> 1) : 2048 + (jj >> 1); } }
    float wv[32];
#pragma unroll
    for (int i = 0; i < 32; ++i) { const int kk = 2 * i + (lane >> 5); wv[i] = W[(size_t)((k0 + kk + kshift) & (K - 1)) * N + src]; }
#pragma unroll
    for (int i = 0; i < 32; ++i) { const int kk = 2 * i + (lane >> 5); float v = wv[i]; if (g) v *= g[k0 + kk]; scr[kk * 33 + (lane & 31)] = v; }
    asm volatile("s_waitcnt lgkmcnt(0)" ::: "memory");
    const int c = lane & 7;
#pragma unroll
    for (int j = 0; j < 4; ++j) { const int n = (lane >> 3) + 8 * j; const LAS float* s = scr + (8 * c) * 33 + n;
        u32x4 o; o[0] = pk2(s[0 * 33], s[1 * 33]); o[1] = pk2(s[2 * 33], s[3 * 33]); o[2] = pk2(s[4 * 33], s[5 * 33]); o[3] = pk2(s[6 * 33], s[7 * 33]);
        *(u32x4*)(WT + (size_t)(n0 + n) * K + k0 + 8 * c) = o; }
    asm volatile("s_waitcnt lgkmcnt(0)" ::: "memory");
}

constexpr int AK_STRIDE = 144, AV_STRIDE = 136, A_KBYTES = 64 * AK_STRIDE, A_VBYTES = 64 * AV_STRIDE, A_BUF = 18432;
static_assert(A_KBYTES + A_VBYTES <= A_BUF, "attention LDS buffer");

constexpr int AW_BYTES = A_KBYTES + A_VBYTES;
static_assert(8 * AW_BYTES <= LDS_BYTES - 64, "attention LDS");
__device__ __forceinline__ void attn_wave(const bf16_t* U, const bf16_t* VT, bf16_t* Y, const float* aog, int b, int h, int qblk, LAS unsigned char* lds) {
    int tid = threadIdx.x; asm volatile("" : "+v"(tid));
    const int wave = __builtin_amdgcn_readfirstlane(tid >> 6), lane = tid & 63, l31 = lane & 31, hi = lane >> 5;
    const int q0 = qblk * 32, t = q0 + l31;
    const size_t trow = (size_t)(b * SEQ + t);
    bf16x8 qf[4];
    {
        const bf16_t* qp = U + trow * UP + UQ + h * HD + 8 * hi;
#pragma unroll
        for (int s = 0; s < 4; ++s) qf[s] = *(const bf16x8*)(qp + 16 * s);
    }
    f32x16 o0, o1;
#pragma unroll
    for (int i = 0; i < 16; ++i) { o0[i] = 0.f; o1[i] = 0.f; }
    float C = 1.f;
    const int ktmax = (q0 + 30) >> 6;
    const int srow = lane >> 3, sch = lane & 7;
    const bf16_t* gk = U + (size_t)(b * SEQ + srow) * UP + UK + h * HD + sch * 8;
    const bf16_t* gv = VT + ((size_t)((b * NH + h) * HD + srow)) * SEQ + sch * 8;
    LAS unsigned char* kb = lds + wave * AW_BYTES;
    LAS unsigned char* vb = kb + A_KBYTES;
    const int kwoff = srow * AK_STRIDE + sch * 16, vwoff = srow * AV_STRIDE + sch * 16;
    u32x4 kr[8], vr[8];
#pragma unroll
    for (int i = 0; i < 8; ++i) { kr[i] = *(const u32x4*)(gk + (size_t)(ktmax * 64 + 8 * i) * UP); vr[i] = *(const u32x4*)(gv + (size_t)(8 * i) * SEQ + ktmax * 64); }
    for (int kt = ktmax; kt >= 0; --kt) {
#pragma unroll
        for (int i = 0; i < 8; ++i) {
            *(LAS u32x4*)(kb + kwoff + 8 * i * AK_STRIDE) = kr[i];
            u32x2 a = {vr[i][0], vr[i][1]}, c = {vr[i][2], vr[i][3]};
            *(LAS u32x2*)(vb + vwoff + 8 * i * AV_STRIDE) = a; *(LAS u32x2*)(vb + vwoff + 8 * i * AV_STRIDE + 8) = c;
        }
        if (kt > 0) {
#pragma unroll
            for (int i = 0; i < 8; ++i) { kr[i] = *(const u32x4*)(gk + (size_t)((kt - 1) * 64 + 8 * i) * UP); vr[i] = *(const u32x4*)(gv + (size_t)(8 * i) * SEQ + (kt - 1) * 64); }
        }
        {
            f32x16 p0, p1;
#pragma unroll
            for (int i = 0; i < 16; ++i) { p0[i] = 0.f; p1[i] = 0.f; }
#pragma unroll
            for (int s = 0; s < 4; ++s) {
                const bf16x8 ka = *(const LAS bf16x8*)(kb + l31 * AK_STRIDE + 32 * s + 16 * hi);
                const bf16x8 kc = *(const LAS bf16x8*)(kb + (32 + l31) * AK_STRIDE + 32 * s + 16 * hi);
                p0 = MFMA32(ka, qf[s], p0); p1 = MFMA32(kc, qf[s], p1);
            }
            const int lim0 = t - (64 * kt + 4 * hi), lim1 = lim0 - 32;
            const bool diag = (64 * kt + 63 >= q0);
            f32x16 m0, m1;
            float G0[4], G1[4];
#pragma unroll
            for (int g = 0; g < 4; ++g) {
                float s0 = 1.f, s1 = 1.f;
#pragma unroll
                for (int i = 0; i < 4; ++i) {
                    const int r = 4 * g + i, cr = i + 8 * g;
                    const float e0 = fexp2(fminf(p0[r], 100.f)), e1 = fexp2(fminf(p1[r], 100.f));
                    float r0 = frcp(1.0f + e0), r1 = frcp(1.0f + e1);
                    float b0 = e0 * r0, b1 = e1 * r1;
                    if (diag) { const bool v0 = cr < lim0, v1 = cr < lim1; r0 = v0 ? r0 : 1.f; b0 = v0 ? b0 : 0.f; r1 = v1 ? r1 : 1.f; b1 = v1 ? b1 : 0.f; }
                    m0[r] = r0; m1[r] = r1; p0[r] = b0; p1[r] = b1; s0 *= r0; s1 *= r1;
                }
                G0[g] = s0; G1[g] = s1;
            }
            float X0[4], X1[4];
#pragma unroll
            for (int g = 0; g < 4; ++g) { X0[g] = shx(G0[g], 32, lane); X1[g] = shx(G1[g], 32, lane); }
            float run = C;
#pragma unroll
            for (int g = 3; g >= 0; --g) {
                float a = hi == 0 ? run * X1[g] : run;
#pragma unroll
                for (int i = 3; i >= 0; --i) { const int r = 4 * g + i; const float w = a * p1[r]; a *= m1[r]; p1[r] = w; }
                run *= G1[g] * X1[g];
            }
#pragma unroll
            for (int g = 3; g >= 0; --g) {
                float a = hi == 0 ? run * X0[g] : run;
#pragma unroll
                for (int i = 3; i >= 0; --i) { const int r = 4 * g + i; const float w = a * p0[r]; a *= m0[r]; p0[r] = w; }
                run *= G0[g] * X0[g];
            }
            C = run;
#pragma unroll
            for (int kh = 0; kh < 2; ++kh)
#pragma unroll
                for (int sh = 0; sh < 2; ++sh) {
                    u32x4 xw;
                    if (kh == 0) { xw[0] = pk2(p0[8 * sh + 0], p0[8 * sh + 1]); xw[1] = pk2(p0[8 * sh + 2], p0[8 * sh + 3]); xw[2] = pk2(p0[8 * sh + 4], p0[8 * sh + 5]); xw[3] = pk2(p0[8 * sh + 6], p0[8 * sh + 7]); }
                    else         { xw[0] = pk2(p1[8 * sh + 0], p1[8 * sh + 1]); xw[1] = pk2(p1[8 * sh + 2], p1[8 * sh + 3]); xw[2] = pk2(p1[8 * sh + 4], p1[8 * sh + 5]); xw[3] = pk2(p1[8 * sh + 6], p1[8 * sh + 7]); }
                    const bf16x8 xf = __builtin_bit_cast(bf16x8, xw);
                    const int koff = 2 * (32 * kh + 16 * sh + 4 * hi);
                    {
                        const LAS unsigned char* vp = vb + l31 * AV_STRIDE + koff;
                        const u32x2 lo = *(const LAS u32x2*)vp, hh = *(const LAS u32x2*)(vp + 16);
                        u32x4 vw = {lo[0], lo[1], hh[0], hh[1]};
                        o0 = MFMA32(__builtin_bit_cast(bf16x8, vw), xf, o0);
                    }
                    {
                        const LAS unsigned char* vp = vb + (32 + l31) * AV_STRIDE + koff;
                        const u32x2 lo = *(const LAS u32x2*)vp, hh = *(const LAS u32x2*)(vp + 16);
                        u32x4 vw = {lo[0], lo[1], hh[0], hh[1]};
                        o1 = MFMA32(__builtin_bit_cast(bf16x8, vw), xf, o1);
                    }
                }
        }
        if (__builtin_amdgcn_ballot_w64(C > 7.5e-37f) == 0ull) break;
    }
    float sq = 0.f;
#pragma unroll
    for (int i = 0; i < 16; ++i) sq += o0[i] * o0[i] + o1[i] * o1[i];
    sq += shx(sq, 32, lane);
    const float rs = frsq(sq * (1.0f / HD) + EPS);
    const bf16_t* sgp = U + trow * UP + USGA + h * HD;
    bf16_t* yp = Y + trow * DM + 512 + h * HD;
#pragma unroll
    for (int dt = 0; dt < 2; ++dt)
#pragma unroll
        for (int g = 0; g < 4; ++g) {
            const int d0 = 32 * dt + 8 * g + 4 * hi;
            const f32x4 gn = *(const f32x4*)(aog + d0);
            const u32x2 sg = *(const u32x2*)(sgp + d0);
            float v0, v1, v2, v3;
            if (dt == 0) { v0 = o0[4 * g + 0]; v1 = o0[4 * g + 1]; v2 = o0[4 * g + 2]; v3 = o0[4 * g + 3]; }
            else         { v0 = o1[4 * g + 0]; v1 = o1[4 * g + 1]; v2 = o1[4 * g + 2]; v3 = o1[4 * g + 3]; }
            u32x2 w;
            w[0] = pk2(v0 * rs * gn[0] * bflo(sg[0]), v1 * rs * gn[1] * bfhi(sg[0]));
            w[1] = pk2(v2 * rs * gn[2] * bflo(sg[1]), v3 * rs * gn[3] * bfhi(sg[1]));
            *(u32x2*)(yp + d0) = w;
        }
}

constexpr int CT = 32, C_XH = 0, C_XH_BYTES = (CT + 30) * 1024, C_CO = C_XH_BYTES, C_CO_BYTES = CT * CD * 4;
static_assert(C_CO + C_CO_BYTES <= LDS_BYTES, "conv LDS map");

__device__ __forceinline__ void convpre_unit(const bf16_t* U, bf16_t* C2, const float* dww, const float* dwb, const float* lng, const float* lnb, int cu, LAS unsigned char* lds) {
    int tid = threadIdx.x; asm volatile("" : "+v"(tid));
    const int wave = __builtin_amdgcn_readfirstlane(tid >> 6), lane = tid & 63;
    const int r0 = cu * CT, b = r0 >> 11, s0 = r0 & 2047;
    __syncthreads();
    for (int i = tid; i < (CT + 30) * 64; i += 512) {
        const int row = i >> 6, ch = i & 63, s = s0 - 30 + row;
        u32x4 v = {0u, 0u, 0u, 0u};
        if (s >= 0) v = *(const u32x4*)(U + (size_t)(b * SEQ + s) * UP + UGLU + ch * 8);
        *(LAS u32x4*)(lds + C_XH + row * 1024 + ch * 16) = v;
    }
    __syncthreads();
    {
        const int chp = tid & 255, tg = tid >> 8;
        f32x2 w2[CWID];
#pragma unroll
        for (int j = 0; j < CWID; ++j) w2[j] = *(const f32x2*)(dww + (size_t)j * CD + 2 * chp);
        const f32x2 bias = *(const f32x2*)(dwb + 2 * chp);
        const LAS unsigned char* xp = lds + C_XH + (tg * 16) * 1024 + chp * 4;
        f32x2 xv[16 + CWID - 1];
#pragma unroll
        for (int i = 0; i < 16 + CWID - 1; ++i) { const unsigned xu = *(const LAS unsigned*)(xp + i * 1024); f32x2 t2 = {bflo(xu), bfhi(xu)}; xv[i] = t2; }
#pragma unroll
        for (int tt = 0; tt < 16; ++tt) {
            f32x2 a = bias;
#pragma unroll
            for (int j = 0; j < CWID; ++j) a = a + w2[j] * xv[tt + j];
            *(LAS f32x2*)(lds + C_CO + (tg * 16 + tt) * 2048 + chp * 8) = a;
        }
    }
    __syncthreads();
    {
        const f32x4 g0 = *(const f32x4*)(lng + lane * 4), g1 = *(const f32x4*)(lng + 256 + lane * 4);
        const f32x4 b0 = *(const f32x4*)(lnb + lane * 4), b1 = *(const f32x4*)(lnb + 256 + lane * 4);
#pragma unroll
        for (int tt = 0; tt < 4; ++tt) {
            const int tl = wave * 4 + tt;
            f32x4 v0 = *(const LAS f32x4*)(lds + C_CO + tl * 2048 + lane * 16), v1 = *(const LAS f32x4*)(lds + C_CO + tl * 2048 + 1024 + lane * 16);
            const float mean = wave_sum((v0[0] + v0[1]) + (v0[2] + v0[3]) + (v1[0] + v1[1]) + (v1[2] + v1[3]), lane) * (1.0f / CD);
            v0 = v0 - mean; v1 = v1 - mean;
            const float var = wave_sum((v0[0] * v0[0] + v0[1] * v0[1]) + (v0[2] * v0[2] + v0[3] * v0[3]) + (v1[0] * v1[0] + v1[1] * v1[1]) + (v1[2] * v1[2] + v1[3] * v1[3]), lane) * (1.0f / CD);
            const float rs = frsq(var + EPS);
            v0 = v0 * rs * g0 + b0; v1 = v1 * rs * g1 + b1;
            u32x2 wa, wb;
            wa[0] = pk2(siluf_(v0[0]), siluf_(v0[1])); wa[1] = pk2(siluf_(v0[2]), siluf_(v0[3]));
            wb[0] = pk2(siluf_(v1[0]), siluf_(v1[1])); wb[1] = pk2(siluf_(v1[2]), siluf_(v1[3]));
            bf16_t* cp = C2 + (size_t)(r0 + tl) * CD + lane * 4;
            *(u32x2*)cp = wa; *(u32x2*)(cp + 256) = wb;
        }
    }
}

#define XB_TMO      128
#define XB_XCNT(j)  (256  + 64 * (j))
#define XB_XSUB(j)  (1280 + 64 * (j))
#define XB_XGEN(j)  (2304 + 64 * (j))
#define XB_TOP      3328
#define XB_TOPGEN   3392
#define XCD_BAR_WORDS 3456
#define XB_SPIN_CAP (1u << 18)

__device__ __forceinline__ unsigned xb_ld(unsigned* p)              { return __hip_atomic_load(p, __ATOMIC_RELAXED, __HIP_MEMORY_SCOPE_AGENT); }
__device__ __forceinline__ unsigned xb_add(unsigned* p, unsigned v) { return __hip_atomic_fetch_add(p, v, __ATOMIC_RELAXED, __HIP_MEMORY_SCOPE_AGENT); }
__device__ __forceinline__ unsigned xb_xcc_id() { return (unsigned)__builtin_amdgcn_s_getreg((3 << 11) | 20) & 0xFu; }
#define XB_SPIN(cond, bar) do { unsigned _sp = 0; while (cond) { __builtin_amdgcn_s_sleep(1); \
    if ((++_sp & 255u) == 0u) { if (xb_ld(&(bar)[XB_TMO])) break; if (_sp > XB_SPIN_CAP) { atomicAdd(&(bar)[XB_TMO], 1u); break; } } } } while (0)

struct XcdBarrier {
    unsigned* bar; unsigned x;
    volatile LAS unsigned* st;
};

__device__ __forceinline__ XcdBarrier xcd_barrier_post(unsigned* bar, volatile LAS unsigned* st) {
    XcdBarrier b; b.bar = bar; b.x = xb_xcc_id(); b.st = st;
    if (threadIdx.x == 0) (void)xb_add(&bar[XB_XCNT(b.x)], 1u);
    return b;
}
__device__ __forceinline__ void xcd_barrier_complete(unsigned* bar, unsigned x, unsigned& nloc, unsigned& nx) {
    const unsigned G = gridDim.x * gridDim.y * gridDim.z;
    unsigned sum, cnt, mine, sp = 0u;
    for (;;) {
        sum = 0u; cnt = 0u; mine = 0u;
#pragma unroll
        for (unsigned j = 0; j < 16; ++j) { const unsigned c = xb_ld(&bar[XB_XCNT(j)]); sum += c; cnt += (c > 0u) ? 1u : 0u; mine = (j == x) ? c : mine; }
        if (sum == G) break;
        __builtin_amdgcn_s_sleep(1);
        if ((++sp & 255u) == 0u) { if (xb_ld(&bar[XB_TMO])) break; if (sp > XB_SPIN_CAP) { atomicAdd(&bar[XB_TMO], 1u); break; } }
    }
    nloc = mine > 0u ? mine : 1u; nx = cnt > 0u ? cnt : 1u;
}

__device__ __forceinline__ void xcd_barrier(const XcdBarrier& b) {
    asm volatile("s_waitcnt vmcnt(0)" ::: "memory");
    __syncthreads();
    if (threadIdx.x == 0) {
        unsigned* bar = b.bar;
        __builtin_amdgcn_s_waitcnt(0);
        unsigned nloc = b.st[0], nx = b.st[1];
        if (nloc == 0u) { xcd_barrier_complete(bar, b.x, nloc, nx); b.st[0] = nloc; b.st[1] = nx; }
        const unsigned old = xb_add(&bar[XB_XSUB(b.x)], 1u);
        const unsigned gen = old / nloc;
        if (old + 1u == (gen + 1u) * nloc) {
            __builtin_amdgcn_fence(__ATOMIC_RELEASE, "agent");
            asm volatile("s_waitcnt vmcnt(0)" ::: "memory");
            const unsigned og = xb_add(&bar[XB_TOP], 1u);
            const unsigned tg = og / nx;
            if (og + 1u == (tg + 1u) * nx) xb_add(&bar[XB_TOPGEN], 1u);
            else XB_SPIN(xb_ld(&bar[XB_TOPGEN]) == tg, bar);
            __builtin_amdgcn_fence(__ATOMIC_ACQUIRE, "agent");
            xb_add(&bar[XB_XGEN(b.x)], 1u);
            asm volatile("s_waitcnt vmcnt(0)" ::: "memory");
        } else {
            XB_SPIN(xb_ld(&bar[XB_XGEN(b.x)]) == gen, bar);
            __builtin_amdgcn_fence(__ATOMIC_ACQUIRE, "agent");
            asm volatile("s_waitcnt vmcnt(0)" ::: "memory");
        }
    }
    __syncthreads();
}

struct Params { const float* in[16]; float* out; unsigned char* ws; int ph_lo, ph_hi; };

template <int ph>
__device__ __forceinline__ void run_phase(const Params& P, LAS unsigned char* lds) {
    const int G = gridDim.x, bid = blockIdx.x;
    unsigned char* ws = P.ws;
    const float* x = P.in[0];
    float* out = P.out;
    bf16_t* HB = (bf16_t*)(ws + WS_HB); bf16_t* H1B = (bf16_t*)(ws + WS_H1B); bf16_t* Ub = (bf16_t*)(ws + WS_U); bf16_t* VT = (bf16_t*)(ws + WS_VT); bf16_t* Yb = (bf16_t*)(ws + WS_Y);
    bf16_t* C2 = (bf16_t*)(ws + WS_C2); bf16_t* EB = (bf16_t*)(ws + WS_EB);
    float* ssA = (float*)(ws + WS_SSA); float* ssB = (float*)(ws + WS_SSB); float* ssC = (float*)(ws + WS_SSC);
    int tid = threadIdx.x; asm volatile("" : "+v"(tid));
    const int lane = tid & 63, wave = __builtin_amdgcn_readfirstlane(tid >> 6);
    const int gw = bid * 8 + wave, NGW = G * 8;
    if constexpr (ph == 0) {
        LAS float* scr = (LAS float*)(lds + wave * 16384);
        for (int it = gw; it < 2 * 3072; it += NGW) {
            const int l = it / 3072; int r = it - l * 3072;
            unsigned char* wb = ws + (size_t)l * W_LAYER;
            if (r < 1792) { tr_item<true>(P.in[3] + (size_t)l * DM * DIN, DM, DIN, (bf16_t*)(wb + W_IN), P.in[2] + l * DM, scr, r, lane); continue; } r -= 1792;
            if (r < 128) { tr_item<false>(P.in[9] + (size_t)l * CD * CD, CD, CD, (bf16_t*)(wb + W_PW), nullptr, scr, r, lane); continue; } r -= 128;
            if (r < 512) { tr_item<false>(P.in[11] + (size_t)l * DM * DM, DM, DM, (bf16_t*)(wb + W_OUT), nullptr, scr, r, lane, 512); continue; } r -= 512;
            if (r < 512) { tr_item<false>(P.in[13] + (size_t)l * DM * DM, DM, DM, (bf16_t*)(wb + W_PG), P.in[12] + l * DM, scr, r, lane); continue; } r -= 512;
            tr_item<false>(P.in[14] + (size_t)l * PLE * DM, PLE, DM, (bf16_t*)(wb + W_PLE), nullptr, scr, r, lane);
        }
        for (int row = gw; row < MT; row += 2 * NGW) {
            const int row2 = row + NGW;
            const f32x4* xr = (const f32x4*)(x + (size_t)row * DM) + lane;
            const f32x4* xr2 = (const f32x4*)(x + (size_t)(row2 < MT ? row2 : row) * DM) + lane;
            f32x4 va[4], vb[4];
#pragma unroll
            for (int j = 0; j < 4; ++j) { va[j] = xr[64 * j]; vb[j] = xr2[64 * j]; }
            u32x2* ob = (u32x2*)(HB + (size_t)row * DM) + lane;
            float s = 0.f, s2 = 0.f;
#pragma unroll
            for (int j = 0; j < 4; ++j) { const f32x4 v = va[j]; s += (v[0] * v[0] + v[1] * v[1]) + (v[2] * v[2] + v[3] * v[3]); u32x2 w; w[0] = pk2(v[0], v[1]); w[1] = pk2(v[2], v[3]); ob[64 * j] = w; }
            s = wave_sum(s, lane);
            if (lane < 16) ssA[(size_t)row * 16 + lane] = (lane == 0) ? s : 0.f;
            if (row2 < MT) {
                u32x2* ob2 = (u32x2*)(HB + (size_t)row2 * DM) + lane;
#pragma unroll
                for (int j = 0; j < 4; ++j) { const f32x4 v = vb[j]; s2 += (v[0] * v[0] + v[1] * v[1]) + (v[2] * v[2] + v[3] * v[3]); u32x2 w; w[0] = pk2(v[0], v[1]); w[1] = pk2(v[2], v[3]); ob2[64 * j] = w; }
                s2 = wave_sum(s2, lane);
                if (lane < 16) ssA[(size_t)row2 * 16 + lane] = (lane == 0) ? s2 : 0.f;
            }
        }
        {
            const f32x4* pp = (const f32x4*)P.in[1]; u32x2* pb = (u32x2*)(ws + WS_PB);
            const int NV = 2 * MT * PLE / 4, stp = G * 512;
            for (int i = bid * 512 + tid; i < NV; i += 4 * stp) {
                f32x4 v[4];
#pragma unroll
                for (int j = 0; j < 4; ++j) { const int ii = i + j * stp; v[j] = pp[ii < NV ? ii : i]; }
#pragma unroll
                for (int j = 0; j < 4; ++j) { const int ii = i + j * stp; if (ii < NV) { u32x2 w; w[0] = pk2(v[j][0], v[j][1]); w[1] = pk2(v[j][2], v[j][3]); pb[ii] = w; } }
            }
        }
    } else if constexpr (ph == NPHASE - 1) {
        const float* fg = P.in[15];
        for (int row = gw; row < MT; row += 2 * NGW) {
            const int row2 = row + NGW; const bool has2 = row2 < MT; const int r2 = has2 ? row2 : row;
            const u32x4* hr = (const u32x4*)(HB + (size_t)row * DM) + lane; const u32x4* hr2 = (const u32x4*)(HB + (size_t)r2 * DM) + lane;
            const u32x4 a0 = hr[0], a1 = hr[64], b0 = hr2[0], b1 = hr2[64];
            const float p1 = (lane < 16) ? ssA[(size_t)row * 16 + lane] : 0.f, p2 = (lane < 16) ? ssA[(size_t)r2 * 16 + lane] : 0.f;
            const f32x4 g0 = *(const f32x4*)(fg + 8 * lane), g1 = *(const f32x4*)(fg + 8 * lane + 4), g2 = *(const f32x4*)(fg + 512 + 8 * lane), g3 = *(const f32x4*)(fg + 512 + 8 * lane + 4);
            const float rs = frsq(wave_sum(p1, lane) * (1.0f / DM) + EPS), rs2 = frsq(wave_sum(p2, lane) * (1.0f / DM) + EPS);
            float* o = out + (size_t)row * DM + 8 * lane;
            { f32x4 t0 = {bflo(a0[0]), bfhi(a0[0]), bflo(a0[1]), bfhi(a0[1])}, t1 = {bflo(a0[2]), bfhi(a0[2]), bflo(a0[3]), bfhi(a0[3])}, t2 = {bflo(a1[0]), bfhi(a1[0]), bflo(a1[1]), bfhi(a1[1])}, t3 = {bflo(a1[2]), bfhi(a1[2]), bflo(a1[3]), bfhi(a1[3])};
              *(f32x4*)o = t0 * rs * g0; *(f32x4*)(o + 4) = t1 * rs * g1; *(f32x4*)(o + 512) = t2 * rs * g2; *(f32x4*)(o + 516) = t3 * rs * g3; }
            if (has2) {
                float* o2 = out + (size_t)row2 * DM + 8 * lane;
                f32x4 t0 = {bflo(b0[0]), bfhi(b0[0]), bflo(b0[1]), bfhi(b0[1])}, t1 = {bflo(b0[2]), bfhi(b0[2]), bflo(b0[3]), bfhi(b0[3])}, t2 = {bflo(b1[0]), bfhi(b1[0]), bflo(b1[1]), bfhi(b1[1])}, t3 = {bflo(b1[2]), bfhi(b1[2]), bflo(b1[3]), bfhi(b1[3])};
                *(f32x4*)o2 = t0 * rs2 * g0; *(f32x4*)(o2 + 4) = t1 * rs2 * g1; *(f32x4*)(o2 + 512) = t2 * rs2 * g2; *(f32x4*)(o2 + 516) = t3 * rs2 * g3;
            }
        }
    } else {
        constexpr int l = (ph - 1) / 5, k = (ph - 1) % 5;
        unsigned char* wb = ws + (size_t)l * W_LAYER;
        if constexpr (k == 0) {
            pg8::Gemm g{HB, (const bf16_t*)(wb + W_IN), MT, DIN, DM}; pg8::StaticOrder S; S.init(MT, DIN, G, bid);
            EpiIn E{Ub, VT, ssA};
            pg8::gemm_phase<EpiIn, pg8::StaticOrder, true, true>(lds, g, S, E, threadIdx.x);
        } else if constexpr (k == 1) {
            const float* aog = P.in[4] + l * HD;
            const float* dww = P.in[5] + (size_t)l * CWID * CD; const float* dwb = P.in[6] + l * CD;
            const float* lng = P.in[7] + l * CD; const float* lnb = P.in[8] + l * CD;
#pragma unroll 1
            for (int rep_ = 0; rep_ < ((PROBE_DUP & 2) ? 2 : 1); ++rep_)
#pragma unroll 1
                for (int item = gw; item < NB * NH * (SEQ / 32); item += NGW) {
                    const int bh = item >> 6, qq = item & 63, qblk = (item >= NB * NH * (SEQ / 64)) ? 63 - qq : qq;
                    attn_wave(Ub, VT, Yb, aog, bh >> 3, bh & 7, qblk, lds);
                }
            __syncthreads();
            for (int it = bid; it < 256; it += G) {
#pragma unroll 1
                for (int uu = 0; uu < ((PROBE_DUP & 4) ? 4 : 2); ++uu) convpre_unit(Ub, C2, dww, dwb, lng, lnb, 2 * it + (uu & 1), lds);
            }
            __syncthreads();
        } else if constexpr (k == 2) {
            const int nb0 = G / 2;
            {
                pg8::Gemm g{C2, (const bf16_t*)(wb + W_PW), MT, CD, CD}; SubOrder S; S.init(MT, CD, nb0, bid);
                EpiPw E{Ub, Yb, P.in[10] + l * CD, ssC};
                pg8::gemm_phase<EpiPw, SubOrder, true, true>(lds, g, S, E, threadIdx.x);
            }
            {
                pg8::Gemm g{(const bf16_t*)(ws + WS_PB) + (size_t)l * MT * PLE, (const bf16_t*)(wb + W_PLE), MT, DM, PLE}; SubOrder S; S.init(MT, DM, G - nb0, bid - nb0);
                EpiE E{EB};
                int t2 = threadIdx.x; asm volatile("" : "+v"(t2));
                pg8::gemm_phase<EpiE, SubOrder, true, true>(lds, g, S, E, t2);
            }
        } else if constexpr (k == 3) {
            pg8::Gemm g{Yb, (const bf16_t*)(wb + W_OUT), MT, DM, DM}; pg8::StaticOrder S; S.init(MT, DM, G, bid);
            EpiOut<(l > 0)> E{x, HB, H1B, ssB, ssC};
            pg8::gemm_phase<EpiOut<(l > 0)>, pg8::StaticOrder, true, true>(lds, g, S, E, threadIdx.x);
        } else {
            pg8::Gemm g{H1B, (const bf16_t*)(wb + W_PG), MT, DM, DM}; pg8::StaticOrder S; S.init(MT, DM, G, bid);
            EpiGate<false> E{out, H1B, EB, HB, ssB, ssA, 0};
            pg8::gemm_phase<EpiGate<false>, pg8::StaticOrder, true, true>(lds, g, S, E, threadIdx.x);
            if constexpr ((PROBE_DUP & 128) != 0) { int t3 = threadIdx.x; asm volatile("" : "+v"(t3)); pg8::gemm_phase<EpiGate<false>, pg8::StaticOrder, true, true>(lds, g, S, E, t3); }
        }
    }
}

__global__ void __launch_bounds__(512, 2) fwd(Params P) {
    extern __shared__ __attribute__((aligned(16))) unsigned char lds_raw[];
    LAS unsigned char* lds = (LAS unsigned char*)lds_raw;
    const int lo = P.ph_lo, hi = P.ph_hi;
    volatile LAS unsigned* st = (volatile LAS unsigned*)(lds + LDS_BYTES - 64);
    if (threadIdx.x < 16) st[threadIdx.x] = 0u;
    __syncthreads();
    const XcdBarrier bar = xcd_barrier_post((unsigned*)(P.ws + WS_CTL), st);
#define PROBE_PH(k) ((((PROBE_DUP) & 8) && (k) == 0) || (((PROBE_DUP) & 1) && (k) == 1) || (((PROBE_DUP) & 32) && ((k) == 3 || (k) == 8)) || (((PROBE_DUP) & 16) && (k) == 4))
#define SEAM() do { if (hi > NPHASE) cg::this_grid().sync(); else xcd_barrier(bar); } while (0)
#define PHASE(k) if (lo <= (k) && (k) < hi) { run_phase<(k)>(P, lds); if constexpr (PROBE_PH(k)) { __syncthreads(); run_phase<(k)>(P, lds); } \
        if constexpr (((PROBE_DUP) & 64) != 0) { SEAM(); } if ((k) + 1 < hi) SEAM(); }
    PHASE(0) PHASE(1) PHASE(2) PHASE(3) PHASE(4) PHASE(5) PHASE(6) PHASE(7) PHASE(8) PHASE(9) PHASE(10) PHASE(11)
    if constexpr (((PROBE_DUP) & 256) != 0) { SEAM(); PHASE(0) PHASE(1) PHASE(2) PHASE(3) PHASE(4) PHASE(5) PHASE(6) PHASE(7) PHASE(8) PHASE(9) PHASE(10) PHASE(11) }
#undef PHASE
#undef SEAM
}

#ifndef MK_N_LAUNCHES
#define MK_N_LAUNCHES 1
#endif
extern "C" void kernel_launch(void* const* d_in, const int* in_sizes, int n_in, void* d_out, int out_size, void* d_ws, size_t ws_size, hipStream_t stream) {
    static int grid = 0;
    if (grid == 0) {
        if (n_in != 16 || out_size != MT * DM || ws_size < WS_END) { fprintf(stderr, "kernel_launch: unexpected shapes (n_in %d, out %d, ws %zu)\n", n_in, out_size, ws_size); grid = -1; return; }
        int dev = 0, cus = 0, per_cu = 0;
        (void)hipGetDevice(&dev);
        (void)hipDeviceGetAttribute(&cus, hipDeviceAttributeMultiprocessorCount, dev);
        if (hipFuncSetAttribute((const void*)fwd, hipFuncAttributeMaxDynamicSharedMemorySize, LDS_BYTES) != hipSuccess) { fprintf(stderr, "kernel_launch: hipFuncSetAttribute failed\n"); grid = -1; return; }
        if (hipOccupancyMaxActiveBlocksPerMultiprocessor(&per_cu, (const void*)fwd, 512, LDS_BYTES) != hipSuccess || per_cu < 1) { fprintf(stderr, "kernel_launch: occupancy query says %d\n", per_cu); per_cu = 1; }
        (void)hipGetLastError();
        grid = cus * 1;
        if (grid <= 0) grid = 256;
    }
    if (grid < 0) return;
    if (hipMemsetAsync((unsigned char*)d_ws + WS_CTL, 0, CTL_BYTES, stream) != hipSuccess) { fprintf(stderr, "kernel_launch: memset of barrier words failed\n"); return; }
    Params p{};
    for (int i = 0; i < 16; ++i) p.in[i] = (const float*)d_in[i];
    p.out = (float*)d_out; p.ws = (unsigned char*)d_ws;
#if MK_N_LAUNCHES == 1
    p.ph_lo = 0; p.ph_hi = NPHASE;
    void* args[] = {&p};
    hipError_t e = hipLaunchCooperativeKernel((const void*)fwd, dim3(grid), dim3(512), args, LDS_BYTES, stream);
    if (e != hipSuccess) fprintf(stderr, "kernel_launch: cooperative launch failed: %s (grid %d)\n", hipGetErrorString(e), grid);
#else
    for (int ph = 0; ph < NPHASE; ++ph) {
        p.ph_lo = ph; p.ph_hi = ph + 1;
        hipLaunchKernelGGL(fwd, dim3(grid), dim3(512), LDS_BYTES, stream, p);
    }
#endif
}
```

```cpp
#include <hip/hip_runtime.h>
#include <hip/hip_cooperative_groups.h>
#include <cstdio>
#include <cstdint>
namespace cg = cooperative_groups;
namespace pg8 {
#define PG8_LAS __attribute__((address_space(3)))
typedef unsigned short bf16_t;
typedef short bf16x8 __attribute__((ext_vector_type(8)));
typedef float f32x4 __attribute__((ext_vector_type(4)));
typedef unsigned u32x4 __attribute__((ext_vector_type(4)));
constexpr int BM = 256, BK = 64, HALF = 128, HTB = HALF * BK * 2  , STAGE_BYTES = 8 * HTB, NXCD = 8, WGM = 8;

__host__ __device__ __forceinline__ int lds_byte(int r, int c) { const int st = (r >> 4) * 2 + (c >> 5), rr = r & 15, cc = c & 31, ob = rr * 64 + cc * 2; return st * 1024 + (ob ^ (((ob >> 9) & 1) << 5)); }
__host__ __device__ __forceinline__ void stage_rc(int b, int& R, int& C) { const int st = b / 1024, sb = b % 1024, swz = sb ^ (((sb >> 9) & 1) << 5); R = (st >> 1) * 16 + swz / 64; C = (st & 1) * 32 + (swz % 64) / 2; }
__host__ __device__ __forceinline__ int perm32(int rho) { const int n = rho >> 4, i = rho & 15; return 8 * (i >> 2) + 4 * n + (i & 3); }

struct Unit { int pm, pn; };
struct Gemm { const bf16_t* A; const bf16_t* Bt; int M, N, K; };

struct StaticOrder {
    int nM, nN, nwg, G, c;
    __host__ __device__ void init(int M, int N, int G_, int c_) { nM = M / BM; nN = N / BM; nwg = nM * nN; G = G_; c = c_; }
    __host__ __device__ bool next(int i, Unit& u) const {
        const long L = (long)i * G + c; if (L >= nwg) return false;
        int wgid = (int)L; { const int q = nwg / NXCD, r = nwg % NXCD, xcd = wgid % NXCD, off = wgid / NXCD; wgid = (xcd < r ? xcd * (q + 1) : r * (q + 1) + (xcd - r) * q) + off; }
        const int nig = WGM * nN, gid = wgid / nig, fm = gid * WGM, gsz = (nM - fm) < WGM ? (nM - fm) : WGM;
        u.pm = fm + ((wgid % nig) % gsz); u.pn = (wgid % nig) / gsz; return true;
    }
    __device__ __forceinline__ void a_ready(const Unit&) const {}
    __device__ __forceinline__ void done(const Unit&) const {}
};

template <class Epi, class Sched, bool ALIGN_EPI = false, bool SP2 = false>
__device__ __forceinline__ void gemm_phase(PG8_LAS unsigned char* lds, const Gemm g, const Sched& S, const Epi& E, const int tid_in) {
    const int tid = tid_in, wid = __builtin_amdgcn_readfirstlane(tid >> 6), lane = tid & 63, wr = wid >> 2, wc = wid & 3, fr = lane & 15, fq = lane >> 4;
    const int K = g.K, nt = K / BK;
    unsigned voffA[2], voffB[2];
#pragma unroll
    for (int i = 0; i < 2; ++i) { int R, C; stage_rc(tid * 16 + i * 8192, R, C); const int Rb = Epi::PERM ? ((R & ~31) + perm32(R & 31)) : R;
        voffA[i] = (unsigned)(R * K + C) * 2u; voffB[i] = (unsigned)(Rb * K + C) * 2u; }
    const size_t kstep = (size_t)(BK * 2);
    const size_t hstep = (size_t)HALF * K * 2;
    const size_t tstep = 2 * hstep;
    const unsigned ldsw = (unsigned)wid * 1024u;
    const int aoff = lds_byte(wr * 64 + fr, fq * 8), boff = lds_byte(wc * 32 + fr, fq * 8);
#define PG8_SA(b, h) (((b) * 2 + (h)) * HTB)
#define PG8_SB(b, h) ((4 + (b) * 2 + (h)) * HTB)
#define PG8_STAGE(bufoff, gbase, voff) do { _Pragma("unroll") for (int _i = 0; _i < 2; ++_i) \
        __builtin_amdgcn_global_load_lds((const unsigned*)((const char*)(gbase) + (voff)[_i]), (PG8_LAS unsigned*)(lds + (bufoff) + ldsw + _i * 8192), 16, 0, 0); } while (0)
#define PG8_LDA(dst, b, h) do { _Pragma("unroll") for (int m = 0; m < 4; ++m) _Pragma("unroll") for (int k = 0; k < 2; ++k) dst[m][k] = *(const PG8_LAS bf16x8*)(lds + PG8_SA(b, h) + aoff + m * 2048 + k * 1024); } while (0)
#define PG8_LDB(dst, b, h) do { _Pragma("unroll") for (int n = 0; n < 2; ++n) _Pragma("unroll") for (int k = 0; k < 2; ++k) dst[n][k] = *(const PG8_LAS bf16x8*)(lds + PG8_SB(b, h) + boff + n * 2048 + k * 1024); } while (0)
#define PG8_MMA(ai, bj, At, Bt) do { __builtin_amdgcn_s_setprio(1); _Pragma("unroll") for (int m = 0; m < 4; ++m) _Pragma("unroll") for (int n = 0; n < 2; ++n) _Pragma("unroll") for (int k = 0; k < 2; ++k) \
        acc[ai][bj][m][n] = __builtin_amdgcn_mfma_f32_16x16x32_bf16(Bt[n][k], At[m][k], acc[ai][bj][m][n], 0, 0, 0); __builtin_amdgcn_s_setprio(0); } while (0)
#define PG8_WAIT_V(n) asm volatile("s_waitcnt vmcnt(" #n ")" ::: "memory")
#define PG8_WAIT_L(n) asm volatile("s_waitcnt lgkmcnt(" #n ")" ::: "memory")
#define PG8_BAR __builtin_amdgcn_s_barrier()
#define PG8_SCHED __builtin_amdgcn_sched_barrier(0)
    Unit cur, nxt; int ui = 0;
    if (!S.next(0, cur)) return;
    f32x4 acc[2][2][4][2];
#pragma unroll
    for (int a = 0; a < 2; ++a)
#pragma unroll
        for (int b = 0; b < 2; ++b)
#pragma unroll
            for (int m = 0; m < 4; ++m)
#pragma unroll
                for (int n = 0; n < 2; ++n) acc[a][b][m][n] = (f32x4){0.f, 0.f, 0.f, 0.f};
    bf16x8 At[4][2], B0[2][2], B1[2][2];
    const char* cA = (const char*)g.A + (size_t)cur.pm * tstep; const char* cB = (const char*)g.Bt + (size_t)cur.pn * tstep;
    S.a_ready(cur);
    if constexpr (SP2) {
        PG8_STAGE(PG8_SB(0, 0), cB, voffB); PG8_STAGE(PG8_SB(0, 1), cB + hstep, voffB); PG8_STAGE(PG8_SA(0, 0), cA, voffA); PG8_STAGE(PG8_SA(0, 1), cA + hstep, voffA);
        if (wr == 1) PG8_BAR;
        PG8_WAIT_V(2); PG8_BAR;
        PG8_STAGE(PG8_SB(1, 0), cB + kstep, voffB); PG8_STAGE(PG8_SA(1, 0), cA + kstep, voffA); PG8_STAGE(PG8_SB(1, 1), cB + hstep + kstep, voffB);
        PG8_WAIT_V(6); PG8_BAR;
    } else {
        PG8_STAGE(PG8_SB(0, 0), cB, voffB); PG8_STAGE(PG8_SA(0, 0), cA, voffA); PG8_STAGE(PG8_SB(0, 1), cB + hstep, voffB); PG8_STAGE(PG8_SA(0, 1), cA + hstep, voffA);
        if (wr == 1) PG8_BAR;
        PG8_WAIT_V(4); PG8_BAR;
        PG8_STAGE(PG8_SB(1, 0), cB + kstep, voffB); PG8_STAGE(PG8_SA(1, 0), cA + kstep, voffA); PG8_STAGE(PG8_SB(1, 1), cB + hstep + kstep, voffB);
        PG8_WAIT_V(6); PG8_BAR;
    }
    for (;;) {
        const bool has_next = S.next(ui + 1, nxt);
        const char* nA = has_next ? (const char*)g.A + (size_t)nxt.pm * tstep : cA; const char* nB = has_next ? (const char*)g.Bt + (size_t)nxt.pn * tstep : cB;
        for (int t = 0; t < nt; t += 2) {
            if constexpr (Epi::MID_T > 0) { if (t == Epi::MID_T) E.mid(acc, cur); }
            const bool last = (t == nt - 2);
            const char* a1 = cA + (size_t)(t + 1) * kstep;
            const char* a2 = last ? nA : cA + (size_t)(t + 2) * kstep; const char* b2 = last ? nB : cB + (size_t)(t + 2) * kstep;
            const char* a3 = a2 + kstep; const char* b3 = b2 + kstep;
            if (last && has_next) S.a_ready(nxt);
            if constexpr (SP2) {
            PG8_LDB(B0, 0, 0); PG8_LDB(B1, 0, 1); PG8_SCHED; PG8_LDA(At, 0, 0); PG8_STAGE(PG8_SA(1, 1), a1 + hstep, voffA);
            PG8_WAIT_V(8); PG8_WAIT_L(0); PG8_BAR; PG8_MMA(0, 0, At, B0); PG8_MMA(0, 1, At, B1); PG8_BAR; PG8_SCHED;
            PG8_LDA(At, 0, 1); PG8_STAGE(PG8_SB(0, 0), b2, voffB); PG8_STAGE(PG8_SB(0, 1), b2 + hstep, voffB); PG8_STAGE(PG8_SA(0, 0), a2, voffA);
            PG8_WAIT_V(8); PG8_WAIT_L(0); PG8_BAR; PG8_MMA(1, 0, At, B0); PG8_MMA(1, 1, At, B1); PG8_BAR; PG8_SCHED;
            PG8_LDB(B0, 1, 0); PG8_LDB(B1, 1, 1); PG8_SCHED; PG8_LDA(At, 1, 0); PG8_STAGE(PG8_SA(0, 1), a2 + hstep, voffA);
            PG8_WAIT_V(8); PG8_WAIT_L(0); PG8_BAR; PG8_MMA(0, 0, At, B0); PG8_MMA(0, 1, At, B1); PG8_BAR; PG8_SCHED;
            PG8_LDA(At, 1, 1); PG8_STAGE(PG8_SB(1, 0), b3, voffB); PG8_STAGE(PG8_SB(1, 1), b3 + hstep, voffB); PG8_STAGE(PG8_SA(1, 0), a3, voffA);
            PG8_WAIT_V(8); PG8_WAIT_L(0); PG8_BAR; PG8_MMA(1, 0, At, B0); PG8_MMA(1, 1, At, B1); PG8_BAR; PG8_SCHED;
            } else {
            PG8_LDB(B0, 0, 0); PG8_SCHED; PG8_LDA(At, 0, 0); PG8_STAGE(PG8_SA(1, 1), a1 + hstep, voffA);
            PG8_WAIT_L(8); PG8_BAR; PG8_WAIT_L(0); PG8_MMA(0, 0, At, B0); PG8_BAR; PG8_SCHED;
            PG8_LDB(B1, 0, 1); PG8_STAGE(PG8_SB(0, 0), b2, voffB);
            PG8_BAR; PG8_WAIT_L(0); PG8_MMA(0, 1, At, B1); PG8_BAR;
            PG8_LDA(At, 0, 1); PG8_STAGE(PG8_SA(0, 0), a2, voffA);
            PG8_BAR; PG8_WAIT_L(0); PG8_MMA(1, 0, At, B0); PG8_BAR; PG8_SCHED;
            PG8_STAGE(PG8_SB(0, 1), b2 + hstep, voffB);
            PG8_WAIT_V(6); PG8_BAR; PG8_MMA(1, 1, At, B1); PG8_BAR;
            PG8_LDB(B0, 1, 0); PG8_SCHED; PG8_LDA(At, 1, 0); PG8_STAGE(PG8_SA(0, 1), a2 + hstep, voffA);
            PG8_WAIT_L(8); PG8_BAR; PG8_WAIT_L(0); PG8_MMA(0, 0, At, B0); PG8_BAR; PG8_SCHED;
            PG8_LDB(B1, 1, 1); PG8_STAGE(PG8_SB(1, 0), b3, voffB);
            PG8_BAR; PG8_WAIT_L(0); PG8_MMA(0, 1, At, B1); PG8_BAR;
            PG8_LDA(At, 1, 1); PG8_STAGE(PG8_SA(1, 0), a3, voffA);
            PG8_BAR; PG8_WAIT_L(0); PG8_MMA(1, 0, At, B0); PG8_BAR; PG8_SCHED;
            PG8_STAGE(PG8_SB(1, 1), b3 + hstep, voffB);
            PG8_WAIT_V(6); PG8_BAR; PG8_MMA(1, 1, At, B1); PG8_BAR;
            }
        }
        if constexpr (ALIGN_EPI) { if (wr == 0) PG8_BAR; }
        if constexpr (!Epi::AFTER_DRAIN) { E(acc, cur, wr, wc, fr, fq); S.done(cur); }
        if (!has_next) break;
#pragma unroll
        for (int a = 0; a < 2; ++a)
#pragma unroll
            for (int b = 0; b < 2; ++b)
#pragma unroll
                for (int m = 0; m < 4; ++m)
#pragma unroll
                    for (int n = 0; n < 2; ++n) acc[a][b][m][n] = (f32x4){0.f, 0.f, 0.f, 0.f};
        cur = nxt; cA = nA; cB = nB; ++ui;
        if constexpr (ALIGN_EPI) { if (wr == 1) PG8_BAR; }
    }
    PG8_WAIT_V(0);
    if constexpr (!ALIGN_EPI) { if (wr == 0) PG8_BAR; }
    PG8_BAR;
    if constexpr (Epi::AFTER_DRAIN) { E.fused(acc, cur, wr, wc, fr, fq, lds, wid, lane); S.done(cur); }
#undef PG8_SA
#undef PG8_SB
#undef PG8_STAGE
#undef PG8_LDA
#undef PG8_LDB
#undef PG8_MMA
#undef PG8_WAIT_V
#undef PG8_WAIT_L
#undef PG8_BAR
#undef PG8_SCHED
}
}

#define LAS __attribute__((address_space(3)))
typedef unsigned short bf16_t;
typedef short bf16x8 __attribute__((ext_vector_type(8)));
typedef float f32x4 __attribute__((ext_vector_type(4)));
typedef float f32x2 __attribute__((ext_vector_type(2)));
typedef float f32x16 __attribute__((ext_vector_type(16)));
typedef unsigned u32x4 __attribute__((ext_vector_type(4)));
typedef unsigned u32x2 __attribute__((ext_vector_type(2)));
typedef __bf16 bf16x2_t __attribute__((ext_vector_type(2)));

constexpr int NB = 8, SEQ = 2048, DM = 1024, MT = NB * SEQ, DIN = 3584, NH = 8, HD = 64, CWID = 31, PLE = 256, CD = 512;
constexpr float EPS = 1e-6f;
constexpr float QSCALE = 0.125f * 1.4426950408889634f;

constexpr size_t MiB = 1u << 20;
constexpr size_t W_IN = 0, W_PW = 7340032, W_OUT = W_PW + 524288, W_PG = W_OUT + 2097152, W_PLE = W_PG + 2097152, W_LAYER = 12 * MiB;
static_assert(W_PLE + 524288 == W_LAYER, "weight map");
constexpr int UP = 2560, UQ = 0, UK = 512, USGA = 1024, UGLU = 1536, USGC = 2048;
constexpr size_t WS_PB = 24 * MiB, WS_HB = 40 * MiB, WS_Y = 72 * MiB, WS_VT = 104 * MiB, WS_SSA = 120 * MiB, WS_SSB = 121 * MiB, WS_SSC = 122 * MiB, WS_U = 123 * MiB;
constexpr size_t WS_H1B = WS_U  , WS_C2 = 203 * MiB, WS_EB = 219 * MiB, WS_CTL = 252 * MiB, CTL_BYTES = 16384, WS_END = WS_CTL + CTL_BYTES;
static_assert(WS_U + (size_t)MT * UP * 2 <= WS_C2, "ws map");
constexpr int LDS_BYTES = 147456;
constexpr int NPHASE = 12;
#ifndef PROBE_DUP
#define PROBE_DUP 0
#endif

__device__ __forceinline__ unsigned pk2(float lo, float hi) { f32x2 v = {lo, hi}; bf16x2_t b = __builtin_convertvector(v, bf16x2_t); return __builtin_bit_cast(unsigned, b); }
__device__ __forceinline__ float bflo(unsigned u) { return __builtin_bit_cast(float, u << 16); }
__device__ __forceinline__ float bfhi(unsigned u) { return __builtin_bit_cast(float, u & 0xffff0000u); }
__device__ __forceinline__ float fexp2(float x) { return __builtin_amdgcn_exp2f(x); }
__device__ __forceinline__ float flog2(float x) { return __builtin_amdgcn_logf(x); }
__device__ __forceinline__ float frcp(float x) { return __builtin_amdgcn_rcpf(x); }
__device__ __forceinline__ float frsq(float x) { return __builtin_amdgcn_rsqf(x); }
__device__ __forceinline__ float sigmoidf_(float x) { return frcp(1.0f + fexp2(-1.4426950408889634f * x)); }
__device__ __forceinline__ float siluf_(float x) { return x * sigmoidf_(x); }
#define MFMA32(a, b, c) __builtin_amdgcn_mfma_f32_32x32x16_bf16((a), (b), (c), 0, 0, 0)

__device__ __forceinline__ float shx(float v, int m, int lane) { return __builtin_bit_cast(float, __builtin_amdgcn_ds_bpermute((lane ^ m) << 2, __builtin_bit_cast(int, v))); }
__device__ __forceinline__ float wave_sum(float v, int lane) {
#pragma unroll
    for (int o = 1; o < 64; o <<= 1) v += shx(v, o, lane);
    return v;
}
__device__ __forceinline__ float row_rstd(const float* ss, int row, int fq, int lane) {
    const f32x4 p = *(const f32x4*)(ss + (size_t)row * 16 + fq * 4);
    float s = (p[0] + p[1]) + (p[2] + p[3]);
    s += shx(s, 16, lane); s += shx(s, 32, lane);
    return frsq(s * (1.0f / DM) + EPS);
}

struct EpiIn {
    static constexpr bool PERM = true, AFTER_DRAIN = false; static constexpr int MID_T = 0;
    bf16_t* U; bf16_t* VT; const float* ss;
    __device__ __forceinline__ void operator()(const f32x4 (&acc)[2][2][4][2], const pg8::Unit& u, int, int, int, int) const {
        int t_ = threadIdx.x; asm volatile("" : "+v"(t_));
        const int lane = t_ & 63, fr = lane & 15, fq = lane >> 4, wid_ = __builtin_amdgcn_readfirstlane(t_ >> 6), wr = wid_ >> 2, wc = wid_ & 3;
        const int pn = u.pn;
        f32x4 pp[2][4];
#pragma unroll
        for (int ai = 0; ai < 2; ++ai)
#pragma unroll
            for (int m = 0; m < 4; ++m) pp[ai][m] = *(const f32x4*)(ss + (size_t)(u.pm * 256 + ai * 128 + wr * 64 + m * 16 + fr) * 16 + fq * 4);
#pragma unroll
        for (int ai = 0; ai < 2; ++ai)
#pragma unroll
            for (int m = 0; m < 4; ++m) {
                const int row = u.pm * 256 + ai * 128 + wr * 64 + m * 16 + fr;
                float s_ = (pp[ai][m][0] + pp[ai][m][1]) + (pp[ai][m][2] + pp[ai][m][3]);
                s_ += shx(s_, 16, lane); s_ += shx(s_, 32, lane);
                const float rs = frsq(s_ * (1.0f / DM) + EPS);
#pragma unroll
                for (int bj = 0; bj < 2; ++bj) {
                    const int col0 = pn * 256 + bj * 128 + wc * 32 + 8 * fq;
                    f32x4 v0 = acc[ai][bj][m][0] * rs, v1 = acc[ai][bj][m][1] * rs;
                    if (pn < 4) {
                        const float sc = pn < 2 ? QSCALE : 1.0f;
                        v0 = v0 * sc; v1 = v1 * sc;
                        u32x4 w; w[0] = pk2(v0[0], v0[1]); w[1] = pk2(v0[2], v0[3]); w[2] = pk2(v1[0], v1[1]); w[3] = pk2(v1[2], v1[3]);
                        *(u32x4*)(U + (size_t)row * UP + col0) = w;
                    } else if (pn < 6) {
                        const int vc = col0 - 1024, hh = vc >> 6, d0 = vc & 63, b = row >> 11, s = row & 2047;
                        bf16_t* vp = VT + ((size_t)((b * NH + hh) * HD + d0)) * SEQ + s;
                        const unsigned w0 = pk2(v0[0], v0[1]), w1 = pk2(v0[2], v0[3]), w2 = pk2(v1[0], v1[1]), w3 = pk2(v1[2], v1[3]);
                        vp[0 * SEQ] = (bf16_t)(w0 & 0xffffu); vp[1 * SEQ] = (bf16_t)(w0 >> 16);
                        vp[2 * SEQ] = (bf16_t)(w1 & 0xffffu); vp[3 * SEQ] = (bf16_t)(w1 >> 16);
                        vp[4 * SEQ] = (bf16_t)(w2 & 0xffffu); vp[5 * SEQ] = (bf16_t)(w2 >> 16);
                        vp[6 * SEQ] = (bf16_t)(w3 & 0xffffu); vp[7 * SEQ] = (bf16_t)(w3 >> 16);
                    } else if (pn < 8 || pn >= 12) {
                        u32x4 w; w[0] = pk2(siluf_(v0[0]), siluf_(v0[1])); w[1] = pk2(siluf_(v0[2]), siluf_(v0[3]));
                        w[2] = pk2(siluf_(v1[0]), siluf_(v1[1])); w[3] = pk2(siluf_(v1[2]), siluf_(v1[3]));
                        *(u32x4*)(U + (size_t)row * UP + (pn < 8 ? col0 - 512 : col0 - 1024)) = w;
                    } else {
                        const int ch0 = (col0 - 2048) >> 1;
                        u32x2 w; w[0] = pk2(v0[0] * sigmoidf_(v0[1]), v0[2] * sigmoidf_(v0[3])); w[1] = pk2(v1[0] * sigmoidf_(v1[1]), v1[2] * sigmoidf_(v1[3]));
                        *(u32x2*)(U + (size_t)row * UP + UGLU + ch0) = w;
                    }
                }
                asm volatile("" ::: "memory");
            }
    }
};

struct EpiPw {
    static constexpr bool PERM = true, AFTER_DRAIN = false; static constexpr int MID_T = 0;
    const bf16_t* U; bf16_t* Y; const float* cog; float* ssC;
    __device__ __forceinline__ void operator()(const f32x4 (&acc)[2][2][4][2], const pg8::Unit& u, int, int, int, int) const {
        int t_ = threadIdx.x; asm volatile("" : "+v"(t_));
        const int lane = t_ & 63, fr = lane & 15, fq = lane >> 4, wid_ = __builtin_amdgcn_readfirstlane(t_ >> 6), wr = wid_ >> 2, wc = wid_ & 3;
#pragma unroll
        for (int ai = 0; ai < 2; ++ai)
#pragma unroll
            for (int m = 0; m < 4; ++m) {
                const int row = u.pm * 256 + ai * 128 + wr * 64 + m * 16 + fr;
                float sq = 0.f;
#pragma unroll
                for (int bj = 0; bj < 2; ++bj) {
                    const int col0 = u.pn * 256 + bj * 128 + wc * 32 + 8 * fq;
                    const f32x4 v0 = acc[ai][bj][m][0], v1 = acc[ai][bj][m][1];
                    sq += (v0[0] * v0[0] + v0[1] * v0[1]) + (v0[2] * v0[2] + v0[3] * v0[3]) + (v1[0] * v1[0] + v1[1] * v1[1]) + (v1[2] * v1[2] + v1[3] * v1[3]);
                    const f32x4 g0 = *(const f32x4*)(cog + col0), g1 = *(const f32x4*)(cog + col0 + 4);
                    const u32x4 sg = *(const u32x4*)(U + (size_t)row * UP + USGC + col0);
                    u32x4 w;
                    w[0] = pk2(v0[0] * g0[0] * bflo(sg[0]), v0[1] * g0[1] * bfhi(sg[0])); w[1] = pk2(v0[2] * g0[2] * bflo(sg[1]), v0[3] * g0[3] * bfhi(sg[1]));
                    w[2] = pk2(v1[0] * g1[0] * bflo(sg[2]), v1[1] * g1[1] * bfhi(sg[2])); w[3] = pk2(v1[2] * g1[2] * bflo(sg[3]), v1[3] * g1[3] * bfhi(sg[3]));
                    *(u32x4*)(Y + (size_t)row * DM + col0) = w;
                }
                sq += shx(sq, 16, lane); sq += shx(sq, 32, lane);
                if (fq == 0) ssC[(size_t)row * 8 + u.pn * 4 + wc] = sq;
                asm volatile("" ::: "memory");
            }
    }
};

struct EpiE {
    static constexpr bool PERM = true, AFTER_DRAIN = false; static constexpr int MID_T = 0;
    bf16_t* EB;
    __device__ __forceinline__ void operator()(const f32x4 (&acc)[2][2][4][2], const pg8::Unit& u, int, int, int, int) const {
        int t_ = threadIdx.x; asm volatile("" : "+v"(t_));
        const int lane = t_ & 63, fr = lane & 15, fq = lane >> 4, wid_ = __builtin_amdgcn_readfirstlane(t_ >> 6), wr = wid_ >> 2, wc = wid_ & 3;
#pragma unroll
        for (int ai = 0; ai < 2; ++ai)
#pragma unroll
            for (int m = 0; m < 4; ++m) {
                const int row = u.pm * 256 + ai * 128 + wr * 64 + m * 16 + fr;
#pragma unroll
                for (int bj = 0; bj < 2; ++bj) {
                    const int col0 = u.pn * 256 + bj * 128 + wc * 32 + 8 * fq;
                    const f32x4 v0 = acc[ai][bj][m][0], v1 = acc[ai][bj][m][1];
                    u32x4 w; w[0] = pk2(v0[0], v0[1]); w[1] = pk2(v0[2], v0[3]); w[2] = pk2(v1[0], v1[1]); w[3] = pk2(v1[2], v1[3]);
                    *(u32x4*)(EB + (size_t)row * DM + col0) = w;
                }
                asm volatile("" ::: "memory");
            }
    }
};

template <bool BB> struct EpiOut {
    static constexpr bool PERM = true, AFTER_DRAIN = false; static constexpr int MID_T = 8;
    const float* base; const bf16_t* baseb; bf16_t* HB; float* ss; const float* ssC;
    __device__ __forceinline__ void mid(f32x4 (&acc)[2][2][4][2], const pg8::Unit& u) const {
        int t_ = threadIdx.x; asm volatile("" : "+v"(t_));
        const int lane = t_ & 63, fr = lane & 15, fq = lane >> 4, wid_ = __builtin_amdgcn_readfirstlane(t_ >> 6), wr = wid_ >> 2;
        f32x2 pc[2][4];
#pragma unroll
        for (int ai = 0; ai < 2; ++ai)
#pragma unroll
            for (int m = 0; m < 4; ++m) pc[ai][m] = *(const f32x2*)(ssC + (size_t)(u.pm * 256 + ai * 128 + wr * 64 + m * 16 + fr) * 8 + fq * 2);
#pragma unroll
        for (int ai = 0; ai < 2; ++ai)
#pragma unroll
            for (int m = 0; m < 4; ++m) {
                const f32x2 p = pc[ai][m];
                float s = p[0] + p[1];
                s += shx(s, 16, lane); s += shx(s, 32, lane);
                const float rs = frsq(s * (1.0f / CD) + EPS);
#pragma unroll
                for (int bj = 0; bj < 2; ++bj)
#pragma unroll
                    for (int n = 0; n < 2; ++n) acc[ai][bj][m][n] = acc[ai][bj][m][n] * rs;
            }
    }
    __device__ __forceinline__ void operator()(const f32x4 (&acc)[2][2][4][2], const pg8::Unit& u, int, int, int, int) const {
        int t_ = threadIdx.x; asm volatile("" : "+v"(t_));
        const int lane = t_ & 63, fr = lane & 15, fq = lane >> 4, wid_ = __builtin_amdgcn_readfirstlane(t_ >> 6), wr = wid_ >> 2, wc = wid_ & 3;
#pragma unroll
        for (int ai = 0; ai < 2; ++ai)
#pragma unroll
            for (int mp = 0; mp < 2; ++mp) {
                f32x4 bs[2][2][2];
#pragma unroll
                for (int mm = 0; mm < 2; ++mm)
#pragma unroll
                    for (int bj = 0; bj < 2; ++bj) {
                        const size_t off = (size_t)(u.pm * 256 + ai * 128 + wr * 64 + (2 * mp + mm) * 16 + fr) * DM + u.pn * 256 + bj * 128 + wc * 32 + 8 * fq;
                        if constexpr (BB) { const u32x4 r1 = *(const u32x4*)(baseb + off); f32x4 t0 = {bflo(r1[0]), bfhi(r1[0]), bflo(r1[1]), bfhi(r1[1])}, t1 = {bflo(r1[2]), bfhi(r1[2]), bflo(r1[3]), bfhi(r1[3])}; bs[mm][bj][0] = t0; bs[mm][bj][1] = t1; }
                        else { bs[mm][bj][0] = *(const f32x4*)(base + off); bs[mm][bj][1] = *(const f32x4*)(base + off + 4); }
                    }
#pragma unroll
                for (int mm = 0; mm < 2; ++mm) {
                    const int m = 2 * mp + mm;
                    const int row = u.pm * 256 + ai * 128 + wr * 64 + m * 16 + fr;
                    float sq = 0.f;
#pragma unroll
                    for (int bj = 0; bj < 2; ++bj) {
                        const size_t off = (size_t)row * DM + u.pn * 256 + bj * 128 + wc * 32 + 8 * fq;
                        const f32x4 h0 = bs[mm][bj][0] + acc[ai][bj][m][0], h1 = bs[mm][bj][1] + acc[ai][bj][m][1];
                        u32x4 w; w[0] = pk2(h0[0], h0[1]); w[1] = pk2(h0[2], h0[3]); w[2] = pk2(h1[0], h1[1]); w[3] = pk2(h1[2], h1[3]);
                        *(u32x4*)(HB + off) = w;
                        sq += (h0[0] * h0[0] + h0[1] * h0[1]) + (h0[2] * h0[2] + h0[3] * h0[3]) + (h1[0] * h1[0] + h1[1] * h1[1]) + (h1[2] * h1[2] + h1[3] * h1[3]);
                    }
                    sq += shx(sq, 16, lane); sq += shx(sq, 32, lane);
                    if (fq == 0) ss[(size_t)row * 16 + u.pn * 4 + wc] = sq;
                }
                asm volatile("" ::: "memory");
            }
    }
};

template <bool WF> struct EpiGate {
    static constexpr bool PERM = true, AFTER_DRAIN = false; static constexpr int MID_T = 0;
    float* out; const bf16_t* H1; const bf16_t* EB; bf16_t* HB; const float* ss_in; float* ss_out; int dummy;
    __device__ __forceinline__ void operator()(const f32x4 (&acc)[2][2][4][2], const pg8::Unit& u, int, int, int, int) const {
        int t_ = threadIdx.x; asm volatile("" : "+v"(t_));
        const int lane = t_ & 63, fr = lane & 15, fq = lane >> 4, wid_ = __builtin_amdgcn_readfirstlane(t_ >> 6), wr = wid_ >> 2, wc = wid_ & 3;
        f32x4 pp[2][4];
#pragma unroll
        for (int ai = 0; ai < 2; ++ai)
#pragma unroll
            for (int m = 0; m < 4; ++m) pp[ai][m] = *(const f32x4*)(ss_in + (size_t)(u.pm * 256 + ai * 128 + wr * 64 + m * 16 + fr) * 16 + fq * 4);
        float rsv[2][4];
#pragma unroll
        for (int ai = 0; ai < 2; ++ai)
#pragma unroll
            for (int m = 0; m < 4; ++m) {
                float s_ = (pp[ai][m][0] + pp[ai][m][1]) + (pp[ai][m][2] + pp[ai][m][3]);
                s_ += shx(s_, 16, lane); s_ += shx(s_, 32, lane);
                rsv[ai][m] = frsq(s_ * (1.0f / DM) + EPS);
            }
        asm volatile("" ::: "memory");
#pragma unroll
        for (int ai = 0; ai < 2; ++ai)
#pragma unroll
            for (int mp = 0; mp < 2; ++mp) {
                u32x4 bs[2][2], es[2][2];
#pragma unroll
                for (int mm = 0; mm < 2; ++mm)
#pragma unroll
                    for (int bj = 0; bj < 2; ++bj) {
                        const size_t off = (size_t)(u.pm * 256 + ai * 128 + wr * 64 + (2 * mp + mm) * 16 + fr) * DM + u.pn * 256 + bj * 128 + wc * 32 + 8 * fq;
                        bs[mm][bj] = *(const u32x4*)(H1 + off); es[mm][bj] = *(const u32x4*)(EB + off);
                    }
#pragma unroll
                for (int mm = 0; mm < 2; ++mm) {
                    const int m = 2 * mp + mm;
                    const int row = u.pm * 256 + ai * 128 + wr * 64 + m * 16 + fr;
                    const float rs = rsv[ai][m];
                    float sq = 0.f;
#pragma unroll
                    for (int bj = 0; bj < 2; ++bj) {
                        const size_t off = (size_t)row * DM + u.pn * 256 + bj * 128 + wc * 32 + 8 * fq;
                        const f32x4 a0 = acc[ai][bj][m][0] * rs, a1 = acc[ai][bj][m][1] * rs;
                        const u32x4 e = es[mm][bj]; const u32x4 r1 = bs[mm][bj];
                        f32x4 h0 = {bflo(r1[0]), bfhi(r1[0]), bflo(r1[1]), bfhi(r1[1])}, h1 = {bflo(r1[2]), bfhi(r1[2]), bflo(r1[3]), bfhi(r1[3])};
                        h0[0] += bflo(e[0]) * sigmoidf_(a0[0]); h0[1] += bfhi(e[0]) * sigmoidf_(a0[1]); h0[2] += bflo(e[1]) * sigmoidf_(a0[2]); h0[3] += bfhi(e[1]) * sigmoidf_(a0[3]);
                        h1[0] += bflo(e[2]) * sigmoidf_(a1[0]); h1[1] += bfhi(e[2]) * sigmoidf_(a1[1]); h1[2] += bflo(e[3]) * sigmoidf_(a1[2]); h1[3] += bfhi(e[3]) * sigmoidf_(a1[3]);
                        if constexpr (WF) { *(f32x4*)(out + off) = h0; *(f32x4*)(out + off + 4) = h1; }
                        u32x4 w; w[0] = pk2(h0[0], h0[1]); w[1] = pk2(h0[2], h0[3]); w[2] = pk2(h1[0], h1[1]); w[3] = pk2(h1[2], h1[3]);
                        *(u32x4*)(HB + off) = w;
                        sq += (h0[0] * h0[0] + h0[1] * h0[1]) + (h0[2] * h0[2] + h0[3] * h0[3]) + (h1[0] * h1[0] + h1[1] * h1[1]) + (h1[2] * h1[2] + h1[3] * h1[3]);
                    }
                    sq += shx(sq, 16, lane); sq += shx(sq, 32, lane);
                    if (fq == 0) ss_out[(size_t)row * 16 + u.pn * 4 + wc] = sq;
                }
                asm volatile("" ::: "memory");
            }
    }
};

struct SubOrder {
    int nN, nwg, nb, c;
    __device__ void init(int M, int N, int nb_, int c_) { nN = N / 256; nwg = (M / 256) * nN; nb = nb_; c = c_; }
    __device__ bool next(int i, pg8::Unit& u) const { if (c < 0 || c >= nb) return false; const int L = i * nb + c; if (L >= nwg) return false; u.pm = L / nN; u.pn = L % nN; return true; }
    __device__ __forceinline__ void a_ready(const pg8::Unit&) const {}
    __device__ __forceinline__ void done(const pg8::Unit&) const {}
};

template <bool REMAP>
__device__ __forceinline__ void tr_item(const float* W, int K, int N, bf16_t* WT, const float* g, LAS float* scr, int item, int lane, int kshift = 0) {
    const int nblk = N / 32, kb = item / nblk, nb = item % nblk, k0 = 64 * kb, n0 = 32 * nb;
    int src = n0 + (lane & 31);
    if (REMAP) { if (src >= 2048 && src < 3072) { const int jj = src - 2048; src = (jj & 1) ? 2560 + (jj >> 1) : 2048 + (jj >> 1); } }
    float wv[32];
#pragma unroll
    for (int i = 0; i < 32; ++i) { const int kk = 2 * i + (lane >> 5); wv[i] = W[(size_t)((k0 + kk + kshift) & (K - 1)) * N + src]; }
#pragma unroll
    for (int i = 0; i < 32; ++i) { const int kk = 2 * i + (lane >> 5); float v = wv[i]; if (g) v *= g[k0 + kk]; scr[kk * 33 + (lane & 31)] = v; }
    asm volatile("s_waitcnt lgkmcnt(0)" ::: "memory");
    const int c = lane & 7;
#pragma unroll
    for (int j = 0; j < 4; ++j) { const int n = (lane >> 3) + 8 * j; const LAS float* s = scr + (8 * c) * 33 + n;
        u32x4 o; o[0] = pk2(s[0 * 33], s[1 * 33]); o[1] = pk2(s[2 * 33], s[3 * 33]); o[2] = pk2(s[4 * 33], s[5 * 33]); o[3] = pk2(s[6 * 33], s[7 * 33]);
        *(u32x4*)(WT + (size_t)(n0 + n) * K + k0 + 8 * c) = o; }
    asm volatile("s_waitcnt lgkmcnt(0)" ::: "memory");
}

constexpr int AK_STRIDE = 144, AV_STRIDE = 136, A_KBYTES = 64 * AK_STRIDE, A_VBYTES = 64 * AV_STRIDE, A_BUF = 18432;
static_assert(A_KBYTES + A_VBYTES <= A_BUF, "attention LDS buffer");

constexpr int AW_BYTES = A_KBYTES + A_VBYTES;
static_assert(8 * AW_BYTES <= LDS_BYTES - 64, "attention LDS");
__device__ __forceinline__ void attn_wave(const bf16_t* U, const bf16_t* VT, bf16_t* Y, const float* aog, int b, int h, int qblk, LAS unsigned char* lds) {
    int tid = threadIdx.x; asm volatile("" : "+v"(tid));
    const int wave = __builtin_amdgcn_readfirstlane(tid >> 6), lane = tid & 63, l31 = lane & 31, hi = lane >> 5;
    const int q0 = qblk * 32, t = q0 + l31;
    const size_t trow = (size_t)(b * SEQ + t);
    bf16x8 qf[4];
    {
        const bf16_t* qp = U + trow * UP + UQ + h * HD + 8 * hi;
#pragma unroll
        for (int s = 0; s < 4; ++s) qf[s] = *(const bf16x8*)(qp + 16 * s);
    }
    f32x16 o0, o1;
#pragma unroll
    for (int i = 0; i < 16; ++i) { o0[i] = 0.f; o1[i] = 0.f; }
    float C = 1.f;
    const int ktmax = (q0 + 30) >> 6;
    const int srow = lane >> 3, sch = lane & 7;
    const bf16_t* gk = U + (size_t)(b * SEQ + srow) * UP + UK + h * HD + sch * 8;
    const bf16_t* gv = VT + ((size_t)((b * NH + h) * HD + srow)) * SEQ + sch * 8;
    LAS unsigned char* kb = lds + wave * AW_BYTES;
    LAS unsigned char* vb = kb + A_KBYTES;
    const int kwoff = srow * AK_STRIDE + sch * 16, vwoff = srow * AV_STRIDE + sch * 16;
    u32x4 kr[8], vr[8];
#pragma unroll
    for (int i = 0; i < 8; ++i) { kr[i] = *(const u32x4*)(gk + (size_t)(ktmax * 64 + 8 * i) * UP); vr[i] = *(const u32x4*)(gv + (size_t)(8 * i) * SEQ + ktmax * 64); }
    for (int kt = ktmax; kt >= 0; --kt) {
#pragma unroll
        for (int i = 0; i < 8; ++i) {
            *(LAS u32x4*)(kb + kwoff + 8 * i * AK_STRIDE) = kr[i];
            u32x2 a = {vr[i][0], vr[i][1]}, c = {vr[i][2], vr[i][3]};
            *(LAS u32x2*)(vb + vwoff + 8 * i * AV_STRIDE) = a; *(LAS u32x2*)(vb + vwoff + 8 * i * AV_STRIDE + 8) = c;
        }
        if (kt > 0) {
#pragma unroll
            for (int i = 0; i < 8; ++i) { kr[i] = *(const u32x4*)(gk + (size_t)((kt - 1) * 64 + 8 * i) * UP); vr[i] = *(const u32x4*)(gv + (size_t)(8 * i) * SEQ + (kt - 1) * 64); }
        }
        {
            f32x16 p0, p1;
#pragma unroll
            for (int i = 0; i < 16; ++i) { p0[i] = 0.f; p1[i] = 0.f; }
#pragma unroll
            for (int s = 0; s < 4; ++s) {
                const bf16x8 ka = *(const LAS bf16x8*)(kb + l31 * AK_STRIDE + 32 * s + 16 * hi);
                const bf16x8 kc = *(const LAS bf16x8*)(kb + (32 + l31) * AK_STRIDE + 32 * s + 16 * hi);
                p0 = MFMA32(ka, qf[s], p0); p1 = MFMA32(kc, qf[s], p1);
            }
            const int lim0 = t - (64 * kt + 4 * hi), lim1 = lim0 - 32;
            const bool diag = (64 * kt + 63 >= q0);
            f32x16 m0, m1;
            float G0[4], G1[4];
#pragma unroll
            for (int g = 0; g < 4; ++g) {
                float s0 = 1.f, s1 = 1.f;
#pragma unroll
                for (int i = 0; i < 4; ++i) {
                    const int r = 4 * g + i, cr = i + 8 * g;
                    const float e0 = fexp2(fminf(p0[r], 100.f)), e1 = fexp2(fminf(p1[r], 100.f));
                    float r0 = frcp(1.0f + e0), r1 = frcp(1.0f + e1);
                    float b0 = e0 * r0, b1 = e1 * r1;
                    if (diag) { const bool v0 = cr < lim0, v1 = cr < lim1; r0 = v0 ? r0 : 1.f; b0 = v0 ? b0 : 0.f; r1 = v1 ? r1 : 1.f; b1 = v1 ? b1 : 0.f; }
                    m0[r] = r0; m1[r] = r1; p0[r] = b0; p1[r] = b1; s0 *= r0; s1 *= r1;
                }
                G0[g] = s0; G1[g] = s1;
            }
            float X0[4], X1[4];
#pragma unroll
            for (int g = 0; g < 4; ++g) { X0[g] = shx(G0[g], 32, lane); X1[g] = shx(G1[g], 32, lane); }
            float run = C;
#pragma unroll
            for (int g = 3; g >= 0; --g) {
                float a = hi == 0 ? run * X1[g] : run;
#pragma unroll
                for (int i = 3; i >= 0; --i) { const int r = 4 * g + i; const float w = a * p1[r]; a *= m1[r]; p1[r] = w; }
                run *= G1[g] * X1[g];
            }
#pragma unroll
            for (int g = 3; g >= 0; --g) {
                float a = hi == 0 ? run * X0[g] : run;
#pragma unroll
                for (int i = 3; i >= 0; --i) { const int r = 4 * g + i; const float w = a * p0[r]; a *= m0[r]; p0[r] = w; }
                run *= G0[g] * X0[g];
            }
            C = run;
#pragma unroll
            for (int kh = 0; kh < 2; ++kh)
#pragma unroll
                for (int sh = 0; sh < 2; ++sh) {
                    u32x4 xw;
                    if (kh == 0) { xw[0] = pk2(p0[8 * sh + 0], p0[8 * sh + 1]); xw[1] = pk2(p0[8 * sh + 2], p0[8 * sh + 3]); xw[2] = pk2(p0[8 * sh + 4], p0[8 * sh + 5]); xw[3] = pk2(p0[8 * sh + 6], p0[8 * sh + 7]); }
                    else         { xw[0] = pk2(p1[8 * sh + 0], p1[8 * sh + 1]); xw[1] = pk2(p1[8 * sh + 2], p1[8 * sh + 3]); xw[2] = pk2(p1[8 * sh + 4], p1[8 * sh + 5]); xw[3] = pk2(p1[8 * sh + 6], p1[8 * sh + 7]); }
                    const bf16x8 xf = __builtin_bit_cast(bf16x8, xw);
                    const int koff = 2 * (32 * kh + 16 * sh + 4 * hi);
                    {
                        const LAS unsigned char* vp = vb + l31 * AV_STRIDE + koff;
                        const u32x2 lo = *(const LAS u32x2*)vp, hh = *(const LAS u32x2*)(vp + 16);
                        u32x4 vw = {lo[0], lo[1], hh[0], hh[1]};
                        o0 = MFMA32(__builtin_bit_cast(bf16x8, vw), xf, o0);
                    }
                    {
                        const LAS unsigned char* vp = vb + (32 + l31) * AV_STRIDE + koff;
                        const u32x2 lo = *(const LAS u32x2*)vp, hh = *(const LAS u32x2*)(vp + 16);
                        u32x4 vw = {lo[0], lo[1], hh[0], hh[1]};
                        o1 = MFMA32(__builtin_bit_cast(bf16x8, vw), xf, o1);
                    }
                }
        }
        if (__builtin_amdgcn_ballot_w64(C > 9.094947e-13f) == 0ull) break;
    }
    float sq = 0.f;
#pragma unroll
    for (int i = 0; i < 16; ++i) sq += o0[i] * o0[i] + o1[i] * o1[i];
    sq += shx(sq, 32, lane);
    const float rs = frsq(sq * (1.0f / HD) + EPS);
    const bf16_t* sgp = U + trow * UP + USGA + h * HD;
    bf16_t* yp = Y + trow * DM + 512 + h * HD;
#pragma unroll
    for (int dt = 0; dt < 2; ++dt)
#pragma unroll
        for (int g = 0; g < 4; ++g) {
            const int d0 = 32 * dt + 8 * g + 4 * hi;
            const f32x4 gn = *(const f32x4*)(aog + d0);
            const u32x2 sg = *(const u32x2*)(sgp + d0);
            float v0, v1, v2, v3;
            if (dt == 0) { v0 = o0[4 * g + 0]; v1 = o0[4 * g + 1]; v2 = o0[4 * g + 2]; v3 = o0[4 * g + 3]; }
            else         { v0 = o1[4 * g + 0]; v1 = o1[4 * g + 1]; v2 = o1[4 * g + 2]; v3 = o1[4 * g + 3]; }
            u32x2 w;
            w[0] = pk2(v0 * rs * gn[0] * bflo(sg[0]), v1 * rs * gn[1] * bfhi(sg[0]));
            w[1] = pk2(v2 * rs * gn[2] * bflo(sg[1]), v3 * rs * gn[3] * bfhi(sg[1]));
            *(u32x2*)(yp + d0) = w;
        }
}

constexpr int CT = 32, C_XH = 0, C_XH_BYTES = (CT + 30) * 1024, C_CO = C_XH_BYTES, C_CO_BYTES = CT * CD * 4;
static_assert(C_CO + C_CO_BYTES <= LDS_BYTES, "conv LDS map");

__device__ __forceinline__ void convpre_unit(const bf16_t* U, bf16_t* C2, const float* dww, const float* dwb, const float* lng, const float* lnb, int cu, LAS unsigned char* lds) {
    int tid = threadIdx.x; asm volatile("" : "+v"(tid));
    const int wave = __builtin_amdgcn_readfirstlane(tid >> 6), lane = tid & 63;
    const int r0 = cu * CT, b = r0 >> 11, s0 = r0 & 2047;
    __syncthreads();
    for (int i = tid; i < (CT + 30) * 64; i += 512) {
        const int row = i >> 6, ch = i & 63, s = s0 - 30 + row;
        u32x4 v = {0u, 0u, 0u, 0u};
        if (s >= 0) v = *(const u32x4*)(U + (size_t)(b * SEQ + s) * UP + UGLU + ch * 8);
        *(LAS u32x4*)(lds + C_XH + row * 1024 + ch * 16) = v;
    }
    __syncthreads();
    {
        const int chp = tid & 255, tg = tid >> 8;
        f32x2 w2[CWID];
#pragma unroll
        for (int j = 0; j < CWID; ++j) w2[j] = *(const f32x2*)(dww + (size_t)j * CD + 2 * chp);
        const f32x2 bias = *(const f32x2*)(dwb + 2 * chp);
        const LAS unsigned char* xp = lds + C_XH + (tg * 16) * 1024 + chp * 4;
        f32x2 xv[16 + CWID - 1];
#pragma unroll
        for (int i = 0; i < 16 + CWID - 1; ++i) { const unsigned xu = *(const LAS unsigned*)(xp + i * 1024); f32x2 t2 = {bflo(xu), bfhi(xu)}; xv[i] = t2; }
#pragma unroll
        for (int tt = 0; tt < 16; ++tt) {
            f32x2 a = bias;
#pragma unroll
            for (int j = 0; j < CWID; ++j) a = a + w2[j] * xv[tt + j];
            *(LAS f32x2*)(lds + C_CO + (tg * 16 + tt) * 2048 + chp * 8) = a;
        }
    }
    __syncthreads();
    {
        const f32x4 g0 = *(const f32x4*)(lng + lane * 4), g1 = *(const f32x4*)(lng + 256 + lane * 4);
        const f32x4 b0 = *(const f32x4*)(lnb + lane * 4), b1 = *(const f32x4*)(lnb + 256 + lane * 4);
#pragma unroll
        for (int tt = 0; tt < 4; ++tt) {
            const int tl = wave * 4 + tt;
            f32x4 v0 = *(const LAS f32x4*)(lds + C_CO + tl * 2048 + lane * 16), v1 = *(const LAS f32x4*)(lds + C_CO + tl * 2048 + 1024 + lane * 16);
            const float mean = wave_sum((v0[0] + v0[1]) + (v0[2] + v0[3]) + (v1[0] + v1[1]) + (v1[2] + v1[3]), lane) * (1.0f / CD);
            v0 = v0 - mean; v1 = v1 - mean;
            const float var = wave_sum((v0[0] * v0[0] + v0[1] * v0[1]) + (v0[2] * v0[2] + v0[3] * v0[3]) + (v1[0] * v1[0] + v1[1] * v1[1]) + (v1[2] * v1[2] + v1[3] * v1[3]), lane) * (1.0f / CD);
            const float rs = frsq(var + EPS);
            v0 = v0 * rs * g0 + b0; v1 = v1 * rs * g1 + b1;
            u32x2 wa, wb;
            wa[0] = pk2(siluf_(v0[0]), siluf_(v0[1])); wa[1] = pk2(siluf_(v0[2]), siluf_(v0[3]));
            wb[0] = pk2(siluf_(v1[0]), siluf_(v1[1])); wb[1] = pk2(siluf_(v1[2]), siluf_(v1[3]));
            bf16_t* cp = C2 + (size_t)(r0 + tl) * CD + lane * 4;
            *(u32x2*)cp = wa; *(u32x2*)(cp + 256) = wb;
        }
    }
}

#define XB_TMO      128
#define XB_XCNT(j)  (256  + 64 * (j))
#define XB_XSUB(j)  (1280 + 64 * (j))
#define XB_XGEN(j)  (2304 + 64 * (j))
#define XB_TOP      3328
#define XB_TOPGEN   3392
#define XCD_BAR_WORDS 3456
#define XB_SPIN_CAP (1u << 18)

__device__ __forceinline__ unsigned xb_ld(unsigned* p)              { return __hip_atomic_load(p, __ATOMIC_RELAXED, __HIP_MEMORY_SCOPE_AGENT); }
__device__ __forceinline__ unsigned xb_add(unsigned* p, unsigned v) { return __hip_atomic_fetch_add(p, v, __ATOMIC_RELAXED, __HIP_MEMORY_SCOPE_AGENT); }
__device__ __forceinline__ unsigned xb_xcc_id() { return (unsigned)__builtin_amdgcn_s_getreg((3 << 11) | 20) & 0xFu; }
#define XB_SPIN(cond, bar) do { unsigned _sp = 0; while (cond) { __builtin_amdgcn_s_sleep(1); \
    if ((++_sp & 255u) == 0u) { if (xb_ld(&(bar)[XB_TMO])) break; if (_sp > XB_SPIN_CAP) { atomicAdd(&(bar)[XB_TMO], 1u); break; } } } } while (0)

struct XcdBarrier {
    unsigned* bar; unsigned x;
    volatile LAS unsigned* st;
};

__device__ __forceinline__ XcdBarrier xcd_barrier_post(unsigned* bar, volatile LAS unsigned* st) {
    XcdBarrier b; b.bar = bar; b.x = xb_xcc_id(); b.st = st;
    if (threadIdx.x == 0) (void)xb_add(&bar[XB_XCNT(b.x)], 1u);
    return b;
}
__device__ __forceinline__ void xcd_barrier_complete(unsigned* bar, unsigned x, unsigned& nloc, unsigned& nx) {
    const unsigned G = gridDim.x * gridDim.y * gridDim.z;
    unsigned sum, cnt, mine, sp = 0u;
    for (;;) {
        sum = 0u; cnt = 0u; mine = 0u;
#pragma unroll
        for (unsigned j = 0; j < 16; ++j) { const unsigned c = xb_ld(&bar[XB_XCNT(j)]); sum += c; cnt += (c > 0u) ? 1u : 0u; mine = (j == x) ? c : mine; }
        if (sum == G) break;
        __builtin_amdgcn_s_sleep(1);
        if ((++sp & 255u) == 0u) { if (xb_ld(&bar[XB_TMO])) break; if (sp > XB_SPIN_CAP) { atomicAdd(&bar[XB_TMO], 1u); break; } }
    }
    nloc = mine > 0u ? mine : 1u; nx = cnt > 0u ? cnt : 1u;
}

__device__ __forceinline__ void xcd_barrier(const XcdBarrier& b) {
    asm volatile("s_waitcnt vmcnt(0)" ::: "memory");
    __syncthreads();
    if (threadIdx.x == 0) {
        unsigned* bar = b.bar;
        __builtin_amdgcn_s_waitcnt(0);
        unsigned nloc = b.st[0], nx = b.st[1];
        if (nloc == 0u) { xcd_barrier_complete(bar, b.x, nloc, nx); b.st[0] = nloc; b.st[1] = nx; }
        const unsigned old = xb_add(&bar[XB_XSUB(b.x)], 1u);
        const unsigned gen = old / nloc;
        if (old + 1u == (gen + 1u) * nloc) {
            __builtin_amdgcn_fence(__ATOMIC_RELEASE, "agent");
            asm volatile("s_waitcnt vmcnt(0)" ::: "memory");
            const unsigned og = xb_add(&bar[XB_TOP], 1u);
            const unsigned tg = og / nx;
            if (og + 1u == (tg + 1u) * nx) xb_add(&bar[XB_TOPGEN], 1u);
            else XB_SPIN(xb_ld(&bar[XB_TOPGEN]) == tg, bar);
            __builtin_amdgcn_fence(__ATOMIC_ACQUIRE, "agent");
            xb_add(&bar[XB_XGEN(b.x)], 1u);
            asm volatile("s_waitcnt vmcnt(0)" ::: "memory");
        } else {
            XB_SPIN(xb_ld(&bar[XB_XGEN(b.x)]) == gen, bar);
            __builtin_amdgcn_fence(__ATOMIC_ACQUIRE, "agent");
            asm volatile("s_waitcnt vmcnt(0)" ::: "memory");
        }
    }
    __syncthreads();
}

struct Params { const float* in[16]; float* out; unsigned char* ws; int ph_lo, ph_hi; };

template <int ph>
__device__ __forceinline__ void run_phase(const Params& P, LAS unsigned char* lds) {
    const int G = gridDim.x, bid = blockIdx.x;
    unsigned char* ws = P.ws;
    const float* x = P.in[0];
    float* out = P.out;
    bf16_t* HB = (bf16_t*)(ws + WS_HB); bf16_t* H1B = (bf16_t*)(ws + WS_H1B); bf16_t* Ub = (bf16_t*)(ws + WS_U); bf16_t* VT = (bf16_t*)(ws + WS_VT); bf16_t* Yb = (bf16_t*)(ws + WS_Y);
    bf16_t* C2 = (bf16_t*)(ws + WS_C2); bf16_t* EB = (bf16_t*)(ws + WS_EB);
    float* ssA = (float*)(ws + WS_SSA); float* ssB = (float*)(ws + WS_SSB); float* ssC = (float*)(ws + WS_SSC);
    int tid = threadIdx.x; asm volatile("" : "+v"(tid));
    const int lane = tid & 63, wave = __builtin_amdgcn_readfirstlane(tid >> 6);
    const int gw = bid * 8 + wave, NGW = G * 8;
    if constexpr (ph == 0) {
        LAS float* scr = (LAS float*)(lds + wave * 16384);
        for (int it = gw; it < 2 * 3072; it += NGW) {
            const int l = it / 3072; int r = it - l * 3072;
            unsigned char* wb = ws + (size_t)l * W_LAYER;
            if (r < 1792) { tr_item<true>(P.in[3] + (size_t)l * DM * DIN, DM, DIN, (bf16_t*)(wb + W_IN), P.in[2] + l * DM, scr, r, lane); continue; } r -= 1792;
            if (r < 128) { tr_item<false>(P.in[9] + (size_t)l * CD * CD, CD, CD, (bf16_t*)(wb + W_PW), nullptr, scr, r, lane); continue; } r -= 128;
            if (r < 512) { tr_item<false>(P.in[11] + (size_t)l * DM * DM, DM, DM, (bf16_t*)(wb + W_OUT), nullptr, scr, r, lane, 512); continue; } r -= 512;
            if (r < 512) { tr_item<false>(P.in[13] + (size_t)l * DM * DM, DM, DM, (bf16_t*)(wb + W_PG), P.in[12] + l * DM, scr, r, lane); continue; } r -= 512;
            tr_item<false>(P.in[14] + (size_t)l * PLE * DM, PLE, DM, (bf16_t*)(wb + W_PLE), nullptr, scr, r, lane);
        }
        for (int row = gw; row < MT; row += 2 * NGW) {
            const int row2 = row + NGW;
            const f32x4* xr = (const f32x4*)(x + (size_t)row * DM) + lane;
            const f32x4* xr2 = (const f32x4*)(x + (size_t)(row2 < MT ? row2 : row) * DM) + lane;
            f32x4 va[4], vb[4];
#pragma unroll
            for (int j = 0; j < 4; ++j) { va[j] = xr[64 * j]; vb[j] = xr2[64 * j]; }
            u32x2* ob = (u32x2*)(HB + (size_t)row * DM) + lane;
            float s = 0.f, s2 = 0.f;
#pragma unroll
            for (int j = 0; j < 4; ++j) { const f32x4 v = va[j]; s += (v[0] * v[0] + v[1] * v[1]) + (v[2] * v[2] + v[3] * v[3]); u32x2 w; w[0] = pk2(v[0], v[1]); w[1] = pk2(v[2], v[3]); ob[64 * j] = w; }
            s = wave_sum(s, lane);
            if (lane < 16) ssA[(size_t)row * 16 + lane] = (lane == 0) ? s : 0.f;
            if (row2 < MT) {
                u32x2* ob2 = (u32x2*)(HB + (size_t)row2 * DM) + lane;
#pragma unroll
                for (int j = 0; j < 4; ++j) { const f32x4 v = vb[j]; s2 += (v[0] * v[0] + v[1] * v[1]) + (v[2] * v[2] + v[3] * v[3]); u32x2 w; w[0] = pk2(v[0], v[1]); w[1] = pk2(v[2], v[3]); ob2[64 * j] = w; }
                s2 = wave_sum(s2, lane);
                if (lane < 16) ssA[(size_t)row2 * 16 + lane] = (lane == 0) ? s2 : 0.f;
            }
        }
        {
            const f32x4* pp = (const f32x4*)P.in[1]; u32x2* pb = (u32x2*)(ws + WS_PB);
            const int NV = 2 * MT * PLE / 4, stp = G * 512;
            for (int i = bid * 512 + tid; i < NV; i += 4 * stp) {
                f32x4 v[4];
#pragma unroll
                for (int j = 0; j < 4; ++j) { const int ii = i + j * stp; v[j] = pp[ii < NV ? ii : i]; }
#pragma unroll
                for (int j = 0; j < 4; ++j) { const int ii = i + j * stp; if (ii < NV) { u32x2 w; w[0] = pk2(v[j][0], v[j][1]); w[1] = pk2(v[j][2], v[j][3]); pb[ii] = w; } }
            }
        }
    } else if constexpr (ph == NPHASE - 1) {
        const float* fg = P.in[15];
        for (int row = gw; row < MT; row += 2 * NGW) {
            const int row2 = row + NGW; const bool has2 = row2 < MT; const int r2 = has2 ? row2 : row;
            const u32x4* hr = (const u32x4*)(HB + (size_t)row * DM) + lane; const u32x4* hr2 = (const u32x4*)(HB + (size_t)r2 * DM) + lane;
            const u32x4 a0 = hr[0], a1 = hr[64], b0 = hr2[0], b1 = hr2[64];
            const float p1 = (lane < 16) ? ssA[(size_t)row * 16 + lane] : 0.f, p2 = (lane < 16) ? ssA[(size_t)r2 * 16 + lane] : 0.f;
            const f32x4 g0 = *(const f32x4*)(fg + 8 * lane), g1 = *(const f32x4*)(fg + 8 * lane + 4), g2 = *(const f32x4*)(fg + 512 + 8 * lane), g3 = *(const f32x4*)(fg + 512 + 8 * lane + 4);
            const float rs = frsq(wave_sum(p1, lane) * (1.0f / DM) + EPS), rs2 = frsq(wave_sum(p2, lane) * (1.0f / DM) + EPS);
            float* o = out + (size_t)row * DM + 8 * lane;
            { f32x4 t0 = {bflo(a0[0]), bfhi(a0[0]), bflo(a0[1]), bfhi(a0[1])}, t1 = {bflo(a0[2]), bfhi(a0[2]), bflo(a0[3]), bfhi(a0[3])}, t2 = {bflo(a1[0]), bfhi(a1[0]), bflo(a1[1]), bfhi(a1[1])}, t3 = {bflo(a1[2]), bfhi(a1[2]), bflo(a1[3]), bfhi(a1[3])};
              *(f32x4*)o = t0 * rs * g0; *(f32x4*)(o + 4) = t1 * rs * g1; *(f32x4*)(o + 512) = t2 * rs * g2; *(f32x4*)(o + 516) = t3 * rs * g3; }
            if (has2) {
                float* o2 = out + (size_t)row2 * DM + 8 * lane;
                f32x4 t0 = {bflo(b0[0]), bfhi(b0[0]), bflo(b0[1]), bfhi(b0[1])}, t1 = {bflo(b0[2]), bfhi(b0[2]), bflo(b0[3]), bfhi(b0[3])}, t2 = {bflo(b1[0]), bfhi(b1[0]), bflo(b1[1]), bfhi(b1[1])}, t3 = {bflo(b1[2]), bfhi(b1[2]), bflo(b1[3]), bfhi(b1[3])};
                *(f32x4*)o2 = t0 * rs2 * g0; *(f32x4*)(o2 + 4) = t1 * rs2 * g1; *(f32x4*)(o2 + 512) = t2 * rs2 * g2; *(f32x4*)(o2 + 516) = t3 * rs2 * g3;
            }
        }
    } else {
        constexpr int l = (ph - 1) / 5, k = (ph - 1) % 5;
        unsigned char* wb = ws + (size_t)l * W_LAYER;
        if constexpr (k == 0) {
            pg8::Gemm g{HB, (const bf16_t*)(wb + W_IN), MT, DIN, DM}; pg8::StaticOrder S; S.init(MT, DIN, G, bid);
            EpiIn E{Ub, VT, ssA};
            pg8::gemm_phase<EpiIn, pg8::StaticOrder, true, true>(lds, g, S, E, threadIdx.x);
        } else if constexpr (k == 1) {
            const float* aog = P.in[4] + l * HD;
            const float* dww = P.in[5] + (size_t)l * CWID * CD; const float* dwb = P.in[6] + l * CD;
            const float* lng = P.in[7] + l * CD; const float* lnb = P.in[8] + l * CD;
#pragma unroll 1
            for (int rep_ = 0; rep_ < ((PROBE_DUP & 2) ? 2 : 1); ++rep_)
#pragma unroll 1
                for (int item = gw; item < NB * NH * (SEQ / 32); item += NGW) {
                    const int bh = item >> 6, qq = item & 63, qblk = (item >= NB * NH * (SEQ / 64)) ? 63 - qq : qq;
                    attn_wave(Ub, VT, Yb, aog, bh >> 3, bh & 7, qblk, lds);
                }
            __syncthreads();
            for (int it = bid; it < 256; it += G) {
#pragma unroll 1
                for (int uu = 0; uu < ((PROBE_DUP & 4) ? 4 : 2); ++uu) convpre_unit(Ub, C2, dww, dwb, lng, lnb, 2 * it + (uu & 1), lds);
            }
            __syncthreads();
        } else if constexpr (k == 2) {
            const int nb0 = G / 2;
            {
                pg8::Gemm g{C2, (const bf16_t*)(wb + W_PW), MT, CD, CD}; SubOrder S; S.init(MT, CD, nb0, bid);
                EpiPw E{Ub, Yb, P.in[10] + l * CD, ssC};
                pg8::gemm_phase<EpiPw, SubOrder, true, true>(lds, g, S, E, threadIdx.x);
            }
            {
                pg8::Gemm g{(const bf16_t*)(ws + WS_PB) + (size_t)l * MT * PLE, (const bf16_t*)(wb + W_PLE), MT, DM, PLE}; SubOrder S; S.init(MT, DM, G - nb0, bid - nb0);
                EpiE E{EB};
                int t2 = threadIdx.x; asm volatile("" : "+v"(t2));
                pg8::gemm_phase<EpiE, SubOrder, true, true>(lds, g, S, E, t2);
            }
        } else if constexpr (k == 3) {
            pg8::Gemm g{Yb, (const bf16_t*)(wb + W_OUT), MT, DM, DM}; pg8::StaticOrder S; S.init(MT, DM, G, bid);
            EpiOut<(l > 0)> E{x, HB, H1B, ssB, ssC};
            pg8::gemm_phase<EpiOut<(l > 0)>, pg8::StaticOrder, true, true>(lds, g, S, E, threadIdx.x);
        } else {
            pg8::Gemm g{H1B, (const bf16_t*)(wb + W_PG), MT, DM, DM}; pg8::StaticOrder S; S.init(MT, DM, G, bid);
            EpiGate<false> E{out, H1B, EB, HB, ssB, ssA, 0};
            pg8::gemm_phase<EpiGate<false>, pg8::StaticOrder, true, true>(lds, g, S, E, threadIdx.x);
            if constexpr ((PROBE_DUP & 128) != 0) { int t3 = threadIdx.x; asm volatile("" : "+v"(t3)); pg8::gemm_phase<EpiGate<false>, pg8::StaticOrder, true, true>(lds, g, S, E, t3); }
        }
    }
}

__global__ void __launch_bounds__(512, 2) fwd(Params P) {
    extern __shared__ __attribute__((aligned(16))) unsigned char lds_raw[];
    LAS unsigned char* lds = (LAS unsigned char*)lds_raw;
    const int lo = P.ph_lo, hi = P.ph_hi;
    volatile LAS unsigned* st = (volatile LAS unsigned*)(lds + LDS_BYTES - 64);
    if (threadIdx.x < 16) st[threadIdx.x] = 0u;
    __syncthreads();
    const XcdBarrier bar = xcd_barrier_post((unsigned*)(P.ws + WS_CTL), st);
#define PROBE_PH(k) ((((PROBE_DUP) & 8) && (k) == 0) || (((PROBE_DUP) & 1) && (k) == 1) || (((PROBE_DUP) & 32) && ((k) == 3 || (k) == 8)) || (((PROBE_DUP) & 16) && (k) == 4))
#define SEAM() do { if (hi > NPHASE) cg::this_grid().sync(); else xcd_barrier(bar); } while (0)
#define PHASE(k) if (lo <= (k) && (k) < hi) { run_phase<(k)>(P, lds); if constexpr (PROBE_PH(k)) { __syncthreads(); run_phase<(k)>(P, lds); } \
        if constexpr (((PROBE_DUP) & 64) != 0) { SEAM(); } if ((k) + 1 < hi) SEAM(); }
    PHASE(0) PHASE(1) PHASE(2) PHASE(3) PHASE(4) PHASE(5) PHASE(6) PHASE(7) PHASE(8) PHASE(9) PHASE(10) PHASE(11)
    if constexpr (((PROBE_DUP) & 256) != 0) { SEAM(); PHASE(0) PHASE(1) PHASE(2) PHASE(3) PHASE(4) PHASE(5) PHASE(6) PHASE(7) PHASE(8) PHASE(9) PHASE(10) PHASE(11) }
#undef PHASE
#undef SEAM
}

#ifndef MK_N_LAUNCHES
#define MK_N_LAUNCHES 1
#endif
extern "C" void kernel_launch(void* const* d_in, const int* in_sizes, int n_in, void* d_out, int out_size, void* d_ws, size_t ws_size, hipStream_t stream) {
    static int grid = 0;
    if (grid == 0) {
        if (n_in != 16 || out_size != MT * DM || ws_size < WS_END) { fprintf(stderr, "kernel_launch: unexpected shapes (n_in %d, out %d, ws %zu)\n", n_in, out_size, ws_size); grid = -1; return; }
        int dev = 0, cus = 0, per_cu = 0;
        (void)hipGetDevice(&dev);
        (void)hipDeviceGetAttribute(&cus, hipDeviceAttributeMultiprocessorCount, dev);
        if (hipFuncSetAttribute((const void*)fwd, hipFuncAttributeMaxDynamicSharedMemorySize, LDS_BYTES) != hipSuccess) { fprintf(stderr, "kernel_launch: hipFuncSetAttribute failed\n"); grid = -1; return; }
        if (hipOccupancyMaxActiveBlocksPerMultiprocessor(&per_cu, (const void*)fwd, 512, LDS_BYTES) != hipSuccess || per_cu < 1) { fprintf(stderr, "kernel_launch: occupancy query says %d\n", per_cu); per_cu = 1; }
        (void)hipGetLastError();
        grid = cus * 1;
        if (grid <= 0) grid = 256;
    }
    if (grid < 0) return;
    if (hipMemsetAsync((unsigned char*)d_ws + WS_CTL, 0, CTL_BYTES, stream) != hipSuccess) { fprintf(stderr, "kernel_launch: memset of barrier words failed\n"); return; }
    Params p{};
    for (int i = 0; i < 16; ++i) p.in[i] = (const float*)d_in[i];
    p.out = (float*)d_out; p.ws = (unsigned char*)d_ws;
#if MK_N_LAUNCHES == 1
    p.ph_lo = 0; p.ph_hi = NPHASE;
    void* args[] = {&p};
    hipError_t e = hipLaunchCooperativeKernel((const void*)fwd, dim3(grid), dim3(512), args, LDS_BYTES, stream);
    if (e != hipSuccess) fprintf(stderr, "kernel_launch: cooperative launch failed: %s (grid %d)\n", hipGetErrorString(e), grid);
#else
    for (int ph = 0; ph < NPHASE; ++ph) {
        p.ph_lo = ph; p.ph_hi = ph + 1;
        hipLaunchKernelGGL(fwd, dim3(grid), dim3(512), LDS_BYTES, stream, p);
    }
#endif
}
```

```cpp
#include <hip/hip_runtime.h>
#include <hip/hip_cooperative_groups.h>
#include <cstdio>
#include <cstdint>
namespace cg = cooperative_groups;
namespace pg8 {
#define PG8_LAS __attribute__((address_space(3)))
typedef unsigned short bf16_t;
typedef short bf16x8 __attribute__((ext_vector_type(8)));
typedef float f32x4 __attribute__((ext_vector_type(4)));
typedef unsigned u32x4 __attribute__((ext_vector_type(4)));
constexpr int BM = 256, BK = 64, HALF = 128, HTB = HALF * BK * 2  , STAGE_BYTES = 8 * HTB, NXCD = 8, WGM = 8;

__host__ __device__ __forceinline__ int lds_byte(int r, int c) { const int st = (r >> 4) * 2 + (c >> 5), rr = r & 15, cc = c & 31, ob = rr * 64 + cc * 2; return st * 1024 + (ob ^ (((ob >> 9) & 1) << 5)); }
__host__ __device__ __forceinline__ void stage_rc(int b, int& R, int& C) { const int st = b / 1024, sb = b % 1024, swz = sb ^ (((sb >> 9) & 1) << 5); R = (st >> 1) * 16 + swz / 64; C = (st & 1) * 32 + (swz % 64) / 2; }
__host__ __device__ __forceinline__ int perm32(int rho) { const int n = rho >> 4, i = rho & 15; return 8 * (i >> 2) + 4 * n + (i & 3); }

struct Unit { int pm, pn; };
struct Gemm { const bf16_t* A; const bf16_t* Bt; int M, N, K; };

struct StaticOrder {
    int nM, nN, nwg, G, c;
    __host__ __device__ void init(int M, int N, int G_, int c_) { nM = M / BM; nN = N / BM; nwg = nM * nN; G = G_; c = c_; }
    __host__ __device__ bool next(int i, Unit& u) const {
        const long L = (long)i * G + c; if (L >= nwg) return false;
        int wgid = (int)L; { const int q = nwg / NXCD, r = nwg % NXCD, xcd = wgid % NXCD, off = wgid / NXCD; wgid = (xcd < r ? xcd * (q + 1) : r * (q + 1) + (xcd - r) * q) + off; }
        const int nig = WGM * nN, gid = wgid / nig, fm = gid * WGM, gsz = (nM - fm) < WGM ? (nM - fm) : WGM;
        u.pm = fm + ((wgid % nig) % gsz); u.pn = (wgid % nig) / gsz; return true;
    }
    __device__ __forceinline__ void a_ready(const Unit&) const {}
    __device__ __forceinline__ void done(const Unit&) const {}
};

template <class Epi, class Sched, bool ALIGN_EPI = false, bool SP2 = false>
__device__ __forceinline__ void gemm_phase(PG8_LAS unsigned char* lds, const Gemm g, const Sched& S, const Epi& E, const int tid_in) {
    const int tid = tid_in, wid = __builtin_amdgcn_readfirstlane(tid >> 6), lane = tid & 63, wr = wid >> 2, wc = wid & 3, fr = lane & 15, fq = lane >> 4;
    const int K = g.K, nt = K / BK;
    unsigned voffA[2], voffB[2];
#pragma unroll
    for (int i = 0; i < 2; ++i) { int R, C; stage_rc(tid * 16 + i * 8192, R, C); const int Rb = Epi::PERM ? ((R & ~31) + perm32(R & 31)) : R;
        voffA[i] = (unsigned)(R * K + C) * 2u; voffB[i] = (unsigned)(Rb * K + C) * 2u; }
    const size_t kstep = (size_t)(BK * 2);
    const size_t hstep = (size_t)HALF * K * 2;
    const size_t tstep = 2 * hstep;
    const unsigned ldsw = (unsigned)wid * 1024u;
    const int aoff = lds_byte(wr * 64 + fr, fq * 8), boff = lds_byte(wc * 32 + fr, fq * 8);
#define PG8_SA(b, h) (((b) * 2 + (h)) * HTB)
#define PG8_SB(b, h) ((4 + (b) * 2 + (h)) * HTB)
#define PG8_STAGE(bufoff, gbase, voff) do { _Pragma("unroll") for (int _i = 0; _i < 2; ++_i) \
        __builtin_amdgcn_global_load_lds((const unsigned*)((const char*)(gbase) + (voff)[_i]), (PG8_LAS unsigned*)(lds + (bufoff) + ldsw + _i * 8192), 16, 0, 0); } while (0)
#define PG8_LDA(dst, b, h) do { _Pragma("unroll") for (int m = 0; m < 4; ++m) _Pragma("unroll") for (int k = 0; k < 2; ++k) dst[m][k] = *(const PG8_LAS bf16x8*)(lds + PG8_SA(b, h) + aoff + m * 2048 + k * 1024); } while (0)
#define PG8_LDB(dst, b, h) do { _Pragma("unroll") for (int n = 0; n < 2; ++n) _Pragma("unroll") for (int k = 0; k < 2; ++k) dst[n][k] = *(const PG8_LAS bf16x8*)(lds + PG8_SB(b, h) + boff + n * 2048 + k * 1024); } while (0)
#define PG8_MMA(ai, bj, At, Bt) do { __builtin_amdgcn_s_setprio(1); _Pragma("unroll") for (int m = 0; m < 4; ++m) _Pragma("unroll") for (int n = 0; n < 2; ++n) _Pragma("unroll") for (int k = 0; k < 2; ++k) \
        acc[ai][bj][m][n] = __builtin_amdgcn_mfma_f32_16x16x32_bf16(Bt[n][k], At[m][k], acc[ai][bj][m][n], 0, 0, 0); __builtin_amdgcn_s_setprio(0); } while (0)
#define PG8_WAIT_V(n) asm volatile("s_waitcnt vmcnt(" #n ")" ::: "memory")
#define PG8_WAIT_L(n) asm volatile("s_waitcnt lgkmcnt(" #n ")" ::: "memory")
#define PG8_BAR __builtin_amdgcn_s_barrier()
#define PG8_SCHED __builtin_amdgcn_sched_barrier(0)
    Unit cur, nxt; int ui = 0;
    if (!S.next(0, cur)) return;
    f32x4 acc[2][2][4][2];
#pragma unroll
    for (int a = 0; a < 2; ++a)
#pragma unroll
        for (int b = 0; b < 2; ++b)
#pragma unroll
            for (int m = 0; m < 4; ++m)
#pragma unroll
                for (int n = 0; n < 2; ++n) acc[a][b][m][n] = (f32x4){0.f, 0.f, 0.f, 0.f};
    bf16x8 At[4][2], B0[2][2], B1[2][2];
    const char* cA = (const char*)g.A + (size_t)cur.pm * tstep; const char* cB = (const char*)g.Bt + (size_t)cur.pn * tstep;
    S.a_ready(cur);
    if constexpr (SP2) {
        PG8_STAGE(PG8_SB(0, 0), cB, voffB); PG8_STAGE(PG8_SB(0, 1), cB + hstep, voffB); PG8_STAGE(PG8_SA(0, 0), cA, voffA); PG8_STAGE(PG8_SA(0, 1), cA + hstep, voffA);
        if (wr == 1) PG8_BAR;
        PG8_WAIT_V(2); PG8_BAR;
        PG8_STAGE(PG8_SB(1, 0), cB + kstep, voffB); PG8_STAGE(PG8_SA(1, 0), cA + kstep, voffA); PG8_STAGE(PG8_SB(1, 1), cB + hstep + kstep, voffB);
        PG8_WAIT_V(6); PG8_BAR;
    } else {
        PG8_STAGE(PG8_SB(0, 0), cB, voffB); PG8_STAGE(PG8_SA(0, 0), cA, voffA); PG8_STAGE(PG8_SB(0, 1), cB + hstep, voffB); PG8_STAGE(PG8_SA(0, 1), cA + hstep, voffA);
        if (wr == 1) PG8_BAR;
        PG8_WAIT_V(4); PG8_BAR;
        PG8_STAGE(PG8_SB(1, 0), cB + kstep, voffB); PG8_STAGE(PG8_SA(1, 0), cA + kstep, voffA); PG8_STAGE(PG8_SB(1, 1), cB + hstep + kstep, voffB);
        PG8_WAIT_V(6); PG8_BAR;
    }
    for (;;) {
        const bool has_next = S.next(ui + 1, nxt);
        const char* nA = has_next ? (const char*)g.A + (size_t)nxt.pm * tstep : cA; const char* nB = has_next ? (const char*)g.Bt + (size_t)nxt.pn * tstep : cB;
        for (int t = 0; t < nt; t += 2) {
            if constexpr (Epi::MID_T > 0) { if (t == Epi::MID_T) E.mid(acc, cur); }
            const bool last = (t == nt - 2);
            const char* a1 = cA + (size_t)(t + 1) * kstep;
            const char* a2 = last ? nA : cA + (size_t)(t + 2) * kstep; const char* b2 = last ? nB : cB + (size_t)(t + 2) * kstep;
            const char* a3 = a2 + kstep; const char* b3 = b2 + kstep;
            if (last && has_next) S.a_ready(nxt);
            if constexpr (SP2) {
            PG8_LDB(B0, 0, 0); PG8_LDB(B1, 0, 1); PG8_SCHED; PG8_LDA(At, 0, 0); PG8_STAGE(PG8_SA(1, 1), a1 + hstep, voffA);
            PG8_WAIT_V(8); PG8_WAIT_L(0); PG8_BAR; PG8_MMA(0, 0, At, B0); PG8_MMA(0, 1, At, B1); PG8_BAR; PG8_SCHED;
            PG8_LDA(At, 0, 1); PG8_STAGE(PG8_SB(0, 0), b2, voffB); PG8_STAGE(PG8_SB(0, 1), b2 + hstep, voffB); PG8_STAGE(PG8_SA(0, 0), a2, voffA);
            PG8_WAIT_V(8); PG8_WAIT_L(0); PG8_BAR; PG8_MMA(1, 0, At, B0); PG8_MMA(1, 1, At, B1); PG8_BAR; PG8_SCHED;
            PG8_LDB(B0, 1, 0); PG8_LDB(B1, 1, 1); PG8_SCHED; PG8_LDA(At, 1, 0); PG8_STAGE(PG8_SA(0, 1), a2 + hstep, voffA);
            PG8_WAIT_V(8); PG8_WAIT_L(0); PG8_BAR; PG8_MMA(0, 0, At, B0); PG8_MMA(0, 1, At, B1); PG8_BAR; PG8_SCHED;
            PG8_LDA(At, 1, 1); PG8_STAGE(PG8_SB(1, 0), b3, voffB); PG8_STAGE(PG8_SB(1, 1), b3 + hstep, voffB); PG8_STAGE(PG8_SA(1, 0), a3, voffA);
            PG8_WAIT_V(8); PG8_WAIT_L(0); PG8_BAR; PG8_MMA(1, 0, At, B0); PG8_MMA(1, 1, At, B1); PG8_BAR; PG8_SCHED;
            } else {
            PG8_LDB(B0, 0, 0); PG8_SCHED; PG8_LDA(At, 0, 0); PG8_STAGE(PG8_SA(1, 1), a1 + hstep, voffA);
            PG8_WAIT_L(8); PG8_BAR; PG8_WAIT_L(0); PG8_MMA(0, 0, At, B0); PG8_BAR; PG8_SCHED;
            PG8_LDB(B1, 0, 1); PG8_STAGE(PG8_SB(0, 0), b2, voffB);
            PG8_BAR; PG8_WAIT_L(0); PG8_MMA(0, 1, At, B1); PG8_BAR;
            PG8_LDA(At, 0, 1); PG8_STAGE(PG8_SA(0, 0), a2, voffA);
            PG8_BAR; PG8_WAIT_L(0); PG8_MMA(1, 0, At, B0); PG8_BAR; PG8_SCHED;
            PG8_STAGE(PG8_SB(0, 1), b2 + hstep, voffB);
            PG8_WAIT_V(6); PG8_BAR; PG8_MMA(1, 1, At, B1); PG8_BAR;
            PG8_LDB(B0, 1, 0); PG8_SCHED; PG8_LDA(At, 1, 0); PG8_STAGE(PG8_SA(0, 1), a2 + hstep, voffA);
            PG8_WAIT_L(8); PG8_BAR; PG8_WAIT_L(0); PG8_MMA(0, 0, At, B0); PG8_BAR; PG8_SCHED;
            PG8_LDB(B1, 1, 1); PG8_STAGE(PG8_SB(1, 0), b3, voffB);
            PG8_BAR; PG8_WAIT_L(0); PG8_MMA(0, 1, At, B1); PG8_BAR;
            PG8_LDA(At, 1, 1); PG8_STAGE(PG8_SA(1, 0), a3, voffA);
            PG8_BAR; PG8_WAIT_L(0); PG8_MMA(1, 0, At, B0); PG8_BAR; PG8_SCHED;
            PG8_STAGE(PG8_SB(1, 1), b3 + hstep, voffB);
            PG8_WAIT_V(6); PG8_BAR; PG8_MMA(1, 1, At, B1); PG8_BAR;
            }
        }
        if constexpr (ALIGN_EPI) { if (wr == 0) PG8_BAR; }
        if constexpr (!Epi::AFTER_DRAIN) { E(acc, cur, wr, wc, fr, fq); S.done(cur); }
        if (!has_next) break;
#pragma unroll
        for (int a = 0; a < 2; ++a)
#pragma unroll
            for (int b = 0; b < 2; ++b)
#pragma unroll
                for (int m = 0; m < 4; ++m)
#pragma unroll
                    for (int n = 0; n < 2; ++n) acc[a][b][m][n] = (f32x4){0.f, 0.f, 0.f, 0.f};
        cur = nxt; cA = nA; cB = nB; ++ui;
        if constexpr (ALIGN_EPI) { if (wr == 1) PG8_BAR; }
    }
    PG8_WAIT_V(0);
    if constexpr (!ALIGN_EPI) { if (wr == 0) PG8_BAR; }
    PG8_BAR;
    if constexpr (Epi::AFTER_DRAIN) { E.fused(acc, cur, wr, wc, fr, fq, lds, wid, lane); S.done(cur); }
#undef PG8_SA
#undef PG8_SB
#undef PG8_STAGE
#undef PG8_LDA
#undef PG8_LDB
#undef PG8_MMA
#undef PG8_WAIT_V
#undef PG8_WAIT_L
#undef PG8_BAR
#undef PG8_SCHED
}
}

#define LAS __attribute__((address_space(3)))
typedef unsigned short bf16_t;
typedef short bf16x8 __attribute__((ext_vector_type(8)));
typedef float f32x4 __attribute__((ext_vector_type(4)));
typedef float f32x2 __attribute__((ext_vector_type(2)));
typedef float f32x16 __attribute__((ext_vector_type(16)));
typedef unsigned u32x4 __attribute__((ext_vector_type(4)));
typedef unsigned u32x2 __attribute__((ext_vector_type(2)));
typedef __bf16 bf16x2_t __attribute__((ext_vector_type(2)));

constexpr int NB = 8, SEQ = 2048, DM = 1024, MT = NB * SEQ, DIN = 3584, NH = 8, HD = 64, CWID = 31, PLE = 256, CD = 512;
constexpr float EPS = 1e-6f;
constexpr float QSCALE = 0.125f * 1.4426950408889634f;

constexpr size_t MiB = 1u << 20;
constexpr size_t W_IN = 0, W_PW = 7340032, W_OUT = W_PW + 524288, W_PG = W_OUT + 2097152, W_PLE = W_PG + 2097152, W_LAYER = 12 * MiB;
static_assert(W_PLE + 524288 == W_LAYER, "weight map");
constexpr int UP = 2560, UQ = 0, UK = 512, USGA = 1024, UGLU = 1536, USGC = 2048;
constexpr size_t WS_PB = 24 * MiB, WS_HB = 40 * MiB, WS_Y = 72 * MiB, WS_VT = 104 * MiB, WS_SSA = 120 * MiB, WS_SSB = 121 * MiB, WS_SSC = 122 * MiB, WS_U = 123 * MiB;
constexpr size_t WS_H1B = WS_U  , WS_C2 = 203 * MiB, WS_EB = 219 * MiB, WS_CTL = 252 * MiB, CTL_BYTES = 16384, WS_END = WS_CTL + CTL_BYTES;
static_assert(WS_U + (size_t)MT * UP * 2 <= WS_C2, "ws map");
constexpr int LDS_BYTES = 147456;
constexpr int NPHASE = 12;
#ifndef PROBE_DUP
#define PROBE_DUP 0
#endif

__device__ __forceinline__ unsigned pk2(float lo, float hi) { f32x2 v = {lo, hi}; bf16x2_t b = __builtin_convertvector(v, bf16x2_t); return __builtin_bit_cast(unsigned, b); }
__device__ __forceinline__ float bflo(unsigned u) { return __builtin_bit_cast(float, u << 16); }
__device__ __forceinline__ float bfhi(unsigned u) { return __builtin_bit_cast(float, u & 0xffff0000u); }
__device__ __forceinline__ float fexp2(float x) { return __builtin_amdgcn_exp2f(x); }
__device__ __forceinline__ float flog2(float x) { return __builtin_amdgcn_logf(x); }
__device__ __forceinline__ float frcp(float x) { return __builtin_amdgcn_rcpf(x); }
__device__ __forceinline__ float frsq(float x) { return __builtin_amdgcn_rsqf(x); }
__device__ __forceinline__ float sigmoidf_(float x) { return frcp(1.0f + fexp2(-1.4426950408889634f * x)); }
__device__ __forceinline__ float siluf_(float x) { return x * sigmoidf_(x); }
#define MFMA32(a, b, c) __builtin_amdgcn_mfma_f32_32x32x16_bf16((a), (b), (c), 0, 0, 0)

__device__ __forceinline__ float shx(float v, int m, int lane) { return __builtin_bit_cast(float, __builtin_amdgcn_ds_bpermute((lane ^ m) << 2, __builtin_bit_cast(int, v))); }
__device__ __forceinline__ float wave_sum(float v, int lane) {
#pragma unroll
    for (int o = 1; o < 64; o <<= 1) v += shx(v, o, lane);
    return v;
}
__device__ __forceinline__ float row_rstd(const float* ss, int row, int fq, int lane) {
    const f32x4 p = *(const f32x4*)(ss + (size_t)row * 16 + fq * 4);
    float s = (p[0] + p[1]) + (p[2] + p[3]);
    s += shx(s, 16, lane); s += shx(s, 32, lane);
    return frsq(s * (1.0f / DM) + EPS);
}

struct EpiIn {
    static constexpr bool PERM = true, AFTER_DRAIN = false; static constexpr int MID_T = 0;
    bf16_t* U; bf16_t* VT; const float* ss; int pn_off;
    __device__ __forceinline__ void operator()(const f32x4 (&acc)[2][2][4][2], const pg8::Unit& u, int, int, int, int) const {
        int t_ = threadIdx.x; asm volatile("" : "+v"(t_));
        const int lane = t_ & 63, fr = lane & 15, fq = lane >> 4, wid_ = __builtin_amdgcn_readfirstlane(t_ >> 6), wr = wid_ >> 2, wc = wid_ & 3;
        const int pn = u.pn + pn_off;
        f32x4 pp[2][4];
#pragma unroll
        for (int ai = 0; ai < 2; ++ai)
#pragma unroll
            for (int m = 0; m < 4; ++m) pp[ai][m] = *(const f32x4*)(ss + (size_t)(u.pm * 256 + ai * 128 + wr * 64 + m * 16 + fr) * 16 + fq * 4);
#pragma unroll
        for (int ai = 0; ai < 2; ++ai)
#pragma unroll
            for (int m = 0; m < 4; ++m) {
                const int row = u.pm * 256 + ai * 128 + wr * 64 + m * 16 + fr;
                float s_ = (pp[ai][m][0] + pp[ai][m][1]) + (pp[ai][m][2] + pp[ai][m][3]);
                s_ += shx(s_, 16, lane); s_ += shx(s_, 32, lane);
                const float rs = frsq(s_ * (1.0f / DM) + EPS);
#pragma unroll
                for (int bj = 0; bj < 2; ++bj) {
                    const int col0 = pn * 256 + bj * 128 + wc * 32 + 8 * fq;
                    f32x4 v0 = acc[ai][bj][m][0] * rs, v1 = acc[ai][bj][m][1] * rs;
                    if (pn < 4) {
                        const float sc = pn < 2 ? QSCALE : 1.0f;
                        v0 = v0 * sc; v1 = v1 * sc;
                        u32x4 w; w[0] = pk2(v0[0], v0[1]); w[1] = pk2(v0[2], v0[3]); w[2] = pk2(v1[0], v1[1]); w[3] = pk2(v1[2], v1[3]);
                        *(u32x4*)(U + (size_t)row * UP + col0) = w;
                    } else if (pn < 6) {
                        const int vc = col0 - 1024, hh = vc >> 6, d0 = vc & 63, b = row >> 11, s = row & 2047;
                        bf16_t* vp = VT + ((size_t)((b * NH + hh) * HD + d0)) * SEQ + s;
                        const unsigned w0 = pk2(v0[0], v0[1]), w1 = pk2(v0[2], v0[3]), w2 = pk2(v1[0], v1[1]), w3 = pk2(v1[2], v1[3]);
                        vp[0 * SEQ] = (bf16_t)(w0 & 0xffffu); vp[1 * SEQ] = (bf16_t)(w0 >> 16);
                        vp[2 * SEQ] = (bf16_t)(w1 & 0xffffu); vp[3 * SEQ] = (bf16_t)(w1 >> 16);
                        vp[4 * SEQ] = (bf16_t)(w2 & 0xffffu); vp[5 * SEQ] = (bf16_t)(w2 >> 16);
                        vp[6 * SEQ] = (bf16_t)(w3 & 0xffffu); vp[7 * SEQ] = (bf16_t)(w3 >> 16);
                    } else if (pn < 8 || pn >= 12) {
                        u32x4 w; w[0] = pk2(siluf_(v0[0]), siluf_(v0[1])); w[1] = pk2(siluf_(v0[2]), siluf_(v0[3]));
                        w[2] = pk2(siluf_(v1[0]), siluf_(v1[1])); w[3] = pk2(siluf_(v1[2]), siluf_(v1[3]));
                        *(u32x4*)(U + (size_t)row * UP + (pn < 8 ? col0 - 512 : col0 - 1024)) = w;
                    } else {
                        const int ch0 = (col0 - 2048) >> 1;
                        u32x2 w; w[0] = pk2(v0[0] * sigmoidf_(v0[1]), v0[2] * sigmoidf_(v0[3])); w[1] = pk2(v1[0] * sigmoidf_(v1[1]), v1[2] * sigmoidf_(v1[3]));
                        *(u32x2*)(U + (size_t)row * UP + UGLU + ch0) = w;
                    }
                }
                asm volatile("" ::: "memory");
            }
    }
};

struct EpiPw {
    static constexpr bool PERM = true, AFTER_DRAIN = false; static constexpr int MID_T = 0;
    const bf16_t* U; bf16_t* Y; const float* cog; float* ssC;
    __device__ __forceinline__ void operator()(const f32x4 (&acc)[2][2][4][2], const pg8::Unit& u, int, int, int, int) const {
        int t_ = threadIdx.x; asm volatile("" : "+v"(t_));
        const int lane = t_ & 63, fr = lane & 15, fq = lane >> 4, wid_ = __builtin_amdgcn_readfirstlane(t_ >> 6), wr = wid_ >> 2, wc = wid_ & 3;
#pragma unroll
        for (int ai = 0; ai < 2; ++ai)
#pragma unroll
            for (int m = 0; m < 4; ++m) {
                const int row = u.pm * 256 + ai * 128 + wr * 64 + m * 16 + fr;
                float sq = 0.f;
#pragma unroll
                for (int bj = 0; bj < 2; ++bj) {
                    const int col0 = u.pn * 256 + bj * 128 + wc * 32 + 8 * fq;
                    const f32x4 v0 = acc[ai][bj][m][0], v1 = acc[ai][bj][m][1];
                    sq += (v0[0] * v0[0] + v0[1] * v0[1]) + (v0[2] * v0[2] + v0[3] * v0[3]) + (v1[0] * v1[0] + v1[1] * v1[1]) + (v1[2] * v1[2] + v1[3] * v1[3]);
                    const f32x4 g0 = *(const f32x4*)(cog + col0), g1 = *(const f32x4*)(cog + col0 + 4);
                    const u32x4 sg = *(const u32x4*)(U + (size_t)row * UP + USGC + col0);
                    u32x4 w;
                    w[0] = pk2(v0[0] * g0[0] * bflo(sg[0]), v0[1] * g0[1] * bfhi(sg[0])); w[1] = pk2(v0[2] * g0[2] * bflo(sg[1]), v0[3] * g0[3] * bfhi(sg[1]));
                    w[2] = pk2(v1[0] * g1[0] * bflo(sg[2]), v1[1] * g1[1] * bfhi(sg[2])); w[3] = pk2(v1[2] * g1[2] * bflo(sg[3]), v1[3] * g1[3] * bfhi(sg[3]));
                    *(u32x4*)(Y + (size_t)row * DM + col0) = w;
                }
                sq += shx(sq, 16, lane); sq += shx(sq, 32, lane);
                if (fq == 0) ssC[(size_t)row * 8 + u.pn * 4 + wc] = sq;
                asm volatile("" ::: "memory");
            }
    }
};

struct EpiE {
    static constexpr bool PERM = true, AFTER_DRAIN = false; static constexpr int MID_T = 0;
    bf16_t* EB;
    __device__ __forceinline__ void operator()(const f32x4 (&acc)[2][2][4][2], const pg8::Unit& u, int, int, int, int) const {
        int t_ = threadIdx.x; asm volatile("" : "+v"(t_));
        const int lane = t_ & 63, fr = lane & 15, fq = lane >> 4, wid_ = __builtin_amdgcn_readfirstlane(t_ >> 6), wr = wid_ >> 2, wc = wid_ & 3;
#pragma unroll
        for (int ai = 0; ai < 2; ++ai)
#pragma unroll
            for (int m = 0; m < 4; ++m) {
                const int row = u.pm * 256 + ai * 128 + wr * 64 + m * 16 + fr;
#pragma unroll
                for (int bj = 0; bj < 2; ++bj) {
                    const int col0 = u.pn * 256 + bj * 128 + wc * 32 + 8 * fq;
                    const f32x4 v0 = acc[ai][bj][m][0], v1 = acc[ai][bj][m][1];
                    u32x4 w; w[0] = pk2(v0[0], v0[1]); w[1] = pk2(v0[2], v0[3]); w[2] = pk2(v1[0], v1[1]); w[3] = pk2(v1[2], v1[3]);
                    *(u32x4*)(EB + (size_t)row * DM + col0) = w;
                }
                asm volatile("" ::: "memory");
            }
    }
};

template <bool BB> struct EpiOut {
    static constexpr bool PERM = true, AFTER_DRAIN = false; static constexpr int MID_T = 8;
    const float* base; const bf16_t* baseb; bf16_t* HB; float* ss; const float* ssC;
    __device__ __forceinline__ void mid(f32x4 (&acc)[2][2][4][2], const pg8::Unit& u) const {
        int t_ = threadIdx.x; asm volatile("" : "+v"(t_));
        const int lane = t_ & 63, fr = lane & 15, fq = lane >> 4, wid_ = __builtin_amdgcn_readfirstlane(t_ >> 6), wr = wid_ >> 2;
        f32x2 pc[2][4];
#pragma unroll
        for (int ai = 0; ai < 2; ++ai)
#pragma unroll
            for (int m = 0; m < 4; ++m) pc[ai][m] = *(const f32x2*)(ssC + (size_t)(u.pm * 256 + ai * 128 + wr * 64 + m * 16 + fr) * 8 + fq * 2);
#pragma unroll
        for (int ai = 0; ai < 2; ++ai)
#pragma unroll
            for (int m = 0; m < 4; ++m) {
                const f32x2 p = pc[ai][m];
                float s = p[0] + p[1];
                s += shx(s, 16, lane); s += shx(s, 32, lane);
                const float rs = frsq(s * (1.0f / CD) + EPS);
#pragma unroll
                for (int bj = 0; bj < 2; ++bj)
#pragma unroll
                    for (int n = 0; n < 2; ++n) acc[ai][bj][m][n] = acc[ai][bj][m][n] * rs;
            }
    }
    __device__ __forceinline__ void operator()(const f32x4 (&acc)[2][2][4][2], const pg8::Unit& u, int, int, int, int) const {
        int t_ = threadIdx.x; asm volatile("" : "+v"(t_));
        const int lane = t_ & 63, fr = lane & 15, fq = lane >> 4, wid_ = __builtin_amdgcn_readfirstlane(t_ >> 6), wr = wid_ >> 2, wc = wid_ & 3;
#pragma unroll
        for (int ai = 0; ai < 2; ++ai)
#pragma unroll
            for (int mp = 0; mp < 2; ++mp) {
                f32x4 bs[2][2][2];
#pragma unroll
                for (int mm = 0; mm < 2; ++mm)
#pragma unroll
                    for (int bj = 0; bj < 2; ++bj) {
                        const size_t off = (size_t)(u.pm * 256 + ai * 128 + wr * 64 + (2 * mp + mm) * 16 + fr) * DM + u.pn * 256 + bj * 128 + wc * 32 + 8 * fq;
                        if constexpr (BB) { const u32x4 r1 = *(const u32x4*)(baseb + off); f32x4 t0 = {bflo(r1[0]), bfhi(r1[0]), bflo(r1[1]), bfhi(r1[1])}, t1 = {bflo(r1[2]), bfhi(r1[2]), bflo(r1[3]), bfhi(r1[3])}; bs[mm][bj][0] = t0; bs[mm][bj][1] = t1; }
                        else { bs[mm][bj][0] = *(const f32x4*)(base + off); bs[mm][bj][1] = *(const f32x4*)(base + off + 4); }
                    }
#pragma unroll
                for (int mm = 0; mm < 2; ++mm) {
                    const int m = 2 * mp + mm;
                    const int row = u.pm * 256 + ai * 128 + wr * 64 + m * 16 + fr;
                    float sq = 0.f;
#pragma unroll
                    for (int bj = 0; bj < 2; ++bj) {
                        const size_t off = (size_t)row * DM + u.pn * 256 + bj * 128 + wc * 32 + 8 * fq;
                        const f32x4 h0 = bs[mm][bj][0] + acc[ai][bj][m][0], h1 = bs[mm][bj][1] + acc[ai][bj][m][1];
                        u32x4 w; w[0] = pk2(h0[0], h0[1]); w[1] = pk2(h0[2], h0[3]); w[2] = pk2(h1[0], h1[1]); w[3] = pk2(h1[2], h1[3]);
                        *(u32x4*)(HB + off) = w;
                        sq += (h0[0] * h0[0] + h0[1] * h0[1]) + (h0[2] * h0[2] + h0[3] * h0[3]) + (h1[0] * h1[0] + h1[1] * h1[1]) + (h1[2] * h1[2] + h1[3] * h1[3]);
                    }
                    sq += shx(sq, 16, lane); sq += shx(sq, 32, lane);
                    if (fq == 0) ss[(size_t)row * 16 + u.pn * 4 + wc] = sq;
                }
                asm volatile("" ::: "memory");
            }
    }
};

template <bool WF> struct EpiGate {
    static constexpr bool PERM = true, AFTER_DRAIN = false; static constexpr int MID_T = 0;
    float* out; const bf16_t* H1; const bf16_t* EB; bf16_t* HB; const float* ss_in; float* ss_out; int dummy;
    __device__ __forceinline__ void operator()(const f32x4 (&acc)[2][2][4][2], const pg8::Unit& u, int, int, int, int) const {
        int t_ = threadIdx.x; asm volatile("" : "+v"(t_));
        const int lane = t_ & 63, fr = lane & 15, fq = lane >> 4, wid_ = __builtin_amdgcn_readfirstlane(t_ >> 6), wr = wid_ >> 2, wc = wid_ & 3;
        f32x4 pp[2][4];
#pragma unroll
        for (int ai = 0; ai < 2; ++ai)
#pragma unroll
            for (int m = 0; m < 4; ++m) pp[ai][m] = *(const f32x4*)(ss_in + (size_t)(u.pm * 256 + ai * 128 + wr * 64 + m * 16 + fr) * 16 + fq * 4);
        float rsv[2][4];
#pragma unroll
        for (int ai = 0; ai < 2; ++ai)
#pragma unroll
            for (int m = 0; m < 4; ++m) {
                float s_ = (pp[ai][m][0] + pp[ai][m][1]) + (pp[ai][m][2] + pp[ai][m][3]);
                s_ += shx(s_, 16, lane); s_ += shx(s_, 32, lane);
                rsv[ai][m] = frsq(s_ * (1.0f / DM) + EPS);
            }
        asm volatile("" ::: "memory");
#pragma unroll
        for (int ai = 0; ai < 2; ++ai)
#pragma unroll
            for (int mp = 0; mp < 2; ++mp) {
                u32x4 bs[2][2], es[2][2];
#pragma unroll
                for (int mm = 0; mm < 2; ++mm)
#pragma unroll
                    for (int bj = 0; bj < 2; ++bj) {
                        const size_t off = (size_t)(u.pm * 256 + ai * 128 + wr * 64 + (2 * mp + mm) * 16 + fr) * DM + u.pn * 256 + bj * 128 + wc * 32 + 8 * fq;
                        bs[mm][bj] = *(const u32x4*)(H1 + off); es[mm][bj] = *(const u32x4*)(EB + off);
                    }
#pragma unroll
                for (int mm = 0; mm < 2; ++mm) {
                    const int m = 2 * mp + mm;
                    const int row = u.pm * 256 + ai * 128 + wr * 64 + m * 16 + fr;
                    const float rs = rsv[ai][m];
                    float sq = 0.f;
#pragma unroll
                    for (int bj = 0; bj < 2; ++bj) {
                        const size_t off = (size_t)row * DM + u.pn * 256 + bj * 128 + wc * 32 + 8 * fq;
                        const f32x4 a0 = acc[ai][bj][m][0] * rs, a1 = acc[ai][bj][m][1] * rs;
                        const u32x4 e = es[mm][bj]; const u32x4 r1 = bs[mm][bj];
                        f32x4 h0 = {bflo(r1[0]), bfhi(r1[0]), bflo(r1[1]), bfhi(r1[1])}, h1 = {bflo(r1[2]), bfhi(r1[2]), bflo(r1[3]), bfhi(r1[3])};
                        h0[0] += bflo(e[0]) * sigmoidf_(a0[0]); h0[1] += bfhi(e[0]) * sigmoidf_(a0[1]); h0[2] += bflo(e[1]) * sigmoidf_(a0[2]); h0[3] += bfhi(e[1]) * sigmoidf_(a0[3]);
                        h1[0] += bflo(e[2]) * sigmoidf_(a1[0]); h1[1] += bfhi(e[2]) * sigmoidf_(a1[1]); h1[2] += bflo(e[3]) * sigmoidf_(a1[2]); h1[3] += bfhi(e[3]) * sigmoidf_(a1[3]);
                        if constexpr (WF) { *(f32x4*)(out + off) = h0; *(f32x4*)(out + off + 4) = h1; }
                        u32x4 w; w[0] = pk2(h0[0], h0[1]); w[1] = pk2(h0[2], h0[3]); w[2] = pk2(h1[0], h1[1]); w[3] = pk2(h1[2], h1[3]);
                        *(u32x4*)(HB + off) = w;
                        sq += (h0[0] * h0[0] + h0[1] * h0[1]) + (h0[2] * h0[2] + h0[3] * h0[3]) + (h1[0] * h1[0] + h1[1] * h1[1]) + (h1[2] * h1[2] + h1[3] * h1[3]);
                    }
                    sq += shx(sq, 16, lane); sq += shx(sq, 32, lane);
                    if (fq == 0) ss_out[(size_t)row * 16 + u.pn * 4 + wc] = sq;
                }
                asm volatile("" ::: "memory");
            }
    }
};

struct SubOrder {
    int nN, nwg, nb, c;
    __device__ void init(int M, int N, int nb_, int c_) { nN = N / 256; nwg = (M / 256) * nN; nb = nb_; c = c_; }
    __device__ bool next(int i, pg8::Unit& u) const { if (c < 0 || c >= nb) return false; const int L = i * nb + c; if (L >= nwg) return false; u.pm = L / nN; u.pn = L % nN; return true; }
    __device__ __forceinline__ void a_ready(const pg8::Unit&) const {}
    __device__ __forceinline__ void done(const pg8::Unit&) const {}
};

template <bool REMAP>
__device__ __forceinline__ void tr_item(const float* W, int K, int N, bf16_t* WT, const float* g, LAS float* scr, int item, int lane, int kshift = 0) {
    const int nblk = N / 32, kb = item / nblk, nb = item % nblk, k0 = 64 * kb, n0 = 32 * nb;
    int src = n0 + (lane & 31);
    if (REMAP) { if (src >= 2048 && src < 3072) { const int jj = src - 2048; src = (jj & 1) ? 2560 + (jj >> 1) : 2048 + (jj >> 1); } }
    float wv[32];
#pragma unroll
    for (int i = 0; i < 32; ++i) { const int kk = 2 * i + (lane >> 5); wv[i] = W[(size_t)((k0 + kk + kshift) & (K - 1)) * N + src]; }
#pragma unroll
    for (int i = 0; i < 32; ++i) { const int kk = 2 * i + (lane >> 5); float v = wv[i]; if (g) v *= g[k0 + kk]; scr[kk * 33 + (lane & 31)] = v; }
    asm volatile("s_waitcnt lgkmcnt(0)" ::: "memory");
    const int c = lane & 7;
#pragma unroll
    for (int j = 0; j < 4; ++j) { const int n = (lane >> 3) + 8 * j; const LAS float* s = scr + (8 * c) * 33 + n;
        u32x4 o; o[0] = pk2(s[0 * 33], s[1 * 33]); o[1] = pk2(s[2 * 33], s[3 * 33]); o[2] = pk2(s[4 * 33], s[5 * 33]); o[3] = pk2(s[6 * 33], s[7 * 33]);
        *(u32x4*)(WT + (size_t)(n0 + n) * K + k0 + 8 * c) = o; }
    asm volatile("s_waitcnt lgkmcnt(0)" ::: "memory");
}

constexpr int AK_STRIDE = 144, AV_STRIDE = 136, A_KBYTES = 64 * AK_STRIDE, A_VBYTES = 64 * AV_STRIDE, A_BUF = 18432;
static_assert(A_KBYTES + A_VBYTES <= A_BUF, "attention LDS buffer");

constexpr int AW_BYTES = A_KBYTES + A_VBYTES;
static_assert(8 * AW_BYTES <= LDS_BYTES - 64, "attention LDS");
__device__ __forceinline__ void attn_wave(const bf16_t* U, const bf16_t* VT, bf16_t* Y, const float* aog, int b, int h, int qblk, LAS unsigned char* lds) {
    int tid = threadIdx.x; asm volatile("" : "+v"(tid));
    const int wave = __builtin_amdgcn_readfirstlane(tid >> 6), lane = tid & 63, l31 = lane & 31, hi = lane >> 5;
    const int q0 = qblk * 32, t = q0 + l31;
    const size_t trow = (size_t)(b * SEQ + t);
    bf16x8 qf[4];
    {
        const bf16_t* qp = U + trow * UP + UQ + h * HD + 8 * hi;
#pragma unroll
        for (int s = 0; s < 4; ++s) qf[s] = *(const bf16x8*)(qp + 16 * s);
    }
    f32x16 o0, o1;
#pragma unroll
    for (int i = 0; i < 16; ++i) { o0[i] = 0.f; o1[i] = 0.f; }
    float C = 1.f;
    const int ktmax = (q0 + 30) >> 6;
    const int srow = lane >> 3, sch = lane & 7;
    const bf16_t* gk = U + (size_t)(b * SEQ + srow) * UP + UK + h * HD + sch * 8;
    const bf16_t* gv = VT + ((size_t)((b * NH + h) * HD + srow)) * SEQ + sch * 8;
    LAS unsigned char* kb = lds + wave * AW_BYTES;
    LAS unsigned char* vb = kb + A_KBYTES;
    const int kwoff = srow * AK_STRIDE + sch * 16, vwoff = srow * AV_STRIDE + sch * 16;
    u32x4 kr[8], vr[8];
#pragma unroll
    for (int i = 0; i < 8; ++i) { kr[i] = *(const u32x4*)(gk + (size_t)(ktmax * 64 + 8 * i) * UP); vr[i] = *(const u32x4*)(gv + (size_t)(8 * i) * SEQ + ktmax * 64); }
    for (int kt = ktmax; kt >= 0; --kt) {
#pragma unroll
        for (int i = 0; i < 8; ++i) {
            *(LAS u32x4*)(kb + kwoff + 8 * i * AK_STRIDE) = kr[i];
            u32x2 a = {vr[i][0], vr[i][1]}, c = {vr[i][2], vr[i][3]};
            *(LAS u32x2*)(vb + vwoff + 8 * i * AV_STRIDE) = a; *(LAS u32x2*)(vb + vwoff + 8 * i * AV_STRIDE + 8) = c;
        }
        if (kt > 0) {
#pragma unroll
            for (int i = 0; i < 8; ++i) { kr[i] = *(const u32x4*)(gk + (size_t)((kt - 1) * 64 + 8 * i) * UP); vr[i] = *(const u32x4*)(gv + (size_t)(8 * i) * SEQ + (kt - 1) * 64); }
        }
        {
            f32x16 p0, p1;
#pragma unroll
            for (int i = 0; i < 16; ++i) { p0[i] = 0.f; p1[i] = 0.f; }
#pragma unroll
            for (int s = 0; s < 4; ++s) {
                const bf16x8 ka = *(const LAS bf16x8*)(kb + l31 * AK_STRIDE + 32 * s + 16 * hi);
                const bf16x8 kc = *(const LAS bf16x8*)(kb + (32 + l31) * AK_STRIDE + 32 * s + 16 * hi);
                p0 = MFMA32(ka, qf[s], p0); p1 = MFMA32(kc, qf[s], p1);
            }
            const int lim0 = t - (64 * kt + 4 * hi), lim1 = lim0 - 32;
            const bool diag = (64 * kt + 63 >= q0);
            f32x16 m0, m1;
            float G0[4], G1[4];
#pragma unroll
            for (int g = 0; g < 4; ++g) {
                float s0 = 1.f, s1 = 1.f;
#pragma unroll
                for (int i = 0; i < 4; ++i) {
                    const int r = 4 * g + i, cr = i + 8 * g;
                    const float e0 = fexp2(fminf(p0[r], 100.f)), e1 = fexp2(fminf(p1[r], 100.f));
                    float r0 = frcp(1.0f + e0), r1 = frcp(1.0f + e1);
                    float b0 = e0 * r0, b1 = e1 * r1;
                    if (diag) { const bool v0 = cr < lim0, v1 = cr < lim1; r0 = v0 ? r0 : 1.f; b0 = v0 ? b0 : 0.f; r1 = v1 ? r1 : 1.f; b1 = v1 ? b1 : 0.f; }
                    m0[r] = r0; m1[r] = r1; p0[r] = b0; p1[r] = b1; s0 *= r0; s1 *= r1;
                }
                G0[g] = s0; G1[g] = s1;
            }
            float X0[4], X1[4];
#pragma unroll
            for (int g = 0; g < 4; ++g) { X0[g] = shx(G0[g], 32, lane); X1[g] = shx(G1[g], 32, lane); }
            float run = C;
#pragma unroll
            for (int g = 3; g >= 0; --g) {
                float a = hi == 0 ? run * X1[g] : run;
#pragma unroll
                for (int i = 3; i >= 0; --i) { const int r = 4 * g + i; const float w = a * p1[r]; a *= m1[r]; p1[r] = w; }
                run *= G1[g] * X1[g];
            }
#pragma unroll
            for (int g = 3; g >= 0; --g) {
                float a = hi == 0 ? run * X0[g] : run;
#pragma unroll
                for (int i = 3; i >= 0; --i) { const int r = 4 * g + i; const float w = a * p0[r]; a *= m0[r]; p0[r] = w; }
                run *= G0[g] * X0[g];
            }
            C = run;
#pragma unroll
            for (int kh = 0; kh < 2; ++kh)
#pragma unroll
                for (int sh = 0; sh < 2; ++sh) {
                    u32x4 xw;
                    if (kh == 0) { xw[0] = pk2(p0[8 * sh + 0], p0[8 * sh + 1]); xw[1] = pk2(p0[8 * sh + 2], p0[8 * sh + 3]); xw[2] = pk2(p0[8 * sh + 4], p0[8 * sh + 5]); xw[3] = pk2(p0[8 * sh + 6], p0[8 * sh + 7]); }
                    else         { xw[0] = pk2(p1[8 * sh + 0], p1[8 * sh + 1]); xw[1] = pk2(p1[8 * sh + 2], p1[8 * sh + 3]); xw[2] = pk2(p1[8 * sh + 4], p1[8 * sh + 5]); xw[3] = pk2(p1[8 * sh + 6], p1[8 * sh + 7]); }
                    const bf16x8 xf = __builtin_bit_cast(bf16x8, xw);
                    const int koff = 2 * (32 * kh + 16 * sh + 4 * hi);
                    {
                        const LAS unsigned char* vp = vb + l31 * AV_STRIDE + koff;
                        const u32x2 lo = *(const LAS u32x2*)vp, hh = *(const LAS u32x2*)(vp + 16);
                        u32x4 vw = {lo[0], lo[1], hh[0], hh[1]};
                        o0 = MFMA32(__builtin_bit_cast(bf16x8, vw), xf, o0);
                    }
                    {
                        const LAS unsigned char* vp = vb + (32 + l31) * AV_STRIDE + koff;
                        const u32x2 lo = *(const LAS u32x2*)vp, hh = *(const LAS u32x2*)(vp + 16);
                        u32x4 vw = {lo[0], lo[1], hh[0], hh[1]};
                        o1 = MFMA32(__builtin_bit_cast(bf16x8, vw), xf, o1);
                    }
                }
        }
        if (__builtin_amdgcn_ballot_w64(C > 9.094947e-13f) == 0ull) break;
    }
    float sq = 0.f;
#pragma unroll
    for (int i = 0; i < 16; ++i) sq += o0[i] * o0[i] + o1[i] * o1[i];
    sq += shx(sq, 32, lane);
    const float rs = frsq(sq * (1.0f / HD) + EPS);
    const bf16_t* sgp = U + trow * UP + USGA + h * HD;
    bf16_t* yp = Y + trow * DM + 512 + h * HD;
#pragma unroll
    for (int dt = 0; dt < 2; ++dt)
#pragma unroll
        for (int g = 0; g < 4; ++g) {
            const int d0 = 32 * dt + 8 * g + 4 * hi;
            const f32x4 gn = *(const f32x4*)(aog + d0);
            const u32x2 sg = *(const u32x2*)(sgp + d0);
            float v0, v1, v2, v3;
            if (dt == 0) { v0 = o0[4 * g + 0]; v1 = o0[4 * g + 1]; v2 = o0[4 * g + 2]; v3 = o0[4 * g + 3]; }
            else         { v0 = o1[4 * g + 0]; v1 = o1[4 * g + 1]; v2 = o1[4 * g + 2]; v3 = o1[4 * g + 3]; }
            u32x2 w;
            w[0] = pk2(v0 * rs * gn[0] * bflo(sg[0]), v1 * rs * gn[1] * bfhi(sg[0]));
            w[1] = pk2(v2 * rs * gn[2] * bflo(sg[1]), v3 * rs * gn[3] * bfhi(sg[1]));
            *(u32x2*)(yp + d0) = w;
        }
}

constexpr int CT = 32, C_XH = 0, C_XH_BYTES = (CT + 30) * 1024, C_CO = C_XH_BYTES, C_CO_BYTES = CT * CD * 4;
static_assert(C_CO + C_CO_BYTES <= LDS_BYTES, "conv LDS map");

__device__ __forceinline__ void convpre_unit(const bf16_t* U, bf16_t* C2, const float* dww, const float* dwb, const float* lng, const float* lnb, int cu, LAS unsigned char* lds) {
    int tid = threadIdx.x; asm volatile("" : "+v"(tid));
    const int wave = __builtin_amdgcn_readfirstlane(tid >> 6), lane = tid & 63;
    const int r0 = cu * CT, b = r0 >> 11, s0 = r0 & 2047;
    __syncthreads();
    for (int i = tid; i < (CT + 30) * 64; i += 512) {
        const int row = i >> 6, ch = i & 63, s = s0 - 30 + row;
        u32x4 v = {0u, 0u, 0u, 0u};
        if (s >= 0) v = *(const u32x4*)(U + (size_t)(b * SEQ + s) * UP + UGLU + ch * 8);
        *(LAS u32x4*)(lds + C_XH + row * 1024 + ch * 16) = v;
    }
    __syncthreads();
    {
        const int chp = tid & 255, tg = tid >> 8;
        f32x2 w2[CWID];
#pragma unroll
        for (int j = 0; j < CWID; ++j) w2[j] = *(const f32x2*)(dww + (size_t)j * CD + 2 * chp);
        const f32x2 bias = *(const f32x2*)(dwb + 2 * chp);
        const LAS unsigned char* xp = lds + C_XH + (tg * 16) * 1024 + chp * 4;
        f32x2 xv[16 + CWID - 1];
#pragma unroll
        for (int i = 0; i < 16 + CWID - 1; ++i) { const unsigned xu = *(const LAS unsigned*)(xp + i * 1024); f32x2 t2 = {bflo(xu), bfhi(xu)}; xv[i] = t2; }
#pragma unroll
        for (int tt = 0; tt < 16; ++tt) {
            f32x2 a = bias;
#pragma unroll
            for (int j = 0; j < CWID; ++j) a = a + w2[j] * xv[tt + j];
            *(LAS f32x2*)(lds + C_CO + (tg * 16 + tt) * 2048 + chp * 8) = a;
        }
    }
    __syncthreads();
    {
        const f32x4 g0 = *(const f32x4*)(lng + lane * 4), g1 = *(const f32x4*)(lng + 256 + lane * 4);
        const f32x4 b0 = *(const f32x4*)(lnb + lane * 4), b1 = *(const f32x4*)(lnb + 256 + lane * 4);
#pragma unroll
        for (int tt = 0; tt < 4; ++tt) {
            const int tl = wave * 4 + tt;
            f32x4 v0 = *(const LAS f32x4*)(lds + C_CO + tl * 2048 + lane * 16), v1 = *(const LAS f32x4*)(lds + C_CO + tl * 2048 + 1024 + lane * 16);
            const float mean = wave_sum((v0[0] + v0[1]) + (v0[2] + v0[3]) + (v1[0] + v1[1]) + (v1[2] + v1[3]), lane) * (1.0f / CD);
            v0 = v0 - mean; v1 = v1 - mean;
            const float var = wave_sum((v0[0] * v0[0] + v0[1] * v0[1]) + (v0[2] * v0[2] + v0[3] * v0[3]) + (v1[0] * v1[0] + v1[1] * v1[1]) + (v1[2] * v1[2] + v1[3] * v1[3]), lane) * (1.0f / CD);
            const float rs = frsq(var + EPS);
            v0 = v0 * rs * g0 + b0; v1 = v1 * rs * g1 + b1;
            u32x2 wa, wb;
            wa[0] = pk2(siluf_(v0[0]), siluf_(v0[1])); wa[1] = pk2(siluf_(v0[2]), siluf_(v0[3]));
            wb[0] = pk2(siluf_(v1[0]), siluf_(v1[1])); wb[1] = pk2(siluf_(v1[2]), siluf_(v1[3]));
            bf16_t* cp = C2 + (size_t)(r0 + tl) * CD + lane * 4;
            *(u32x2*)cp = wa; *(u32x2*)(cp + 256) = wb;
        }
    }
}

#define XB_TMO      128
#define XB_XCNT(j)  (256  + 64 * (j))
#define XB_XSUB(j)  (1280 + 64 * (j))
#define XB_XGEN(j)  (2304 + 64 * (j))
#define XB_TOP      3328
#define XB_TOPGEN   3392
#define XCD_BAR_WORDS 3456
#define XB_SPIN_CAP (1u << 18)

__device__ __forceinline__ unsigned xb_ld(unsigned* p)              { return __hip_atomic_load(p, __ATOMIC_RELAXED, __HIP_MEMORY_SCOPE_AGENT); }
__device__ __forceinline__ unsigned xb_add(unsigned* p, unsigned v) { return __hip_atomic_fetch_add(p, v, __ATOMIC_RELAXED, __HIP_MEMORY_SCOPE_AGENT); }
__device__ __forceinline__ unsigned xb_xcc_id() { return (unsigned)__builtin_amdgcn_s_getreg((3 << 11) | 20) & 0xFu; }
#define XB_SPIN(cond, bar) do { unsigned _sp = 0; while (cond) { __builtin_amdgcn_s_sleep(1); \
    if ((++_sp & 255u) == 0u) { if (xb_ld(&(bar)[XB_TMO])) break; if (_sp > XB_SPIN_CAP) { atomicAdd(&(bar)[XB_TMO], 1u); break; } } } } while (0)

struct XcdBarrier {
    unsigned* bar; unsigned x;
    volatile LAS unsigned* st;
};

__device__ __forceinline__ XcdBarrier xcd_barrier_post(unsigned* bar, volatile LAS unsigned* st) {
    XcdBarrier b; b.bar = bar; b.x = xb_xcc_id(); b.st = st;
    if (threadIdx.x == 0) (void)xb_add(&bar[XB_XCNT(b.x)], 1u);
    return b;
}
__device__ __forceinline__ void xcd_barrier_complete(unsigned* bar, unsigned x, unsigned& nloc, unsigned& nx) {
    const unsigned G = gridDim.x * gridDim.y * gridDim.z;
    unsigned sum, cnt, mine, sp = 0u;
    for (;;) {
        sum = 0u; cnt = 0u; mine = 0u;
#pragma unroll
        for (unsigned j = 0; j < 16; ++j) { const unsigned c = xb_ld(&bar[XB_XCNT(j)]); sum += c; cnt += (c > 0u) ? 1u : 0u; mine = (j == x) ? c : mine; }
        if (sum == G) break;
        __builtin_amdgcn_s_sleep(1);
        if ((++sp & 255u) == 0u) { if (xb_ld(&bar[XB_TMO])) break; if (sp > XB_SPIN_CAP) { atomicAdd(&bar[XB_TMO], 1u); break; } }
    }
    nloc = mine > 0u ? mine : 1u; nx = cnt > 0u ? cnt : 1u;
}

__device__ __forceinline__ void xcd_barrier(const XcdBarrier& b) {
    asm volatile("s_waitcnt vmcnt(0)" ::: "memory");
    __syncthreads();
    if (threadIdx.x == 0) {
        unsigned* bar = b.bar;
        __builtin_amdgcn_s_waitcnt(0);
        unsigned nloc = b.st[0], nx = b.st[1];
        if (nloc == 0u) { xcd_barrier_complete(bar, b.x, nloc, nx); b.st[0] = nloc; b.st[1] = nx; }
        const unsigned old = xb_add(&bar[XB_XSUB(b.x)], 1u);
        const unsigned gen = old / nloc;
        if (old + 1u == (gen + 1u) * nloc) {
            __builtin_amdgcn_fence(__ATOMIC_RELEASE, "agent");
            asm volatile("s_waitcnt vmcnt(0)" ::: "memory");
            const unsigned og = xb_add(&bar[XB_TOP], 1u);
            const unsigned tg = og / nx;
            if (og + 1u == (tg + 1u) * nx) xb_add(&bar[XB_TOPGEN], 1u);
            else XB_SPIN(xb_ld(&bar[XB_TOPGEN]) == tg, bar);
            __builtin_amdgcn_fence(__ATOMIC_ACQUIRE, "agent");
            xb_add(&bar[XB_XGEN(b.x)], 1u);
            asm volatile("s_waitcnt vmcnt(0)" ::: "memory");
        } else {
            XB_SPIN(xb_ld(&bar[XB_XGEN(b.x)]) == gen, bar);
            __builtin_amdgcn_fence(__ATOMIC_ACQUIRE, "agent");
            asm volatile("s_waitcnt vmcnt(0)" ::: "memory");
        }
    }
    __syncthreads();
}

struct Params { const float* in[16]; float* out; unsigned char* ws; int ph_lo, ph_hi; };

template <int ph>
__device__ __forceinline__ void run_phase(const Params& P, LAS unsigned char* lds) {
    const int G = gridDim.x, bid = blockIdx.x;
    unsigned char* ws = P.ws;
    const float* x = P.in[0];
    float* out = P.out;
    bf16_t* HB = (bf16_t*)(ws + WS_HB); bf16_t* H1B = (bf16_t*)(ws + WS_H1B); bf16_t* Ub = (bf16_t*)(ws + WS_U); bf16_t* VT = (bf16_t*)(ws + WS_VT); bf16_t* Yb = (bf16_t*)(ws + WS_Y);
    bf16_t* C2 = (bf16_t*)(ws + WS_C2); bf16_t* EB = (bf16_t*)(ws + WS_EB);
    float* ssA = (float*)(ws + WS_SSA); float* ssB = (float*)(ws + WS_SSB); float* ssC = (float*)(ws + WS_SSC);
    int tid = threadIdx.x; asm volatile("" : "+v"(tid));
    const int lane = tid & 63, wave = __builtin_amdgcn_readfirstlane(tid >> 6);
    const int gw = bid * 8 + wave, NGW = G * 8;
    if constexpr (ph == 0) {
        LAS float* scr = (LAS float*)(lds + wave * 16384);
        for (int it = gw; it < 2 * 3072; it += NGW) {
            const int l = it / 3072; int r = it - l * 3072;
            unsigned char* wb = ws + (size_t)l * W_LAYER;
            if (r < 1792) { tr_item<true>(P.in[3] + (size_t)l * DM * DIN, DM, DIN, (bf16_t*)(wb + W_IN), P.in[2] + l * DM, scr, r, lane); continue; } r -= 1792;
            if (r < 128) { tr_item<false>(P.in[9] + (size_t)l * CD * CD, CD, CD, (bf16_t*)(wb + W_PW), nullptr, scr, r, lane); continue; } r -= 128;
            if (r < 512) { tr_item<false>(P.in[11] + (size_t)l * DM * DM, DM, DM, (bf16_t*)(wb + W_OUT), nullptr, scr, r, lane, 512); continue; } r -= 512;
            if (r < 512) { tr_item<false>(P.in[13] + (size_t)l * DM * DM, DM, DM, (bf16_t*)(wb + W_PG), P.in[12] + l * DM, scr, r, lane); continue; } r -= 512;
            tr_item<false>(P.in[14] + (size_t)l * PLE * DM, PLE, DM, (bf16_t*)(wb + W_PLE), nullptr, scr, r, lane);
        }
        for (int row = gw; row < MT; row += 2 * NGW) {
            const int row2 = row + NGW;
            const f32x4* xr = (const f32x4*)(x + (size_t)row * DM) + lane;
            const f32x4* xr2 = (const f32x4*)(x + (size_t)(row2 < MT ? row2 : row) * DM) + lane;
            f32x4 va[4], vb[4];
#pragma unroll
            for (int j = 0; j < 4; ++j) { va[j] = xr[64 * j]; vb[j] = xr2[64 * j]; }
            u32x2* ob = (u32x2*)(HB + (size_t)row * DM) + lane;
            float s = 0.f, s2 = 0.f;
#pragma unroll
            for (int j = 0; j < 4; ++j) { const f32x4 v = va[j]; s += (v[0] * v[0] + v[1] * v[1]) + (v[2] * v[2] + v[3] * v[3]); u32x2 w; w[0] = pk2(v[0], v[1]); w[1] = pk2(v[2], v[3]); ob[64 * j] = w; }
            s = wave_sum(s, lane);
            if (lane < 16) ssA[(size_t)row * 16 + lane] = (lane == 0) ? s : 0.f;
            if (row2 < MT) {
                u32x2* ob2 = (u32x2*)(HB + (size_t)row2 * DM) + lane;
#pragma unroll
                for (int j = 0; j < 4; ++j) { const f32x4 v = vb[j]; s2 += (v[0] * v[0] + v[1] * v[1]) + (v[2] * v[2] + v[3] * v[3]); u32x2 w; w[0] = pk2(v[0], v[1]); w[1] = pk2(v[2], v[3]); ob2[64 * j] = w; }
                s2 = wave_sum(s2, lane);
                if (lane < 16) ssA[(size_t)row2 * 16 + lane] = (lane == 0) ? s2 : 0.f;
            }
        }
        {
            const f32x4* pp = (const f32x4*)P.in[1]; u32x2* pb = (u32x2*)(ws + WS_PB);
            const int NV = 2 * MT * PLE / 4, stp = G * 512;
            for (int i = bid * 512 + tid; i < NV; i += 4 * stp) {
                f32x4 v[4];
#pragma unroll
                for (int j = 0; j < 4; ++j) { const int ii = i + j * stp; v[j] = pp[ii < NV ? ii : i]; }
#pragma unroll
                for (int j = 0; j < 4; ++j) { const int ii = i + j * stp; if (ii < NV) { u32x2 w; w[0] = pk2(v[j][0], v[j][1]); w[1] = pk2(v[j][2], v[j][3]); pb[ii] = w; } }
            }
        }
    } else if constexpr (ph == NPHASE - 1) {
        const float* fg = P.in[15];
        for (int row = gw; row < MT; row += 2 * NGW) {
            const int row2 = row + NGW; const bool has2 = row2 < MT; const int r2 = has2 ? row2 : row;
            const u32x4* hr = (const u32x4*)(HB + (size_t)row * DM) + lane; const u32x4* hr2 = (const u32x4*)(HB + (size_t)r2 * DM) + lane;
            const u32x4 a0 = hr[0], a1 = hr[64], b0 = hr2[0], b1 = hr2[64];
            const float p1 = (lane < 16) ? ssA[(size_t)row * 16 + lane] : 0.f, p2 = (lane < 16) ? ssA[(size_t)r2 * 16 + lane] : 0.f;
            const f32x4 g0 = *(const f32x4*)(fg + 8 * lane), g1 = *(const f32x4*)(fg + 8 * lane + 4), g2 = *(const f32x4*)(fg + 512 + 8 * lane), g3 = *(const f32x4*)(fg + 512 + 8 * lane + 4);
            const float rs = frsq(wave_sum(p1, lane) * (1.0f / DM) + EPS), rs2 = frsq(wave_sum(p2, lane) * (1.0f / DM) + EPS);
            float* o = out + (size_t)row * DM + 8 * lane;
            { f32x4 t0 = {bflo(a0[0]), bfhi(a0[0]), bflo(a0[1]), bfhi(a0[1])}, t1 = {bflo(a0[2]), bfhi(a0[2]), bflo(a0[3]), bfhi(a0[3])}, t2 = {bflo(a1[0]), bfhi(a1[0]), bflo(a1[1]), bfhi(a1[1])}, t3 = {bflo(a1[2]), bfhi(a1[2]), bflo(a1[3]), bfhi(a1[3])};
              *(f32x4*)o = t0 * rs * g0; *(f32x4*)(o + 4) = t1 * rs * g1; *(f32x4*)(o + 512) = t2 * rs * g2; *(f32x4*)(o + 516) = t3 * rs * g3; }
            if (has2) {
                float* o2 = out + (size_t)row2 * DM + 8 * lane;
                f32x4 t0 = {bflo(b0[0]), bfhi(b0[0]), bflo(b0[1]), bfhi(b0[1])}, t1 = {bflo(b0[2]), bfhi(b0[2]), bflo(b0[3]), bfhi(b0[3])}, t2 = {bflo(b1[0]), bfhi(b1[0]), bflo(b1[1]), bfhi(b1[1])}, t3 = {bflo(b1[2]), bfhi(b1[2]), bflo(b1[3]), bfhi(b1[3])};
                *(f32x4*)o2 = t0 * rs2 * g0; *(f32x4*)(o2 + 4) = t1 * rs2 * g1; *(f32x4*)(o2 + 512) = t2 * rs2 * g2; *(f32x4*)(o2 + 516) = t3 * rs2 * g3;
            }
        }
    } else {
        constexpr int l = (ph - 1) / 5, k = (ph - 1) % 5;
        unsigned char* wb = ws + (size_t)l * W_LAYER;
        if constexpr (k == 0) {
            pg8::Gemm g{HB, (const bf16_t*)(wb + W_IN), MT, DIN - CD, DM}; pg8::StaticOrder S; S.init(MT, DIN - CD, G, bid);
            EpiIn E{Ub, VT, ssA, 0};
            pg8::gemm_phase<EpiIn, pg8::StaticOrder, true, true>(lds, g, S, E, threadIdx.x);
        } else if constexpr (k == 1) {
            const float* aog = P.in[4] + l * HD;
            const float* dww = P.in[5] + (size_t)l * CWID * CD; const float* dwb = P.in[6] + l * CD;
            const float* lng = P.in[7] + l * CD; const float* lnb = P.in[8] + l * CD;
            const int nb0 = G / 2; const bool gcu = bid < nb0;
            {
                pg8::Gemm g{HB, (const bf16_t*)(wb + W_IN) + (size_t)(DIN - CD) * DM, MT, CD, DM}; SubOrder S; S.init(MT, CD, nb0, bid);
                EpiIn E{Ub, VT, ssA, 12};
                pg8::gemm_phase<EpiIn, SubOrder, true, true>(lds, g, S, E, threadIdx.x);
            }
            __syncthreads();
            constexpr int NITEM = NB * NH * (SEQ / 32);
            const int n0 = (NITEM * 5 / 8) / nb0, n1 = (NITEM - n0 * nb0) / (G - nb0);
            const int i_lo = gcu ? bid * n0 : n0 * nb0 + (bid - nb0) * n1;
            const int i_hi = gcu ? i_lo + n0 : ((bid == G - 1) ? NITEM : i_lo + n1);
#pragma unroll 1
            for (int rep_ = 0; rep_ < ((PROBE_DUP & 2) ? 2 : 1); ++rep_) {
#pragma unroll 1
                for (int item = i_lo + wave; item < i_hi; item += 8) {
                    const int bh = item >> 6, qblk = item & 63;
                    attn_wave(Ub, VT, Yb, aog, bh >> 3, bh & 7, qblk, lds);
                }
            }
            __syncthreads();
            if (!gcu) {
#pragma unroll 1
                for (int rep_ = 0; rep_ < ((PROBE_DUP & 4) ? 2 : 1); ++rep_)
#pragma unroll 1
                    for (int cu = bid - nb0; cu < MT / CT; cu += G - nb0) convpre_unit(Ub, C2, dww, dwb, lng, lnb, cu, lds);
            }
            __syncthreads();
        } else if constexpr (k == 2) {
            const int nb0 = G / 2;
            {
                pg8::Gemm g{C2, (const bf16_t*)(wb + W_PW), MT, CD, CD}; SubOrder S; S.init(MT, CD, nb0, bid);
                EpiPw E{Ub, Yb, P.in[10] + l * CD, ssC};
                pg8::gemm_phase<EpiPw, SubOrder, true, true>(lds, g, S, E, threadIdx.x);
            }
            {
                pg8::Gemm g{(const bf16_t*)(ws + WS_PB) + (size_t)l * MT * PLE, (const bf16_t*)(wb + W_PLE), MT, DM, PLE}; SubOrder S; S.init(MT, DM, G - nb0, bid - nb0);
                EpiE E{EB};
                int t2 = threadIdx.x; asm volatile("" : "+v"(t2));
                pg8::gemm_phase<EpiE, SubOrder, true, true>(lds, g, S, E, t2);
            }
        } else if constexpr (k == 3) {
            pg8::Gemm g{Yb, (const bf16_t*)(wb + W_OUT), MT, DM, DM}; pg8::StaticOrder S; S.init(MT, DM, G, bid);
            EpiOut<(l > 0)> E{x, HB, H1B, ssB, ssC};
            pg8::gemm_phase<EpiOut<(l > 0)>, pg8::StaticOrder, true, true>(lds, g, S, E, threadIdx.x);
        } else {
            pg8::Gemm g{H1B, (const bf16_t*)(wb + W_PG), MT, DM, DM}; pg8::StaticOrder S; S.init(MT, DM, G, bid);
            EpiGate<false> E{out, H1B, EB, HB, ssB, ssA, 0};
            pg8::gemm_phase<EpiGate<false>, pg8::StaticOrder, true, true>(lds, g, S, E, threadIdx.x);
            if constexpr ((PROBE_DUP & 128) != 0) { int t3 = threadIdx.x; asm volatile("" : "+v"(t3)); pg8::gemm_phase<EpiGate<false>, pg8::StaticOrder, true, true>(lds, g, S, E, t3); }
        }
    }
}

__global__ void __launch_bounds__(512, 2) fwd(Params P) {
    extern __shared__ __attribute__((aligned(16))) unsigned char lds_raw[];
    LAS unsigned char* lds = (LAS unsigned char*)lds_raw;
    const int lo = P.ph_lo, hi = P.ph_hi;
    volatile LAS unsigned* st = (volatile LAS unsigned*)(lds + LDS_BYTES - 64);
    if (threadIdx.x < 16) st[threadIdx.x] = 0u;
    __syncthreads();
    const XcdBarrier bar = xcd_barrier_post((unsigned*)(P.ws + WS_CTL), st);
#define PROBE_PH(k) ((((PROBE_DUP) & 8) && (k) == 0) || (((PROBE_DUP) & 1) && (k) == 1) || (((PROBE_DUP) & 32) && ((k) == 3 || (k) == 8)) || (((PROBE_DUP) & 16) && (k) == 4))
#define SEAM() do { if (hi > NPHASE) cg::this_grid().sync(); else xcd_barrier(bar); } while (0)
#define PHASE(k) if (lo <= (k) && (k) < hi) { run_phase<(k)>(P, lds); if constexpr (PROBE_PH(k)) { __syncthreads(); run_phase<(k)>(P, lds); } \
        if constexpr (((PROBE_DUP) & 64) != 0) { SEAM(); } if ((k) + 1 < hi) SEAM(); }
    PHASE(0) PHASE(1) PHASE(2) PHASE(3) PHASE(4) PHASE(5) PHASE(6) PHASE(7) PHASE(8) PHASE(9) PHASE(10) PHASE(11)
    if constexpr (((PROBE_DUP) & 256) != 0) { SEAM(); PHASE(0) PHASE(1) PHASE(2) PHASE(3) PHASE(4) PHASE(5) PHASE(6) PHASE(7) PHASE(8) PHASE(9) PHASE(10) PHASE(11) }
#undef PHASE
#undef SEAM
}

#ifndef MK_N_LAUNCHES
#define MK_N_LAUNCHES 1
#endif
extern "C" void kernel_launch(void* const* d_in, const int* in_sizes, int n_in, void* d_out, int out_size, void* d_ws, size_t ws_size, hipStream_t stream) {
    static int grid = 0;
    if (grid == 0) {
        if (n_in != 16 || out_size != MT * DM || ws_size < WS_END) { fprintf(stderr, "kernel_launch: unexpected shapes (n_in %d, out %d, ws %zu)\n", n_in, out_size, ws_size); grid = -1; return; }
        int dev = 0, cus = 0, per_cu = 0;
        (void)hipGetDevice(&dev);
        (void)hipDeviceGetAttribute(&cus, hipDeviceAttributeMultiprocessorCount, dev);
        if (hipFuncSetAttribute((const void*)fwd, hipFuncAttributeMaxDynamicSharedMemorySize, LDS_BYTES) != hipSuccess) { fprintf(stderr, "kernel_launch: hipFuncSetAttribute failed\n"); grid = -1; return; }
        if (hipOccupancyMaxActiveBlocksPerMultiprocessor(&per_cu, (const void*)fwd, 512, LDS_BYTES) != hipSuccess || per_cu < 1) { fprintf(stderr, "kernel_launch: occupancy query says %d\n", per_cu); per_cu = 1; }
        (void)hipGetLastError();
        grid = cus * 1;
        if (grid <= 0) grid = 256;
    }
    if (grid < 0) return;
    if (hipMemsetAsync((unsigned char*)d_ws + WS_CTL, 0, CTL_BYTES, stream) != hipSuccess) { fprintf(stderr, "kernel_launch: memset of barrier words failed\n"); return; }
    Params p{};
    for (int i = 0; i < 16; ++i) p.in[i] = (const float*)d_in[i];
    p.out = (float*)d_out; p.ws = (unsigned char*)d_ws;
#if MK_N_LAUNCHES == 1
    p.ph_lo = 0; p.ph_hi = NPHASE;
    void* args[] = {&p};
    hipError_t e = hipLaunchCooperativeKernel((const void*)fwd, dim3(grid), dim3(512), args, LDS_BYTES, stream);
    if (e != hipSuccess) fprintf(stderr, "kernel_launch: cooperative launch failed: %s (grid %d)\n", hipGetErrorString(e), grid);
#else
    for (int ph = 0; ph < NPHASE; ++ph) {
        p.ph_lo = ph; p.ph_hi = ph + 1;
        hipLaunchKernelGGL(fwd, dim3(grid), dim3(512), LDS_BYTES, stream, p);
    }
#endif
}
```

```cpp
#include <hip/hip_runtime.h>
#include <hip/hip_cooperative_groups.h>
#include <cstdio>
#include <cstdint>
namespace cg = cooperative_groups;
namespace pg8 {
#define PG8_LAS __attribute__((address_space(3)))
typedef unsigned short bf16_t;
typedef short bf16x8 __attribute__((ext_vector_type(8)));
typedef float f32x4 __attribute__((ext_vector_type(4)));
typedef unsigned u32x4 __attribute__((ext_vector_type(4)));
constexpr int BM = 256, BK = 64, HALF = 128, HTB = HALF * BK * 2  , STAGE_BYTES = 8 * HTB, NXCD = 8, WGM = 8;

__host__ __device__ __forceinline__ int lds_byte(int r, int c) { const int st = (r >> 4) * 2 + (c >> 5), rr = r & 15, cc = c & 31, ob = rr * 64 + cc * 2; return st * 1024 + (ob ^ (((ob >> 9) & 1) << 5)); }
__host__ __device__ __forceinline__ void stage_rc(int b, int& R, int& C) { const int st = b / 1024, sb = b % 1024, swz = sb ^ (((sb >> 9) & 1) << 5); R = (st >> 1) * 16 + swz / 64; C = (st & 1) * 32 + (swz % 64) / 2; }
__host__ __device__ __forceinline__ int perm32(int rho) { const int n = rho >> 4, i = rho & 15; return 8 * (i >> 2) + 4 * n + (i & 3); }

struct Unit { int pm, pn; };
struct Gemm { const bf16_t* A; const bf16_t* Bt; int M, N, K; };

struct StaticOrder {
    int nM, nN, nwg, G, c;
    __host__ __device__ void init(int M, int N, int G_, int c_) { nM = M / BM; nN = N / BM; nwg = nM * nN; G = G_; c = c_; }
    __host__ __device__ bool next(int i, Unit& u) const {
        const long L = (long)i * G + c; if (L >= nwg) return false;
        int wgid = (int)L; { const int q = nwg / NXCD, r = nwg % NXCD, xcd = wgid % NXCD, off = wgid / NXCD; wgid = (xcd < r ? xcd * (q + 1) : r * (q + 1) + (xcd - r) * q) + off; }
        const int nig = WGM * nN, gid = wgid / nig, fm = gid * WGM, gsz = (nM - fm) < WGM ? (nM - fm) : WGM;
        u.pm = fm + ((wgid % nig) % gsz); u.pn = (wgid % nig) / gsz; return true;
    }
    __device__ __forceinline__ void a_ready(const Unit&) const {}
    __device__ __forceinline__ void done(const Unit&) const {}
};

template <class Epi, class Sched, bool ALIGN_EPI = false, bool SP2 = false>
__device__ __forceinline__ void gemm_phase(PG8_LAS unsigned char* lds, const Gemm g, const Sched& S, const Epi& E, const int tid_in) {
    const int tid = tid_in, wid = __builtin_amdgcn_readfirstlane(tid >> 6), lane = tid & 63, wr = wid >> 2, wc = wid & 3, fr = lane & 15, fq = lane >> 4;
    const int K = g.K, nt = K / BK;
    unsigned voffA[2], voffB[2];
#pragma unroll
    for (int i = 0; i < 2; ++i) { int R, C; stage_rc(tid * 16 + i * 8192, R, C); const int Rb = Epi::PERM ? ((R & ~31) + perm32(R & 31)) : R;
        voffA[i] = (unsigned)(R * K + C) * 2u; voffB[i] = (unsigned)(Rb * K + C) * 2u; }
    const size_t kstep = (size_t)(BK * 2);
    const size_t hstep = (size_t)HALF * K * 2;
    const size_t tstep = 2 * hstep;
    const unsigned ldsw = (unsigned)wid * 1024u;
    const int aoff = lds_byte(wr * 64 + fr, fq * 8), boff = lds_byte(wc * 32 + fr, fq * 8);
#define PG8_SA(b, h) (((b) * 2 + (h)) * HTB)
#define PG8_SB(b, h) ((4 + (b) * 2 + (h)) * HTB)
#define PG8_STAGE(bufoff, gbase, voff) do { _Pragma("unroll") for (int _i = 0; _i < 2; ++_i) \
        __builtin_amdgcn_global_load_lds((const unsigned*)((const char*)(gbase) + (voff)[_i]), (PG8_LAS unsigned*)(lds + (bufoff) + ldsw + _i * 8192), 16, 0, 0); } while (0)
#define PG8_LDA(dst, b, h) do { _Pragma("unroll") for (int m = 0; m < 4; ++m) _Pragma("unroll") for (int k = 0; k < 2; ++k) dst[m][k] = *(const PG8_LAS bf16x8*)(lds + PG8_SA(b, h) + aoff + m * 2048 + k * 1024); } while (0)
#define PG8_LDB(dst, b, h) do { _Pragma("unroll") for (int n = 0; n < 2; ++n) _Pragma("unroll") for (int k = 0; k < 2; ++k) dst[n][k] = *(const PG8_LAS bf16x8*)(lds + PG8_SB(b, h) + boff + n * 2048 + k * 1024); } while (0)
#define PG8_MMA(ai, bj, At, Bt) do { __builtin_amdgcn_s_setprio(1); _Pragma("unroll") for (int m = 0; m < 4; ++m) _Pragma("unroll") for (int n = 0; n < 2; ++n) _Pragma("unroll") for (int k = 0; k < 2; ++k) \
        acc[ai][bj][m][n] = __builtin_amdgcn_mfma_f32_16x16x32_bf16(Bt[n][k], At[m][k], acc[ai][bj][m][n], 0, 0, 0); __builtin_amdgcn_s_setprio(0); } while (0)
#define PG8_WAIT_V(n) asm volatile("s_waitcnt vmcnt(" #n ")" ::: "memory")
#define PG8_WAIT_L(n) asm volatile("s_waitcnt lgkmcnt(" #n ")" ::: "memory")
#define PG8_BAR __builtin_amdgcn_s_barrier()
#define PG8_SCHED __builtin_amdgcn_sched_barrier(0)
    Unit cur, nxt; int ui = 0;
    if (!S.next(0, cur)) return;
    f32x4 acc[2][2][4][2];
#pragma unroll
    for (int a = 0; a < 2; ++a)
#pragma unroll
        for (int b = 0; b < 2; ++b)
#pragma unroll
            for (int m = 0; m < 4; ++m)
#pragma unroll
                for (int n = 0; n < 2; ++n) acc[a][b][m][n] = (f32x4){0.f, 0.f, 0.f, 0.f};
    bf16x8 At[4][2], B0[2][2], B1[2][2];
    const char* cA = (const char*)g.A + (size_t)cur.pm * tstep; const char* cB = (const char*)g.Bt + (size_t)cur.pn * tstep;
    S.a_ready(cur);
    if constexpr (SP2) {
        PG8_STAGE(PG8_SB(0, 0), cB, voffB); PG8_STAGE(PG8_SB(0, 1), cB + hstep, voffB); PG8_STAGE(PG8_SA(0, 0), cA, voffA); PG8_STAGE(PG8_SA(0, 1), cA + hstep, voffA);
        if (wr == 1) PG8_BAR;
        PG8_WAIT_V(2); PG8_BAR;
        PG8_STAGE(PG8_SB(1, 0), cB + kstep, voffB); PG8_STAGE(PG8_SA(1, 0), cA + kstep, voffA); PG8_STAGE(PG8_SB(1, 1), cB + hstep + kstep, voffB);
        PG8_WAIT_V(6); PG8_BAR;
    } else {
        PG8_STAGE(PG8_SB(0, 0), cB, voffB); PG8_STAGE(PG8_SA(0, 0), cA, voffA); PG8_STAGE(PG8_SB(0, 1), cB + hstep, voffB); PG8_STAGE(PG8_SA(0, 1), cA + hstep, voffA);
        if (wr == 1) PG8_BAR;
        PG8_WAIT_V(4); PG8_BAR;
        PG8_STAGE(PG8_SB(1, 0), cB + kstep, voffB); PG8_STAGE(PG8_SA(1, 0), cA + kstep, voffA); PG8_STAGE(PG8_SB(1, 1), cB + hstep + kstep, voffB);
        PG8_WAIT_V(6); PG8_BAR;
    }
    for (;;) {
        const bool has_next = S.next(ui + 1, nxt);
        const char* nA = has_next ? (const char*)g.A + (size_t)nxt.pm * tstep : cA; const char* nB = has_next ? (const char*)g.Bt + (size_t)nxt.pn * tstep : cB;
        for (int t = 0; t < nt; t += 2) {
            if constexpr (Epi::MID_T > 0) { if (t == Epi::MID_T) E.mid(acc, cur); }
            const bool last = (t == nt - 2);
            const char* a1 = cA + (size_t)(t + 1) * kstep;
            const char* a2 = last ? nA : cA + (size_t)(t + 2) * kstep; const char* b2 = last ? nB : cB + (size_t)(t + 2) * kstep;
            const char* a3 = a2 + kstep; const char* b3 = b2 + kstep;
            if (last && has_next) S.a_ready(nxt);
            if constexpr (SP2) {
            PG8_LDB(B0, 0, 0); PG8_LDB(B1, 0, 1); PG8_SCHED; PG8_LDA(At, 0, 0); PG8_STAGE(PG8_SA(1, 1), a1 + hstep, voffA);
            PG8_WAIT_V(8); PG8_WAIT_L(0); PG8_BAR; PG8_MMA(0, 0, At, B0); PG8_MMA(0, 1, At, B1); PG8_BAR; PG8_SCHED;
            PG8_LDA(At, 0, 1); PG8_STAGE(PG8_SB(0, 0), b2, voffB); PG8_STAGE(PG8_SB(0, 1), b2 + hstep, voffB); PG8_STAGE(PG8_SA(0, 0), a2, voffA);
            PG8_WAIT_V(8); PG8_WAIT_L(0); PG8_BAR; PG8_MMA(1, 0, At, B0); PG8_MMA(1, 1, At, B1); PG8_BAR; PG8_SCHED;
            PG8_LDB(B0, 1, 0); PG8_LDB(B1, 1, 1); PG8_SCHED; PG8_LDA(At, 1, 0); PG8_STAGE(PG8_SA(0, 1), a2 + hstep, voffA);
            PG8_WAIT_V(8); PG8_WAIT_L(0); PG8_BAR; PG8_MMA(0, 0, At, B0); PG8_MMA(0, 1, At, B1); PG8_BAR; PG8_SCHED;
            PG8_LDA(At, 1, 1); PG8_STAGE(PG8_SB(1, 0), b3, voffB); PG8_STAGE(PG8_SB(1, 1), b3 + hstep, voffB); PG8_STAGE(PG8_SA(1, 0), a3, voffA);
            PG8_WAIT_V(8); PG8_WAIT_L(0); PG8_BAR; PG8_MMA(1, 0, At, B0); PG8_MMA(1, 1, At, B1); PG8_BAR; PG8_SCHED;
            } else {
            PG8_LDB(B0, 0, 0); PG8_SCHED; PG8_LDA(At, 0, 0); PG8_STAGE(PG8_SA(1, 1), a1 + hstep, voffA);
            PG8_WAIT_L(8); PG8_BAR; PG8_WAIT_L(0); PG8_MMA(0, 0, At, B0); PG8_BAR; PG8_SCHED;
            PG8_LDB(B1, 0, 1); PG8_STAGE(PG8_SB(0, 0), b2, voffB);
            PG8_BAR; PG8_WAIT_L(0); PG8_MMA(0, 1, At, B1); PG8_BAR;
            PG8_LDA(At, 0, 1); PG8_STAGE(PG8_SA(0, 0), a2, voffA);
            PG8_BAR; PG8_WAIT_L(0); PG8_MMA(1, 0, At, B0); PG8_BAR; PG8_SCHED;
            PG8_STAGE(PG8_SB(0, 1), b2 + hstep, voffB);
            PG8_WAIT_V(6); PG8_BAR; PG8_MMA(1, 1, At, B1); PG8_BAR;
            PG8_LDB(B0, 1, 0); PG8_SCHED; PG8_LDA(At, 1, 0); PG8_STAGE(PG8_SA(0, 1), a2 + hstep, voffA);
            PG8_WAIT_L(8); PG8_BAR; PG8_WAIT_L(0); PG8_MMA(0, 0, At, B0); PG8_BAR; PG8_SCHED;
            PG8_LDB(B1, 1, 1); PG8_STAGE(PG8_SB(1, 0), b3, voffB);
            PG8_BAR; PG8_WAIT_L(0); PG8_MMA(0, 1, At, B1); PG8_BAR;
            PG8_LDA(At, 1, 1); PG8_STAGE(PG8_SA(1, 0), a3, voffA);
            PG8_BAR; PG8_WAIT_L(0); PG8_MMA(1, 0, At, B0); PG8_BAR; PG8_SCHED;
            PG8_STAGE(PG8_SB(1, 1), b3 + hstep, voffB);
            PG8_WAIT_V(6); PG8_BAR; PG8_MMA(1, 1, At, B1); PG8_BAR;
            }
        }
        if constexpr (ALIGN_EPI) { if (wr == 0) PG8_BAR; }
        if constexpr (!Epi::AFTER_DRAIN) { E(acc, cur, wr, wc, fr, fq); S.done(cur); }
        if (!has_next) break;
#pragma unroll
        for (int a = 0; a < 2; ++a)
#pragma unroll
            for (int b = 0; b < 2; ++b)
#pragma unroll
                for (int m = 0; m < 4; ++m)
#pragma unroll
                    for (int n = 0; n < 2; ++n) acc[a][b][m][n] = (f32x4){0.f, 0.f, 0.f, 0.f};
        cur = nxt; cA = nA; cB = nB; ++ui;
        if constexpr (ALIGN_EPI) { if (wr == 1) PG8_BAR; }
    }
    PG8_WAIT_V(0);
    if constexpr (!ALIGN_EPI) { if (wr == 0) PG8_BAR; }
    PG8_BAR;
    if constexpr (Epi::AFTER_DRAIN) { E.fused(acc, cur, wr, wc, fr, fq, lds, wid, lane); S.done(cur); }
#undef PG8_SA
#undef PG8_SB
#undef PG8_STAGE
#undef PG8_LDA
#undef PG8_LDB
#undef PG8_MMA
#undef PG8_WAIT_V
#undef PG8_WAIT_L
#undef PG8_BAR
#undef PG8_SCHED
}
}

#define LAS __attribute__((address_space(3)))
typedef unsigned short bf16_t;
typedef short bf16x8 __attribute__((ext_vector_type(8)));
typedef float f32x4 __attribute__((ext_vector_type(4)));
typedef float f32x2 __attribute__((ext_vector_type(2)));
typedef float f32x16 __attribute__((ext_vector_type(16)));
typedef unsigned u32x4 __attribute__((ext_vector_type(4)));
typedef unsigned u32x2 __attribute__((ext_vector_type(2)));
typedef __bf16 bf16x2_t __attribute__((ext_vector_type(2)));

constexpr int NB = 8, SEQ = 2048, DM = 1024, MT = NB * SEQ, DIN = 3584, NH = 8, HD = 64, CWID = 31, PLE = 256, CD = 512;
constexpr float EPS = 1e-6f;
constexpr float QSCALE = 0.125f * 1.4426950408889634f;

constexpr size_t MiB = 1u << 20;
constexpr size_t W_IN = 0, W_PW = 7340032, W_OUT = W_PW + 524288, W_PG = W_OUT + 2097152, W_PLE = W_PG + 2097152, W_LAYER = 12 * MiB;
static_assert(W_PLE + 524288 == W_LAYER, "weight map");
constexpr int UP = 2560, UQ = 0, UK = 512, USGA = 1024, UGLU = 1536, USGC = 2048;
constexpr size_t WS_PB = 24 * MiB, WS_HB = 40 * MiB, WS_Y = 72 * MiB, WS_VT = 104 * MiB, WS_SSA = 120 * MiB, WS_SSB = 121 * MiB, WS_SSC = 122 * MiB, WS_U = 123 * MiB;
constexpr size_t WS_H1B = WS_U  , WS_C2 = 203 * MiB, WS_EB = 219 * MiB, WS_CTL = 252 * MiB, CTL_BYTES = 16384, WS_END = WS_CTL + CTL_BYTES;
static_assert(WS_U + (size_t)MT * UP * 2 <= WS_C2, "ws map");
constexpr int LDS_BYTES = 147456;
constexpr int NPHASE = 12;
#ifndef PROBE_DUP
#define PROBE_DUP 0
#endif

__device__ __forceinline__ unsigned pk2(float lo, float hi) { f32x2 v = {lo, hi}; bf16x2_t b = __builtin_convertvector(v, bf16x2_t); return __builtin_bit_cast(unsigned, b); }
__device__ __forceinline__ float bflo(unsigned u) { return __builtin_bit_cast(float, u << 16); }
__device__ __forceinline__ float bfhi(unsigned u) { return __builtin_bit_cast(float, u & 0xffff0000u); }
__device__ __forceinline__ float fexp2(float x) { return __builtin_amdgcn_exp2f(x); }
__device__ __forceinline__ float flog2(float x) { return __builtin_amdgcn_logf(x); }
__device__ __forceinline__ float frcp(float x) { return __builtin_amdgcn_rcpf(x); }
__device__ __forceinline__ float frsq(float x) { return __builtin_amdgcn_rsqf(x); }
__device__ __forceinline__ float sigmoidf_(float x) { return frcp(1.0f + fexp2(-1.4426950408889634f * x)); }
__device__ __forceinline__ float siluf_(float x) { return x * sigmoidf_(x); }
#define MFMA32(a, b, c) __builtin_amdgcn_mfma_f32_32x32x16_bf16((a), (b), (c), 0, 0, 0)

__device__ __forceinline__ float shx(float v, int m, int lane) { return __builtin_bit_cast(float, __builtin_amdgcn_ds_bpermute((lane ^ m) << 2, __builtin_bit_cast(int, v))); }
__device__ __forceinline__ float wave_sum(float v, int lane) {
#pragma unroll
    for (int o = 1; o < 64; o <<= 1) v += shx(v, o, lane);
    return v;
}
__device__ __forceinline__ float row_rstd(const float* ss, int row, int fq, int lane) {
    const f32x4 p = *(const f32x4*)(ss + (size_t)row * 16 + fq * 4);
    float s = (p[0] + p[1]) + (p[2] + p[3]);
    s += shx(s, 16, lane); s += shx(s, 32, lane);
    return frsq(s * (1.0f / DM) + EPS);
}

struct EpiIn {
    static constexpr bool PERM = true, AFTER_DRAIN = false; static constexpr int MID_T = 0;
    bf16_t* U; bf16_t* VT; const float* ss; int pn_off;
    __device__ __forceinline__ void operator()(const f32x4 (&acc)[2][2][4][2], const pg8::Unit& u, int, int, int, int) const {
        int t_ = threadIdx.x; asm volatile("" : "+v"(t_));
        const int lane = t_ & 63, fr = lane & 15, fq = lane >> 4, wid_ = __builtin_amdgcn_readfirstlane(t_ >> 6), wr = wid_ >> 2, wc = wid_ & 3;
        const int pn = u.pn + pn_off;
        f32x4 pp[2][4];
#pragma unroll
        for (int ai = 0; ai < 2; ++ai)
#pragma unroll
            for (int m = 0; m < 4; ++m) pp[ai][m] = *(const f32x4*)(ss + (size_t)(u.pm * 256 + ai * 128 + wr * 64 + m * 16 + fr) * 16 + fq * 4);
#pragma unroll
        for (int ai = 0; ai < 2; ++ai)
#pragma unroll
            for (int m = 0; m < 4; ++m) {
                const int row = u.pm * 256 + ai * 128 + wr * 64 + m * 16 + fr;
                float s_ = (pp[ai][m][0] + pp[ai][m][1]) + (pp[ai][m][2] + pp[ai][m][3]);
                s_ += shx(s_, 16, lane); s_ += shx(s_, 32, lane);
                const float rs = frsq(s_ * (1.0f / DM) + EPS);
#pragma unroll
                for (int bj = 0; bj < 2; ++bj) {
                    const int col0 = pn * 256 + bj * 128 + wc * 32 + 8 * fq;
                    f32x4 v0 = acc[ai][bj][m][0] * rs, v1 = acc[ai][bj][m][1] * rs;
                    if (pn < 4) {
                        const float sc = pn < 2 ? QSCALE : 1.0f;
                        v0 = v0 * sc; v1 = v1 * sc;
                        u32x4 w; w[0] = pk2(v0[0], v0[1]); w[1] = pk2(v0[2], v0[3]); w[2] = pk2(v1[0], v1[1]); w[3] = pk2(v1[2], v1[3]);
                        *(u32x4*)(U + (size_t)row * UP + col0) = w;
                    } else if (pn < 6) {
                        const int vc = col0 - 1024, hh = vc >> 6, d0 = vc & 63, b = row >> 11, s = row & 2047;
                        bf16_t* vp = VT + ((size_t)((b * NH + hh) * HD + d0)) * SEQ + s;
                        const unsigned w0 = pk2(v0[0], v0[1]), w1 = pk2(v0[2], v0[3]), w2 = pk2(v1[0], v1[1]), w3 = pk2(v1[2], v1[3]);
                        vp[0 * SEQ] = (bf16_t)(w0 & 0xffffu); vp[1 * SEQ] = (bf16_t)(w0 >> 16);
                        vp[2 * SEQ] = (bf16_t)(w1 & 0xffffu); vp[3 * SEQ] = (bf16_t)(w1 >> 16);
                        vp[4 * SEQ] = (bf16_t)(w2 & 0xffffu); vp[5 * SEQ] = (bf16_t)(w2 >> 16);
                        vp[6 * SEQ] = (bf16_t)(w3 & 0xffffu); vp[7 * SEQ] = (bf16_t)(w3 >> 16);
                    } else if (pn < 8 || pn >= 12) {
                        u32x4 w; w[0] = pk2(siluf_(v0[0]), siluf_(v0[1])); w[1] = pk2(siluf_(v0[2]), siluf_(v0[3]));
                        w[2] = pk2(siluf_(v1[0]), siluf_(v1[1])); w[3] = pk2(siluf_(v1[2]), siluf_(v1[3]));
                        *(u32x4*)(U + (size_t)row * UP + (pn < 8 ? col0 - 512 : col0 - 1024)) = w;
                    } else {
                        const int ch0 = (col0 - 2048) >> 1;
                        u32x2 w; w[0] = pk2(v0[0] * sigmoidf_(v0[1]), v0[2] * sigmoidf_(v0[3])); w[1] = pk2(v1[0] * sigmoidf_(v1[1]), v1[2] * sigmoidf_(v1[3]));
                        *(u32x2*)(U + (size_t)row * UP + UGLU + ch0) = w;
                    }
                }
                asm volatile("" ::: "memory");
            }
    }
};

struct EpiPw {
    static constexpr bool PERM = true, AFTER_DRAIN = false; static constexpr int MID_T = 0;
    const bf16_t* U; bf16_t* Y; const float* cog; float* ssC;
    __device__ __forceinline__ void operator()(const f32x4 (&acc)[2][2][4][2], const pg8::Unit& u, int, int, int, int) const {
        int t_ = threadIdx.x; asm volatile("" : "+v"(t_));
        const int lane = t_ & 63, fr = lane & 15, fq = lane >> 4, wid_ = __builtin_amdgcn_readfirstlane(t_ >> 6), wr = wid_ >> 2, wc = wid_ & 3;
#pragma unroll
        for (int ai = 0; ai < 2; ++ai)
#pragma unroll
            for (int m = 0; m < 4; ++m) {
                const int row = u.pm * 256 + ai * 128 + wr * 64 + m * 16 + fr;
                float sq = 0.f;
#pragma unroll
                for (int bj = 0; bj < 2; ++bj) {
                    const int col0 = u.pn * 256 + bj * 128 + wc * 32 + 8 * fq;
                    const f32x4 v0 = acc[ai][bj][m][0], v1 = acc[ai][bj][m][1];
                    sq += (v0[0] * v0[0] + v0[1] * v0[1]) + (v0[2] * v0[2] + v0[3] * v0[3]) + (v1[0] * v1[0] + v1[1] * v1[1]) + (v1[2] * v1[2] + v1[3] * v1[3]);
                    const f32x4 g0 = *(const f32x4*)(cog + col0), g1 = *(const f32x4*)(cog + col0 + 4);
                    const u32x4 sg = *(const u32x4*)(U + (size_t)row * UP + USGC + col0);
                    u32x4 w;
                    w[0] = pk2(v0[0] * g0[0] * bflo(sg[0]), v0[1] * g0[1] * bfhi(sg[0])); w[1] = pk2(v0[2] * g0[2] * bflo(sg[1]), v0[3] * g0[3] * bfhi(sg[1]));
                    w[2] = pk2(v1[0] * g1[0] * bflo(sg[2]), v1[1] * g1[1] * bfhi(sg[2])); w[3] = pk2(v1[2] * g1[2] * bflo(sg[3]), v1[3] * g1[3] * bfhi(sg[3]));
                    *(u32x4*)(Y + (size_t)row * DM + col0) = w;
                }
                sq += shx(sq, 16, lane); sq += shx(sq, 32, lane);
                if (fq == 0) ssC[(size_t)row * 8 + u.pn * 4 + wc] = sq;
                asm volatile("" ::: "memory");
            }
    }
};

struct EpiE {
    static constexpr bool PERM = true, AFTER_DRAIN = false; static constexpr int MID_T = 0;
    bf16_t* EB;
    __device__ __forceinline__ void operator()(const f32x4 (&acc)[2][2][4][2], const pg8::Unit& u, int, int, int, int) const {
        int t_ = threadIdx.x; asm volatile("" : "+v"(t_));
        const int lane = t_ & 63, fr = lane & 15, fq = lane >> 4, wid_ = __builtin_amdgcn_readfirstlane(t_ >> 6), wr = wid_ >> 2, wc = wid_ & 3;
#pragma unroll
        for (int ai = 0; ai < 2; ++ai)
#pragma unroll
            for (int m = 0; m < 4; ++m) {
                const int row = u.pm * 256 + ai * 128 + wr * 64 + m * 16 + fr;
#pragma unroll
                for (int bj = 0; bj < 2; ++bj) {
                    const int col0 = u.pn * 256 + bj * 128 + wc * 32 + 8 * fq;
                    const f32x4 v0 = acc[ai][bj][m][0], v1 = acc[ai][bj][m][1];
                    u32x4 w; w[0] = pk2(v0[0], v0[1]); w[1] = pk2(v0[2], v0[3]); w[2] = pk2(v1[0], v1[1]); w[3] = pk2(v1[2], v1[3]);
                    *(u32x4*)(EB + (size_t)row * DM + col0) = w;
                }
                asm volatile("" ::: "memory");
            }
    }
};

template <bool BB> struct EpiOut {
    static constexpr bool PERM = true, AFTER_DRAIN = false; static constexpr int MID_T = 8;
    const float* base; const bf16_t* baseb; bf16_t* HB; float* ss; const float* ssC;
    __device__ __forceinline__ void mid(f32x4 (&acc)[2][2][4][2], const pg8::Unit& u) const {
        int t_ = threadIdx.x; asm volatile("" : "+v"(t_));
        const int lane = t_ & 63, fr = lane & 15, fq = lane >> 4, wid_ = __builtin_amdgcn_readfirstlane(t_ >> 6), wr = wid_ >> 2;
        f32x2 pc[2][4];
#pragma unroll
        for (int ai = 0; ai < 2; ++ai)
#pragma unroll
            for (int m = 0; m < 4; ++m) pc[ai][m] = *(const f32x2*)(ssC + (size_t)(u.pm * 256 + ai * 128 + wr * 64 + m * 16 + fr) * 8 + fq * 2);
#pragma unroll
        for (int ai = 0; ai < 2; ++ai)
#pragma unroll
            for (int m = 0; m < 4; ++m) {
                const f32x2 p = pc[ai][m];
                float s = p[0] + p[1];
                s += shx(s, 16, lane); s += shx(s, 32, lane);
                const float rs = frsq(s * (1.0f / CD) + EPS);
#pragma unroll
                for (int bj = 0; bj < 2; ++bj)
#pragma unroll
                    for (int n = 0; n < 2; ++n) acc[ai][bj][m][n] = acc[ai][bj][m][n] * rs;
            }
    }
    __device__ __forceinline__ void operator()(const f32x4 (&acc)[2][2][4][2], const pg8::Unit& u, int, int, int, int) const {
        int t_ = threadIdx.x; asm volatile("" : "+v"(t_));
        const int lane = t_ & 63, fr = lane & 15, fq = lane >> 4, wid_ = __builtin_amdgcn_readfirstlane(t_ >> 6), wr = wid_ >> 2, wc = wid_ & 3;
#pragma unroll
        for (int ai = 0; ai < 2; ++ai)
#pragma unroll
            for (int mp = 0; mp < 2; ++mp) {
                f32x4 bs[2][2][2];
#pragma unroll
                for (int mm = 0; mm < 2; ++mm)
#pragma unroll
                    for (int bj = 0; bj < 2; ++bj) {
                        const size_t off = (size_t)(u.pm * 256 + ai * 128 + wr * 64 + (2 * mp + mm) * 16 + fr) * DM + u.pn * 256 + bj * 128 + wc * 32 + 8 * fq;
                        if constexpr (BB) { const u32x4 r1 = *(const u32x4*)(baseb + off); f32x4 t0 = {bflo(r1[0]), bfhi(r1[0]), bflo(r1[1]), bfhi(r1[1])}, t1 = {bflo(r1[2]), bfhi(r1[2]), bflo(r1[3]), bfhi(r1[3])}; bs[mm][bj][0] = t0; bs[mm][bj][1] = t1; }
                        else { bs[mm][bj][0] = *(const f32x4*)(base + off); bs[mm][bj][1] = *(const f32x4*)(base + off + 4); }
                    }
#pragma unroll
                for (int mm = 0; mm < 2; ++mm) {
                    const int m = 2 * mp + mm;
                    const int row = u.pm * 256 + ai * 128 + wr * 64 + m * 16 + fr;
                    float sq = 0.f;
#pragma unroll
                    for (int bj = 0; bj < 2; ++bj) {
                        const size_t off = (size_t)row * DM + u.pn * 256 + bj * 128 + wc * 32 + 8 * fq;
                        const f32x4 h0 = bs[mm][bj][0] + acc[ai][bj][m][0], h1 = bs[mm][bj][1] + acc[ai][bj][m][1];
                        u32x4 w; w[0] = pk2(h0[0], h0[1]); w[1] = pk2(h0[2], h0[3]); w[2] = pk2(h1[0], h1[1]); w[3] = pk2(h1[2], h1[3]);
                        *(u32x4*)(HB + off) = w;
                        sq += (h0[0] * h0[0] + h0[1] * h0[1]) + (h0[2] * h0[2] + h0[3] * h0[3]) + (h1[0] * h1[0] + h1[1] * h1[1]) + (h1[2] * h1[2] + h1[3] * h1[3]);
                    }
                    sq += shx(sq, 16, lane); sq += shx(sq, 32, lane);
                    if (fq == 0) ss[(size_t)row * 16 + u.pn * 4 + wc] = sq;
                }
                asm volatile("" ::: "memory");
            }
    }
};

template <bool WF> struct EpiGate {
    static constexpr bool PERM = true, AFTER_DRAIN = false; static constexpr int MID_T = 0;
    float* out; const bf16_t* H1; const bf16_t* EB; bf16_t* HB; const float* ss_in; float* ss_out; int dummy;
    __device__ __forceinline__ void operator()(const f32x4 (&acc)[2][2][4][2], const pg8::Unit& u, int, int, int, int) const {
        int t_ = threadIdx.x; asm volatile("" : "+v"(t_));
        const int lane = t_ & 63, fr = lane & 15, fq = lane >> 4, wid_ = __builtin_amdgcn_readfirstlane(t_ >> 6), wr = wid_ >> 2, wc = wid_ & 3;
        f32x4 pp[2][4];
#pragma unroll
        for (int ai = 0; ai < 2; ++ai)
#pragma unroll
            for (int m = 0; m < 4; ++m) pp[ai][m] = *(const f32x4*)(ss_in + (size_t)(u.pm * 256 + ai * 128 + wr * 64 + m * 16 + fr) * 16 + fq * 4);
        float rsv[2][4];
#pragma unroll
        for (int ai = 0; ai < 2; ++ai)
#pragma unroll
            for (int m = 0; m < 4; ++m) {
                float s_ = (pp[ai][m][0] + pp[ai][m][1]) + (pp[ai][m][2] + pp[ai][m][3]);
                s_ += shx(s_, 16, lane); s_ += shx(s_, 32, lane);
                rsv[ai][m] = frsq(s_ * (1.0f / DM) + EPS);
            }
        asm volatile("" ::: "memory");
#pragma unroll
        for (int ai = 0; ai < 2; ++ai)
#pragma unroll
            for (int mp = 0; mp < 2; ++mp) {
                u32x4 bs[2][2], es[2][2];
#pragma unroll
                for (int mm = 0; mm < 2; ++mm)
#pragma unroll
                    for (int bj = 0; bj < 2; ++bj) {
                        const size_t off = (size_t)(u.pm * 256 + ai * 128 + wr * 64 + (2 * mp + mm) * 16 + fr) * DM + u.pn * 256 + bj * 128 + wc * 32 + 8 * fq;
                        bs[mm][bj] = *(const u32x4*)(H1 + off); es[mm][bj] = *(const u32x4*)(EB + off);
                    }
#pragma unroll
                for (int mm = 0; mm < 2; ++mm) {
                    const int m = 2 * mp + mm;
                    const int row = u.pm * 256 + ai * 128 + wr * 64 + m * 16 + fr;
                    const float rs = rsv[ai][m];
                    float sq = 0.f;
#pragma unroll
                    for (int bj = 0; bj < 2; ++bj) {
                        const size_t off = (size_t)row * DM + u.pn * 256 + bj * 128 + wc * 32 + 8 * fq;
                        const f32x4 a0 = acc[ai][bj][m][0] * rs, a1 = acc[ai][bj][m][1] * rs;
                        const u32x4 e = es[mm][bj]; const u32x4 r1 = bs[mm][bj];
                        f32x4 h0 = {bflo(r1[0]), bfhi(r1[0]), bflo(r1[1]), bfhi(r1[1])}, h1 = {bflo(r1[2]), bfhi(r1[2]), bflo(r1[3]), bfhi(r1[3])};
                        h0[0] += bflo(e[0]) * sigmoidf_(a0[0]); h0[1] += bfhi(e[0]) * sigmoidf_(a0[1]); h0[2] += bflo(e[1]) * sigmoidf_(a0[2]); h0[3] += bfhi(e[1]) * sigmoidf_(a0[3]);
                        h1[0] += bflo(e[2]) * sigmoidf_(a1[0]); h1[1] += bfhi(e[2]) * sigmoidf_(a1[1]); h1[2] += bflo(e[3]) * sigmoidf_(a1[2]); h1[3] += bfhi(e[3]) * sigmoidf_(a1[3]);
                        if constexpr (WF) { *(f32x4*)(out + off) = h0; *(f32x4*)(out + off + 4) = h1; }
                        u32x4 w; w[0] = pk2(h0[0], h0[1]); w[1] = pk2(h0[2], h0[3]); w[2] = pk2(h1[0], h1[1]); w[3] = pk2(h1[2], h1[3]);
                        *(u32x4*)(HB + off) = w;
                        sq += (h0[0] * h0[0] + h0[1] * h0[1]) + (h0[2] * h0[2] + h0[3] * h0[3]) + (h1[0] * h1[0] + h1[1] * h1[1]) + (h1[2] * h1[2] + h1[3] * h1[3]);
                    }
                    sq += shx(sq, 16, lane); sq += shx(sq, 32, lane);
                    if (fq == 0) ss_out[(size_t)row * 16 + u.pn * 4 + wc] = sq;
                }
                asm volatile("" ::: "memory");
            }
    }
};

struct SubOrder {
    int nN, nwg, nb, c;
    __device__ void init(int M, int N, int nb_, int c_) { nN = N / 256; nwg = (M / 256) * nN; nb = nb_; c = c_; }
    __device__ bool next(int i, pg8::Unit& u) const { if (c < 0 || c >= nb) return false; const int L = i * nb + c; if (L >= nwg) return false; u.pm = L / nN; u.pn = L % nN; return true; }
    __device__ __forceinline__ void a_ready(const pg8::Unit&) const {}
    __device__ __forceinline__ void done(const pg8::Unit&) const {}
};

template <bool REMAP>
__device__ __forceinline__ void tr_item(const float* W, int K, int N, bf16_t* WT, const float* g, LAS float* scr, int item, int lane, int kshift = 0) {
    const int nblk = N / 32, kb = item / nblk, nb = item % nblk, k0 = 64 * kb, n0 = 32 * nb;
    int src = n0 + (lane & 31);
    if (REMAP) { if (src >= 2048 && src < 3072) { const int jj = src - 2048; src = (jj & 1) ? 2560 + (jj >> 1) : 2048 + (jj >> 1); } }
    float wv[32];
#pragma unroll
    for (int i = 0; i < 32; ++i) { const int kk = 2 * i + (lane >> 5); wv[i] = W[(size_t)((k0 + kk + kshift) & (K - 1)) * N + src]; }
#pragma unroll
    for (int i = 0; i < 32; ++i) { const int kk = 2 * i + (lane >> 5); float v = wv[i]; if (g) v *= g[k0 + kk]; scr[kk * 33 + (lane & 31)] = v; }
    asm volatile("s_waitcnt lgkmcnt(0)" ::: "memory");
    const int c = lane & 7;
#pragma unroll
    for (int j = 0; j < 4; ++j) { const int n = (lane >> 3) + 8 * j; const LAS float* s = scr + (8 * c) * 33 + n;
        u32x4 o; o[0] = pk2(s[0 * 33], s[1 * 33]); o[1] = pk2(s[2 * 33], s[3 * 33]); o[2] = pk2(s[4 * 33], s[5 * 33]); o[3] = pk2(s[6 * 33], s[7 * 33]);
        *(u32x4*)(WT + (size_t)(n0 + n) * K + k0 + 8 * c) = o; }
    asm volatile("s_waitcnt lgkmcnt(0)" ::: "memory");
}

constexpr int AK_STRIDE = 144, AV_STRIDE = 136, A_KBYTES = 64 * AK_STRIDE, A_VBYTES = 64 * AV_STRIDE, A_BUF = 18432;
static_assert(A_KBYTES + A_VBYTES <= A_BUF, "attention LDS buffer");

constexpr int AW_BYTES = A_KBYTES + A_VBYTES;
static_assert(8 * AW_BYTES <= LDS_BYTES - 64, "attention LDS");
__device__ __forceinline__ void attn_wave(const bf16_t* U, const bf16_t* VT, bf16_t* Y, const float* aog, int b, int h, int qblk, LAS unsigned char* lds) {
    int tid = threadIdx.x; asm volatile("" : "+v"(tid));
    const int wave = __builtin_amdgcn_readfirstlane(tid >> 6), lane = tid & 63, l31 = lane & 31, hi = lane >> 5;
    const int q0 = qblk * 32, t = q0 + l31;
    const size_t trow = (size_t)(b * SEQ + t);
    bf16x8 qf[4];
    {
        const bf16_t* qp = U + trow * UP + UQ + h * HD + 8 * hi;
#pragma unroll
        for (int s = 0; s < 4; ++s) qf[s] = *(const bf16x8*)(qp + 16 * s);
    }
    f32x16 o0, o1;
#pragma unroll
    for (int i = 0; i < 16; ++i) { o0[i] = 0.f; o1[i] = 0.f; }
    float C = 1.f;
    const int ktmax = (q0 + 30) >> 6;
    const int srow = lane >> 3, sch = lane & 7;
    const bf16_t* gk = U + (size_t)(b * SEQ + srow) * UP + UK + h * HD + sch * 8;
    const bf16_t* gv = VT + ((size_t)((b * NH + h) * HD + srow)) * SEQ + sch * 8;
    LAS unsigned char* kb = lds + wave * AW_BYTES;
    LAS unsigned char* vb = kb + A_KBYTES;
    const int kwoff = srow * AK_STRIDE + sch * 16, vwoff = srow * AV_STRIDE + sch * 16;
    u32x4 kr[8], vr[8];
#pragma unroll
    for (int i = 0; i < 8; ++i) { kr[i] = *(const u32x4*)(gk + (size_t)(ktmax * 64 + 8 * i) * UP); vr[i] = *(const u32x4*)(gv + (size_t)(8 * i) * SEQ + ktmax * 64); }
    for (int kt = ktmax; kt >= 0; --kt) {
#pragma unroll
        for (int i = 0; i < 8; ++i) {
            *(LAS u32x4*)(kb + kwoff + 8 * i * AK_STRIDE) = kr[i];
            u32x2 a = {vr[i][0], vr[i][1]}, c = {vr[i][2], vr[i][3]};
            *(LAS u32x2*)(vb + vwoff + 8 * i * AV_STRIDE) = a; *(LAS u32x2*)(vb + vwoff + 8 * i * AV_STRIDE + 8) = c;
        }
        if (kt > 0) {
#pragma unroll
            for (int i = 0; i < 8; ++i) { kr[i] = *(const u32x4*)(gk + (size_t)((kt - 1) * 64 + 8 * i) * UP); vr[i] = *(const u32x4*)(gv + (size_t)(8 * i) * SEQ + (kt - 1) * 64); }
        }
        {
            f32x16 p0, p1;
#pragma unroll
            for (int i = 0; i < 16; ++i) { p0[i] = 0.f; p1[i] = 0.f; }
#pragma unroll
            for (int s = 0; s < 4; ++s) {
                const bf16x8 ka = *(const LAS bf16x8*)(kb + l31 * AK_STRIDE + 32 * s + 16 * hi);
                const bf16x8 kc = *(const LAS bf16x8*)(kb + (32 + l31) * AK_STRIDE + 32 * s + 16 * hi);
                p0 = MFMA32(ka, qf[s], p0); p1 = MFMA32(kc, qf[s], p1);
            }
            const int lim0 = t - (64 * kt + 4 * hi), lim1 = lim0 - 32;
            const bool diag = (64 * kt + 63 >= q0);
            f32x16 m0, m1;
            float G0[4], G1[4];
#pragma unroll
            for (int g = 0; g < 4; ++g) {
                float s0 = 1.f, s1 = 1.f;
#pragma unroll
                for (int i = 0; i < 4; ++i) {
                    const int r = 4 * g + i, cr = i + 8 * g;
                    const float e0 = fexp2(fminf(p0[r], 100.f)), e1 = fexp2(fminf(p1[r], 100.f));
                    float r0 = frcp(1.0f + e0), r1 = frcp(1.0f + e1);
                    float b0 = e0 * r0, b1 = e1 * r1;
                    if (diag) { const bool v0 = cr < lim0, v1 = cr < lim1; r0 = v0 ? r0 : 1.f; b0 = v0 ? b0 : 0.f; r1 = v1 ? r1 : 1.f; b1 = v1 ? b1 : 0.f; }
                    m0[r] = r0; m1[r] = r1; p0[r] = b0; p1[r] = b1; s0 *= r0; s1 *= r1;
                }
                G0[g] = s0; G1[g] = s1;
            }
            float X0[4], X1[4];
#pragma unroll
            for (int g = 0; g < 4; ++g) { X0[g] = shx(G0[g], 32, lane); X1[g] = shx(G1[g], 32, lane); }
            float run = C;
#pragma unroll
            for (int g = 3; g >= 0; --g) {
                float a = hi == 0 ? run * X1[g] : run;
#pragma unroll
                for (int i = 3; i >= 0; --i) { const int r = 4 * g + i; const float w = a * p1[r]; a *= m1[r]; p1[r] = w; }
                run *= G1[g] * X1[g];
            }
#pragma unroll
            for (int g = 3; g >= 0; --g) {
                float a = hi == 0 ? run * X0[g] : run;
#pragma unroll
                for (int i = 3; i >= 0; --i) { const int r = 4 * g + i; const float w = a * p0[r]; a *= m0[r]; p0[r] = w; }
                run *= G0[g] * X0[g];
            }
            C = run;
#pragma unroll
            for (int kh = 0; kh < 2; ++kh)
#pragma unroll
                for (int sh = 0; sh < 2; ++sh) {
                    u32x4 xw;
                    if (kh == 0) { xw[0] = pk2(p0[8 * sh + 0], p0[8 * sh + 1]); xw[1] = pk2(p0[8 * sh + 2], p0[8 * sh + 3]); xw[2] = pk2(p0[8 * sh + 4], p0[8 * sh + 5]); xw[3] = pk2(p0[8 * sh + 6], p0[8 * sh + 7]); }
                    else         { xw[0] = pk2(p1[8 * sh + 0], p1[8 * sh + 1]); xw[1] = pk2(p1[8 * sh + 2], p1[8 * sh + 3]); xw[2] = pk2(p1[8 * sh + 4], p1[8 * sh + 5]); xw[3] = pk2(p1[8 * sh + 6], p1[8 * sh + 7]); }
                    const bf16x8 xf = __builtin_bit_cast(bf16x8, xw);
                    const int koff = 2 * (32 * kh + 16 * sh + 4 * hi);
                    {
                        const LAS unsigned char* vp = vb + l31 * AV_STRIDE + koff;
                        const u32x2 lo = *(const LAS u32x2*)vp, hh = *(const LAS u32x2*)(vp + 16);
                        u32x4 vw = {lo[0], lo[1], hh[0], hh[1]};
                        o0 = MFMA32(__builtin_bit_cast(bf16x8, vw), xf, o0);
                    }
                    {
                        const LAS unsigned char* vp = vb + (32 + l31) * AV_STRIDE + koff;
                        const u32x2 lo = *(const LAS u32x2*)vp, hh = *(const LAS u32x2*)(vp + 16);
                        u32x4 vw = {lo[0], lo[1], hh[0], hh[1]};
                        o1 = MFMA32(__builtin_bit_cast(bf16x8, vw), xf, o1);
                    }
                }
        }
        if (__builtin_amdgcn_ballot_w64(C > 9.094947e-13f) == 0ull) break;
    }
    float sq = 0.f;
#pragma unroll
    for (int i = 0; i < 16; ++i) sq += o0[i] * o0[i] + o1[i] * o1[i];
    sq += shx(sq, 32, lane);
    const float rs = frsq(sq * (1.0f / HD) + EPS);
    const bf16_t* sgp = U + trow * UP + USGA + h * HD;
    bf16_t* yp = Y + trow * DM + 512 + h * HD;
#pragma unroll
    for (int dt = 0; dt < 2; ++dt)
#pragma unroll
        for (int g = 0; g < 4; ++g) {
            const int d0 = 32 * dt + 8 * g + 4 * hi;
            const f32x4 gn = *(const f32x4*)(aog + d0);
            const u32x2 sg = *(const u32x2*)(sgp + d0);
            float v0, v1, v2, v3;
            if (dt == 0) { v0 = o0[4 * g + 0]; v1 = o0[4 * g + 1]; v2 = o0[4 * g + 2]; v3 = o0[4 * g + 3]; }
            else         { v0 = o1[4 * g + 0]; v1 = o1[4 * g + 1]; v2 = o1[4 * g + 2]; v3 = o1[4 * g + 3]; }
            u32x2 w;
            w[0] = pk2(v0 * rs * gn[0] * bflo(sg[0]), v1 * rs * gn[1] * bfhi(sg[0]));
            w[1] = pk2(v2 * rs * gn[2] * bflo(sg[1]), v3 * rs * gn[3] * bfhi(sg[1]));
            *(u32x2*)(yp + d0) = w;
        }
}

constexpr int CT = 32, C_XH = 0, C_XH_BYTES = (CT + 30) * 1024, C_CO = C_XH_BYTES, C_CO_BYTES = CT * CD * 4;
static_assert(C_CO + C_CO_BYTES <= LDS_BYTES, "conv LDS map");

__device__ __forceinline__ void convpre_units(const bf16_t* U, bf16_t* C2, const float* dww, const float* dwb, const float* lng, const float* lnb, int cu0, int cstride, int ncu, LAS unsigned char* lds) {
    int tid = threadIdx.x; asm volatile("" : "+v"(tid));
    const int wave = __builtin_amdgcn_readfirstlane(tid >> 6), lane = tid & 63;
    if (cu0 >= ncu) return;
    const int chp = tid & 255, tg = tid >> 8;
    f32x2 w2[CWID];
#pragma unroll
    for (int j = 0; j < CWID; ++j) w2[j] = *(const f32x2*)(dww + (size_t)j * CD + 2 * chp);
    const f32x2 bias = *(const f32x2*)(dwb + 2 * chp);
    const f32x4 g0 = *(const f32x4*)(lng + lane * 4), g1 = *(const f32x4*)(lng + 256 + lane * 4);
    const f32x4 b0 = *(const f32x4*)(lnb + lane * 4), b1 = *(const f32x4*)(lnb + 256 + lane * 4);
    constexpr int NCH = (CT + 30) * 64, NLD = (NCH + 511) / 512;
    u32x4 hreg[NLD];
    auto halo_load = [&](int cu) {
        const int r0 = cu * CT, b = r0 >> 11, s0 = r0 & 2047;
#pragma unroll
        for (int q = 0; q < NLD; ++q) {
            const int i = tid + q * 512, row = i >> 6, ch = i & 63, s = s0 - 30 + row;
            u32x4 v = {0u, 0u, 0u, 0u};
            if (i < NCH && s >= 0) v = *(const u32x4*)(U + (size_t)(b * SEQ + s) * UP + UGLU + ch * 8);
            hreg[q] = v;
        }
    };
    auto halo_store = [&]() {
#pragma unroll
        for (int q = 0; q < NLD; ++q) { const int i = tid + q * 512; if (i < NCH) *(LAS u32x4*)(lds + C_XH + (i >> 6) * 1024 + (i & 63) * 16) = hreg[q]; }
    };
    __syncthreads();
    halo_load(cu0); halo_store();
#pragma unroll 1
    for (int cu = cu0; cu < ncu; cu += cstride) {
        const int r0 = cu * CT, nxt = cu + cstride;
        __syncthreads();
        if (nxt < ncu) halo_load(nxt);
        {
            const LAS unsigned char* xp = lds + C_XH + (tg * 16) * 1024 + chp * 4;
            f32x2 xv[16 + CWID - 1];
#pragma unroll
            for (int i = 0; i < 16 + CWID - 1; ++i) { const unsigned xu = *(const LAS unsigned*)(xp + i * 1024); f32x2 t2 = {bflo(xu), bfhi(xu)}; xv[i] = t2; }
#pragma unroll
            for (int tt = 0; tt < 16; ++tt) {
                f32x2 a = bias;
#pragma unroll
                for (int j = 0; j < CWID; ++j) a = a + w2[j] * xv[tt + j];
                *(LAS f32x2*)(lds + C_CO + (tg * 16 + tt) * 2048 + chp * 8) = a;
            }
        }
        __syncthreads();
        if (nxt < ncu) halo_store();
#pragma unroll
        for (int tt = 0; tt < 4; ++tt) {
            const int tl = wave * 4 + tt;
            f32x4 v0 = *(const LAS f32x4*)(lds + C_CO + tl * 2048 + lane * 16), v1 = *(const LAS f32x4*)(lds + C_CO + tl * 2048 + 1024 + lane * 16);
            const float mean = wave_sum((v0[0] + v0[1]) + (v0[2] + v0[3]) + (v1[0] + v1[1]) + (v1[2] + v1[3]), lane) * (1.0f / CD);
            v0 = v0 - mean; v1 = v1 - mean;
            const float var = wave_sum((v0[0] * v0[0] + v0[1] * v0[1]) + (v0[2] * v0[2] + v0[3] * v0[3]) + (v1[0] * v1[0] + v1[1] * v1[1]) + (v1[2] * v1[2] + v1[3] * v1[3]), lane) * (1.0f / CD);
            const float rs = frsq(var + EPS);
            v0 = v0 * rs * g0 + b0; v1 = v1 * rs * g1 + b1;
            u32x2 wa, wb;
            wa[0] = pk2(siluf_(v0[0]), siluf_(v0[1])); wa[1] = pk2(siluf_(v0[2]), siluf_(v0[3]));
            wb[0] = pk2(siluf_(v1[0]), siluf_(v1[1])); wb[1] = pk2(siluf_(v1[2]), siluf_(v1[3]));
            bf16_t* cp = C2 + (size_t)(r0 + tl) * CD + lane * 4;
            *(u32x2*)cp = wa; *(u32x2*)(cp + 256) = wb;
        }
    }
}

#define XB_TMO      128
#define XB_XCNT(j)  (256  + 64 * (j))
#define XB_XSUB(j)  (1280 + 64 * (j))
#define XB_XGEN(j)  (2304 + 64 * (j))
#define XB_TOP      3328
#define XB_TOPGEN   3392
#define XCD_BAR_WORDS 3456
#define XB_SPIN_CAP (1u << 18)

__device__ __forceinline__ unsigned xb_ld(unsigned* p)              { return __hip_atomic_load(p, __ATOMIC_RELAXED, __HIP_MEMORY_SCOPE_AGENT); }
__device__ __forceinline__ unsigned xb_add(unsigned* p, unsigned v) { return __hip_atomic_fetch_add(p, v, __ATOMIC_RELAXED, __HIP_MEMORY_SCOPE_AGENT); }
__device__ __forceinline__ unsigned xb_xcc_id() { return (unsigned)__builtin_amdgcn_s_getreg((3 << 11) | 20) & 0xFu; }
#define XB_SPIN(cond, bar) do { unsigned _sp = 0; while (cond) { __builtin_amdgcn_s_sleep(1); \
    if ((++_sp & 255u) == 0u) { if (xb_ld(&(bar)[XB_TMO])) break; if (_sp > XB_SPIN_CAP) { atomicAdd(&(bar)[XB_TMO], 1u); break; } } } } while (0)

struct XcdBarrier {
    unsigned* bar; unsigned x;
    volatile LAS unsigned* st;
};

__device__ __forceinline__ XcdBarrier xcd_barrier_post(unsigned* bar, volatile LAS unsigned* st) {
    XcdBarrier b; b.bar = bar; b.x = xb_xcc_id(); b.st = st;
    if (threadIdx.x == 0) (void)xb_add(&bar[XB_XCNT(b.x)], 1u);
    return b;
}
__device__ __forceinline__ void xcd_barrier_complete(unsigned* bar, unsigned x, unsigned& nloc, unsigned& nx) {
    const unsigned G = gridDim.x * gridDim.y * gridDim.z;
    unsigned sum, cnt, mine, sp = 0u;
    for (;;) {
        sum = 0u; cnt = 0u; mine = 0u;
#pragma unroll
        for (unsigned j = 0; j < 16; ++j) { const unsigned c = xb_ld(&bar[XB_XCNT(j)]); sum += c; cnt += (c > 0u) ? 1u : 0u; mine = (j == x) ? c : mine; }
        if (sum == G) break;
        __builtin_amdgcn_s_sleep(1);
        if ((++sp & 255u) == 0u) { if (xb_ld(&bar[XB_TMO])) break; if (sp > XB_SPIN_CAP) { atomicAdd(&bar[XB_TMO], 1u); break; } }
    }
    nloc = mine > 0u ? mine : 1u; nx = cnt > 0u ? cnt : 1u;
}

__device__ __forceinline__ void xcd_barrier(const XcdBarrier& b) {
    asm volatile("s_waitcnt vmcnt(0)" ::: "memory");
    __syncthreads();
    if (threadIdx.x == 0) {
        unsigned* bar = b.bar;
        __builtin_amdgcn_s_waitcnt(0);
        unsigned nloc = b.st[0], nx = b.st[1];
        if (nloc == 0u) { xcd_barrier_complete(bar, b.x, nloc, nx); b.st[0] = nloc; b.st[1] = nx; }
        const unsigned old = xb_add(&bar[XB_XSUB(b.x)], 1u);
        const unsigned gen = old / nloc;
        if (old + 1u == (gen + 1u) * nloc) {
            __builtin_amdgcn_fence(__ATOMIC_RELEASE, "agent");
            asm volatile("s_waitcnt vmcnt(0)" ::: "memory");
            const unsigned og = xb_add(&bar[XB_TOP], 1u);
            const unsigned tg = og / nx;
            if (og + 1u == (tg + 1u) * nx) xb_add(&bar[XB_TOPGEN], 1u);
            else XB_SPIN(xb_ld(&bar[XB_TOPGEN]) == tg, bar);
            __builtin_amdgcn_fence(__ATOMIC_ACQUIRE, "agent");
            xb_add(&bar[XB_XGEN(b.x)], 1u);
            asm volatile("s_waitcnt vmcnt(0)" ::: "memory");
        } else {
            XB_SPIN(xb_ld(&bar[XB_XGEN(b.x)]) == gen, bar);
            __builtin_amdgcn_fence(__ATOMIC_ACQUIRE, "agent");
            asm volatile("s_waitcnt vmcnt(0)" ::: "memory");
        }
    }
    __syncthreads();
}

struct Params { const float* in[16]; float* out; unsigned char* ws; int ph_lo, ph_hi; };

template <int ph>
__device__ __forceinline__ void run_phase(const Params& P, LAS unsigned char* lds) {
    const int G = gridDim.x, bid = blockIdx.x;
    unsigned char* ws = P.ws;
    const float* x = P.in[0];
    float* out = P.out;
    bf16_t* HB = (bf16_t*)(ws + WS_HB); bf16_t* H1B = (bf16_t*)(ws + WS_H1B); bf16_t* Ub = (bf16_t*)(ws + WS_U); bf16_t* VT = (bf16_t*)(ws + WS_VT); bf16_t* Yb = (bf16_t*)(ws + WS_Y);
    bf16_t* C2 = (bf16_t*)(ws + WS_C2); bf16_t* EB = (bf16_t*)(ws + WS_EB);
    float* ssA = (float*)(ws + WS_SSA); float* ssB = (float*)(ws + WS_SSB); float* ssC = (float*)(ws + WS_SSC);
    int tid = threadIdx.x; asm volatile("" : "+v"(tid));
    const int lane = tid & 63, wave = __builtin_amdgcn_readfirstlane(tid >> 6);
    const int gw = bid * 8 + wave, NGW = G * 8;
    if constexpr (ph == 0) {
        LAS float* scr = (LAS float*)(lds + wave * 16384);
        for (int it = gw; it < 2 * 3072; it += NGW) {
            const int l = it / 3072; int r = it - l * 3072;
            unsigned char* wb = ws + (size_t)l * W_LAYER;
            if (r < 1792) { tr_item<true>(P.in[3] + (size_t)l * DM * DIN, DM, DIN, (bf16_t*)(wb + W_IN), P.in[2] + l * DM, scr, r, lane); continue; } r -= 1792;
            if (r < 128) { tr_item<false>(P.in[9] + (size_t)l * CD * CD, CD, CD, (bf16_t*)(wb + W_PW), nullptr, scr, r, lane); continue; } r -= 128;
            if (r < 512) { tr_item<false>(P.in[11] + (size_t)l * DM * DM, DM, DM, (bf16_t*)(wb + W_OUT), nullptr, scr, r, lane, 512); continue; } r -= 512;
            if (r < 512) { tr_item<false>(P.in[13] + (size_t)l * DM * DM, DM, DM, (bf16_t*)(wb + W_PG), P.in[12] + l * DM, scr, r, lane); continue; } r -= 512;
            tr_item<false>(P.in[14] + (size_t)l * PLE * DM, PLE, DM, (bf16_t*)(wb + W_PLE), nullptr, scr, r, lane);
        }
        for (int row = gw; row < MT; row += 2 * NGW) {
            const int row2 = row + NGW;
            const f32x4* xr = (const f32x4*)(x + (size_t)row * DM) + lane;
            const f32x4* xr2 = (const f32x4*)(x + (size_t)(row2 < MT ? row2 : row) * DM) + lane;
            f32x4 va[4], vb[4];
#pragma unroll
            for (int j = 0; j < 4; ++j) { va[j] = xr[64 * j]; vb[j] = xr2[64 * j]; }
            u32x2* ob = (u32x2*)(HB + (size_t)row * DM) + lane;
            float s = 0.f, s2 = 0.f;
#pragma unroll
            for (int j = 0; j < 4; ++j) { const f32x4 v = va[j]; s += (v[0] * v[0] + v[1] * v[1]) + (v[2] * v[2] + v[3] * v[3]); u32x2 w; w[0] = pk2(v[0], v[1]); w[1] = pk2(v[2], v[3]); ob[64 * j] = w; }
            s = wave_sum(s, lane);
            if (lane < 16) ssA[(size_t)row * 16 + lane] = (lane == 0) ? s : 0.f;
            if (row2 < MT) {
                u32x2* ob2 = (u32x2*)(HB + (size_t)row2 * DM) + lane;
#pragma unroll
                for (int j = 0; j < 4; ++j) { const f32x4 v = vb[j]; s2 += (v[0] * v[0] + v[1] * v[1]) + (v[2] * v[2] + v[3] * v[3]); u32x2 w; w[0] = pk2(v[0], v[1]); w[1] = pk2(v[2], v[3]); ob2[64 * j] = w; }
                s2 = wave_sum(s2, lane);
                if (lane < 16) ssA[(size_t)row2 * 16 + lane] = (lane == 0) ? s2 : 0.f;
            }
        }
        {
            const f32x4* pp = (const f32x4*)P.in[1]; u32x2* pb = (u32x2*)(ws + WS_PB);
            const int NV = 2 * MT * PLE / 4, stp = G * 512;
            for (int i = bid * 512 + tid; i < NV; i += 4 * stp) {
                f32x4 v[4];
#pragma unroll
                for (int j = 0; j < 4; ++j) { const int ii = i + j * stp; v[j] = pp[ii < NV ? ii : i]; }
#pragma unroll
                for (int j = 0; j < 4; ++j) { const int ii = i + j * stp; if (ii < NV) { u32x2 w; w[0] = pk2(v[j][0], v[j][1]); w[1] = pk2(v[j][2], v[j][3]); pb[ii] = w; } }
            }
        }
    } else if constexpr (ph == NPHASE - 1) {
        const float* fg = P.in[15];
        for (int row = gw; row < MT; row += 2 * NGW) {
            const int row2 = row + NGW; const bool has2 = row2 < MT; const int r2 = has2 ? row2 : row;
            const u32x4* hr = (const u32x4*)(HB + (size_t)row * DM) + lane; const u32x4* hr2 = (const u32x4*)(HB + (size_t)r2 * DM) + lane;
            const u32x4 a0 = hr[0], a1 = hr[64], b0 = hr2[0], b1 = hr2[64];
            const float p1 = (lane < 16) ? ssA[(size_t)row * 16 + lane] : 0.f, p2 = (lane < 16) ? ssA[(size_t)r2 * 16 + lane] : 0.f;
            const f32x4 g0 = *(const f32x4*)(fg + 8 * lane), g1 = *(const f32x4*)(fg + 8 * lane + 4), g2 = *(const f32x4*)(fg + 512 + 8 * lane), g3 = *(const f32x4*)(fg + 512 + 8 * lane + 4);
            const float rs = frsq(wave_sum(p1, lane) * (1.0f / DM) + EPS), rs2 = frsq(wave_sum(p2, lane) * (1.0f / DM) + EPS);
            float* o = out + (size_t)row * DM + 8 * lane;
            { f32x4 t0 = {bflo(a0[0]), bfhi(a0[0]), bflo(a0[1]), bfhi(a0[1])}, t1 = {bflo(a0[2]), bfhi(a0[2]), bflo(a0[3]), bfhi(a0[3])}, t2 = {bflo(a1[0]), bfhi(a1[0]), bflo(a1[1]), bfhi(a1[1])}, t3 = {bflo(a1[2]), bfhi(a1[2]), bflo(a1[3]), bfhi(a1[3])};
              *(f32x4*)o = t0 * rs * g0; *(f32x4*)(o + 4) = t1 * rs * g1; *(f32x4*)(o + 512) = t2 * rs * g2; *(f32x4*)(o + 516) = t3 * rs * g3; }
            if (has2) {
                float* o2 = out + (size_t)row2 * DM + 8 * lane;
                f32x4 t0 = {bflo(b0[0]), bfhi(b0[0]), bflo(b0[1]), bfhi(b0[1])}, t1 = {bflo(b0[2]), bfhi(b0[2]), bflo(b0[3]), bfhi(b0[3])}, t2 = {bflo(b1[0]), bfhi(b1[0]), bflo(b1[1]), bfhi(b1[1])}, t3 = {bflo(b1[2]), bfhi(b1[2]), bflo(b1[3]), bfhi(b1[3])};
                *(f32x4*)o2 = t0 * rs2 * g0; *(f32x4*)(o2 + 4) = t1 * rs2 * g1; *(f32x4*)(o2 + 512) = t2 * rs2 * g2; *(f32x4*)(o2 + 516) = t3 * rs2 * g3;
            }
        }
    } else {
        constexpr int l = (ph - 1) / 5, k = (ph - 1) % 5;
        unsigned char* wb = ws + (size_t)l * W_LAYER;
        if constexpr (k == 0) {
            pg8::Gemm g{HB, (const bf16_t*)(wb + W_IN), MT, DIN - CD, DM}; pg8::StaticOrder S; S.init(MT, DIN - CD, G, bid);
            EpiIn E{Ub, VT, ssA, 0};
            pg8::gemm_phase<EpiIn, pg8::StaticOrder, true, true>(lds, g, S, E, threadIdx.x);
        } else if constexpr (k == 1) {
            const float* aog = P.in[4] + l * HD;
            const float* dww = P.in[5] + (size_t)l * CWID * CD; const float* dwb = P.in[6] + l * CD;
            const float* lng = P.in[7] + l * CD; const float* lnb = P.in[8] + l * CD;
            const int nb0 = G / 2; const bool gcu = bid < nb0;
            {
                pg8::Gemm g{HB, (const bf16_t*)(wb + W_IN) + (size_t)(DIN - CD) * DM, MT, CD, DM}; SubOrder S; S.init(MT, CD, nb0, bid);
                EpiIn E{Ub, VT, ssA, 12};
                pg8::gemm_phase<EpiIn, SubOrder, true, true>(lds, g, S, E, threadIdx.x);
            }
            __syncthreads();
            constexpr int NITEM = NB * NH * (SEQ / 32);
            const int n0 = (NITEM / 2) / nb0, n1 = (NITEM - n0 * nb0) / (G - nb0);
            const int i_lo = gcu ? bid * n0 : n0 * nb0 + (bid - nb0) * n1;
            const int i_hi = gcu ? i_lo + n0 : ((bid == G - 1) ? NITEM : i_lo + n1);
#pragma unroll 1
            for (int rep_ = 0; rep_ < ((PROBE_DUP & 2) ? 2 : 1); ++rep_) {
#pragma unroll 1
                for (int item = i_lo + wave; item < i_hi; item += 8) {
                    const int bh = item >> 6, qblk = item & 63;
                    attn_wave(Ub, VT, Yb, aog, bh >> 3, bh & 7, qblk, lds);
                }
            }
            __syncthreads();
            if (!gcu) {
#pragma unroll 1
                for (int rep_ = 0; rep_ < ((PROBE_DUP & 4) ? 2 : 1); ++rep_) convpre_units(Ub, C2, dww, dwb, lng, lnb, bid - nb0, G - nb0, MT / CT, lds);
            }
            __syncthreads();
        } else if constexpr (k == 2) {
            const int nb0 = G / 2;
            {
                pg8::Gemm g{C2, (const bf16_t*)(wb + W_PW), MT, CD, CD}; SubOrder S; S.init(MT, CD, nb0, bid);
                EpiPw E{Ub, Yb, P.in[10] + l * CD, ssC};
                pg8::gemm_phase<EpiPw, SubOrder, true, true>(lds, g, S, E, threadIdx.x);
            }
            {
                pg8::Gemm g{(const bf16_t*)(ws + WS_PB) + (size_t)l * MT * PLE, (const bf16_t*)(wb + W_PLE), MT, DM, PLE}; SubOrder S; S.init(MT, DM, G - nb0, bid - nb0);
                EpiE E{EB};
                int t2 = threadIdx.x; asm volatile("" : "+v"(t2));
                pg8::gemm_phase<EpiE, SubOrder, true, true>(lds, g, S, E, t2);
            }
        } else if constexpr (k == 3) {
            pg8::Gemm g{Yb, (const bf16_t*)(wb + W_OUT), MT, DM, DM}; pg8::StaticOrder S; S.init(MT, DM, G, bid);
            EpiOut<(l > 0)> E{x, HB, H1B, ssB, ssC};
            pg8::gemm_phase<EpiOut<(l > 0)>, pg8::StaticOrder, true, true>(lds, g, S, E, threadIdx.x);
        } else {
            pg8::Gemm g{H1B, (const bf16_t*)(wb + W_PG), MT, DM, DM}; pg8::StaticOrder S; S.init(MT, DM, G, bid);
            EpiGate<false> E{out, H1B, EB, HB, ssB, ssA, 0};
            pg8::gemm_phase<EpiGate<false>, pg8::StaticOrder, true, true>(lds, g, S, E, threadIdx.x);
            if constexpr ((PROBE_DUP & 128) != 0) { int t3 = threadIdx.x; asm volatile("" : "+v"(t3)); pg8::gemm_phase<EpiGate<false>, pg8::StaticOrder, true, true>(lds, g, S, E, t3); }
        }
    }
}

__global__ void __launch_bounds__(512, 2) fwd(Params P) {
    extern __shared__ __attribute__((aligned(16))) unsigned char lds_raw[];
    LAS unsigned char* lds = (LAS unsigned char*)lds_raw;
    const int lo = P.ph_lo, hi = P.ph_hi;
    volatile LAS unsigned* st = (volatile LAS unsigned*)(lds + LDS_BYTES - 64);
    if (threadIdx.x < 16) st[threadIdx.x] = 0u;
    __syncthreads();
    const XcdBarrier bar = xcd_barrier_post((unsigned*)(P.ws + WS_CTL), st);
#define PROBE_PH(k) ((((PROBE_DUP) & 8) && (k) == 0) || (((PROBE_DUP) & 1) && (k) == 1) || (((PROBE_DUP) & 32) && ((k) == 3 || (k) == 8)) || (((PROBE_DUP) & 16) && (k) == 4))
#define SEAM() do { if (hi > NPHASE) cg::this_grid().sync(); else xcd_barrier(bar); } while (0)
#define PHASE(k) if (lo <= (k) && (k) < hi) { run_phase<(k)>(P, lds); if constexpr (PROBE_PH(k)) { __syncthreads(); run_phase<(k)>(P, lds); } \
        if constexpr (((PROBE_DUP) & 64) != 0) { SEAM(); } if ((k) + 1 < hi) SEAM(); }
    PHASE(0) PHASE(1) PHASE(2) PHASE(3) PHASE(4) PHASE(5) PHASE(6) PHASE(7) PHASE(8) PHASE(9) PHASE(10) PHASE(11)
    if constexpr (((PROBE_DUP) & 256) != 0) { SEAM(); PHASE(0) PHASE(1) PHASE(2) PHASE(3) PHASE(4) PHASE(5) PHASE(6) PHASE(7) PHASE(8) PHASE(9) PHASE(10) PHASE(11) }
#undef PHASE
#undef SEAM
}

#ifndef MK_N_LAUNCHES
#define MK_N_LAUNCHES 1
#endif
extern "C" void kernel_launch(void* const* d_in, const int* in_sizes, int n_in, void* d_out, int out_size, void* d_ws, size_t ws_size, hipStream_t stream) {
    static int grid = 0;
    if (grid == 0) {
        if (n_in != 16 || out_size != MT * DM || ws_size < WS_END) { fprintf(stderr, "kernel_launch: unexpected shapes (n_in %d, out %d, ws %zu)\n", n_in, out_size, ws_size); grid = -1; return; }
        int dev = 0, cus = 0, per_cu = 0;
        (void)hipGetDevice(&dev);
        (void)hipDeviceGetAttribute(&cus, hipDeviceAttributeMultiprocessorCount, dev);
        if (hipFuncSetAttribute((const void*)fwd, hipFuncAttributeMaxDynamicSharedMemorySize, LDS_BYTES) != hipSuccess) { fprintf(stderr, "kernel_launch: hipFuncSetAttribute failed\n"); grid = -1; return; }
        if (hipOccupancyMaxActiveBlocksPerMultiprocessor(&per_cu, (const void*)fwd, 512, LDS_BYTES) != hipSuccess || per_cu < 1) { fprintf(stderr, "kernel_launch: occupancy query says %d\n", per_cu); per_cu = 1; }
        (void)hipGetLastError();
        grid = cus * 1;
        if (grid <= 0) grid = 256;
    }
    if (grid < 0) return;
    if (hipMemsetAsync((unsigned char*)d_ws + WS_CTL, 0, CTL_BYTES, stream) != hipSuccess) { fprintf(stderr, "kernel_launch: memset of barrier words failed\n"); return; }
    Params p{};
    for (int i = 0; i < 16; ++i) p.in[i] = (const float*)d_in[i];
    p.out = (float*)d_out; p.ws = (unsigned char*)d_ws;
#if MK_N_LAUNCHES == 1
    p.ph_lo = 0; p.ph_hi = NPHASE;
    void* args[] = {&p};
    hipError_t e = hipLaunchCooperativeKernel((const void*)fwd, dim3(grid), dim3(512), args, LDS_BYTES, stream);
    if (e != hipSuccess) fprintf(stderr, "kernel_launch: cooperative launch failed: %s (grid %d)\n", hipGetErrorString(e), grid);
#else
    for (int ph = 0; ph < NPHASE; ++ph) {
        p.ph_lo = ph; p.ph_hi = ph + 1;
        hipLaunchKernelGGL(fwd, dim3(grid), dim3(512), LDS_BYTES, stream, p);
    }
#endif
}
```
